# Optimizing an MI355X kernel written in HIP

```python
import math
import jax
import jax.numpy as jnp
from jax import lax
import numpy as np

D_MODEL = 2048
BATCH = 1
SEQ = 8192
DEPTH = 4

N_MEM = 256
Q_BLOCK = 128
RMS_EPS = 1e-6
NEG_INF = -1e30
MAX_POS_OFFSET = 1024

S5_WIDTH = 1024
S5_GROUP = 16
S5_GROUPS = S5_WIDTH // S5_GROUP
S5_STATE = 64
S5_DT_MIN = 1e-3
S5_DT_MAX = 1e-1

FOX_HEADS = 8
FOX_HEAD_DIM = 128
FOX_WIDTH = FOX_HEADS * FOX_HEAD_DIM
FOX_FORGET_BIAS = 2.0

MEM_HEADS = 4
MEM_HEAD_DIM = 128
MEM_WIDTH = MEM_HEADS * MEM_HEAD_DIM

MLA_HEADS = 8
MLA_Q_RANK = 512
MLA_KV_RANK = 512
MLA_NOPE = 128
MLA_ROPE = 64
MLA_V = 128
MLA_WIDTH = MLA_HEADS * MLA_V
ROPE_THETA = 10000.0

NSA_HEADS = 8
NSA_KV_GROUPS = 2
NSA_HEAD_DIM = 128
NSA_WIDTH = NSA_HEADS * NSA_HEAD_DIM
NSA_KV = NSA_KV_GROUPS * NSA_HEAD_DIM
NSA_CMP_LEN = 32
NSA_CMP_STRIDE = 16
NSA_CMP_HIDDEN = 256
NSA_SLC_BLOCK = 64
NSA_SLC_TOPK = 16
NSA_WINDOW = 512
FORCE_SCORE = 1e6

T5_BUCKETS = 32
T5_MAX_DIST = 1024

N_EVEN = (DEPTH + 1) // 2
N_ODD = DEPTH // 2
EVEN_SPLITS = (S5_WIDTH, S5_WIDTH, FOX_WIDTH, FOX_WIDTH, FOX_WIDTH, FOX_HEADS, FOX_WIDTH, MEM_WIDTH, MEM_WIDTH)
ODD_SPLITS = (MLA_Q_RANK, MLA_KV_RANK, MLA_ROPE, MLA_WIDTH, NSA_WIDTH, NSA_KV, NSA_KV, NSA_KV, NSA_KV, NSA_KV, NSA_KV, 3 * NSA_HEADS, NSA_WIDTH, MEM_WIDTH, MEM_WIDTH)
EVEN_IN = sum(EVEN_SPLITS)
ODD_IN = sum(ODD_SPLITS)
MIX_WIDTH = S5_WIDTH + FOX_WIDTH + MEM_WIDTH

kernel_name = 'hybrid_s5_fox_mla_nsa_trunk'


def rms_norm(x, g):
    xf = x.astype(jnp.float32)
    y = xf * lax.rsqrt(jnp.mean(xf * xf, axis=-1, keepdims=True) + RMS_EPS)
    return (y * g.astype(jnp.float32)).astype(x.dtype)


def split_cols(h, sizes):
    return jnp.split(h, np.cumsum(sizes)[:-1].tolist(), axis=-1)


def rope(x, positions):
    half = x.shape[-1] // 2
    inv_freq = ROPE_THETA ** (-jnp.arange(half, dtype=jnp.float32) / half)
    ang = positions.astype(jnp.float32)[..., None] * inv_freq
    cos = jnp.cos(ang)[:, :, None, :]
    sin = jnp.sin(ang)[:, :, None, :]
    x1 = x[..., :half].astype(jnp.float32)
    x2 = x[..., half:].astype(jnp.float32)
    return jnp.concatenate([x1 * cos - x2 * sin, x1 * sin + x2 * cos], axis=-1).astype(x.dtype)


def t5_bucket(dist):
    n = jnp.maximum(dist, 0)
    max_exact = T5_BUCKETS // 2
    log_ratio = jnp.log(jnp.maximum(n, 1).astype(jnp.float32) / max_exact) / math.log(T5_MAX_DIST / max_exact)
    large = jnp.minimum(max_exact + (log_ratio * (T5_BUCKETS - max_exact)).astype(jnp.int32), T5_BUCKETS - 1)
    return jnp.where(n < max_exact, n, large)


def causal_block_attention(q, k, v, scale, log_decay=None):
    B_, L, H, _ = q.shape
    nblk = L // Q_BLOCK
    k_idx = jnp.arange(L)
    qb = q.reshape(B_, nblk, Q_BLOCK, H, -1).swapaxes(0, 1)
    cb = None if log_decay is None else log_decay.reshape(B_, nblk, Q_BLOCK, H).swapaxes(0, 1)
    ck = None if log_decay is None else log_decay.transpose(0, 2, 1)[:, :, None, :]

    def one_block(args):
        qi, ci, blk = args
        s = jnp.einsum('bqhd,bkhd->bhqk', qi, k, preferred_element_type=jnp.float32) * scale
        if ci is not None:
            s = s + ci.transpose(0, 2, 1)[..., None] - ck
        t = blk * Q_BLOCK + jnp.arange(Q_BLOCK)
        s = jnp.where(k_idx[None, :] <= t[:, None], s, NEG_INF)
        p = jax.nn.softmax(s, axis=-1)
        return jnp.einsum('bhqk,bkhd->bqhd', p.astype(v.dtype), v)

    o = lax.map(one_block, (qb, cb, jnp.arange(nblk)))
    return o.swapaxes(0, 1).reshape(B_, L, H, v.shape[-1])


def memory_attention(q, mem_kv):
    B_, L, _ = q.shape
    M = mem_kv.shape[1]
    qh = q.reshape(B_, L, MEM_HEADS, MEM_HEAD_DIM)
    km, vm = jnp.split(mem_kv, 2, axis=-1)
    km = km.reshape(B_, M, MEM_HEADS, MEM_HEAD_DIM)
    vm = vm.reshape(B_, M, MEM_HEADS, MEM_HEAD_DIM)
    s = jnp.einsum('blhd,bmhd->bhlm', qh, km, preferred_element_type=jnp.float32) * MEM_HEAD_DIM ** -0.5
    p = jax.nn.softmax(s, axis=-1)
    return jnp.einsum('bhlm,bmhd->blhd', p.astype(vm.dtype), vm).reshape(B_, L, MEM_WIDTH)


def s5_mixer(u, lam_re, lam_im, log_dt, b_re, b_im, c_re, c_im, d_skip, w_glu):
    f32 = jnp.float32
    B_, L, _ = u.shape
    uf = u.astype(f32).reshape(B_, L, S5_GROUPS, S5_GROUP)
    dt = jnp.exp(log_dt.astype(f32))[:, None]
    lr = lam_re.astype(f32)
    li = lam_im.astype(f32)
    mag = jnp.exp(lr * dt)
    ab_re = mag * jnp.cos(li * dt)
    ab_im = mag * jnp.sin(li * dt)
    den = lr * lr + li * li
    nr = ab_re - 1.0
    f_re = (nr * lr + ab_im * li) / den
    f_im = (ab_im * lr - nr * li) / den
    br = b_re.astype(f32)
    bim = b_im.astype(f32)
    bb_re = f_re[..., None] * br - f_im[..., None] * bim
    bb_im = f_re[..., None] * bim + f_im[..., None] * br
    bu_re = jnp.einsum('gpc,blgc->blgp', bb_re, uf)
    bu_im = jnp.einsum('gpc,blgc->blgp', bb_im, uf)
    a_re = jnp.broadcast_to(ab_re, bu_re.shape)
    a_im = jnp.broadcast_to(ab_im, bu_im.shape)

    def combine(e1, e2):
        a1r, a1i, b1r, b1i = e1
        a2r, a2i, b2r, b2i = e2
        return (a2r * a1r - a2i * a1i, a2r * a1i + a2i * a1r,
                a2r * b1r - a2i * b1i + b2r, a2r * b1i + a2i * b1r + b2i)

    _, _, xr, xi = lax.associative_scan(combine, (a_re, a_im, bu_re, bu_im), axis=1)
    y = (jnp.einsum('gcp,blgp->blgc', c_re.astype(f32), xr)
         - jnp.einsum('gcp,blgp->blgc', c_im.astype(f32), xi)
         + d_skip.astype(f32) * uf).reshape(B_, L, S5_WIDTH)
    z = jax.nn.gelu(y)
    z = z * jax.nn.sigmoid(z @ w_glu.astype(f32))
    return z.astype(u.dtype)


def mla_attention(c_q, c_kv, k_rope, positions, g_cq, g_ckv, w_uq, w_ukv):
    B_, L, _ = c_q.shape
    q = (rms_norm(c_q, g_cq) @ w_uq).reshape(B_, L, MLA_HEADS, MLA_NOPE + MLA_ROPE)
    q = jnp.concatenate([q[..., :MLA_NOPE], rope(q[..., MLA_NOPE:], positions)], axis=-1)
    kv = (rms_norm(c_kv, g_ckv) @ w_ukv).reshape(B_, L, MLA_HEADS, MLA_NOPE + MLA_V)
    kr = rope(k_rope[:, :, None, :], positions)
    k = jnp.concatenate([kv[..., :MLA_NOPE], jnp.broadcast_to(kr, (B_, L, MLA_HEADS, MLA_ROPE))], axis=-1)
    v = kv[..., MLA_NOPE:]
    o = causal_block_attention(q, k, v, (MLA_NOPE + MLA_ROPE) ** -0.5)
    return o.reshape(B_, L, MLA_WIDTH)


def nsa_attention(q, k_cmp, v_cmp, k_slc, v_slc, k_win, v_win, gate_logits, positions, t5_table, cmp_pe, cmp_w1, cmp_w2):
    f32 = jnp.float32
    B_, L, _ = q.shape
    G = NSA_KV_GROUPS
    R = NSA_HEADS // NSA_KV_GROUPS
    dh = NSA_HEAD_DIM
    scale = dh ** -0.5
    nblk = L // Q_BLOCK
    qh = q.reshape(B_, L, G, R, dh)
    k_cmp, v_cmp, k_slc, v_slc, k_win, v_win = [t.reshape(B_, L, G, dh) for t in (k_cmp, v_cmp, k_slc, v_slc, k_win, v_win)]
    gates = jax.nn.sigmoid(gate_logits.astype(f32)).reshape(B_, L, G, R, 3)

    n_cmp = (L - NSA_CMP_LEN) // NSA_CMP_STRIDE + 1
    cmp_idx = np.arange(n_cmp)[:, None] * NSA_CMP_STRIDE + np.arange(NSA_CMP_LEN)[None, :]

    def compress(t, pe, w1, w2):
        blocks = t[:, cmp_idx] + pe[None, None, :, None, :]
        blocks = blocks.transpose(0, 1, 3, 2, 4).reshape(B_, n_cmp, G, NSA_CMP_LEN * dh)
        return jax.nn.gelu(blocks @ w1) @ w2

    kc = compress(k_cmp, cmp_pe[0], cmp_w1[0], cmp_w2[0])
    vc = compress(v_cmp, cmp_pe[1], cmp_w1[1], cmp_w2[1])
    cmp_end = cmp_idx[:, -1]
    cmp_end_j = jnp.asarray(cmp_end)
    pos_cmp = positions[:, cmp_end]

    n_slc = L // NSA_SLC_BLOCK
    n_top = min(NSA_SLC_TOPK, n_slc)
    cs = np.arange(n_cmp) * NSA_CMP_STRIDE
    ss = np.arange(n_slc) * NSA_SLC_BLOCK
    ov = np.clip(np.minimum(cs[:, None] + NSA_CMP_LEN, ss[None, :] + NSA_SLC_BLOCK) - np.maximum(cs[:, None], ss[None, :]), 0, None) / NSA_CMP_LEN
    overlap = jnp.asarray(ov, jnp.float32)
    k_slc_g = k_slc.transpose(0, 2, 1, 3)
    v_slc_g = v_slc.transpose(0, 2, 1, 3)

    k_win_p = jnp.pad(k_win, ((0, 0), (NSA_WINDOW, 0), (0, 0), (0, 0)))
    v_win_p = jnp.pad(v_win, ((0, 0), (NSA_WINDOW, 0), (0, 0), (0, 0)))
    pos_p = jnp.pad(positions, ((0, 0), (NSA_WINDOW, 0)))

    table_gr = t5_table.reshape(T5_BUCKETS, G, R)
    bi = jnp.arange(B_)[:, None, None, None]
    gi = jnp.arange(G)[None, :, None, None]

    def head_bias(dist):
        return table_gr[t5_bucket(dist)].transpose(0, 3, 4, 1, 2).astype(f32)

    def one_block(args):
        qi, gq, pos_q, blk = args
        t = blk * Q_BLOCK + jnp.arange(Q_BLOCK)
        s = jnp.einsum('bqgrd,bngd->bgrqn', qi, kc, preferred_element_type=f32) * scale
        s = s + head_bias(pos_q[:, :, None] - pos_cmp[:, None, :])
        valid = cmp_end_j[None, :] <= t[:, None]
        p_c = jnp.where(valid, jax.nn.softmax(jnp.where(valid, s, NEG_INF), axis=-1), 0.0)
        o_c = jnp.einsum('bgrqn,bngd->bqgrd', p_c.astype(vc.dtype), vc)
        imp = jnp.einsum('bgrqn,nj->bgqj', p_c, overlap)
        j = jnp.arange(n_slc)
        cur = (t // NSA_SLC_BLOCK)[:, None]
        forced = (j == 0) | (j == cur) | (j == cur - 1)
        score = jnp.where(forced, FORCE_SCORE, jnp.where(j > cur, -1.0, imp))
        _, sel = lax.top_k(score, n_top)
        tok = (sel[..., None] * NSA_SLC_BLOCK + jnp.arange(NSA_SLC_BLOCK)).reshape(B_, G, Q_BLOCK, n_top * NSA_SLC_BLOCK)
        ks = k_slc_g[bi, gi, tok]
        vs = v_slc_g[bi, gi, tok]
        s = jnp.einsum('bqgrd,bgqsd->bgrqs', qi, ks, preferred_element_type=f32) * scale
        dist = pos_q[:, None, :, None] - positions[bi, tok]
        s = s + table_gr[t5_bucket(dist), gi].transpose(0, 1, 4, 2, 3).astype(f32)
        smask = (tok <= t[None, None, :, None])[:, :, None]
        p_s = jax.nn.softmax(jnp.where(smask, s, NEG_INF), axis=-1)
        o_s = jnp.einsum('bgrqs,bgqsd->bqgrd', p_s.astype(vs.dtype), vs)
        kw = lax.dynamic_slice_in_dim(k_win_p, blk * Q_BLOCK, Q_BLOCK + NSA_WINDOW, axis=1)
        vw = lax.dynamic_slice_in_dim(v_win_p, blk * Q_BLOCK, Q_BLOCK + NSA_WINDOW, axis=1)
        pk = lax.dynamic_slice_in_dim(pos_p, blk * Q_BLOCK, Q_BLOCK + NSA_WINDOW, axis=1)
        kidx = blk * Q_BLOCK - NSA_WINDOW + jnp.arange(Q_BLOCK + NSA_WINDOW)
        band = (kidx[None, :] >= 0) & (kidx[None, :] <= t[:, None]) & (t[:, None] - kidx[None, :] < NSA_WINDOW)
        s = jnp.einsum('bqgrd,bkgd->bgrqk', qi, kw, preferred_element_type=f32) * scale
        s = s + head_bias(pos_q[:, :, None] - pk[:, None, :])
        p_w = jax.nn.softmax(jnp.where(band, s, NEG_INF), axis=-1)
        o_w = jnp.einsum('bgrqk,bkgd->bqgrd', p_w.astype(vw.dtype), vw)
        o = gq[..., 0:1] * o_c + gq[..., 1:2] * o_s + gq[..., 2:3] * o_w
        return o.astype(qi.dtype)

    qb = qh.reshape(B_, nblk, Q_BLOCK, G, R, dh).swapaxes(0, 1)
    gb = gates.reshape(B_, nblk, Q_BLOCK, G, R, 3).swapaxes(0, 1)
    pb = positions.reshape(B_, nblk, Q_BLOCK).swapaxes(0, 1)
    o = lax.map(one_block, (qb, gb, pb, jnp.arange(nblk)))
    return o.swapaxes(0, 1).reshape(B_, L, NSA_WIDTH)


def even_layer(xn, mem_kv, w_in, lam_re, lam_im, log_dt, b_re, b_im, c_re, c_im, d_skip, w_glu, b_f):
    B_, L, _ = xn.shape
    u, g_s5, q, k, v, f_logit, g_fox, q_mem, g_mem = split_cols(xn @ w_in, EVEN_SPLITS)
    y_s5 = s5_mixer(u, lam_re, lam_im, log_dt, b_re, b_im, c_re, c_im, d_skip, w_glu) * jax.nn.silu(g_s5)
    log_f = jax.nn.log_sigmoid((f_logit + b_f).astype(jnp.float32))
    cum = jnp.cumsum(log_f, axis=1)
    heads = lambda t: t.reshape(B_, L, FOX_HEADS, FOX_HEAD_DIM)
    y_fox = causal_block_attention(heads(q), heads(k), heads(v), FOX_HEAD_DIM ** -0.5, cum).reshape(B_, L, FOX_WIDTH)
    y_fox = y_fox * jax.nn.silu(g_fox)
    y_mem = memory_attention(q_mem, mem_kv) * jax.nn.silu(g_mem)
    return jnp.concatenate([y_s5, y_fox.astype(y_s5.dtype), y_mem], axis=-1)


def odd_layer(xn, mem_kv, positions, t5_table, w_in, g_cq, g_ckv, w_uq, w_ukv, cmp_pe, cmp_w1, cmp_w2):
    (c_q, c_kv, k_rope, g_mla, q_nsa, k_cmp, v_cmp, k_slc, v_slc, k_win, v_win,
     nsa_gates, g_nsa, q_mem, g_mem) = split_cols(xn @ w_in, ODD_SPLITS)
    y_mla = mla_attention(c_q, c_kv, k_rope, positions, g_cq, g_ckv, w_uq, w_ukv) * jax.nn.silu(g_mla)
    y_nsa = nsa_attention(q_nsa, k_cmp, v_cmp, k_slc, v_slc, k_win, v_win, nsa_gates, positions, t5_table,
                          cmp_pe, cmp_w1, cmp_w2) * jax.nn.silu(g_nsa)
    y_mem = memory_attention(q_mem, mem_kv) * jax.nn.silu(g_mem)
    return jnp.concatenate([y_mla, y_nsa, y_mem], axis=-1)


def setup_inputs(seed: int = 0) -> dict:
    key = jax.random.key(seed)
    ks = jax.random.split(key, 32)
    f32 = jnp.float32

    def nrm(k, shape, scale):
        return scale * jax.random.normal(k, shape, f32)

    x = nrm(ks[0], (BATCH, SEQ, D_MODEL), 1.0)
    mem = nrm(ks[1], (BATCH, N_MEM, D_MODEL), 1.0)
    positions = jax.random.randint(ks[2], (BATCH, 1), 0, MAX_POS_OFFSET, jnp.int32) + jnp.arange(SEQ, dtype=jnp.int32)[None, :]
    norm_g = 1.0 + nrm(ks[3], (DEPTH, D_MODEL), 0.02)
    mem_norm_g = 1.0 + nrm(ks[4], (D_MODEL,), 0.02)
    final_norm_g = 1.0 + nrm(ks[5], (D_MODEL,), 0.02)
    t5_table = nrm(ks[6], (T5_BUCKETS, NSA_HEADS), 0.5)
    w_out = nrm(ks[7], (DEPTH, MIX_WIDTH, D_MODEL), MIX_WIDTH ** -0.5)
    mem_w_kv = nrm(ks[8], (DEPTH, D_MODEL, 2 * MEM_WIDTH), D_MODEL ** -0.5)
    even_w_in = nrm(ks[9], (N_EVEN, D_MODEL, EVEN_IN), D_MODEL ** -0.5)
    s5_lam_re = -0.5 * jnp.exp(nrm(ks[10], (N_EVEN, S5_GROUPS, S5_STATE), 0.05))
    s5_lam_im = math.pi * jnp.arange(S5_STATE, dtype=f32) + nrm(ks[11], (N_EVEN, S5_GROUPS, S5_STATE), 0.05)
    s5_log_dt = jax.random.uniform(ks[12], (N_EVEN, S5_GROUPS), f32, math.log(S5_DT_MIN), math.log(S5_DT_MAX))
    s5_b_re = nrm(ks[13], (N_EVEN, S5_GROUPS, S5_STATE, S5_GROUP), (2 * S5_GROUP) ** -0.5)
    s5_b_im = nrm(ks[14], (N_EVEN, S5_GROUPS, S5_STATE, S5_GROUP), (2 * S5_GROUP) ** -0.5)
    s5_c_re = nrm(ks[15], (N_EVEN, S5_GROUPS, S5_GROUP, S5_STATE), S5_STATE ** -0.5)
    s5_c_im = nrm(ks[16], (N_EVEN, S5_GROUPS, S5_GROUP, S5_STATE), S5_STATE ** -0.5)
    s5_d = nrm(ks[17], (N_EVEN, S5_GROUPS, S5_GROUP), 1.0)
    s5_w_glu = nrm(ks[18], (N_EVEN, S5_WIDTH, S5_WIDTH), S5_WIDTH ** -0.5)
    fox_b_f = FOX_FORGET_BIAS + nrm(ks[19], (N_EVEN, FOX_HEADS), 0.1)
    odd_w_in = nrm(ks[20], (N_ODD, D_MODEL, ODD_IN), D_MODEL ** -0.5)
    mla_g_cq = 1.0 + nrm(ks[21], (N_ODD, MLA_Q_RANK), 0.02)
    mla_g_ckv = 1.0 + nrm(ks[22], (N_ODD, MLA_KV_RANK), 0.02)
    mla_w_uq = nrm(ks[23], (N_ODD, MLA_Q_RANK, MLA_HEADS * (MLA_NOPE + MLA_ROPE)), MLA_Q_RANK ** -0.5)
    mla_w_ukv = nrm(ks[24], (N_ODD, MLA_KV_RANK, MLA_HEADS * (MLA_NOPE + MLA_V)), MLA_KV_RANK ** -0.5)
    nsa_cmp_pe = nrm(ks[25], (N_ODD, 2, NSA_CMP_LEN, NSA_HEAD_DIM), 0.5)
    nsa_cmp_w1 = nrm(ks[26], (N_ODD, 2, NSA_CMP_LEN * NSA_HEAD_DIM, NSA_CMP_HIDDEN), (NSA_CMP_LEN * NSA_HEAD_DIM) ** -0.5)
    nsa_cmp_w2 = nrm(ks[27], (N_ODD, 2, NSA_CMP_HIDDEN, NSA_HEAD_DIM), NSA_CMP_HIDDEN ** -0.5)
    return {'x': x, 'mem': mem, 'positions': positions, 'norm_g': norm_g, 'mem_norm_g': mem_norm_g,
            'final_norm_g': final_norm_g, 't5_table': t5_table, 'w_out': w_out, 'mem_w_kv': mem_w_kv,
            'even_w_in': even_w_in, 's5_lam_re': s5_lam_re, 's5_lam_im': s5_lam_im, 's5_log_dt': s5_log_dt,
            's5_b_re': s5_b_re, 's5_b_im': s5_b_im, 's5_c_re': s5_c_re, 's5_c_im': s5_c_im, 's5_d': s5_d,
            's5_w_glu': s5_w_glu, 'fox_b_f': fox_b_f, 'odd_w_in': odd_w_in, 'mla_g_cq': mla_g_cq,
            'mla_g_ckv': mla_g_ckv, 'mla_w_uq': mla_w_uq, 'mla_w_ukv': mla_w_ukv, 'nsa_cmp_pe': nsa_cmp_pe,
            'nsa_cmp_w1': nsa_cmp_w1, 'nsa_cmp_w2': nsa_cmp_w2}


def reference(x, mem, positions, norm_g, mem_norm_g, final_norm_g, t5_table, w_out, mem_w_kv,
              even_w_in, s5_lam_re, s5_lam_im, s5_log_dt, s5_b_re, s5_b_im, s5_c_re, s5_c_im, s5_d,
              s5_w_glu, fox_b_f, odd_w_in, mla_g_cq, mla_g_ckv, mla_w_uq, mla_w_ukv, nsa_cmp_pe,
              nsa_cmp_w1, nsa_cmp_w2):
    h = x
    mem_n = rms_norm(mem, mem_norm_g)
    for layer in range(DEPTH):
        xn = rms_norm(h, norm_g[layer])
        mem_kv = mem_n @ mem_w_kv[layer]
        i = layer // 2
        if layer % 2 == 0:
            mixed = even_layer(xn, mem_kv, even_w_in[i], s5_lam_re[i], s5_lam_im[i], s5_log_dt[i], s5_b_re[i],
                               s5_b_im[i], s5_c_re[i], s5_c_im[i], s5_d[i], s5_w_glu[i], fox_b_f[i])
        else:
            mixed = odd_layer(xn, mem_kv, positions, t5_table, odd_w_in[i], mla_g_cq[i], mla_g_ckv[i],
                              mla_w_uq[i], mla_w_ukv[i], nsa_cmp_pe[i], nsa_cmp_w1[i], nsa_cmp_w2[i])
        h = h + (mixed @ w_out[layer]).astype(h.dtype)
    return rms_norm(h, final_norm_g)
```

```cpp
#include <hip/hip_runtime.h>
#include <hip/hip_cooperative_groups.h>
#include <cstdio>
#include <cstdint>
namespace cg = cooperative_groups;

typedef unsigned short bf16;
typedef short bf16x8 __attribute__((ext_vector_type(8)));
typedef float f32x16 __attribute__((ext_vector_type(16)));
typedef float f32x4 __attribute__((ext_vector_type(4)));
typedef __bf16 bf2v __attribute__((ext_vector_type(2)));
typedef float f2v __attribute__((ext_vector_type(2)));

#define DI __device__ __forceinline__
#define MFMA32(a, b, c) __builtin_amdgcn_mfma_f32_32x32x16_bf16((a), (b), (c), 0, 0, 0)

#ifndef LB2
#define LB2 2
#endif
#ifndef PHM
#define PHM 1023
#endif
#ifndef MULTI_LAUNCH
#define MULTI_LAUNCH 0
#endif

constexpr int L = 8192;
constexpr int DM = 2048;
constexpr int NPE = 7296;
constexpr int NPO = 6784;
constexpr int EVEN_IN = 7176;
constexpr int ODD_IN = 6744;
constexpr int MIXW = 2560;
constexpr float LOG2E = 1.4426950408889634f;
constexpr float NEG = -1e30f;
constexpr float EPS = 1e-6f;

constexpr size_t MB = 1024 * 1024;
constexpr size_t WS_WIN = 0;
constexpr size_t WS_WOUT = WS_WIN + 30 * MB;
constexpr size_t WS_WMEM = WS_WOUT + 10 * MB;
constexpr size_t WS_WMISC = WS_WMEM + 4 * MB;
constexpr size_t WS_XN = WS_WMISC + 8 * MB;
constexpr size_t WS_MEMN = WS_XN + 32 * MB;
constexpr size_t WS_P = WS_MEMN + 1 * MB;
constexpr size_t WS_MIXED = WS_P + 114 * MB;
constexpr size_t WS_MEMK = WS_MIXED + 40 * MB;
constexpr size_t WS_MEMVT = WS_MEMK + 256 * 1024;
constexpr size_t WS_ROPEC = WS_MEMVT + 256 * 1024;
constexpr size_t WS_ROPES = WS_ROPEC + 1 * MB;
constexpr size_t WS_FLOG = WS_ROPES + 1 * MB;
constexpr size_t WS_CUML = WS_FLOG + 1 * MB;
constexpr size_t WS_CT = WS_CUML + 256 * 1024;
constexpr size_t WS_S5P = WS_CT + 4096;
constexpr size_t WS_S5E = WS_S5P + 1 * MB;
constexpr size_t WS_CMPB = WS_S5E + 2 * MB;
constexpr size_t WS_VAR = WS_CMPB + 64 * 1024;
constexpr size_t WS_Z = WS_VAR;
constexpr size_t WS_VTFOX = WS_Z + 16 * MB;
constexpr size_t WS_QMLA = WS_VAR;
constexpr size_t WS_KMLA = WS_QMLA + 24 * MB;
constexpr size_t WS_VTMLA = WS_KMLA + 16 * MB;
constexpr size_t WS_VTSLC = WS_VTMLA + 16 * MB;
constexpr size_t WS_VTWIN = WS_VTSLC + 4 * MB;
constexpr size_t WS_HID = WS_VTWIN + 4 * MB;
constexpr size_t WS_KC = WS_HID + 1 * MB;
constexpr size_t WS_VCT = WS_KC + 256 * 1024;
constexpr size_t WS_NSAO = WS_VCT + 256 * 1024;
constexpr size_t WS_END = WS_NSAO + 32 * MB;
constexpr size_t WM_GLU = 0;
constexpr size_t WM_UQ = 0;
constexpr size_t WM_UKV = WM_UQ + 1536 * 512 * 2;
constexpr size_t WM_W1 = WM_UKV + 2048 * 512 * 2;
constexpr size_t WM_W2 = WM_W1 + 2 * 256 * 4096 * 2;

constexpr int SM_EXTRA = 73728;
constexpr int SM_TOTAL = 73728 + 1024;

struct Params {
  const float *x, *mem;
  const int* pos;
  const float *norm_g, *mem_norm_g, *final_norm_g, *t5, *w_out, *mem_w_kv, *even_w_in, *lam_re, *lam_im, *log_dt,
      *b_re, *b_im, *c_re, *c_im, *s5_d, *w_glu, *fox_b_f, *odd_w_in, *g_cq, *g_ckv, *w_uq, *w_ukv, *cmp_pe,
      *cmp_w1, *cmp_w2;
  float* out;
  char* ws;
};

DI unsigned pack2(float a, float b) {
  f2v v = {a, b};
  bf2v r = __builtin_convertvector(v, bf2v);
  return __builtin_bit_cast(unsigned, r);
}
DI float bflo(unsigned u) { return __uint_as_float(u << 16); }
DI float bfhi(unsigned u) { return __uint_as_float(u & 0xffff0000u); }
DI float bf2f(bf16 v) { return __uint_as_float(((unsigned)v) << 16); }
DI bf16 f2bf(float f) { return (bf16)(pack2(f, 0.f) & 0xffffu); }
DI int otid() { int z; asm volatile("s_mov_b32 %0, 0" : "=s"(z)); return (int)threadIdx.x + z; }
DI int crow(int i, int h) { return (i & 3) + 8 * (i >> 2) + 4 * h; }
DI float sigm(float x) { return 1.f / (1.f + __expf(-x)); }
DI float silu(float x) { return x * sigm(x); }
DI float gelu_t(float x) {
  float u = 0.7978845608028654f * (x + 0.044715f * x * x * x);
  float e = __expf(2.f * u);
  float t = 1.f - 2.f / (e + 1.f);
  return 0.5f * x * (1.f + t);
}
DI float ex2(float x) { return __builtin_amdgcn_exp2f(x); }
DI float wave_sum(float v) {
#pragma unroll
  for (int o = 32; o > 0; o >>= 1) v += __shfl_xor(v, o);
  return v;
}
DI uint4 pack8(const float* v) {
  uint4 u;
  u.x = pack2(v[0], v[1]); u.y = pack2(v[2], v[3]); u.z = pack2(v[4], v[5]); u.w = pack2(v[6], v[7]);
  return u;
}

struct CvtSeg {
  const float* src; int lds; int sc0; bf16* dst; int dr0; int ncols; int npad; int K; const float* kscale;
};
DI int cvt_count(const CvtSeg& s) { return (s.K >> 6) * (s.npad >> 6); }
DI void cvt_tile(const CvtSeg& s, int tile, char* smem) {
  float* T = (float*)smem;
  const int tid = otid();
  const int nkt = s.K >> 6;
  const int kt = tile % nkt, nt = tile / nkt;
  const int k0 = kt * 64, n0 = nt * 64;
  __syncthreads();
#pragma unroll
  for (int i = 0; i < 16; ++i) {
    int idx = tid + 256 * i;
    int k = idx >> 6, n = idx & 63;
    float v = 0.f;
    if (n0 + n < s.ncols) {
      v = s.src[(size_t)(k0 + k) * s.lds + s.sc0 + n0 + n];
      if (s.kscale) v *= s.kscale[k0 + k];
    }
    T[k * 65 + n] = v;
  }
  __syncthreads();
#pragma unroll
  for (int j = 0; j < 2; ++j) {
    int c = tid + 256 * j;
    int n = c >> 3, kc = (c & 7) * 8;
    float v[8];
#pragma unroll
    for (int e = 0; e < 8; ++e) v[e] = T[(kc + e) * 65 + n];
    *(uint4*)(s.dst + (size_t)(s.dr0 + n0 + n) * s.K + k0 + kc) = pack8(v);
  }
}

enum { SET_IN_EVEN = 0, SET_IN_ODD, SET_OUT, SET_MEM, SET_MISC_EVEN, SET_MISC_ODD };
DI int cvt_nseg(int set) {
  switch (set) {
    case SET_IN_EVEN: return 3;
    case SET_IN_ODD: return 5;
    case SET_OUT: return 1;
    case SET_MEM: return 1;
    case SET_MISC_EVEN: return 1;
    default: return 6;
  }
}
DI CvtSeg cvt_get(const Params& p, int set, int li, int s) {
  CvtSeg r;
  r.kscale = nullptr;
  char* ws = p.ws;
  if (set == SET_IN_EVEN) {
    r.src = p.even_w_in + (size_t)li * DM * EVEN_IN; r.lds = EVEN_IN; r.K = DM; r.dst = (bf16*)(ws + WS_WIN);
    if (s == 0) { r.sc0 = 0; r.dr0 = 0; r.ncols = 5120; r.npad = 5120; }
    else if (s == 1) { r.sc0 = 5128; r.dr0 = 5120; r.ncols = 2048; r.npad = 2048; }
    else { r.sc0 = 5120; r.dr0 = 7168; r.ncols = 8; r.npad = 128; }
  } else if (set == SET_IN_ODD) {
    r.src = p.odd_w_in + (size_t)li * DM * ODD_IN; r.lds = ODD_IN; r.K = DM; r.dst = (bf16*)(ws + WS_WIN);
    if (s == 0) { r.sc0 = 0; r.dr0 = 0; r.ncols = 1024; r.npad = 1024; }
    else if (s == 1) { r.sc0 = 1088; r.dr0 = 1024; r.ncols = 3584; r.npad = 3584; }
    else if (s == 2) { r.sc0 = 4696; r.dr0 = 4608; r.ncols = 2048; r.npad = 2048; }
    else if (s == 3) { r.sc0 = 1024; r.dr0 = 6656; r.ncols = 64; r.npad = 64; }
    else { r.sc0 = 4672; r.dr0 = 6720; r.ncols = 24; r.npad = 64; }
  } else if (set == SET_OUT) {
    r.src = p.w_out + (size_t)li * MIXW * DM; r.lds = DM; r.K = MIXW; r.dst = (bf16*)(ws + WS_WOUT);
    r.sc0 = 0; r.dr0 = 0; r.ncols = DM; r.npad = DM;
  } else if (set == SET_MEM) {
    r.src = p.mem_w_kv + (size_t)li * DM * 1024; r.lds = 1024; r.K = DM; r.dst = (bf16*)(ws + WS_WMEM);
    r.sc0 = 0; r.dr0 = 0; r.ncols = 1024; r.npad = 1024;
  } else if (set == SET_MISC_EVEN) {
    r.src = p.w_glu + (size_t)li * 1024 * 1024; r.lds = 1024; r.K = 1024; r.dst = (bf16*)(ws + WS_WMISC + WM_GLU);
    r.sc0 = 0; r.dr0 = 0; r.ncols = 1024; r.npad = 1024;
  } else {
    r.sc0 = 0; r.dr0 = 0;
    if (s == 0) {
      r.src = p.w_uq + (size_t)li * 512 * 1536; r.lds = 1536; r.K = 512; r.dst = (bf16*)(ws + WS_WMISC + WM_UQ);
      r.ncols = 1536; r.npad = 1536; r.kscale = p.g_cq + li * 512;
    } else if (s == 1) {
      r.src = p.w_ukv + (size_t)li * 512 * 2048; r.lds = 2048; r.K = 512; r.dst = (bf16*)(ws + WS_WMISC + WM_UKV);
      r.ncols = 2048; r.npad = 2048; r.kscale = p.g_ckv + li * 512;
    } else if (s < 4) {
      int which = s - 2;
      r.src = p.cmp_w1 + (size_t)(li * 2 + which) * 4096 * 256; r.lds = 256; r.K = 4096;
      r.dst = (bf16*)(ws + WS_WMISC + WM_W1) + (size_t)which * 256 * 4096; r.ncols = 256; r.npad = 256;
    } else {
      int which = s - 4;
      r.src = p.cmp_w2 + (size_t)(li * 2 + which) * 256 * 128; r.lds = 128; r.K = 256;
      r.dst = (bf16*)(ws + WS_WMISC + WM_W2) + (size_t)which * 128 * 256; r.ncols = 128; r.npad = 128;
    }
  }
  return r;
}
DI int cvt_set_count(const Params& p, int set, int li) {
  int n = 0;
  for (int s = 0; s < cvt_nseg(set); ++s) n += cvt_count(cvt_get(p, set, li, s));
  return n;
}
DI void cvt_set_task(const Params& p, int set, int li, int t, char* smem) {
  const int ns = cvt_nseg(set);
  for (int s = 0; s < ns; ++s) {
    CvtSeg sg = cvt_get(p, set, li, s);
    int c = cvt_count(sg);
    if (t < c) { cvt_tile(sg, t, smem); return; }
    t -= c;
  }
}

DI void norm_row_bf16(const float* __restrict__ src, const float* __restrict__ g, bf16* __restrict__ dst, int lane) {
  float4 v[8];
  float ss = 0.f;
#pragma unroll
  for (int i = 0; i < 8; ++i) {
    v[i] = *(const float4*)(src + (i * 64 + lane) * 4);
    ss += v[i].x * v[i].x + v[i].y * v[i].y + v[i].z * v[i].z + v[i].w * v[i].w;
  }
  ss = wave_sum(ss);
  float r = rsqrtf(ss * (1.f / DM) + EPS);
#pragma unroll
  for (int i = 0; i < 8; ++i) {
    float4 gg = *(const float4*)(g + (i * 64 + lane) * 4);
    uint2 u;
    u.x = pack2(v[i].x * r * gg.x, v[i].y * r * gg.y);
    u.y = pack2(v[i].z * r * gg.z, v[i].w * r * gg.w);
    *(uint2*)(dst + (i * 64 + lane) * 4) = u;
  }
}
DI void norm_row_f32(float* __restrict__ io, const float* __restrict__ g, int lane) {
  float4 v[8];
  float ss = 0.f;
#pragma unroll
  for (int i = 0; i < 8; ++i) {
    v[i] = *(const float4*)(io + (i * 64 + lane) * 4);
    ss += v[i].x * v[i].x + v[i].y * v[i].y + v[i].z * v[i].z + v[i].w * v[i].w;
  }
  ss = wave_sum(ss);
  float r = rsqrtf(ss * (1.f / DM) + EPS);
#pragma unroll
  for (int i = 0; i < 8; ++i) {
    float4 gg = *(const float4*)(g + (i * 64 + lane) * 4);
    float4 o;
    o.x = v[i].x * r * gg.x; o.y = v[i].y * r * gg.y; o.z = v[i].z * r * gg.z; o.w = v[i].w * r * gg.w;
    *(float4*)(io + (i * 64 + lane) * 4) = o;
  }
}

struct ALin {
  const bf16* p; int ld;
  DI const bf16* operator()(int row, int k) const { return p + (size_t)row * ld + k; }
};
struct ACmp {
  const bf16* p; int m0;
  DI const bf16* operator()(int row, int k) const {
    int gr = m0 + row;
    if (gr > 1021) gr = 1021;
    int n = gr >> 1, g = gr & 1;
    return p + (size_t)(16 * n + (k >> 7)) * NPO + g * 128 + (k & 127);
  }
};

template <class AF, class Epi>
DI void gemm_tile(AF af, const bf16* __restrict__ Bt, int ldb, int K, char* smem, Epi epi) {
  const int tid = otid(), lane = tid & 63, w = tid >> 6, r = lane & 31, h = lane >> 5;
  const int wm = w >> 1, wn = w & 1;
  bf16* As = (bf16*)smem;
  bf16* Bs = As + 2 * 128 * 72;
  f32x16 acc[2][2];
#pragma unroll
  for (int a = 0; a < 2; ++a)
#pragma unroll
    for (int b = 0; b < 2; ++b)
#pragma unroll
      for (int i = 0; i < 16; ++i) acc[a][b][i] = 0.f;
  uint4 ra[4], rb[4];
  auto gload = [&](int k0) {
#pragma unroll
    for (int i = 0; i < 4; ++i) {
      int c = tid + 256 * i;
      int row = c >> 3, kc = (c & 7) * 8;
      ra[i] = *(const uint4*)af(row, k0 + kc);
      rb[i] = *(const uint4*)(Bt + (size_t)row * ldb + k0 + kc);
    }
  };
  auto sstore = [&](int buf) {
#pragma unroll
    for (int i = 0; i < 4; ++i) {
      int c = tid + 256 * i;
      int row = c >> 3, kc = (c & 7) * 8;
      *(uint4*)(As + buf * 9216 + row * 72 + kc) = ra[i];
      *(uint4*)(Bs + buf * 9216 + row * 72 + kc) = rb[i];
    }
  };
  __syncthreads();
  gload(0);
  sstore(0);
  __syncthreads();
  const int nk = K >> 6;
  for (int kt = 0; kt < nk; ++kt) {
    if (kt + 1 < nk) gload((kt + 1) * 64);
    const bf16* a_ = As + (kt & 1) * 9216;
    const bf16* b_ = Bs + (kt & 1) * 9216;
#pragma unroll
    for (int ks = 0; ks < 4; ++ks) {
      bf16x8 fa[2], fb[2];
#pragma unroll
      for (int mb = 0; mb < 2; ++mb) fa[mb] = *(const bf16x8*)(a_ + (wm * 64 + mb * 32 + r) * 72 + ks * 16 + h * 8);
#pragma unroll
      for (int nb = 0; nb < 2; ++nb) fb[nb] = *(const bf16x8*)(b_ + (wn * 64 + nb * 32 + r) * 72 + ks * 16 + h * 8);
#pragma unroll
      for (int mb = 0; mb < 2; ++mb)
#pragma unroll
        for (int nb = 0; nb < 2; ++nb) acc[mb][nb] = MFMA32(fa[mb], fb[nb], acc[mb][nb]);
    }
    if (kt + 1 < nk) sstore((kt + 1) & 1);
    __syncthreads();
  }
  float* Cs = (float*)smem;
#pragma unroll
  for (int mb = 0; mb < 2; ++mb)
#pragma unroll
    for (int nb = 0; nb < 2; ++nb)
#pragma unroll
      for (int i = 0; i < 16; ++i)
        Cs[(wm * 64 + mb * 32 + crow(i, h)) * 132 + wn * 64 + nb * 32 + r] = acc[mb][nb][i];
  __syncthreads();
  epi(Cs);
}

template <class F>
DI void epi_rows(const float* Cs, F f) {
  const int tid = otid();
#pragma unroll
  for (int j = 0; j < 8; ++j) {
    int c = tid + 256 * j;
    int row = c >> 4, cc = (c & 15) * 8;
    float v[8];
    float4 a = *(const float4*)(Cs + row * 132 + cc);
    float4 b = *(const float4*)(Cs + row * 132 + cc + 4);
    v[0] = a.x; v[1] = a.y; v[2] = a.z; v[3] = a.w; v[4] = b.x; v[5] = b.y; v[6] = b.z; v[7] = b.w;
    f(row, cc, v);
  }
}
template <class F>
DI void epi_cols(const float* Cs, F f) {
  const int tid = otid();
#pragma unroll
  for (int j = 0; j < 8; ++j) {
    int c = tid + 256 * j;
    int col = c & 127, r8 = (c >> 7) * 8;
    float v[8];
#pragma unroll
    for (int e = 0; e < 8; ++e) v[e] = Cs[(r8 + e) * 132 + col];
    f(col, r8, v);
  }
}
template <class F>
DI void epi_rope(const float* Cs, int cb, int m0, const float* rc, const float* rs, float scale_unused, F f) {
  const int tid = otid();
#pragma unroll
  for (int j = 0; j < 2; ++j) {
    int c = tid + 256 * j;
    int row = c >> 2, cc = (c & 3) * 8;
    float x1[8], x2[8], o1[8], o2[8];
#pragma unroll
    for (int e = 0; e < 8; ++e) {
      x1[e] = Cs[row * 132 + cb + cc + e];
      x2[e] = Cs[row * 132 + cb + 32 + cc + e];
    }
    const float* pc = rc + (size_t)(m0 + row) * 32 + cc;
    const float* ps = rs + (size_t)(m0 + row) * 32 + cc;
#pragma unroll
    for (int e = 0; e < 8; ++e) {
      float cs = pc[e], sn = ps[e];
      o1[e] = x1[e] * cs - x2[e] * sn;
      o2[e] = x1[e] * sn + x2[e] * cs;
    }
    f(row, cc, o1);
    f(row, cc + 32, o2);
  }
}

template <int DK>
struct KVPre {
  uint4 k[DK / 32];
  uint4 v[4];
  float aux;
};
constexpr int AT_VS = 25600;
constexpr int AT_AUX = 43008;
constexpr int AT_X0 = 43264;
constexpr int AT_IMP = AT_X0 + 12800;
constexpr int AT_SEL = AT_IMP + 16896;

template <int DK, bool PV, class SF, class PH>
DI void attn_tile(const bf16x8 (&qf)[DK / 16], f32x16 (&o)[4], float& m, float& l, const char* smem, SF sf, PH ph) {
  const int lane = otid() & 63, r = lane & 31, h = lane >> 5;
  const bf16* Ks = (const bf16*)smem;
  const bf16* Vs = (const bf16*)(smem + AT_VS);
  const float* auxs = (const float*)(smem + AT_AUX);
  f32x16 s[2];
#pragma unroll
  for (int kb = 0; kb < 2; ++kb) {
#pragma unroll
    for (int i = 0; i < 16; ++i) s[kb][i] = 0.f;
#pragma unroll
    for (int ks = 0; ks < DK / 16; ++ks) {
      bf16x8 a = *(const bf16x8*)(Ks + (kb * 32 + r) * (DK + 8) + ks * 16 + h * 8);
      s[kb] = MFMA32(a, qf[ks], s[kb]);
    }
  }
  float mx = m;
#pragma unroll
  for (int kb = 0; kb < 2; ++kb)
#pragma unroll
    for (int i = 0; i < 16; ++i) {
      int kl = kb * 32 + crow(i, h);
      float v = sf(s[kb][i], kl, auxs[kl]);
      s[kb][i] = v;
      mx = fmaxf(mx, v);
    }
  mx = fmaxf(mx, __shfl_xor(mx, 32));
  float alpha = ex2(m - mx);
  m = mx;
  float psum = 0.f;
#pragma unroll
  for (int kb = 0; kb < 2; ++kb)
#pragma unroll
    for (int i = 0; i < 16; ++i) {
      float pv = ex2(s[kb][i] - mx);
      s[kb][i] = pv;
      psum += pv;
    }
  l = l * alpha + psum;
  ph(0, s[0]);
  ph(1, s[1]);
  if (PV) {
#pragma unroll
    for (int d = 0; d < 4; ++d)
#pragma unroll
      for (int i = 0; i < 16; ++i) o[d][i] *= alpha;
#pragma unroll
    for (int st = 0; st < 4; ++st) {
      const int kb = st >> 1, s2 = st & 1;
      uint4 pu;
      pu.x = pack2(s[kb][8 * s2 + 0], s[kb][8 * s2 + 1]);
      pu.y = pack2(s[kb][8 * s2 + 2], s[kb][8 * s2 + 3]);
      pu.z = pack2(s[kb][8 * s2 + 4], s[kb][8 * s2 + 5]);
      pu.w = pack2(s[kb][8 * s2 + 6], s[kb][8 * s2 + 7]);
      bf16x8 pf = __builtin_bit_cast(bf16x8, pu);
#pragma unroll
      for (int d = 0; d < 4; ++d) {
        const bf16* vp = Vs + (d * 32 + r) * 68 + st * 16 + 4 * h;
        uint2 lo = *(const uint2*)vp;
        uint2 hi = *(const uint2*)(vp + 8);
        uint4 vu = make_uint4(lo.x, lo.y, hi.x, hi.y);
        bf16x8 vf = __builtin_bit_cast(bf16x8, vu);
        o[d] = MFMA32(vf, pf, o[d]);
      }
    }
  }
}

struct NoHook { DI void operator()(int, const f32x16&) const {} };

template <int DK, bool PV, bool PF, class Ctx>
DI void attn_run(const bf16x8 (&qf)[DK / 16], f32x16 (&o)[4], float& m, float& l, const bf16* K1, int ldk1,
                 const bf16* K2, int ldk2, const bf16* Vt, int ldv, int first, Ctx& ctx, char* smem) {
  const int tid = otid();
  int tcur = first;
  if (tcur < 0) return;
  constexpr int CPR = DK / 8;
  constexpr int NKC = DK / 32;
  uint4 rk0, rk1, rk2, rk3, rk4 = make_uint4(0, 0, 0, 0), rk5 = make_uint4(0, 0, 0, 0), rv[4];
  float raux;
  bf16* Ks = (bf16*)smem;
  bf16* Vs = (bf16*)(smem + AT_VS);
  auto ldk = [&](int i, int key0) -> uint4 {
    int c = otid() + 256 * i;
    int row = c / CPR, cc = c % CPR;
    const bf16* src;
    if (DK == 128 || cc < 16) src = K1 + (size_t)(key0 + row) * ldk1 + cc * 8;
    else src = K2 + (size_t)(key0 + row) * ldk2 + (cc - 16) * 8;
    return *(const uint4*)src;
  };
  auto stk = [&](int i, const uint4& v) {
    int c = tid + 256 * i;
    int row = c / CPR, cc = c % CPR;
    *(uint4*)(Ks + row * (DK + 8) + cc * 8) = v;
  };
  auto gload = [&](int key0) {
    rk0 = ldk(0, key0); rk1 = ldk(1, key0); rk2 = ldk(2, key0); rk3 = ldk(3, key0);
    if (NKC > 4) { rk4 = ldk(4, key0); rk5 = ldk(5, key0); }
    const int tl = otid();
#pragma unroll
    for (int i = 0; i < 4; ++i) {
      int c = tl + 256 * i;
      int d = c >> 3, cc = c & 7;
      rv[i] = *(const uint4*)(Vt + (size_t)d * ldv + key0 + cc * 8);
    }
    raux = (tid < 64) ? ctx.aux(key0 + tid) : 0.f;
  };
  auto sstore = [&]() {
    stk(0, rk0); stk(1, rk1); stk(2, rk2); stk(3, rk3);
    if (NKC > 4) { stk(4, rk4); stk(5, rk5); }
#pragma unroll
    for (int i = 0; i < 4; ++i) {
      int c = tid + 256 * i;
      int d = c >> 3, cc = c & 7;
      uint2* dst = (uint2*)(Vs + d * 68 + cc * 8);
      dst[0] = make_uint2(rv[i].x, rv[i].y);
      dst[1] = make_uint2(rv[i].z, rv[i].w);
    }
    if (tid < 64) ((float*)(smem + AT_AUX))[tid] = raux;
  };
  if (PF) gload(tcur * 64);
  while (tcur >= 0) {
    __syncthreads();
    if (!PF) gload(tcur * 64);
    sstore();
    __syncthreads();
    int tnext = ctx.next(tcur);
    if (PF && tnext >= 0) gload(tnext * 64);
    if (!ctx.skip(tcur)) {
      const int tc = tcur;
      attn_tile<DK, PV>(qf, o, m, l, smem,
                        [&](float s, int kl, float ax) { return ctx.score(s, tc * 64 + kl, ax, tc); },
                        [&](int kb, const f32x16& pt) { ctx.hook(kb, pt, tc); });
    }
    tcur = tnext;
  }
}

template <int DK>
DI void load_q(bf16x8 (&qf)[DK / 16], const bf16* qrow, int h) {
#pragma unroll
  for (int ks = 0; ks < DK / 16; ++ks) qf[ks] = *(const bf16x8*)(qrow + ks * 16 + h * 8);
}
DI void zero_o(f32x16 (&o)[4]) {
#pragma unroll
  for (int d = 0; d < 4; ++d)
#pragma unroll
    for (int i = 0; i < 16; ++i) o[d][i] = 0.f;
}

struct CtxCausal {
  int tq, q0w, last; float sc;
  DI int next(int t) const { return t + 1 <= last ? t + 1 : -1; }
  DI float aux(int) const { return 0.f; }
  DI bool skip(int t) const { return t * 64 > q0w + 31; }
  DI float score(float s, int key, float, int) const { return key <= tq ? s * sc : NEG; }
  DI void hook(int, const f32x16&, int) const {}
};
struct CtxFox {
  int tq, q0w, last; float sc, cq; const float* cuml; const float* cpre;
  DI int next(int t) const { return t + 1 <= last ? t + 1 : -1; }
  DI float aux(int key) const { return cuml[key] + cpre[key >> 7]; }
  DI bool skip(int t) const { return t * 64 > q0w + 31; }
  DI float score(float s, int key, float ax, int) const { return key <= tq ? s * sc + (cq - ax) * LOG2E : NEG; }
  DI void hook(int, const f32x16&, int) const {}
};
struct CtxMem {
  float sc;
  DI int next(int t) const { return t + 1 < 4 ? t + 1 : -1; }
  DI float aux(int) const { return 0.f; }
  DI bool skip(int) const { return false; }
  DI float score(float s, int, float, int) const { return s * sc; }
  DI void hook(int, const f32x16&, int) const {}
};

DI void store_out_A(const f32x16 (&o)[4], float inv_l, const bf16* grow, bf16* orow, int h) {
#pragma unroll
  for (int d = 0; d < 4; ++d)
#pragma unroll
    for (int i4 = 0; i4 < 4; ++i4) {
      int dv0 = d * 32 + 8 * i4 + 4 * h;
      uint2 gu = *(const uint2*)(grow + dv0);
      float g0 = bflo(gu.x), g1 = bfhi(gu.x), g2 = bflo(gu.y), g3 = bfhi(gu.y);
      uint2 ou;
      ou.x = pack2(o[d][4 * i4 + 0] * inv_l * silu(g0), o[d][4 * i4 + 1] * inv_l * silu(g1));
      ou.y = pack2(o[d][4 * i4 + 2] * inv_l * silu(g2), o[d][4 * i4 + 3] * inv_l * silu(g3));
      *(uint2*)(orow + dv0) = ou;
    }
}

        struct CtxCmp {
          int tq, posq, last; float sc; const float* lutr; const int* pos; float invl; float* imp; int ql; bool p2;
          DI int next(int t) const { return t + 1 <= last ? t + 1 : -1; }
          DI float aux(int key) const { int n = key < 511 ? key : 510; return __int_as_float(pos[16 * n + 31]); }
          DI bool skip(int) const { return false; }
          DI float score(float s, int key, float ax, int) const {
            bool valid = (16 * key + 31 <= tq) && key < 511;
            int d = posq - __float_as_int(ax);
            d = d < 0 ? 0 : (d > 799 ? 799 : d);
            return valid ? s * sc + lutr[d] : NEG;
          }
          DI void hook(int kb, const f32x16& pt, int tc) const {
            if (!p2) return;
            const int lane = otid() & 63, h = lane >> 5, r = lane & 31;
#pragma unroll
            for (int gq = 0; gq < 4; ++gq) {
              float p3 = 0.5f * pt[4 * gq + 3];
              float vm = (pt[4 * gq] + pt[4 * gq + 1] + pt[4 * gq + 2] + p3) * invl;
              float vs = p3 * invl;
              vm += __shfl_xor(vm, 8); vm += __shfl_xor(vm, 16);
              vs += __shfl_xor(vs, 8); vs += __shfl_xor(vs, 16);
              int j = tc * 16 + kb * 8 + 2 * gq + h;
              if (r < 8) { atomicAdd(&imp[ql * 132 + j], vm); atomicAdd(&imp[ql * 132 + j + 1], vs); }
            }
          }
        };
struct CtxSlc {
  int tq, posq; float sc; const float* lutr; const int* pos; unsigned long long ulo, uhi, mlo, mhi;
  DI bool inu(int j) const {
    unsigned long long a = (ulo >> (j & 63)) & (j < 64 ? 1ull : 0ull);
    unsigned long long b = (uhi >> (j & 63)) & (j >= 64 ? 1ull : 0ull);
    return (a | b) != 0ull;
  }
  DI bool mine(int j) const {
    unsigned long long a = (mlo >> (j & 63)) & (j < 64 ? 1ull : 0ull);
    unsigned long long b = (mhi >> (j & 63)) & (j >= 64 ? 1ull : 0ull);
    return (a | b) != 0ull;
  }
  DI int next(int t) const { for (int j = t + 1; j < 128; ++j) if (inu(j)) return j; return -1; }
  DI float aux(int key) const { return __int_as_float(pos[key]); }
  DI bool skip(int) const { return false; }
  DI float score(float s, int key, float ax, int t) const {
    bool valid = mine(t) && key <= tq;
    int d = posq - __float_as_int(ax);
    d = d < 0 ? 0 : (d > 799 ? 799 : d);
    return valid ? s * sc + lutr[d] : NEG;
  }
  DI void hook(int, const f32x16&, int) const {}
};
struct CtxWin {
  int tq, posq, last; float sc; const float* lutr; const int* pos;
  DI int next(int t) const { return t + 1 <= last ? t + 1 : -1; }
  DI float aux(int key) const { return __int_as_float(pos[key]); }
  DI bool skip(int) const { return false; }
  DI float score(float s, int key, float ax, int) const {
    bool valid = key <= tq && (tq - key) < 512;
    int d = posq - __float_as_int(ax);
    d = d < 0 ? 0 : (d > 799 ? 799 : d);
    return valid ? s * sc + lutr[d] : NEG;
  }
  DI void hook(int, const f32x16&, int) const {}
};

__global__ void __launch_bounds__(256, LB2) mega(Params p, int ph_lo, int ph_hi) {
  __shared__ __attribute__((aligned(16))) char smem[SM_TOTAL];
  const int bid = blockIdx.x, nb = gridDim.x;

  for (int ph = ph_lo; ph <= ph_hi; ++ph) {
    if (ph > ph_lo) cg::this_grid().sync();
    const int tid = otid(), lane = tid & 63, w = tid >> 6, r = lane & 31, h = lane >> 5;
    char* ws = p.ws + (tid - (int)threadIdx.x);
    bf16* XN = (bf16*)(ws + WS_XN);
    bf16* P = (bf16*)(ws + WS_P);
    bf16* MIXED = (bf16*)(ws + WS_MIXED);
    float* ROPEC = (float*)(ws + WS_ROPEC);
    float* ROPES = (float*)(ws + WS_ROPES);
    float* hbuf = p.out;
    const int layer = ph == 0 ? 0 : (ph - 1) / 6;
    const int sub = ph == 0 ? -1 : (ph - 1) % 6;
    const bool even = (layer & 1) == 0;
    const int li = layer >> 1;
    const int NP = even ? NPE : NPO;

    if ((PHM & 1) && (ph == 0 || sub == 5)) {
      if (ph == 0) {
        for (int i = bid * 256 + tid; i < L * 32; i += nb * 256) {
          int t = i >> 5, f = i & 31;
          float inv = powf(10000.f, -(float)f / 32.f);
          float ang = (float)p.pos[t] * inv;
          ROPEC[i] = cosf(ang);
          ROPES[i] = sinf(ang);
        }
        for (int row = bid * 4 + w; row < 256; row += nb * 4)
          norm_row_bf16(p.mem + (size_t)row * DM, p.mem_norm_g, (bf16*)(ws + WS_MEMN) + (size_t)row * DM, lane);
      }
      const int nl = ph == 0 ? 0 : layer + 1;
      if (nl < 4) {
        const float* src = ph == 0 ? p.x : hbuf;
        for (int row = bid * 4 + w; row < L; row += nb * 4)
          norm_row_bf16(src + (size_t)row * DM, p.norm_g + nl * DM, XN + (size_t)row * DM, lane);
      } else {
        for (int row = bid * 4 + w; row < L; row += nb * 4) norm_row_f32(hbuf + (size_t)row * DM, p.final_norm_g, lane);
      }
    }
    if ((PHM & 2) && (ph == 0 || sub == 4)) {
      const int nl = ph == 0 ? 0 : layer + 1;
      if (nl < 4) {
        const bool ne = (nl & 1) == 0;
        const int nli = nl >> 1;
        const int s0 = ne ? SET_IN_EVEN : SET_IN_ODD, s2 = ne ? SET_MISC_EVEN : SET_MISC_ODD;
        const int c0 = cvt_set_count(p, s0, nli), c1 = cvt_set_count(p, SET_MEM, nl), c2 = cvt_set_count(p, s2, nli);
        const int cx = ne ? 16 : 32;
        for (int t = bid; t < c0 + c1 + c2 + cx; t += nb) {
          if (t < c0) cvt_set_task(p, s0, nli, t, smem);
          else if (t < c0 + c1) cvt_set_task(p, SET_MEM, nl, t - c0, smem);
          else if (t < c0 + c1 + c2) cvt_set_task(p, s2, nli, t - c0 - c1, smem);
          else {
            int e = t - c0 - c1 - c2;
            if (ne) {
              float* S5P = (float*)(ws + WS_S5P);
              int gp = e * 256 + tid;
              int g = gp >> 6;
              float dt = expf(p.log_dt[nli * 64 + g]);
              float lr = p.lam_re[nli * 4096 + gp], lim = p.lam_im[nli * 4096 + gp];
              float mag = expf(lr * dt);
              float abr = mag * cosf(lim * dt), abi = mag * sinf(lim * dt);
              float den = lr * lr + lim * lim;
              float nr = abr - 1.f;
              float fre = (nr * lr + abi * lim) / den;
              float fim = (abi * lr - nr * lim) / den;
              S5P[gp] = abr;
              S5P[4096 + gp] = abi;
              float ar = abr, ai = abi;
#pragma unroll
              for (int q = 0; q < 7; ++q) { float nr2 = ar * ar - ai * ai; ai = 2.f * ar * ai; ar = nr2; }
              S5P[8192 + gp] = ar;
              S5P[12288 + gp] = ai;
              const float* br = p.b_re + (size_t)nli * 65536 + gp * 16;
              const float* bi = p.b_im + (size_t)nli * 65536 + gp * 16;
#pragma unroll
              for (int c = 0; c < 16; ++c) {
                S5P[16384 + gp * 16 + c] = fre * br[c] - fim * bi[c];
                S5P[16384 + 65536 + gp * 16 + c] = fre * bi[c] + fim * br[c];
              }
            } else {
              int which = e >> 4, part = e & 15;
              const float* pe = p.cmp_pe + (size_t)(nli * 2 + which) * 4096 + part * 256;
              const float* w1 = p.cmp_w1 + ((size_t)(nli * 2 + which) * 4096 + part * 256) * 256 + tid;
              float acc = 0.f;
#pragma unroll 8
              for (int k = 0; k < 256; ++k) acc += pe[k] * w1[(size_t)k * 256];
              ((float*)(ws + WS_CMPB))[(which * 16 + part) * 256 + tid] = acc;
            }
          }
        }
      }
    }
    if ((PHM & 4) && sub == 0) {
      const int ntn = NP / 128;
      const int n_in = 64 * ntn;
      const bf16* Win = (const bf16*)(ws + WS_WIN);
      for (int t = bid; t < n_in + 16; t += nb) {
        if (t < n_in) {
          const int tm = t / ntn, tn = t % ntn;
          const int m0 = tm * 128, n0 = tn * 128;
          ALin af{XN + (size_t)m0 * DM, DM};
          if (even) {
            gemm_tile(af, Win + (size_t)n0 * DM, DM, DM, smem, [&](const float* Cs) {
              if (n0 >= 4096 && n0 < 5120) {
                bf16* VT = (bf16*)(ws + WS_VTFOX);
                epi_cols(Cs, [&](int col, int r8, const float* v) {
                  *(uint4*)(VT + (size_t)(n0 - 4096 + col) * L + m0 + r8) = pack8(v);
                });
              } else if (n0 == 7168) {
                float* FL = (float*)(ws + WS_FLOG);
                for (int i = tid; i < 128 * 8; i += 256) {
                  int row = i >> 3, c = i & 7;
                  FL[(size_t)(m0 + row) * 8 + c] = Cs[row * 132 + c];
                }
              } else {
                epi_rows(Cs, [&](int row, int cc, const float* v) {
                  *(uint4*)(P + (size_t)(m0 + row) * NPE + n0 + cc) = pack8(v);
                });
              }
            });
          } else {
            gemm_tile(af, Win + (size_t)n0 * DM, DM, DM, smem, [&](const float* Cs) {
              if (n0 == 3840 || n0 == 3968 || n0 == 4352 || n0 == 4480) {
                bf16* VT = (n0 < 4096) ? (bf16*)(ws + WS_VTSLC) + (size_t)(n0 - 3840) * L
                                       : (bf16*)(ws + WS_VTWIN) + (size_t)(n0 - 4352) * L;
                epi_cols(Cs, [&](int col, int r8, const float* v) {
                  *(uint4*)(VT + (size_t)col * L + m0 + r8) = pack8(v);
                });
              } else if (n0 == 6656) {
                epi_rope(Cs, 0, m0, ROPEC, ROPES, 1.f, [&](int row, int cl, const float* v) {
                  *(uint4*)(P + (size_t)(m0 + row) * NPO + 6656 + cl) = pack8(v);
                });
                float* GT = (float*)(ws + WS_FLOG);
                for (int i = tid; i < 128 * 24; i += 256) {
                  int row = i / 24, c = i % 24;
                  GT[(size_t)(m0 + row) * 24 + c] = Cs[row * 132 + 64 + c];
                }
              } else {
                epi_rows(Cs, [&](int row, int cc, const float* v) {
                  *(uint4*)(P + (size_t)(m0 + row) * NPO + n0 + cc) = pack8(v);
                });
              }
            });
          }
        } else {
          const int t2 = t - n_in;
          const int m0 = (t2 >> 3) * 128, n0 = (t2 & 7) * 128;
          ALin af{(const bf16*)(ws + WS_MEMN) + (size_t)m0 * DM, DM};
          gemm_tile(af, (const bf16*)(ws + WS_WMEM) + (size_t)n0 * DM, DM, DM, smem, [&](const float* Cs) {
            if (n0 < 512) {
              bf16* MK = (bf16*)(ws + WS_MEMK);
              epi_rows(Cs, [&](int row, int cc, const float* v) {
                *(uint4*)(MK + (size_t)(m0 + row) * 512 + n0 + cc) = pack8(v);
              });
            } else {
              bf16* MV = (bf16*)(ws + WS_MEMVT);
              epi_cols(Cs, [&](int col, int r8, const float* v) {
                *(uint4*)(MV + (size_t)(n0 - 512 + col) * 256 + m0 + r8) = pack8(v);
              });
            }
          });
        }
      }
    }

    auto mem_attn_task = [&](int t) {
      const int qt = t >> 2, head = t & 3;
      const int tq = qt * 128 + w * 32 + r;
      const int qcol = even ? 6144 : 5632, gcol = even ? 6656 : 6144;
      bf16x8 qf[8];
      load_q<128>(qf, P + (size_t)tq * NP + qcol + head * 128, h);
      f32x16 o[4];
      zero_o(o);
      float m = NEG, l = 0.f;
      CtxMem ctx{0.08838834764831845f * LOG2E};
      attn_run<128, true, true>(qf, o, m, l, (const bf16*)(ws + WS_MEMK) + head * 128, 512, nullptr, 0,
                          (const bf16*)(ws + WS_MEMVT) + (size_t)head * 128 * 256, 256, 0, ctx, smem);
      float lt = l + __shfl_xor(l, 32);
      store_out_A(o, 1.f / lt, P + (size_t)tq * NP + gcol + head * 128, MIXED + (size_t)tq * MIXW + 2048 + head * 128, h);
    };

    if ((PHM & 8) && sub == 1 && even) {
      const int cw = cvt_set_count(p, SET_OUT, layer);
      const int n_s5 = 1024, n_cum = 64, n_mem = 256;
      for (int t = bid; t < n_mem + n_s5 + n_cum + cw; t += nb) {
        if (t < n_mem) {
          mem_attn_task(t);
        } else if (t < n_mem + n_s5) {
          const int t2 = t - n_mem;
          const int ch = t2 >> 4, gq = t2 & 15;
          float* us = (float*)smem;
          __syncthreads();
          for (int i = tid; i < 128 * 8; i += 256) {
            int tt = i >> 3, c8 = (i & 7) * 8;
            uint4 u = *(const uint4*)(P + (size_t)(ch * 128 + tt) * NPE + gq * 64 + c8);
            float* d = us + tt * 64 + c8;
            d[0] = bflo(u.x); d[1] = bfhi(u.x); d[2] = bflo(u.y); d[3] = bfhi(u.y);
            d[4] = bflo(u.z); d[5] = bfhi(u.z); d[6] = bflo(u.w); d[7] = bfhi(u.w);
          }
          __syncthreads();
          const float* S5P = (const float*)(ws + WS_S5P);
          const int gp = (gq * 4 + w) * 64 + lane;
          const float ar = S5P[gp], ai = S5P[4096 + gp];
          float bbr[16], bbi[16];
#pragma unroll
          for (int c = 0; c < 16; ++c) { bbr[c] = S5P[16384 + gp * 16 + c]; bbi[c] = S5P[16384 + 65536 + gp * 16 + c]; }
          float xr = 0.f, xi = 0.f;
          for (int tt = 0; tt < 128; ++tt) {
            const float* up = us + tt * 64 + w * 16;
            float bur = 0.f, bui = 0.f;
#pragma unroll
            for (int c = 0; c < 16; ++c) { float uv = up[c]; bur += bbr[c] * uv; bui += bbi[c] * uv; }
            float nxr = ar * xr - ai * xi + bur;
            float nxi = ar * xi + ai * xr + bui;
            xr = nxr; xi = nxi;
          }
          float2* E = (float2*)(ws + WS_S5E);
          E[(size_t)ch * 4096 + gp] = make_float2(xr, xi);
        } else if (t < n_mem + n_s5 + n_cum) {
          const int ch = t - n_mem - n_s5;
          const float* FL = (const float*)(ws + WS_FLOG);
          float* CUML = (float*)(ws + WS_CUML);
          float* CT = (float*)(ws + WS_CT);
#pragma unroll
          for (int hh = 0; hh < 2; ++hh) {
            const int head = w * 2 + hh;
            const float bf = p.fox_b_f[li * 8 + head];
            const int t0 = ch * 128 + lane * 2;
            float x0 = FL[(size_t)t0 * 8 + head] + bf, x1 = FL[(size_t)(t0 + 1) * 8 + head] + bf;
            float v0 = x0 >= 0.f ? -log1pf(expf(-x0)) : x0 - log1pf(expf(x0));
            float v1 = x1 >= 0.f ? -log1pf(expf(-x1)) : x1 - log1pf(expf(x1));
            float s = v0 + v1;
            float inc = s;
#pragma unroll
            for (int o = 1; o < 64; o <<= 1) {
              float n = __shfl_up(inc, o);
              if (lane >= o) inc += n;
            }
            float excl = inc - s;
            CUML[(size_t)head * L + t0] = excl + v0;
            CUML[(size_t)head * L + t0 + 1] = excl + v0 + v1;
            if (lane == 63) CT[head * 64 + ch] = inc;
          }
        } else {
          cvt_set_task(p, SET_OUT, layer, t - n_mem - n_s5 - n_cum, smem);
        }
      }
    }
    if ((PHM & 16) && sub == 2 && even) {
      const int n_fox = 512, n_s5 = 1024;
      for (int t = bid; t < n_fox + n_s5; t += nb) {
        if (t < n_fox) {
          const int qt = 63 - (t >> 3), head = t & 7;
          const int q0w = qt * 128 + w * 32, tq = q0w + r;
          float* cpre = (float*)(smem + AT_X0);
          __syncthreads();
          if (tid < 64) {
            const float* CT = (const float*)(ws + WS_CT) + head * 64;
            float acc = 0.f;
            for (int c = 0; c < tid; ++c) acc += CT[c];
            cpre[tid] = acc;
          }
          __syncthreads();
          const float* cuml = (const float*)(ws + WS_CUML) + (size_t)head * L;
          bf16x8 qf[8];
          load_q<128>(qf, P + (size_t)tq * NPE + 2048 + head * 128, h);
          f32x16 o[4];
          zero_o(o);
          float m = NEG, l = 0.f;
          CtxFox ctx{tq, q0w, 2 * qt + 1, 0.08838834764831845f * LOG2E, cuml[tq] + cpre[tq >> 7], cuml, cpre};
          attn_run<128, true, true>(qf, o, m, l, P + 3072 + head * 128, NPE, nullptr, 0,
                              (const bf16*)(ws + WS_VTFOX) + (size_t)head * 128 * L, L, 0, ctx, smem);
          float lt = l + __shfl_xor(l, 32);
          store_out_A(o, 1.f / lt, P + (size_t)tq * NPE + 5120 + head * 128, MIXED + (size_t)tq * MIXW + 1024 + head * 128, h);
        } else {
          const int t2 = t - n_fox;
          const int ch = t2 >> 4, gq = t2 & 15;
          float* us = (float*)smem;
          float* xs = (float*)(smem + 32768) + w * 16 * 132;
          __syncthreads();
          for (int i = tid; i < 128 * 8; i += 256) {
            int tt = i >> 3, c8 = (i & 7) * 8;
            uint4 u = *(const uint4*)(P + (size_t)(ch * 128 + tt) * NPE + gq * 64 + c8);
            float* d = us + tt * 64 + c8;
            d[0] = bflo(u.x); d[1] = bfhi(u.x); d[2] = bflo(u.y); d[3] = bfhi(u.y);
            d[4] = bflo(u.z); d[5] = bfhi(u.z); d[6] = bflo(u.w); d[7] = bfhi(u.w);
          }
          __syncthreads();
          const float* S5P = (const float*)(ws + WS_S5P);
          const int g = gq * 4 + w;
          const int gp = g * 64 + lane;
          const float ar = S5P[gp], ai = S5P[4096 + gp];
          const float atr = S5P[8192 + gp], ati = S5P[12288 + gp];
          float xr = 0.f, xi = 0.f;
          {
            const float2* E = (const float2*)(ws + WS_S5E);
            for (int c = 0; c < ch; ++c) {
              float2 e = E[(size_t)c * 4096 + gp];
              float nxr = atr * xr - ati * xi + e.x;
              float nxi = atr * xi + ati * xr + e.y;
              xr = nxr; xi = nxi;
            }
          }
          float bbr[16], bbi[16];
#pragma unroll
          for (int c = 0; c < 16; ++c) { bbr[c] = S5P[16384 + gp * 16 + c]; bbi[c] = S5P[16384 + 65536 + gp * 16 + c]; }
          const int chn = lane & 15, kq = lane >> 4;
          float cb[32];
          {
            const float* cre = p.c_re + ((size_t)li * 64 + g) * 1024 + chn * 64;
            const float* cim = p.c_im + ((size_t)li * 64 + g) * 1024 + chn * 64;
#pragma unroll
            for (int ks = 0; ks < 16; ++ks) { cb[ks] = cre[4 * ks + kq]; cb[16 + ks] = -cim[4 * ks + kq]; }
          }
          const float dsk = p.s5_d[li * 1024 + g * 16 + chn];
          bf16* Z = (bf16*)(ws + WS_Z);
          for (int sc = 0; sc < 8; ++sc) {
#pragma unroll 4
            for (int tt = 0; tt < 16; ++tt) {
              const float* up = us + (sc * 16 + tt) * 64 + w * 16;
              float bur = 0.f, bui = 0.f;
#pragma unroll
              for (int c = 0; c < 16; ++c) { float uv = up[c]; bur += bbr[c] * uv; bui += bbi[c] * uv; }
              float nxr = ar * xr - ai * xi + bur;
              float nxi = ar * xi + ai * xr + bui;
              xr = nxr; xi = nxi;
              xs[tt * 132 + lane] = xr;
              xs[tt * 132 + 64 + lane] = xi;
            }
            __syncthreads();
            f32x4 y = {0.f, 0.f, 0.f, 0.f};
#pragma unroll
            for (int ks = 0; ks < 32; ++ks) {
              float a = xs[chn * 132 + 4 * ks + kq];
              y = __builtin_amdgcn_mfma_f32_16x16x4f32(a, cb[ks], y, 0, 0, 0);
            }
#pragma unroll
            for (int i = 0; i < 4; ++i) {
              int tt = 4 * kq + i;
              float uv = us[(sc * 16 + tt) * 64 + w * 16 + chn];
              float yy = y[i] + dsk * uv;
              Z[(size_t)(ch * 128 + sc * 16 + tt) * 1024 + g * 16 + chn] = f2bf(gelu_t(yy));
            }
            __syncthreads();
          }
        }
      }
    }
    if ((PHM & 32) && sub == 3 && even) {
      const bf16* Z = (const bf16*)(ws + WS_Z);
      for (int t = bid; t < 64 * 8; t += nb) {
        const int m0 = (t >> 3) * 128, n0 = (t & 7) * 128;
        ALin af{Z + (size_t)m0 * 1024, 1024};
        gemm_tile(af, (const bf16*)(ws + WS_WMISC + WM_GLU) + (size_t)n0 * 1024, 1024, 1024, smem, [&](const float* Cs) {
          epi_rows(Cs, [&](int row, int cc, const float* v) {
            uint4 zu = *(const uint4*)(Z + (size_t)(m0 + row) * 1024 + n0 + cc);
            uint4 gu = *(const uint4*)(P + (size_t)(m0 + row) * NPE + 1024 + n0 + cc);
            float zz[8] = {bflo(zu.x), bfhi(zu.x), bflo(zu.y), bfhi(zu.y), bflo(zu.z), bfhi(zu.z), bflo(zu.w), bfhi(zu.w)};
            float gg[8] = {bflo(gu.x), bfhi(gu.x), bflo(gu.y), bfhi(gu.y), bflo(gu.z), bfhi(gu.z), bflo(gu.w), bfhi(gu.w)};
            float o[8];
#pragma unroll
            for (int e = 0; e < 8; ++e) o[e] = zz[e] * sigm(v[e]) * silu(gg[e]);
            *(uint4*)(MIXED + (size_t)(m0 + row) * MIXW + n0 + cc) = pack8(o);
          });
        });
      }
    }
    if ((PHM & 64) && sub == 1 && !even) {
      const int cw = cvt_set_count(p, SET_OUT, layer);
      const int n_c1 = 32, n_q = 64 * 12, n_kv = 64 * 16, n_mem = 256;
      float* rsx = (float*)(smem + SM_EXTRA);
      for (int t = bid; t < n_c1 + n_q + n_kv + n_mem + cw; t += nb) {
        if (t < n_c1) {
          const int which = t >> 4, tm = (t >> 1) & 7, tn = t & 1;
          const int m0 = tm * 128, n0 = tn * 128;
          __syncthreads();
          if (tid < 128) {
            const float* CB = (const float*)(ws + WS_CMPB) + which * 16 * 256 + n0 + tid;
            float b = 0.f;
            for (int q = 0; q < 16; ++q) b += CB[q * 256];
            rsx[tid] = b;
          }
          ACmp af{P + (which ? 3328 : 3072), m0};
          bf16* HID = (bf16*)(ws + WS_HID) + (size_t)which * 1024 * 256;
          gemm_tile(af, (const bf16*)(ws + WS_WMISC + WM_W1) + (size_t)which * 256 * 4096 + (size_t)n0 * 4096, 4096, 4096,
                    smem, [&](const float* Cs) {
                      epi_rows(Cs, [&](int row, int cc, const float* v) {
                        float o[8];
#pragma unroll
                        for (int e = 0; e < 8; ++e) o[e] = gelu_t(v[e] + rsx[cc + e]);
                        *(uint4*)(HID + (size_t)(m0 + row) * 256 + n0 + cc) = pack8(o);
                      });
                    });
        } else if (t < n_c1 + n_q + n_kv) {
          const int t2 = t - n_c1;
          const bool isq = t2 < n_q;
          const int t3 = isq ? t2 : t2 - n_q;
          const int ntn = isq ? 12 : 16;
          const int m0 = (t3 / ntn) * 128, n0 = (t3 % ntn) * 128;
          const bf16* Ab = P + (size_t)m0 * NPO + (isq ? 0 : 512);
          __syncthreads();
          for (int rr = 0; rr < 32; ++rr) {
            int row = w * 32 + rr;
            uint4 u = *(const uint4*)(Ab + (size_t)row * NPO + lane * 8);
            float a0 = bflo(u.x), a1 = bfhi(u.x), a2 = bflo(u.y), a3 = bfhi(u.y), a4 = bflo(u.z), a5 = bfhi(u.z),
                  a6 = bflo(u.w), a7 = bfhi(u.w);
            float ss = a0 * a0 + a1 * a1 + a2 * a2 + a3 * a3 + a4 * a4 + a5 * a5 + a6 * a6 + a7 * a7;
            ss = wave_sum(ss);
            if (lane == 0) rsx[row] = rsqrtf(ss * (1.f / 512.f) + EPS);
          }
          ALin af{Ab, NPO};
          if (isq) {
            bf16* QM = (bf16*)(ws + WS_QMLA);
            gemm_tile(af, (const bf16*)(ws + WS_WMISC + WM_UQ) + (size_t)n0 * 512, 512, 512, smem, [&](const float* Cs) {
              const int md = n0 % 192;
              const int ropehalf = md == 128 ? 0 : (md == 64 ? 1 : -1);
              epi_rows(Cs, [&](int row, int cc, const float* v) {
                if ((cc >> 6) == ropehalf) return;
                float o[8];
                float sc = rsx[row];
#pragma unroll
                for (int e = 0; e < 8; ++e) o[e] = v[e] * sc;
                *(uint4*)(QM + (size_t)(m0 + row) * 1536 + n0 + cc) = pack8(o);
              });
              if (ropehalf >= 0) {
                epi_rope(Cs, ropehalf * 64, m0, ROPEC, ROPES, 1.f, [&](int row, int cl, const float* v) {
                  float o[8];
                  float sc = rsx[row];
#pragma unroll
                  for (int e = 0; e < 8; ++e) o[e] = v[e] * sc;
                  *(uint4*)(QM + (size_t)(m0 + row) * 1536 + n0 + ropehalf * 64 + cl) = pack8(o);
                });
              }
            });
          } else {
            gemm_tile(af, (const bf16*)(ws + WS_WMISC + WM_UKV) + (size_t)n0 * 512, 512, 512, smem, [&](const float* Cs) {
              const int head = n0 >> 8, part = (n0 >> 7) & 1;
              if (part == 0) {
                bf16* KM = (bf16*)(ws + WS_KMLA);
                epi_rows(Cs, [&](int row, int cc, const float* v) {
                  float o[8];
                  float sc = rsx[row];
#pragma unroll
                  for (int e = 0; e < 8; ++e) o[e] = v[e] * sc;
                  *(uint4*)(KM + (size_t)(m0 + row) * 1024 + head * 128 + cc) = pack8(o);
                });
              } else {
                bf16* VT = (bf16*)(ws + WS_VTMLA);
                epi_cols(Cs, [&](int col, int r8, const float* v) {
                  float o[8];
#pragma unroll
                  for (int e = 0; e < 8; ++e) o[e] = v[e] * rsx[r8 + e];
                  *(uint4*)(VT + (size_t)(head * 128 + col) * L + m0 + r8) = pack8(o);
                });
              }
            });
          }
        } else if (t < n_c1 + n_q + n_kv + n_mem) {
          mem_attn_task(t - n_c1 - n_q - n_kv);
        } else {
          cvt_set_task(p, SET_OUT, layer, t - n_c1 - n_q - n_kv - n_mem, smem);
        }
      }
    }
    if ((PHM & 128) && sub == 2 && !even) {
      const int n_mla = 512, n_c2 = 16;
      for (int t = bid; t < n_mla + n_c2; t += nb) {
        if (t < n_mla) {
          const int qt = 63 - (t >> 3), head = t & 7;
          const int q0w = qt * 128 + w * 32, tq = q0w + r;
          bf16x8 qf[12];
          load_q<192>(qf, (const bf16*)(ws + WS_QMLA) + (size_t)tq * 1536 + head * 192, h);
          f32x16 o[4];
          zero_o(o);
          float m = NEG, l = 0.f;
          CtxCausal ctx{tq, q0w, 2 * qt + 1, 0.07216878364870322f * LOG2E};
          attn_run<192, true, true>(qf, o, m, l, (const bf16*)(ws + WS_KMLA) + head * 128, 1024, P + 6656, NPO,
                              (const bf16*)(ws + WS_VTMLA) + (size_t)head * 128 * L, L, 0, ctx, smem);
          float lt = l + __shfl_xor(l, 32);
          store_out_A(o, 1.f / lt, P + (size_t)tq * NPO + 1024 + head * 128, MIXED + (size_t)tq * MIXW + head * 128, h);
        } else {
          const int t2 = t - n_mla;
          const int which = t2 >> 3, m0 = (t2 & 7) * 128;
          ALin af{(const bf16*)(ws + WS_HID) + (size_t)which * 1024 * 256 + (size_t)m0 * 256, 256};
          gemm_tile(af, (const bf16*)(ws + WS_WMISC + WM_W2) + (size_t)which * 128 * 256, 256, 256, smem, [&](const float* Cs) {
            if (which == 0) {
              bf16* KC = (bf16*)(ws + WS_KC);
              epi_rows(Cs, [&](int row, int cc, const float* v) {
                int gr = m0 + row;
                int n = gr >> 1, g = gr & 1;
                *(uint4*)(KC + ((size_t)g * 512 + n) * 128 + cc) = pack8(v);
              });
            } else {
              bf16* VC = (bf16*)(ws + WS_VCT);
              for (int i = tid; i < 128 * 128; i += 256) {
                int row = i & 127, col = i >> 7;
                int gr = m0 + row;
                int n = gr >> 1, g = gr & 1;
                VC[((size_t)g * 128 + col) * 512 + n] = f2bf(Cs[row * 132 + col]);
              }
            }
          });
        }
      }
    }
    if ((PHM & 256) && sub == 3 && !even) {
      const int* pos = p.pos;
      float* lut = (float*)(smem + AT_X0);
      float* imp = (float*)(smem + AT_IMP);
      unsigned* sel = (unsigned*)(smem + AT_SEL);
      const float* GT = (const float*)(ws + WS_FLOG);
      float* NSAO = (float*)(ws + WS_NSAO);
      for (int t = bid; t < 512; t += nb) {
        const int qt = 255 - (t >> 1), g = t & 1;
        const int q0 = qt * 32;
        const int hr = r >> 3, qi = r & 7;
        const int ql = w * 8 + qi;
        const int tq = q0 + ql;
        const int head = g * 4 + hr;
        const int posq = pos[tq];
        __syncthreads();
        for (int i = tid; i < 4 * 800; i += 256) {
          int rr = i / 800, n = i % 800;
          int b;
          if (n < 16) b = n;
          else {
            float lr = logf((float)n / 16.f) / 4.1588830833596715f;
            b = 16 + (int)(lr * 16.f);
            if (b > 31) b = 31;
          }
          lut[i] = p.t5[b * 8 + g * 4 + rr] * LOG2E;
        }
        for (int i = tid; i < 32 * 132; i += 256) imp[i] = 0.f;
        __syncthreads();
        const float* lutr = lut + hr * 800;
        bf16x8 qf[8];
        load_q<128>(qf, P + (size_t)tq * NPO + 2048 + head * 128, h);
        const float sc = 0.08838834764831845f * LOG2E;
        f32x16 o[4];
        float* orow = NSAO + (size_t)tq * 1024 + head * 128;

        const int ncv = min(q0 / 16 + 1, 511);
        const int last_c = (ncv - 1) >> 6;
        float m = NEG, l = 0.f;
        CtxCmp cc{tq, posq, last_c, sc, lutr, pos, 0.f, imp, ql, false};
        zero_o(o);
        const bf16* KCg = (const bf16*)(ws + WS_KC) + (size_t)g * 512 * 128;
        const bf16* VCg = (const bf16*)(ws + WS_VCT) + (size_t)g * 128 * 512;
        attn_run<128, false, false>(qf, o, m, l, KCg, 128, nullptr, 0, VCg, 512, 0, cc, smem);
        float lt = l + __shfl_xor(l, 32);
        const bool has_c = m > -1e29f;
        float m2 = has_c ? m : 0.f;
        float invl = has_c ? 1.f / lt : 0.f;
        cc.invl = invl; cc.p2 = true;
        float l2 = 0.f;
        attn_run<128, true, false>(qf, o, m2, l2, KCg, 128, nullptr, 0, VCg, 512, 0, cc, smem);
        {
          float gs = sigm(GT[(size_t)tq * 24 + head * 3 + 0]) * invl;
#pragma unroll
          for (int d = 0; d < 4; ++d)
#pragma unroll
            for (int i4 = 0; i4 < 4; ++i4) {
              int dv0 = d * 32 + 8 * i4 + 4 * h;
              float4 v = make_float4(o[d][4 * i4] * gs, o[d][4 * i4 + 1] * gs, o[d][4 * i4 + 2] * gs, o[d][4 * i4 + 3] * gs);
              *(float4*)(orow + dv0) = v;
            }
        }
        __syncthreads();
        for (int q8 = 0; q8 < 8; ++q8) {
          const int qq = w * 8 + q8;
          const int tt = q0 + qq;
          const int cur = tt >> 6;
          const float* ip = imp + qq * 132;
          const int j0 = lane, j1 = lane + 64;
          const bool v0 = j0 <= cur, v1 = j1 <= cur;
          const bool f0 = (j0 == 0) || (j0 == cur) || (j0 == cur - 1);
          const bool f1 = (j1 == cur) || (j1 == cur - 1);
          const int nforced = cur == 0 ? 1 : (cur == 1 ? 2 : 3);
          const int nfree = 16 - nforced;
          const float a0 = ip[j0], a1 = ip[j1];
          int r0 = 0, r1 = 0;
          for (int jj = 0; jj <= cur; ++jj) {
            bool fj = (jj == 0) || (jj == cur) || (jj == cur - 1);
            if (fj) continue;
            float vj = ip[jj];
            r0 += (vj > a0 || (vj == a0 && jj < j0)) ? 1 : 0;
            r1 += (vj > a1 || (vj == a1 && jj < j1)) ? 1 : 0;
          }
          bool s0 = v0 && (f0 || r0 < nfree);
          bool s1 = v1 && (f1 || r1 < nfree);
          unsigned long long b0 = __ballot(s0), b1 = __ballot(s1);
          if (lane == 0) {
            sel[qq * 4 + 0] = (unsigned)b0; sel[qq * 4 + 1] = (unsigned)(b0 >> 32);
            sel[qq * 4 + 2] = (unsigned)b1; sel[qq * 4 + 3] = (unsigned)(b1 >> 32);
          }
        }
        __syncthreads();
        unsigned un0, un1, un2, un3;
        {
          un0 = sel[r * 4 + 0]; un1 = sel[r * 4 + 1]; un2 = sel[r * 4 + 2]; un3 = sel[r * 4 + 3];
#pragma unroll
          for (int of = 1; of < 32; of <<= 1) {
            un0 |= __shfl_xor(un0, of); un1 |= __shfl_xor(un1, of); un2 |= __shfl_xor(un2, of); un3 |= __shfl_xor(un3, of);
          }
          un0 = __builtin_amdgcn_readfirstlane(un0); un1 = __builtin_amdgcn_readfirstlane(un1);
          un2 = __builtin_amdgcn_readfirstlane(un2); un3 = __builtin_amdgcn_readfirstlane(un3);
        }
        {
          CtxSlc cs{tq, posq, sc, lutr, pos, (unsigned long long)un0 | ((unsigned long long)un1 << 32),
                    (unsigned long long)un2 | ((unsigned long long)un3 << 32),
                    (unsigned long long)sel[ql * 4] | ((unsigned long long)sel[ql * 4 + 1] << 32),
                    (unsigned long long)sel[ql * 4 + 2] | ((unsigned long long)sel[ql * 4 + 3] << 32)};
          zero_o(o);
          m = NEG; l = 0.f;
          attn_run<128, true, false>(qf, o, m, l, P + 3584 + g * 128, NPO, nullptr, 0,
                              (const bf16*)(ws + WS_VTSLC) + (size_t)g * 128 * L, L, 0, cs, smem);
          lt = l + __shfl_xor(l, 32);
          float gs = sigm(GT[(size_t)tq * 24 + head * 3 + 1]) / lt;
#pragma unroll
          for (int d = 0; d < 4; ++d)
#pragma unroll
            for (int i4 = 0; i4 < 4; ++i4) {
              int dv0 = d * 32 + 8 * i4 + 4 * h;
              float4 v = *(float4*)(orow + dv0);
              v.x += o[d][4 * i4] * gs; v.y += o[d][4 * i4 + 1] * gs; v.z += o[d][4 * i4 + 2] * gs; v.w += o[d][4 * i4 + 3] * gs;
              *(float4*)(orow + dv0) = v;
            }
        }
        {
          const int kfirst = q0 - 511 > 0 ? (q0 - 511) >> 6 : 0;
          CtxWin cwn{tq, posq, (q0 + 31) >> 6, sc, lutr, pos};
          zero_o(o);
          m = NEG; l = 0.f;
          attn_run<128, true, false>(qf, o, m, l, P + 4096 + g * 128, NPO, nullptr, 0,
                              (const bf16*)(ws + WS_VTWIN) + (size_t)g * 128 * L, L, kfirst, cwn, smem);
          lt = l + __shfl_xor(l, 32);
          float gs = sigm(GT[(size_t)tq * 24 + head * 3 + 2]) / lt;
          const bf16* grow = P + (size_t)tq * NPO + 4608 + head * 128;
          bf16* mrow = MIXED + (size_t)tq * MIXW + 1024 + head * 128;
#pragma unroll
          for (int d = 0; d < 4; ++d)
#pragma unroll
            for (int i4 = 0; i4 < 4; ++i4) {
              int dv0 = d * 32 + 8 * i4 + 4 * h;
              float4 v = *(float4*)(orow + dv0);
              v.x += o[d][4 * i4] * gs; v.y += o[d][4 * i4 + 1] * gs; v.z += o[d][4 * i4 + 2] * gs; v.w += o[d][4 * i4 + 3] * gs;
              uint2 gu = *(const uint2*)(grow + dv0);
              uint2 ou;
              ou.x = pack2(v.x * silu(bflo(gu.x)), v.y * silu(bfhi(gu.x)));
              ou.y = pack2(v.z * silu(bflo(gu.y)), v.w * silu(bfhi(gu.y)));
              *(uint2*)(mrow + dv0) = ou;
            }
        }
      }
    }
    if ((PHM & 512) && sub == 4) {
      const float* hin = layer == 0 ? p.x : hbuf;
      for (int t = bid; t < 64 * 16; t += nb) {
        const int m0 = (t >> 4) * 128, n0 = (t & 15) * 128;
        ALin af{MIXED + (size_t)m0 * MIXW, MIXW};
        gemm_tile(af, (const bf16*)(ws + WS_WOUT) + (size_t)n0 * MIXW, MIXW, MIXW, smem, [&](const float* Cs) {
          const int tid2 = otid();
#pragma unroll
          for (int j = 0; j < 16; ++j) {
            int c = tid2 + 256 * j;
            int row = c >> 5, cc = (c & 31) * 4;
            float4 a = *(const float4*)(Cs + row * 132 + cc);
            float4 hv = *(const float4*)(hin + (size_t)(m0 + row) * DM + n0 + cc);
            hv.x += a.x; hv.y += a.y; hv.z += a.z; hv.w += a.w;
            *(float4*)(hbuf + (size_t)(m0 + row) * DM + n0 + cc) = hv;
          }
        });
      }
    }
  }
}

extern "C" void kernel_launch(void* const* d_in, const int* in_sizes, int n_in, void* d_out, int out_size, void* d_ws,
                              size_t ws_size, hipStream_t stream) {
  Params p{};
  p.x = (const float*)d_in[0]; p.mem = (const float*)d_in[1]; p.pos = (const int*)d_in[2];
  p.norm_g = (const float*)d_in[3]; p.mem_norm_g = (const float*)d_in[4]; p.final_norm_g = (const float*)d_in[5];
  p.t5 = (const float*)d_in[6]; p.w_out = (const float*)d_in[7]; p.mem_w_kv = (const float*)d_in[8];
  p.even_w_in = (const float*)d_in[9]; p.lam_re = (const float*)d_in[10]; p.lam_im = (const float*)d_in[11];
  p.log_dt = (const float*)d_in[12]; p.b_re = (const float*)d_in[13]; p.b_im = (const float*)d_in[14];
  p.c_re = (const float*)d_in[15]; p.c_im = (const float*)d_in[16]; p.s5_d = (const float*)d_in[17];
  p.w_glu = (const float*)d_in[18]; p.fox_b_f = (const float*)d_in[19]; p.odd_w_in = (const float*)d_in[20];
  p.g_cq = (const float*)d_in[21]; p.g_ckv = (const float*)d_in[22]; p.w_uq = (const float*)d_in[23];
  p.w_ukv = (const float*)d_in[24]; p.cmp_pe = (const float*)d_in[25]; p.cmp_w1 = (const float*)d_in[26];
  p.cmp_w2 = (const float*)d_in[27];
  p.out = (float*)d_out; p.ws = (char*)d_ws;
  if (ws_size < WS_END) fprintf(stderr, "workspace too small: %zu < %zu\n", ws_size, (size_t)WS_END);
  static int grid_blocks = 0;
  if (!grid_blocks) {
    int dev = 0, cus = 0, per_cu = 0;
    hipGetDevice(&dev);
    hipDeviceGetAttribute(&cus, hipDeviceAttributeMultiprocessorCount, dev);
    hipOccupancyMaxActiveBlocksPerMultiprocessor(&per_cu, mega, 256, 0);
    if (per_cu > 2) per_cu = 2;
    if (per_cu < 1) per_cu = 1;
    grid_blocks = cus * per_cu;
  }
#if MULTI_LAUNCH
  for (int ph = 0; ph <= 24; ++ph) {
    int lo = ph, hi = ph;
    void* args[] = {&p, &lo, &hi};
    hipLaunchCooperativeKernel((void*)mega, dim3(grid_blocks), dim3(256), args, 0, stream);
  }
#else
  int lo = 0, hi = 24;
  void* args[] = {&p, &lo, &hi};
  hipError_t e = hipLaunchCooperativeKernel((void*)mega, dim3(grid_blocks), dim3(256), args, 0, stream);
  if (e != hipSuccess) fprintf(stderr, "cooperative launch failed: %s (grid %d)\n", hipGetErrorString(e), grid_blocks);
#endif
}
```

```cpp
#include <hip/hip_runtime.h>
#include <hip/hip_cooperative_groups.h>
#include <cstdio>
#include <cstdint>
namespace cg = cooperative_groups;

typedef unsigned short bf16;
typedef short bf16x8 __attribute__((ext_vector_type(8)));
typedef float f32x16 __attribute__((ext_vector_type(16)));
typedef float f32x4 __attribute__((ext_vector_type(4)));
typedef __bf16 bf2v __attribute__((ext_vector_type(2)));
typedef float f2v __attribute__((ext_vector_type(2)));

#define DI __device__ __forceinline__
#define MFMA32(a, b, c) __builtin_amdgcn_mfma_f32_32x32x16_bf16((a), (b), (c), 0, 0, 0)

#ifndef LB2
#define LB2 2
#endif
#ifndef REP_PH
#define REP_PH -1
#endif
#ifndef PHM
#define PHM 1023
#endif
#ifndef MULTI_LAUNCH
#define MULTI_LAUNCH 0
#endif

constexpr int L = 8192;
constexpr int DM = 2048;
constexpr int NPE = 7296;
constexpr int NPO = 6784;
constexpr int EVEN_IN = 7176;
constexpr int ODD_IN = 6744;
constexpr int MIXW = 2560;
constexpr float LOG2E = 1.4426950408889634f;
constexpr float NEG = -1e30f;
constexpr float EPS = 1e-6f;

constexpr size_t MB = 1024 * 1024;
constexpr size_t WS_WIN = 0;
constexpr size_t WS_WOUT = WS_WIN + 30 * MB;
constexpr size_t WS_WMEM = WS_WOUT + 10 * MB;
constexpr size_t WS_WMISC = WS_WMEM + 4 * MB;
constexpr size_t WS_XN = WS_WMISC + 8 * MB;
constexpr size_t WS_MEMN = WS_XN + 32 * MB;
constexpr size_t WS_P = WS_MEMN + 1 * MB;
constexpr size_t WS_MIXED = WS_P + 114 * MB;
constexpr size_t WS_MEMK = WS_MIXED + 40 * MB;
constexpr size_t WS_MEMVT = WS_MEMK + 256 * 1024;
constexpr size_t WS_ROPEC = WS_MEMVT + 256 * 1024;
constexpr size_t WS_ROPES = WS_ROPEC + 1 * MB;
constexpr size_t WS_FLOG = WS_ROPES + 1 * MB;
constexpr size_t WS_CUML = WS_FLOG + 1 * MB;
constexpr size_t WS_CT = WS_CUML + 256 * 1024;
constexpr size_t WS_S5P = WS_CT + 4096;
constexpr size_t WS_S5E = WS_S5P + 1 * MB;
constexpr size_t WS_CMPB = WS_S5E + 2 * MB;
constexpr size_t WS_VAR = WS_CMPB + 64 * 1024;
constexpr size_t WS_Z = WS_VAR;
constexpr size_t WS_VTFOX = WS_Z + 16 * MB;
constexpr size_t WS_QMLA = WS_VAR;
constexpr size_t WS_KMLA = WS_QMLA + 24 * MB;
constexpr size_t WS_VTMLA = WS_KMLA + 16 * MB;
constexpr size_t WS_VTSLC = WS_VTMLA + 16 * MB;
constexpr size_t WS_VTWIN = WS_VTSLC + 4 * MB;
constexpr size_t WS_HID = WS_VTWIN + 4 * MB;
constexpr size_t WS_KC = WS_HID + 1 * MB;
constexpr size_t WS_VCT = WS_KC + 256 * 1024;
constexpr size_t WS_NSAO = WS_VCT + 256 * 1024;
constexpr size_t WS_END = WS_NSAO + 32 * MB;
constexpr size_t WM_GLU = 0;
constexpr size_t WM_UQ = 0;
constexpr size_t WM_UKV = WM_UQ + 1536 * 512 * 2;
constexpr size_t WM_W1 = WM_UKV + 2048 * 512 * 2;
constexpr size_t WM_W2 = WM_W1 + 2 * 256 * 4096 * 2;

constexpr int SM_EXTRA = 73728;
constexpr int SM_TOTAL = 73728 + 1024;

struct Params {
  const float *x, *mem;
  const int* pos;
  const float *norm_g, *mem_norm_g, *final_norm_g, *t5, *w_out, *mem_w_kv, *even_w_in, *lam_re, *lam_im, *log_dt,
      *b_re, *b_im, *c_re, *c_im, *s5_d, *w_glu, *fox_b_f, *odd_w_in, *g_cq, *g_ckv, *w_uq, *w_ukv, *cmp_pe,
      *cmp_w1, *cmp_w2;
  float* out;
  char* ws;
};

DI unsigned pack2(float a, float b) {
  f2v v = {a, b};
  bf2v r = __builtin_convertvector(v, bf2v);
  return __builtin_bit_cast(unsigned, r);
}
DI float bflo(unsigned u) { return __uint_as_float(u << 16); }
DI float bfhi(unsigned u) { return __uint_as_float(u & 0xffff0000u); }
DI float bf2f(bf16 v) { return __uint_as_float(((unsigned)v) << 16); }
DI bf16 f2bf(float f) { return (bf16)(pack2(f, 0.f) & 0xffffu); }
DI int otid() { int z; asm volatile("s_mov_b32 %0, 0" : "=s"(z)); return (int)threadIdx.x + z; }
DI int crow(int i, int h) { return (i & 3) + 8 * (i >> 2) + 4 * h; }
DI float sigm(float x) { return 1.f / (1.f + __expf(-x)); }
DI float silu(float x) { return x * sigm(x); }
DI float gelu_t(float x) {
  float u = 0.7978845608028654f * (x + 0.044715f * x * x * x);
  float e = __expf(2.f * u);
  float t = 1.f - 2.f / (e + 1.f);
  return 0.5f * x * (1.f + t);
}
DI float ex2(float x) { return __builtin_amdgcn_exp2f(x); }
DI float wave_sum(float v) {
#pragma unroll
  for (int o = 32; o > 0; o >>= 1) v += __shfl_xor(v, o);
  return v;
}
DI uint4 pack8(const float* v) {
  uint4 u;
  u.x = pack2(v[0], v[1]); u.y = pack2(v[2], v[3]); u.z = pack2(v[4], v[5]); u.w = pack2(v[6], v[7]);
  return u;
}

struct CvtSeg {
  const float* src; int lds; int sc0; bf16* dst; int dr0; int ncols; int npad; int K; const float* kscale;
};
DI int cvt_count(const CvtSeg& s) { return (s.K >> 6) * (s.npad >> 6); }
DI void cvt_tile(const CvtSeg& s, int tile, char* smem) {
  float* T = (float*)smem;
  const int tid = otid();
  const int nkt = s.K >> 6;
  const int kt = tile % nkt, nt = tile / nkt;
  const int k0 = kt * 64, n0 = nt * 64;
  __syncthreads();
#pragma unroll
  for (int i = 0; i < 16; ++i) {
    int idx = tid + 256 * i;
    int k = idx >> 6, n = idx & 63;
    float v = 0.f;
    if (n0 + n < s.ncols) {
      v = s.src[(size_t)(k0 + k) * s.lds + s.sc0 + n0 + n];
      if (s.kscale) v *= s.kscale[k0 + k];
    }
    T[k * 65 + n] = v;
  }
  __syncthreads();
#pragma unroll
  for (int j = 0; j < 2; ++j) {
    int c = tid + 256 * j;
    int n = c >> 3, kc = (c & 7) * 8;
    float v[8];
#pragma unroll
    for (int e = 0; e < 8; ++e) v[e] = T[(kc + e) * 65 + n];
    *(uint4*)(s.dst + (size_t)(s.dr0 + n0 + n) * s.K + k0 + kc) = pack8(v);
  }
}

enum { SET_IN_EVEN = 0, SET_IN_ODD, SET_OUT, SET_MEM, SET_MISC_EVEN, SET_MISC_ODD };
DI int cvt_nseg(int set) {
  switch (set) {
    case SET_IN_EVEN: return 3;
    case SET_IN_ODD: return 5;
    case SET_OUT: return 1;
    case SET_MEM: return 1;
    case SET_MISC_EVEN: return 1;
    default: return 6;
  }
}
DI CvtSeg cvt_get(const Params& p, int set, int li, int s) {
  CvtSeg r;
  r.kscale = nullptr;
  char* ws = p.ws;
  if (set == SET_IN_EVEN) {
    r.src = p.even_w_in + (size_t)li * DM * EVEN_IN; r.lds = EVEN_IN; r.K = DM; r.dst = (bf16*)(ws + WS_WIN);
    if (s == 0) { r.sc0 = 0; r.dr0 = 0; r.ncols = 5120; r.npad = 5120; }
    else if (s == 1) { r.sc0 = 5128; r.dr0 = 5120; r.ncols = 2048; r.npad = 2048; }
    else { r.sc0 = 5120; r.dr0 = 7168; r.ncols = 8; r.npad = 128; }
  } else if (set == SET_IN_ODD) {
    r.src = p.odd_w_in + (size_t)li * DM * ODD_IN; r.lds = ODD_IN; r.K = DM; r.dst = (bf16*)(ws + WS_WIN);
    if (s == 0) { r.sc0 = 0; r.dr0 = 0; r.ncols = 1024; r.npad = 1024; }
    else if (s == 1) { r.sc0 = 1088; r.dr0 = 1024; r.ncols = 3584; r.npad = 3584; }
    else if (s == 2) { r.sc0 = 4696; r.dr0 = 4608; r.ncols = 2048; r.npad = 2048; }
    else if (s == 3) { r.sc0 = 1024; r.dr0 = 6656; r.ncols = 64; r.npad = 64; }
    else { r.sc0 = 4672; r.dr0 = 6720; r.ncols = 24; r.npad = 64; }
  } else if (set == SET_OUT) {
    r.src = p.w_out + (size_t)li * MIXW * DM; r.lds = DM; r.K = MIXW; r.dst = (bf16*)(ws + WS_WOUT);
    r.sc0 = 0; r.dr0 = 0; r.ncols = DM; r.npad = DM;
  } else if (set == SET_MEM) {
    r.src = p.mem_w_kv + (size_t)li * DM * 1024; r.lds = 1024; r.K = DM; r.dst = (bf16*)(ws + WS_WMEM);
    r.sc0 = 0; r.dr0 = 0; r.ncols = 1024; r.npad = 1024;
  } else if (set == SET_MISC_EVEN) {
    r.src = p.w_glu + (size_t)li * 1024 * 1024; r.lds = 1024; r.K = 1024; r.dst = (bf16*)(ws + WS_WMISC + WM_GLU);
    r.sc0 = 0; r.dr0 = 0; r.ncols = 1024; r.npad = 1024;
  } else {
    r.sc0 = 0; r.dr0 = 0;
    if (s == 0) {
      r.src = p.w_uq + (size_t)li * 512 * 1536; r.lds = 1536; r.K = 512; r.dst = (bf16*)(ws + WS_WMISC + WM_UQ);
      r.ncols = 1536; r.npad = 1536; r.kscale = p.g_cq + li * 512;
    } else if (s == 1) {
      r.src = p.w_ukv + (size_t)li * 512 * 2048; r.lds = 2048; r.K = 512; r.dst = (bf16*)(ws + WS_WMISC + WM_UKV);
      r.ncols = 2048; r.npad = 2048; r.kscale = p.g_ckv + li * 512;
    } else if (s < 4) {
      int which = s - 2;
      r.src = p.cmp_w1 + (size_t)(li * 2 + which) * 4096 * 256; r.lds = 256; r.K = 4096;
      r.dst = (bf16*)(ws + WS_WMISC + WM_W1) + (size_t)which * 256 * 4096; r.ncols = 256; r.npad = 256;
    } else {
      int which = s - 4;
      r.src = p.cmp_w2 + (size_t)(li * 2 + which) * 256 * 128; r.lds = 128; r.K = 256;
      r.dst = (bf16*)(ws + WS_WMISC + WM_W2) + (size_t)which * 128 * 256; r.ncols = 128; r.npad = 128;
    }
  }
  return r;
}
DI int cvt_set_count(const Params& p, int set, int li) {
  int n = 0;
  for (int s = 0; s < cvt_nseg(set); ++s) n += cvt_count(cvt_get(p, set, li, s));
  return n;
}
DI void cvt_set_task(const Params& p, int set, int li, int t, char* smem) {
  const int ns = cvt_nseg(set);
  for (int s = 0; s < ns; ++s) {
    CvtSeg sg = cvt_get(p, set, li, s);
    int c = cvt_count(sg);
    if (t < c) { cvt_tile(sg, t, smem); return; }
    t -= c;
  }
}

DI void norm_row_bf16(const float* __restrict__ src, const float* __restrict__ g, bf16* __restrict__ dst, int lane) {
  float4 v[8];
  float ss = 0.f;
#pragma unroll
  for (int i = 0; i < 8; ++i) {
    v[i] = *(const float4*)(src + (i * 64 + lane) * 4);
    ss += v[i].x * v[i].x + v[i].y * v[i].y + v[i].z * v[i].z + v[i].w * v[i].w;
  }
  ss = wave_sum(ss);
  float r = rsqrtf(ss * (1.f / DM) + EPS);
#pragma unroll
  for (int i = 0; i < 8; ++i) {
    float4 gg = *(const float4*)(g + (i * 64 + lane) * 4);
    uint2 u;
    u.x = pack2(v[i].x * r * gg.x, v[i].y * r * gg.y);
    u.y = pack2(v[i].z * r * gg.z, v[i].w * r * gg.w);
    *(uint2*)(dst + (i * 64 + lane) * 4) = u;
  }
}
DI void norm_row_f32(float* __restrict__ io, const float* __restrict__ g, int lane) {
  float4 v[8];
  float ss = 0.f;
#pragma unroll
  for (int i = 0; i < 8; ++i) {
    v[i] = *(const float4*)(io + (i * 64 + lane) * 4);
    ss += v[i].x * v[i].x + v[i].y * v[i].y + v[i].z * v[i].z + v[i].w * v[i].w;
  }
  ss = wave_sum(ss);
  float r = rsqrtf(ss * (1.f / DM) + EPS);
#pragma unroll
  for (int i = 0; i < 8; ++i) {
    float4 gg = *(const float4*)(g + (i * 64 + lane) * 4);
    float4 o;
    o.x = v[i].x * r * gg.x; o.y = v[i].y * r * gg.y; o.z = v[i].z * r * gg.z; o.w = v[i].w * r * gg.w;
    *(float4*)(io + (i * 64 + lane) * 4) = o;
  }
}

struct ALin {
  const bf16* p; int ld;
  DI const bf16* operator()(int row, int k) const { return p + (size_t)row * ld + k; }
};
struct ACmp {
  const bf16* p; int m0;
  DI const bf16* operator()(int row, int k) const {
    int gr = m0 + row;
    if (gr > 1021) gr = 1021;
    int n = gr >> 1, g = gr & 1;
    return p + (size_t)(16 * n + (k >> 7)) * NPO + g * 128 + (k & 127);
  }
};

template <class AF, class Epi>
DI void gemm_tile(AF af, const bf16* __restrict__ Bt, int ldb, int K, char* smem, Epi epi) {
  const int tid = otid(), lane = tid & 63, w = tid >> 6, r = lane & 31, h = lane >> 5;
  const int wm = w >> 1, wn = w & 1;
  bf16* As = (bf16*)smem;
  bf16* Bs = As + 2 * 128 * 72;
  f32x16 acc[2][2];
#pragma unroll
  for (int a = 0; a < 2; ++a)
#pragma unroll
    for (int b = 0; b < 2; ++b)
#pragma unroll
      for (int i = 0; i < 16; ++i) acc[a][b][i] = 0.f;
  uint4 ra0_0, ra0_1, ra0_2, ra0_3, rb0_0, rb0_1, rb0_2, rb0_3, ra1_0, ra1_1, ra1_2, ra1_3, rb1_0, rb1_1, rb1_2, rb1_3;
#define LD1(S, I, K0)                                                                  \
  {                                                                                    \
    int c = tl + 256 * I;                                                              \
    int row = c >> 3, kc = (c & 7) * 8;                                                \
    ra##S##_##I = *(const uint4*)af(row, (K0) + kc);                                   \
    rb##S##_##I = *(const uint4*)(Bt + (size_t)row * ldb + (K0) + kc);                 \
  }
#define ST1(S, I, BUF)                                                                 \
  {                                                                                    \
    int c = tid + 256 * I;                                                             \
    int row = c >> 3, kc = (c & 7) * 8;                                                \
    *(uint4*)(As + (BUF) * 9216 + row * 72 + kc) = ra##S##_##I;                        \
    *(uint4*)(Bs + (BUF) * 9216 + row * 72 + kc) = rb##S##_##I;                        \
  }
#define GLOAD(S, K0) { const int tl = otid(); LD1(S, 0, K0) LD1(S, 1, K0) LD1(S, 2, K0) LD1(S, 3, K0) }
#define SSTORE(S, BUF) { ST1(S, 0, BUF) ST1(S, 1, BUF) ST1(S, 2, BUF) ST1(S, 3, BUF) }
  auto compute = [&](int buf) {
    const bf16* a_ = As + buf * 9216;
    const bf16* b_ = Bs + buf * 9216;
#pragma unroll
    for (int ks = 0; ks < 4; ++ks) {
      bf16x8 fa[2], fb[2];
#pragma unroll
      for (int mb = 0; mb < 2; ++mb) fa[mb] = *(const bf16x8*)(a_ + (wm * 64 + mb * 32 + r) * 72 + ks * 16 + h * 8);
#pragma unroll
      for (int nb = 0; nb < 2; ++nb) fb[nb] = *(const bf16x8*)(b_ + (wn * 64 + nb * 32 + r) * 72 + ks * 16 + h * 8);
#pragma unroll
      for (int mb = 0; mb < 2; ++mb)
#pragma unroll
        for (int nb = 0; nb < 2; ++nb) acc[mb][nb] = MFMA32(fa[mb], fb[nb], acc[mb][nb]);
    }
  };
  __syncthreads();
  const int nk = K >> 6;
  GLOAD(0, 0);
  SSTORE(0, 0);
  GLOAD(0, 64);
  __syncthreads();
  for (int kt = 0; kt < nk; kt += 2) {
    if (kt + 2 < nk) GLOAD(1, (kt + 2) * 64);
    compute(0);
    SSTORE(0, 1);
    __syncthreads();
    if (kt + 3 < nk) GLOAD(0, (kt + 3) * 64);
    compute(1);
    if (kt + 2 < nk) SSTORE(1, 0);
    __syncthreads();
  }
#undef GLOAD
#undef SSTORE
#undef LD1
#undef ST1
  float* Cs = (float*)smem;
#pragma unroll
  for (int mb = 0; mb < 2; ++mb)
#pragma unroll
    for (int nb = 0; nb < 2; ++nb)
#pragma unroll
      for (int i = 0; i < 16; ++i)
        Cs[(wm * 64 + mb * 32 + crow(i, h)) * 132 + wn * 64 + nb * 32 + r] = acc[mb][nb][i];
  __syncthreads();
  epi(Cs);
}

DI void tile_map(int t, int ntn, int& tm, int& tn) {
  const int per = 8 * ntn;
  const int grp = t / per, rem = t - grp * per;
  tm = grp * 8 + (rem & 7);
  tn = rem >> 3;
}
template <class F>
DI void epi_rows(const float* Cs, F f) {
  const int tid = otid();
#pragma unroll
  for (int j = 0; j < 8; ++j) {
    int c = tid + 256 * j;
    int row = c >> 4, cc = (c & 15) * 8;
    float v[8];
    float4 a = *(const float4*)(Cs + row * 132 + cc);
    float4 b = *(const float4*)(Cs + row * 132 + cc + 4);
    v[0] = a.x; v[1] = a.y; v[2] = a.z; v[3] = a.w; v[4] = b.x; v[5] = b.y; v[6] = b.z; v[7] = b.w;
    f(row, cc, v);
  }
}
template <class F>
DI void epi_cols(const float* Cs, F f) {
  const int tid = otid();
#pragma unroll
  for (int j = 0; j < 8; ++j) {
    int c = tid + 256 * j;
    int col = c & 127, r8 = (c >> 7) * 8;
    float v[8];
#pragma unroll
    for (int e = 0; e < 8; ++e) v[e] = Cs[(r8 + e) * 132 + col];
    f(col, r8, v);
  }
}
template <class F>
DI void epi_rope(const float* Cs, int cb, int m0, const float* rc, const float* rs, float scale_unused, F f) {
  const int tid = otid();
#pragma unroll
  for (int j = 0; j < 2; ++j) {
    int c = tid + 256 * j;
    int row = c >> 2, cc = (c & 3) * 8;
    float x1[8], x2[8], o1[8], o2[8];
#pragma unroll
    for (int e = 0; e < 8; ++e) {
      x1[e] = Cs[row * 132 + cb + cc + e];
      x2[e] = Cs[row * 132 + cb + 32 + cc + e];
    }
    const float* pc = rc + (size_t)(m0 + row) * 32 + cc;
    const float* ps = rs + (size_t)(m0 + row) * 32 + cc;
#pragma unroll
    for (int e = 0; e < 8; ++e) {
      float cs = pc[e], sn = ps[e];
      o1[e] = x1[e] * cs - x2[e] * sn;
      o2[e] = x1[e] * sn + x2[e] * cs;
    }
    f(row, cc, o1);
    f(row, cc + 32, o2);
  }
}

template <int DK>
struct KVPre {
  uint4 k[DK / 32];
  uint4 v[4];
  float aux;
};
constexpr int AT_VS = 25600;
constexpr int AT_AUX = 43008;
constexpr int AT_X0 = 43264;
constexpr int AT_IMP = AT_X0 + 12800;
constexpr int AT_SEL = AT_IMP + 16896;

template <int DK, bool PV, class SF, class PH>
DI void attn_tile(const bf16x8 (&qf)[DK / 16], f32x16 (&o)[4], float& m, float& l, const char* smem, SF sf, PH ph) {
  const int lane = otid() & 63, r = lane & 31, h = lane >> 5;
  const bf16* Ks = (const bf16*)smem;
  const bf16* Vs = (const bf16*)(smem + AT_VS);
  const float* auxs = (const float*)(smem + AT_AUX);
  f32x16 s[2];
#pragma unroll
  for (int kb = 0; kb < 2; ++kb) {
#pragma unroll
    for (int i = 0; i < 16; ++i) s[kb][i] = 0.f;
#pragma unroll
    for (int ks = 0; ks < DK / 16; ++ks) {
      bf16x8 a = *(const bf16x8*)(Ks + (kb * 32 + r) * (DK + 8) + ks * 16 + h * 8);
      s[kb] = MFMA32(a, qf[ks], s[kb]);
    }
  }
  float mx = m;
#pragma unroll
  for (int kb = 0; kb < 2; ++kb)
#pragma unroll
    for (int i = 0; i < 16; ++i) {
      int kl = kb * 32 + crow(i, h);
      float v = sf(s[kb][i], kl, auxs[kl]);
      s[kb][i] = v;
      mx = fmaxf(mx, v);
    }
  mx = fmaxf(mx, __shfl_xor(mx, 32));
  float alpha = ex2(m - mx);
  m = mx;
  float psum = 0.f;
#pragma unroll
  for (int kb = 0; kb < 2; ++kb)
#pragma unroll
    for (int i = 0; i < 16; ++i) {
      float pv = ex2(s[kb][i] - mx);
      s[kb][i] = pv;
      psum += pv;
    }
  l = l * alpha + psum;
  ph(0, s[0]);
  ph(1, s[1]);
  if (PV) {
#pragma unroll
    for (int d = 0; d < 4; ++d)
#pragma unroll
      for (int i = 0; i < 16; ++i) o[d][i] *= alpha;
#pragma unroll
    for (int st = 0; st < 4; ++st) {
      const int kb = st >> 1, s2 = st & 1;
      uint4 pu;
      pu.x = pack2(s[kb][8 * s2 + 0], s[kb][8 * s2 + 1]);
      pu.y = pack2(s[kb][8 * s2 + 2], s[kb][8 * s2 + 3]);
      pu.z = pack2(s[kb][8 * s2 + 4], s[kb][8 * s2 + 5]);
      pu.w = pack2(s[kb][8 * s2 + 6], s[kb][8 * s2 + 7]);
      bf16x8 pf = __builtin_bit_cast(bf16x8, pu);
#pragma unroll
      for (int d = 0; d < 4; ++d) {
        const bf16* vp = Vs + (d * 32 + r) * 68 + st * 16 + 4 * h;
        uint2 lo = *(const uint2*)vp;
        uint2 hi = *(const uint2*)(vp + 8);
        uint4 vu = make_uint4(lo.x, lo.y, hi.x, hi.y);
        bf16x8 vf = __builtin_bit_cast(bf16x8, vu);
        o[d] = MFMA32(vf, pf, o[d]);
      }
    }
  }
}

struct NoHook { DI void operator()(int, const f32x16&) const {} };

template <int DK, bool PV, bool PF, class Ctx>
DI void attn_run(const bf16x8 (&qf)[DK / 16], f32x16 (&o)[4], float& m, float& l, const bf16* K1, int ldk1,
                 const bf16* K2, int ldk2, const bf16* Vt, int ldv, int first, Ctx& ctx, char* smem) {
  const int tid = otid();
  int tcur = first;
  if (tcur < 0) return;
  constexpr int CPR = DK / 8;
  constexpr int NKC = DK / 32;
  uint4 rk0, rk1, rk2, rk3, rk4 = make_uint4(0, 0, 0, 0), rk5 = make_uint4(0, 0, 0, 0), rv[4];
  float raux;
  bf16* Ks = (bf16*)smem;
  bf16* Vs = (bf16*)(smem + AT_VS);
  auto ldk = [&](int i, int key0) -> uint4 {
    int c = otid() + 256 * i;
    int row = c / CPR, cc = c % CPR;
    const bf16* src;
    if (DK == 128 || cc < 16) src = K1 + (size_t)(key0 + row) * ldk1 + cc * 8;
    else src = K2 + (size_t)(key0 + row) * ldk2 + (cc - 16) * 8;
    return *(const uint4*)src;
  };
  auto stk = [&](int i, const uint4& v) {
    int c = tid + 256 * i;
    int row = c / CPR, cc = c % CPR;
    *(uint4*)(Ks + row * (DK + 8) + cc * 8) = v;
  };
  auto gload = [&](int key0) {
    rk0 = ldk(0, key0); rk1 = ldk(1, key0); rk2 = ldk(2, key0); rk3 = ldk(3, key0);
    if (NKC > 4) { rk4 = ldk(4, key0); rk5 = ldk(5, key0); }
    const int tl = otid();
#pragma unroll
    for (int i = 0; i < 4; ++i) {
      int c = tl + 256 * i;
      int d = c >> 3, cc = c & 7;
      rv[i] = *(const uint4*)(Vt + (size_t)d * ldv + key0 + cc * 8);
    }
    raux = (tid < 64) ? ctx.aux(key0 + tid) : 0.f;
  };
  auto sstore = [&]() {
    stk(0, rk0); stk(1, rk1); stk(2, rk2); stk(3, rk3);
    if (NKC > 4) { stk(4, rk4); stk(5, rk5); }
#pragma unroll
    for (int i = 0; i < 4; ++i) {
      int c = tid + 256 * i;
      int d = c >> 3, cc = c & 7;
      uint2* dst = (uint2*)(Vs + d * 68 + cc * 8);
      dst[0] = make_uint2(rv[i].x, rv[i].y);
      dst[1] = make_uint2(rv[i].z, rv[i].w);
    }
    if (tid < 64) ((float*)(smem + AT_AUX))[tid] = raux;
  };
  if (PF) gload(tcur * 64);
  while (tcur >= 0) {
    __syncthreads();
    if (!PF) gload(tcur * 64);
    sstore();
    __syncthreads();
    int tnext = ctx.next(tcur);
    if (PF && tnext >= 0) gload(tnext * 64);
    if (!ctx.skip(tcur)) {
      const int tc = tcur;
      attn_tile<DK, PV>(qf, o, m, l, smem,
                        [&](float s, int kl, float ax) { return ctx.score(s, tc * 64 + kl, ax, tc); },
                        [&](int kb, const f32x16& pt) { ctx.hook(kb, pt, tc); });
    }
    tcur = tnext;
  }
}

template <int DK>
DI void load_q(bf16x8 (&qf)[DK / 16], const bf16* qrow, int h) {
#pragma unroll
  for (int ks = 0; ks < DK / 16; ++ks) qf[ks] = *(const bf16x8*)(qrow + ks * 16 + h * 8);
}
DI void zero_o(f32x16 (&o)[4]) {
#pragma unroll
  for (int d = 0; d < 4; ++d)
#pragma unroll
    for (int i = 0; i < 16; ++i) o[d][i] = 0.f;
}

struct CtxCausal {
  int tq, q0w, last; float sc;
  DI int next(int t) const { return t + 1 <= last ? t + 1 : -1; }
  DI float aux(int) const { return 0.f; }
  DI bool skip(int t) const { return t * 64 > q0w + 31; }
  DI float score(float s, int key, float, int) const { return key <= tq ? s * sc : NEG; }
  DI void hook(int, const f32x16&, int) const {}
};
struct CtxFox {
  int tq, q0w, last; float sc, cq; const float* cuml; const float* cpre;
  DI int next(int t) const { return t + 1 <= last ? t + 1 : -1; }
  DI float aux(int key) const { return cuml[key] + cpre[key >> 7]; }
  DI bool skip(int t) const { return t * 64 > q0w + 31; }
  DI float score(float s, int key, float ax, int) const { return key <= tq ? s * sc + (cq - ax) * LOG2E : NEG; }
  DI void hook(int, const f32x16&, int) const {}
};
struct CtxMem {
  float sc;
  DI int next(int t) const { return t + 1 < 4 ? t + 1 : -1; }
  DI float aux(int) const { return 0.f; }
  DI bool skip(int) const { return false; }
  DI float score(float s, int, float, int) const { return s * sc; }
  DI void hook(int, const f32x16&, int) const {}
};

DI void store_out_A(const f32x16 (&o)[4], float inv_l, const bf16* grow, bf16* orow, int h) {
#pragma unroll
  for (int d = 0; d < 4; ++d)
#pragma unroll
    for (int i4 = 0; i4 < 4; ++i4) {
      int dv0 = d * 32 + 8 * i4 + 4 * h;
      uint2 gu = *(const uint2*)(grow + dv0);
      float g0 = bflo(gu.x), g1 = bfhi(gu.x), g2 = bflo(gu.y), g3 = bfhi(gu.y);
      uint2 ou;
      ou.x = pack2(o[d][4 * i4 + 0] * inv_l * silu(g0), o[d][4 * i4 + 1] * inv_l * silu(g1));
      ou.y = pack2(o[d][4 * i4 + 2] * inv_l * silu(g2), o[d][4 * i4 + 3] * inv_l * silu(g3));
      *(uint2*)(orow + dv0) = ou;
    }
}

        struct CtxCmp {
          int tq, posq, last; float sc; const float* lutr; const int* pos; float invl; float* imp; int ql; bool p2;
          DI int next(int t) const { return t + 1 <= last ? t + 1 : -1; }
          DI float aux(int key) const { int n = key < 511 ? key : 510; return __int_as_float(pos[16 * n + 31]); }
          DI bool skip(int) const { return false; }
          DI float score(float s, int key, float ax, int) const {
            bool valid = (16 * key + 31 <= tq) && key < 511;
            int d = posq - __float_as_int(ax);
            d = d < 0 ? 0 : (d > 799 ? 799 : d);
            return valid ? s * sc + lutr[d] : NEG;
          }
          DI void hook(int kb, const f32x16& pt, int tc) const {
            if (!p2) return;
            const int lane = otid() & 63, h = lane >> 5, r = lane & 31;
#pragma unroll
            for (int gq = 0; gq < 4; ++gq) {
              float p3 = 0.5f * pt[4 * gq + 3];
              float vm = (pt[4 * gq] + pt[4 * gq + 1] + pt[4 * gq + 2] + p3) * invl;
              float vs = p3 * invl;
              vm += __shfl_xor(vm, 8); vm += __shfl_xor(vm, 16);
              vs += __shfl_xor(vs, 8); vs += __shfl_xor(vs, 16);
              int j = tc * 16 + kb * 8 + 2 * gq + h;
              if (r < 8) { atomicAdd(&imp[ql * 132 + j], vm); atomicAdd(&imp[ql * 132 + j + 1], vs); }
            }
          }
        };
struct CtxSlc {
  int tq, posq; float sc; const float* lutr; const int* pos; unsigned long long ulo, uhi, mlo, mhi;
  DI bool inu(int j) const {
    unsigned long long a = (ulo >> (j & 63)) & (j < 64 ? 1ull : 0ull);
    unsigned long long b = (uhi >> (j & 63)) & (j >= 64 ? 1ull : 0ull);
    return (a | b) != 0ull;
  }
  DI bool mine(int j) const {
    unsigned long long a = (mlo >> (j & 63)) & (j < 64 ? 1ull : 0ull);
    unsigned long long b = (mhi >> (j & 63)) & (j >= 64 ? 1ull : 0ull);
    return (a | b) != 0ull;
  }
  DI int next(int t) const { for (int j = t + 1; j < 128; ++j) if (inu(j)) return j; return -1; }
  DI float aux(int key) const { return __int_as_float(pos[key]); }
  DI bool skip(int) const { return false; }
  DI float score(float s, int key, float ax, int t) const {
    bool valid = mine(t) && key <= tq;
    int d = posq - __float_as_int(ax);
    d = d < 0 ? 0 : (d > 799 ? 799 : d);
    return valid ? s * sc + lutr[d] : NEG;
  }
  DI void hook(int, const f32x16&, int) const {}
};
struct CtxWin {
  int tq, posq, last; float sc; const float* lutr; const int* pos;
  DI int next(int t) const { return t + 1 <= last ? t + 1 : -1; }
  DI float aux(int key) const { return __int_as_float(pos[key]); }
  DI bool skip(int) const { return false; }
  DI float score(float s, int key, float ax, int) const {
    bool valid = key <= tq && (tq - key) < 512;
    int d = posq - __float_as_int(ax);
    d = d < 0 ? 0 : (d > 799 ? 799 : d);
    return valid ? s * sc + lutr[d] : NEG;
  }
  DI void hook(int, const f32x16&, int) const {}
};

__global__ void __launch_bounds__(256, LB2) mega(Params p, int ph_lo, int ph_hi) {
  __shared__ __attribute__((aligned(16))) char smem[SM_TOTAL];
  const int bid = blockIdx.x, nb = gridDim.x;

  for (int ph = ph_lo; ph <= ph_hi; ++ph) {
    if (ph > ph_lo) cg::this_grid().sync();
    const int nrep = (ph == REP_PH) ? 2 : 1;
    for (int rep = 0; rep < nrep; ++rep) {
    if (rep) cg::this_grid().sync();
    const int tid = otid(), lane = tid & 63, w = tid >> 6, r = lane & 31, h = lane >> 5;
    const int vb = (bid & 7) * (nb >> 3) + (bid >> 3);
    char* ws = p.ws + (tid - (int)threadIdx.x);
    bf16* XN = (bf16*)(ws + WS_XN);
    bf16* P = (bf16*)(ws + WS_P);
    bf16* MIXED = (bf16*)(ws + WS_MIXED);
    float* ROPEC = (float*)(ws + WS_ROPEC);
    float* ROPES = (float*)(ws + WS_ROPES);
    float* hbuf = p.out;
    const int layer = ph == 0 ? 0 : (ph - 1) / 6;
    const int sub = ph == 0 ? -1 : (ph - 1) % 6;
    const bool even = (layer & 1) == 0;
    const int li = layer >> 1;
    const int NP = even ? NPE : NPO;

    if ((PHM & 1) && (ph == 0 || sub == 5)) {
      if (ph == 0) {
        for (int i = bid * 256 + tid; i < L * 32; i += nb * 256) {
          int t = i >> 5, f = i & 31;
          float inv = powf(10000.f, -(float)f / 32.f);
          float ang = (float)p.pos[t] * inv;
          ROPEC[i] = cosf(ang);
          ROPES[i] = sinf(ang);
        }
        for (int row = bid * 4 + w; row < 256; row += nb * 4)
          norm_row_bf16(p.mem + (size_t)row * DM, p.mem_norm_g, (bf16*)(ws + WS_MEMN) + (size_t)row * DM, lane);
      }
      const int nl = ph == 0 ? 0 : layer + 1;
      if (nl < 4) {
        const float* src = ph == 0 ? p.x : hbuf;
        for (int row = bid * 4 + w; row < L; row += nb * 4)
          norm_row_bf16(src + (size_t)row * DM, p.norm_g + nl * DM, XN + (size_t)row * DM, lane);
      } else {
        for (int row = bid * 4 + w; row < L; row += nb * 4) norm_row_f32(hbuf + (size_t)row * DM, p.final_norm_g, lane);
      }
    }
    if ((PHM & 2) && (ph == 0 || sub == 4)) {
      const int nl = ph == 0 ? 0 : layer + 1;
      if (nl < 4) {
        const bool ne = (nl & 1) == 0;
        const int nli = nl >> 1;
        const int s0 = ne ? SET_IN_EVEN : SET_IN_ODD, s2 = ne ? SET_MISC_EVEN : SET_MISC_ODD;
        const int c0 = cvt_set_count(p, s0, nli), c1 = cvt_set_count(p, SET_MEM, nl), c2 = cvt_set_count(p, s2, nli);
        const int cx = ne ? 16 : 32;
        for (int t = bid; t < c0 + c1 + c2 + cx; t += nb) {
          if (t < c0) cvt_set_task(p, s0, nli, t, smem);
          else if (t < c0 + c1) cvt_set_task(p, SET_MEM, nl, t - c0, smem);
          else if (t < c0 + c1 + c2) cvt_set_task(p, s2, nli, t - c0 - c1, smem);
          else {
            int e = t - c0 - c1 - c2;
            if (ne) {
              float* S5P = (float*)(ws + WS_S5P);
              int gp = e * 256 + tid;
              int g = gp >> 6;
              float dt = expf(p.log_dt[nli * 64 + g]);
              float lr = p.lam_re[nli * 4096 + gp], lim = p.lam_im[nli * 4096 + gp];
              float mag = expf(lr * dt);
              float abr = mag * cosf(lim * dt), abi = mag * sinf(lim * dt);
              float den = lr * lr + lim * lim;
              float nr = abr - 1.f;
              float fre = (nr * lr + abi * lim) / den;
              float fim = (abi * lr - nr * lim) / den;
              S5P[gp] = abr;
              S5P[4096 + gp] = abi;
              float ar = abr, ai = abi;
#pragma unroll
              for (int q = 0; q < 7; ++q) { float nr2 = ar * ar - ai * ai; ai = 2.f * ar * ai; ar = nr2; }
              S5P[8192 + gp] = ar;
              S5P[12288 + gp] = ai;
              const float* br = p.b_re + (size_t)nli * 65536 + gp * 16;
              const float* bi = p.b_im + (size_t)nli * 65536 + gp * 16;
#pragma unroll
              for (int c = 0; c < 16; ++c) {
                S5P[16384 + gp * 16 + c] = fre * br[c] - fim * bi[c];
                S5P[16384 + 65536 + gp * 16 + c] = fre * bi[c] + fim * br[c];
              }
            } else {
              int which = e >> 4, part = e & 15;
              const float* pe = p.cmp_pe + (size_t)(nli * 2 + which) * 4096 + part * 256;
              const float* w1 = p.cmp_w1 + ((size_t)(nli * 2 + which) * 4096 + part * 256) * 256 + tid;
              float acc = 0.f;
#pragma unroll 8
              for (int k = 0; k < 256; ++k) acc += pe[k] * w1[(size_t)k * 256];
              ((float*)(ws + WS_CMPB))[(which * 16 + part) * 256 + tid] = acc;
            }
          }
        }
      }
    }
    if ((PHM & 4) && sub == 0) {
      const int ntn = NP / 128;
      const int n_in = 64 * ntn;
      const bf16* Win = (const bf16*)(ws + WS_WIN);
      for (int t = vb; t < n_in + 16; t += nb) {
        if (t < n_in) {
          int tm, tn;
          tile_map(t, ntn, tm, tn);
          const int m0 = tm * 128, n0 = tn * 128;
          ALin af{XN + (size_t)m0 * DM, DM};
          if (even) {
            gemm_tile(af, Win + (size_t)n0 * DM, DM, DM, smem, [&](const float* Cs) {
              if (n0 >= 4096 && n0 < 5120) {
                bf16* VT = (bf16*)(ws + WS_VTFOX);
                epi_cols(Cs, [&](int col, int r8, const float* v) {
                  *(uint4*)(VT + (size_t)(n0 - 4096 + col) * L + m0 + r8) = pack8(v);
                });
              } else if (n0 == 7168) {
                float* FL = (float*)(ws + WS_FLOG);
                for (int i = tid; i < 128 * 8; i += 256) {
                  int row = i >> 3, c = i & 7;
                  FL[(size_t)(m0 + row) * 8 + c] = Cs[row * 132 + c];
                }
              } else {
                epi_rows(Cs, [&](int row, int cc, const float* v) {
                  *(uint4*)(P + (size_t)(m0 + row) * NPE + n0 + cc) = pack8(v);
                });
              }
            });
          } else {
            gemm_tile(af, Win + (size_t)n0 * DM, DM, DM, smem, [&](const float* Cs) {
              if (n0 == 3840 || n0 == 3968 || n0 == 4352 || n0 == 4480) {
                bf16* VT = (n0 < 4096) ? (bf16*)(ws + WS_VTSLC) + (size_t)(n0 - 3840) * L
                                       : (bf16*)(ws + WS_VTWIN) + (size_t)(n0 - 4352) * L;
                epi_cols(Cs, [&](int col, int r8, const float* v) {
                  *(uint4*)(VT + (size_t)col * L + m0 + r8) = pack8(v);
                });
              } else if (n0 == 6656) {
                epi_rope(Cs, 0, m0, ROPEC, ROPES, 1.f, [&](int row, int cl, const float* v) {
                  *(uint4*)(P + (size_t)(m0 + row) * NPO + 6656 + cl) = pack8(v);
                });
                float* GT = (float*)(ws + WS_FLOG);
                for (int i = tid; i < 128 * 24; i += 256) {
                  int row = i / 24, c = i % 24;
                  GT[(size_t)(m0 + row) * 24 + c] = Cs[row * 132 + 64 + c];
                }
              } else {
                epi_rows(Cs, [&](int row, int cc, const float* v) {
                  *(uint4*)(P + (size_t)(m0 + row) * NPO + n0 + cc) = pack8(v);
                });
              }
            });
          }
        } else {
          const int t2 = t - n_in;
          const int m0 = (t2 >> 3) * 128, n0 = (t2 & 7) * 128;
          ALin af{(const bf16*)(ws + WS_MEMN) + (size_t)m0 * DM, DM};
          gemm_tile(af, (const bf16*)(ws + WS_WMEM) + (size_t)n0 * DM, DM, DM, smem, [&](const float* Cs) {
            if (n0 < 512) {
              bf16* MK = (bf16*)(ws + WS_MEMK);
              epi_rows(Cs, [&](int row, int cc, const float* v) {
                *(uint4*)(MK + (size_t)(m0 + row) * 512 + n0 + cc) = pack8(v);
              });
            } else {
              bf16* MV = (bf16*)(ws + WS_MEMVT);
              epi_cols(Cs, [&](int col, int r8, const float* v) {
                *(uint4*)(MV + (size_t)(n0 - 512 + col) * 256 + m0 + r8) = pack8(v);
              });
            }
          });
        }
      }
    }

    auto mem_attn_task = [&](int t) {
      const int qt = t >> 2, head = t & 3;
      const int tq = qt * 128 + w * 32 + r;
      const int qcol = even ? 6144 : 5632, gcol = even ? 6656 : 6144;
      bf16x8 qf[8];
      load_q<128>(qf, P + (size_t)tq * NP + qcol + head * 128, h);
      f32x16 o[4];
      zero_o(o);
      float m = NEG, l = 0.f;
      CtxMem ctx{0.08838834764831845f * LOG2E};
      attn_run<128, true, true>(qf, o, m, l, (const bf16*)(ws + WS_MEMK) + head * 128, 512, nullptr, 0,
                          (const bf16*)(ws + WS_MEMVT) + (size_t)head * 128 * 256, 256, 0, ctx, smem);
      float lt = l + __shfl_xor(l, 32);
      store_out_A(o, 1.f / lt, P + (size_t)tq * NP + gcol + head * 128, MIXED + (size_t)tq * MIXW + 2048 + head * 128, h);
    };

    if ((PHM & 8) && sub == 1 && even) {
      const int cw = cvt_set_count(p, SET_OUT, layer);
      const int n_s5 = 1024, n_cum = 64, n_mem = 256;
      for (int t = bid; t < n_mem + n_s5 + n_cum + cw; t += nb) {
        if (t < n_mem) {
          mem_attn_task(t);
        } else if (t < n_mem + n_s5) {
          const int t2 = t - n_mem;
          const int ch = t2 >> 4, gq = t2 & 15;
          float* us = (float*)smem;
          __syncthreads();
          for (int i = tid; i < 128 * 8; i += 256) {
            int tt = i >> 3, c8 = (i & 7) * 8;
            uint4 u = *(const uint4*)(P + (size_t)(ch * 128 + tt) * NPE + gq * 64 + c8);
            float* d = us + tt * 64 + c8;
            d[0] = bflo(u.x); d[1] = bfhi(u.x); d[2] = bflo(u.y); d[3] = bfhi(u.y);
            d[4] = bflo(u.z); d[5] = bfhi(u.z); d[6] = bflo(u.w); d[7] = bfhi(u.w);
          }
          __syncthreads();
          const float* S5P = (const float*)(ws + WS_S5P);
          const int gp = (gq * 4 + w) * 64 + lane;
          const float ar = S5P[gp], ai = S5P[4096 + gp];
          float bbr[16], bbi[16];
#pragma unroll
          for (int c = 0; c < 16; ++c) { bbr[c] = S5P[16384 + gp * 16 + c]; bbi[c] = S5P[16384 + 65536 + gp * 16 + c]; }
          float xr = 0.f, xi = 0.f;
          for (int tt = 0; tt < 128; ++tt) {
            const float* up = us + tt * 64 + w * 16;
            float bur = 0.f, bui = 0.f;
#pragma unroll
            for (int c = 0; c < 16; ++c) { float uv = up[c]; bur += bbr[c] * uv; bui += bbi[c] * uv; }
            float nxr = ar * xr - ai * xi + bur;
            float nxi = ar * xi + ai * xr + bui;
            xr = nxr; xi = nxi;
          }
          float2* E = (float2*)(ws + WS_S5E);
          E[(size_t)ch * 4096 + gp] = make_float2(xr, xi);
        } else if (t < n_mem + n_s5 + n_cum) {
          const int ch = t - n_mem - n_s5;
          const float* FL = (const float*)(ws + WS_FLOG);
          float* CUML = (float*)(ws + WS_CUML);
          float* CT = (float*)(ws + WS_CT);
#pragma unroll
          for (int hh = 0; hh < 2; ++hh) {
            const int head = w * 2 + hh;
            const float bf = p.fox_b_f[li * 8 + head];
            const int t0 = ch * 128 + lane * 2;
            float x0 = FL[(size_t)t0 * 8 + head] + bf, x1 = FL[(size_t)(t0 + 1) * 8 + head] + bf;
            float v0 = x0 >= 0.f ? -log1pf(expf(-x0)) : x0 - log1pf(expf(x0));
            float v1 = x1 >= 0.f ? -log1pf(expf(-x1)) : x1 - log1pf(expf(x1));
            float s = v0 + v1;
            float inc = s;
#pragma unroll
            for (int o = 1; o < 64; o <<= 1) {
              float n = __shfl_up(inc, o);
              if (lane >= o) inc += n;
            }
            float excl = inc - s;
            CUML[(size_t)head * L + t0] = excl + v0;
            CUML[(size_t)head * L + t0 + 1] = excl + v0 + v1;
            if (lane == 63) CT[head * 64 + ch] = inc;
          }
        } else {
          cvt_set_task(p, SET_OUT, layer, t - n_mem - n_s5 - n_cum, smem);
        }
      }
    }
    if ((PHM & 16) && sub == 2 && even) {
      const int n_fox = 512, n_s5 = 1024;
      for (int t = bid; t < n_fox + n_s5; t += nb) {
        if (t < n_fox) {
          const int qt = 63 - (t >> 3), head = t & 7;
          const int q0w = qt * 128 + w * 32, tq = q0w + r;
          float* cpre = (float*)(smem + AT_X0);
          __syncthreads();
          if (tid < 64) {
            const float* CT = (const float*)(ws + WS_CT) + head * 64;
            float acc = 0.f;
            for (int c = 0; c < tid; ++c) acc += CT[c];
            cpre[tid] = acc;
          }
          __syncthreads();
          const float* cuml = (const float*)(ws + WS_CUML) + (size_t)head * L;
          bf16x8 qf[8];
          load_q<128>(qf, P + (size_t)tq * NPE + 2048 + head * 128, h);
          f32x16 o[4];
          zero_o(o);
          float m = NEG, l = 0.f;
          CtxFox ctx{tq, q0w, 2 * qt + 1, 0.08838834764831845f * LOG2E, cuml[tq] + cpre[tq >> 7], cuml, cpre};
          attn_run<128, true, true>(qf, o, m, l, P + 3072 + head * 128, NPE, nullptr, 0,
                              (const bf16*)(ws + WS_VTFOX) + (size_t)head * 128 * L, L, 0, ctx, smem);
          float lt = l + __shfl_xor(l, 32);
          store_out_A(o, 1.f / lt, P + (size_t)tq * NPE + 5120 + head * 128, MIXED + (size_t)tq * MIXW + 1024 + head * 128, h);
        } else {
          const int t2 = t - n_fox;
          const int ch = t2 >> 4, gq = t2 & 15;
          float* us = (float*)smem;
          float* xs = (float*)(smem + 32768) + w * 16 * 132;
          __syncthreads();
          for (int i = tid; i < 128 * 8; i += 256) {
            int tt = i >> 3, c8 = (i & 7) * 8;
            uint4 u = *(const uint4*)(P + (size_t)(ch * 128 + tt) * NPE + gq * 64 + c8);
            float* d = us + tt * 64 + c8;
            d[0] = bflo(u.x); d[1] = bfhi(u.x); d[2] = bflo(u.y); d[3] = bfhi(u.y);
            d[4] = bflo(u.z); d[5] = bfhi(u.z); d[6] = bflo(u.w); d[7] = bfhi(u.w);
          }
          __syncthreads();
          const float* S5P = (const float*)(ws + WS_S5P);
          const int g = gq * 4 + w;
          const int gp = g * 64 + lane;
          const float ar = S5P[gp], ai = S5P[4096 + gp];
          const float atr = S5P[8192 + gp], ati = S5P[12288 + gp];
          float xr = 0.f, xi = 0.f;
          {
            const float2* E = (const float2*)(ws + WS_S5E);
            for (int c = 0; c < ch; ++c) {
              float2 e = E[(size_t)c * 4096 + gp];
              float nxr = atr * xr - ati * xi + e.x;
              float nxi = atr * xi + ati * xr + e.y;
              xr = nxr; xi = nxi;
            }
          }
          float bbr[16], bbi[16];
#pragma unroll
          for (int c = 0; c < 16; ++c) { bbr[c] = S5P[16384 + gp * 16 + c]; bbi[c] = S5P[16384 + 65536 + gp * 16 + c]; }
          const int chn = lane & 15, kq = lane >> 4;
          float cb[32];
          {
            const float* cre = p.c_re + ((size_t)li * 64 + g) * 1024 + chn * 64;
            const float* cim = p.c_im + ((size_t)li * 64 + g) * 1024 + chn * 64;
#pragma unroll
            for (int ks = 0; ks < 16; ++ks) { cb[ks] = cre[4 * ks + kq]; cb[16 + ks] = -cim[4 * ks + kq]; }
          }
          const float dsk = p.s5_d[li * 1024 + g * 16 + chn];
          bf16* Z = (bf16*)(ws + WS_Z);
          for (int sc = 0; sc < 8; ++sc) {
#pragma unroll 4
            for (int tt = 0; tt < 16; ++tt) {
              const float* up = us + (sc * 16 + tt) * 64 + w * 16;
              float bur = 0.f, bui = 0.f;
#pragma unroll
              for (int c = 0; c < 16; ++c) { float uv = up[c]; bur += bbr[c] * uv; bui += bbi[c] * uv; }
              float nxr = ar * xr - ai * xi + bur;
              float nxi = ar * xi + ai * xr + bui;
              xr = nxr; xi = nxi;
              xs[tt * 132 + lane] = xr;
              xs[tt * 132 + 64 + lane] = xi;
            }
            __syncthreads();
            f32x4 y = {0.f, 0.f, 0.f, 0.f};
#pragma unroll
            for (int ks = 0; ks < 32; ++ks) {
              float a = xs[chn * 132 + 4 * ks + kq];
              y = __builtin_amdgcn_mfma_f32_16x16x4f32(a, cb[ks], y, 0, 0, 0);
            }
#pragma unroll
            for (int i = 0; i < 4; ++i) {
              int tt = 4 * kq + i;
              float uv = us[(sc * 16 + tt) * 64 + w * 16 + chn];
              float yy = y[i] + dsk * uv;
              Z[(size_t)(ch * 128 + sc * 16 + tt) * 1024 + g * 16 + chn] = f2bf(gelu_t(yy));
            }
            __syncthreads();
          }
        }
      }
    }
    if ((PHM & 32) && sub == 3 && even) {
      const bf16* Z = (const bf16*)(ws + WS_Z);
      for (int t = vb; t < 64 * 8; t += nb) {
        int tm, tn;
        tile_map(t, 8, tm, tn);
        const int m0 = tm * 128, n0 = tn * 128;
        ALin af{Z + (size_t)m0 * 1024, 1024};
        gemm_tile(af, (const bf16*)(ws + WS_WMISC + WM_GLU) + (size_t)n0 * 1024, 1024, 1024, smem, [&](const float* Cs) {
          epi_rows(Cs, [&](int row, int cc, const float* v) {
            uint4 zu = *(const uint4*)(Z + (size_t)(m0 + row) * 1024 + n0 + cc);
            uint4 gu = *(const uint4*)(P + (size_t)(m0 + row) * NPE + 1024 + n0 + cc);
            float zz[8] = {bflo(zu.x), bfhi(zu.x), bflo(zu.y), bfhi(zu.y), bflo(zu.z), bfhi(zu.z), bflo(zu.w), bfhi(zu.w)};
            float gg[8] = {bflo(gu.x), bfhi(gu.x), bflo(gu.y), bfhi(gu.y), bflo(gu.z), bfhi(gu.z), bflo(gu.w), bfhi(gu.w)};
            float o[8];
#pragma unroll
            for (int e = 0; e < 8; ++e) o[e] = zz[e] * sigm(v[e]) * silu(gg[e]);
            *(uint4*)(MIXED + (size_t)(m0 + row) * MIXW + n0 + cc) = pack8(o);
          });
        });
      }
    }
    if ((PHM & 64) && sub == 1 && !even) {
      const int cw = cvt_set_count(p, SET_OUT, layer);
      const int n_c1 = 32, n_q = 64 * 12, n_kv = 64 * 16, n_mem = 256;
      float* rsx = (float*)(smem + SM_EXTRA);
      for (int t = vb; t < n_c1 + n_q + n_kv + n_mem + cw; t += nb) {
        if (t < n_c1) {
          const int which = t >> 4, tm = (t >> 1) & 7, tn = t & 1;
          const int m0 = tm * 128, n0 = tn * 128;
          __syncthreads();
          if (tid < 128) {
            const float* CB = (const float*)(ws + WS_CMPB) + which * 16 * 256 + n0 + tid;
            float b = 0.f;
            for (int q = 0; q < 16; ++q) b += CB[q * 256];
            rsx[tid] = b;
          }
          ACmp af{P + (which ? 3328 : 3072), m0};
          bf16* HID = (bf16*)(ws + WS_HID) + (size_t)which * 1024 * 256;
          gemm_tile(af, (const bf16*)(ws + WS_WMISC + WM_W1) + (size_t)which * 256 * 4096 + (size_t)n0 * 4096, 4096, 4096,
                    smem, [&](const float* Cs) {
                      epi_rows(Cs, [&](int row, int cc, const float* v) {
                        float o[8];
#pragma unroll
                        for (int e = 0; e < 8; ++e) o[e] = gelu_t(v[e] + rsx[cc + e]);
                        *(uint4*)(HID + (size_t)(m0 + row) * 256 + n0 + cc) = pack8(o);
                      });
                    });
        } else if (t < n_c1 + n_q + n_kv) {
          const int t2 = t - n_c1;
          const bool isq = t2 < n_q;
          const int t3 = isq ? t2 : t2 - n_q;
          const int ntn = isq ? 12 : 16;
          int tm, tn;
          tile_map(t3, ntn, tm, tn);
          const int m0 = tm * 128, n0 = tn * 128;
          const bf16* Ab = P + (size_t)m0 * NPO + (isq ? 0 : 512);
          __syncthreads();
          for (int rr = 0; rr < 32; ++rr) {
            int row = w * 32 + rr;
            uint4 u = *(const uint4*)(Ab + (size_t)row * NPO + lane * 8);
            float a0 = bflo(u.x), a1 = bfhi(u.x), a2 = bflo(u.y), a3 = bfhi(u.y), a4 = bflo(u.z), a5 = bfhi(u.z),
                  a6 = bflo(u.w), a7 = bfhi(u.w);
            float ss = a0 * a0 + a1 * a1 + a2 * a2 + a3 * a3 + a4 * a4 + a5 * a5 + a6 * a6 + a7 * a7;
            ss = wave_sum(ss);
            if (lane == 0) rsx[row] = rsqrtf(ss * (1.f / 512.f) + EPS);
          }
          ALin af{Ab, NPO};
          if (isq) {
            bf16* QM = (bf16*)(ws + WS_QMLA);
            gemm_tile(af, (const bf16*)(ws + WS_WMISC + WM_UQ) + (size_t)n0 * 512, 512, 512, smem, [&](const float* Cs) {
              const int md = n0 % 192;
              const int ropehalf = md == 128 ? 0 : (md == 64 ? 1 : -1);
              epi_rows(Cs, [&](int row, int cc, const float* v) {
                if ((cc >> 6) == ropehalf) return;
                float o[8];
                float sc = rsx[row];
#pragma unroll
                for (int e = 0; e < 8; ++e) o[e] = v[e] * sc;
                *(uint4*)(QM + (size_t)(m0 + row) * 1536 + n0 + cc) = pack8(o);
              });
              if (ropehalf >= 0) {
                epi_rope(Cs, ropehalf * 64, m0, ROPEC, ROPES, 1.f, [&](int row, int cl, const float* v) {
                  float o[8];
                  float sc = rsx[row];
#pragma unroll
                  for (int e = 0; e < 8; ++e) o[e] = v[e] * sc;
                  *(uint4*)(QM + (size_t)(m0 + row) * 1536 + n0 + ropehalf * 64 + cl) = pack8(o);
                });
              }
            });
          } else {
            gemm_tile(af, (const bf16*)(ws + WS_WMISC + WM_UKV) + (size_t)n0 * 512, 512, 512, smem, [&](const float* Cs) {
              const int head = n0 >> 8, part = (n0 >> 7) & 1;
              if (part == 0) {
                bf16* KM = (bf16*)(ws + WS_KMLA);
                epi_rows(Cs, [&](int row, int cc, const float* v) {
                  float o[8];
                  float sc = rsx[row];
#pragma unroll
                  for (int e = 0; e < 8; ++e) o[e] = v[e] * sc;
                  *(uint4*)(KM + (size_t)(m0 + row) * 1024 + head * 128 + cc) = pack8(o);
                });
              } else {
                bf16* VT = (bf16*)(ws + WS_VTMLA);
                epi_cols(Cs, [&](int col, int r8, const float* v) {
                  float o[8];
#pragma unroll
                  for (int e = 0; e < 8; ++e) o[e] = v[e] * rsx[r8 + e];
                  *(uint4*)(VT + (size_t)(head * 128 + col) * L + m0 + r8) = pack8(o);
                });
              }
            });
          }
        } else if (t < n_c1 + n_q + n_kv + n_mem) {
          mem_attn_task(t - n_c1 - n_q - n_kv);
        } else {
          cvt_set_task(p, SET_OUT, layer, t - n_c1 - n_q - n_kv - n_mem, smem);
        }
      }
    }
    if ((PHM & 128) && sub == 2 && !even) {
      const int n_mla = 512, n_c2 = 16;
      for (int t = bid; t < n_mla + n_c2; t += nb) {
        if (t < n_mla) {
          const int qt = 63 - (t >> 3), head = t & 7;
          const int q0w = qt * 128 + w * 32, tq = q0w + r;
          bf16x8 qf[12];
          load_q<192>(qf, (const bf16*)(ws + WS_QMLA) + (size_t)tq * 1536 + head * 192, h);
          f32x16 o[4];
          zero_o(o);
          float m = NEG, l = 0.f;
          CtxCausal ctx{tq, q0w, 2 * qt + 1, 0.07216878364870322f * LOG2E};
          attn_run<192, true, true>(qf, o, m, l, (const bf16*)(ws + WS_KMLA) + head * 128, 1024, P + 6656, NPO,
                              (const bf16*)(ws + WS_VTMLA) + (size_t)head * 128 * L, L, 0, ctx, smem);
          float lt = l + __shfl_xor(l, 32);
          store_out_A(o, 1.f / lt, P + (size_t)tq * NPO + 1024 + head * 128, MIXED + (size_t)tq * MIXW + head * 128, h);
        } else {
          const int t2 = t - n_mla;
          const int which = t2 >> 3, m0 = (t2 & 7) * 128;
          ALin af{(const bf16*)(ws + WS_HID) + (size_t)which * 1024 * 256 + (size_t)m0 * 256, 256};
          gemm_tile(af, (const bf16*)(ws + WS_WMISC + WM_W2) + (size_t)which * 128 * 256, 256, 256, smem, [&](const float* Cs) {
            if (which == 0) {
              bf16* KC = (bf16*)(ws + WS_KC);
              epi_rows(Cs, [&](int row, int cc, const float* v) {
                int gr = m0 + row;
                int n = gr >> 1, g = gr & 1;
                *(uint4*)(KC + ((size_t)g * 512 + n) * 128 + cc) = pack8(v);
              });
            } else {
              bf16* VC = (bf16*)(ws + WS_VCT);
              for (int i = tid; i < 128 * 128; i += 256) {
                int row = i & 127, col = i >> 7;
                int gr = m0 + row;
                int n = gr >> 1, g = gr & 1;
                VC[((size_t)g * 128 + col) * 512 + n] = f2bf(Cs[row * 132 + col]);
              }
            }
          });
        }
      }
    }
    if ((PHM & 256) && sub == 3 && !even) {
      const int* pos = p.pos;
      float* lut = (float*)(smem + AT_X0);
      float* imp = (float*)(smem + AT_IMP);
      unsigned* sel = (unsigned*)(smem + AT_SEL);
      const float* GT = (const float*)(ws + WS_FLOG);
      float* NSAO = (float*)(ws + WS_NSAO);
      for (int t = bid; t < 512; t += nb) {
        const int qt = 255 - (t >> 1), g = t & 1;
        const int q0 = qt * 32;
        const int hr = r >> 3, qi = r & 7;
        const int ql = w * 8 + qi;
        const int tq = q0 + ql;
        const int head = g * 4 + hr;
        const int posq = pos[tq];
        __syncthreads();
        for (int i = tid; i < 4 * 800; i += 256) {
          int rr = i / 800, n = i % 800;
          int b;
          if (n < 16) b = n;
          else {
            float lr = logf((float)n / 16.f) / 4.1588830833596715f;
            b = 16 + (int)(lr * 16.f);
            if (b > 31) b = 31;
          }
          lut[i] = p.t5[b * 8 + g * 4 + rr] * LOG2E;
        }
        for (int i = tid; i < 32 * 132; i += 256) imp[i] = 0.f;
        __syncthreads();
        const float* lutr = lut + hr * 800;
        bf16x8 qf[8];
        load_q<128>(qf, P + (size_t)tq * NPO + 2048 + head * 128, h);
        const float sc = 0.08838834764831845f * LOG2E;
        f32x16 o[4];
        float* orow = NSAO + (size_t)tq * 1024 + head * 128;

        const int ncv = min(q0 / 16 + 1, 511);
        const int last_c = (ncv - 1) >> 6;
        float m = NEG, l = 0.f;
        CtxCmp cc{tq, posq, last_c, sc, lutr, pos, 0.f, imp, ql, false};
        zero_o(o);
        const bf16* KCg = (const bf16*)(ws + WS_KC) + (size_t)g * 512 * 128;
        const bf16* VCg = (const bf16*)(ws + WS_VCT) + (size_t)g * 128 * 512;
        attn_run<128, false, false>(qf, o, m, l, KCg, 128, nullptr, 0, VCg, 512, 0, cc, smem);
        float lt = l + __shfl_xor(l, 32);
        const bool has_c = m > -1e29f;
        float m2 = has_c ? m : 0.f;
        float invl = has_c ? 1.f / lt : 0.f;
        cc.invl = invl; cc.p2 = true;
        float l2 = 0.f;
        attn_run<128, true, false>(qf, o, m2, l2, KCg, 128, nullptr, 0, VCg, 512, 0, cc, smem);
        {
          float gs = sigm(GT[(size_t)tq * 24 + head * 3 + 0]) * invl;
#pragma unroll
          for (int d = 0; d < 4; ++d)
#pragma unroll
            for (int i4 = 0; i4 < 4; ++i4) {
              int dv0 = d * 32 + 8 * i4 + 4 * h;
              float4 v = make_float4(o[d][4 * i4] * gs, o[d][4 * i4 + 1] * gs, o[d][4 * i4 + 2] * gs, o[d][4 * i4 + 3] * gs);
              *(float4*)(orow + dv0) = v;
            }
        }
        __syncthreads();
        for (int q8 = 0; q8 < 8; ++q8) {
          const int qq = w * 8 + q8;
          const int tt = q0 + qq;
          const int cur = tt >> 6;
          const float* ip = imp + qq * 132;
          const int j0 = lane, j1 = lane + 64;
          const bool v0 = j0 <= cur, v1 = j1 <= cur;
          const bool f0 = (j0 == 0) || (j0 == cur) || (j0 == cur - 1);
          const bool f1 = (j1 == cur) || (j1 == cur - 1);
          const int nforced = cur == 0 ? 1 : (cur == 1 ? 2 : 3);
          const int nfree = 16 - nforced;
          const float a0 = ip[j0], a1 = ip[j1];
          int r0 = 0, r1 = 0;
          for (int jj = 0; jj <= cur; ++jj) {
            bool fj = (jj == 0) || (jj == cur) || (jj == cur - 1);
            if (fj) continue;
            float vj = ip[jj];
            r0 += (vj > a0 || (vj == a0 && jj < j0)) ? 1 : 0;
            r1 += (vj > a1 || (vj == a1 && jj < j1)) ? 1 : 0;
          }
          bool s0 = v0 && (f0 || r0 < nfree);
          bool s1 = v1 && (f1 || r1 < nfree);
          unsigned long long b0 = __ballot(s0), b1 = __ballot(s1);
          if (lane == 0) {
            sel[qq * 4 + 0] = (unsigned)b0; sel[qq * 4 + 1] = (unsigned)(b0 >> 32);
            sel[qq * 4 + 2] = (unsigned)b1; sel[qq * 4 + 3] = (unsigned)(b1 >> 32);
          }
        }
        __syncthreads();
        unsigned un0, un1, un2, un3;
        {
          un0 = sel[r * 4 + 0]; un1 = sel[r * 4 + 1]; un2 = sel[r * 4 + 2]; un3 = sel[r * 4 + 3];
#pragma unroll
          for (int of = 1; of < 32; of <<= 1) {
            un0 |= __shfl_xor(un0, of); un1 |= __shfl_xor(un1, of); un2 |= __shfl_xor(un2, of); un3 |= __shfl_xor(un3, of);
          }
          un0 = __builtin_amdgcn_readfirstlane(un0); un1 = __builtin_amdgcn_readfirstlane(un1);
          un2 = __builtin_amdgcn_readfirstlane(un2); un3 = __builtin_amdgcn_readfirstlane(un3);
        }
        {
          CtxSlc cs{tq, posq, sc, lutr, pos, (unsigned long long)un0 | ((unsigned long long)un1 << 32),
                    (unsigned long long)un2 | ((unsigned long long)un3 << 32),
                    (unsigned long long)sel[ql * 4] | ((unsigned long long)sel[ql * 4 + 1] << 32),
                    (unsigned long long)sel[ql * 4 + 2] | ((unsigned long long)sel[ql * 4 + 3] << 32)};
          zero_o(o);
          m = NEG; l = 0.f;
          attn_run<128, true, false>(qf, o, m, l, P + 3584 + g * 128, NPO, nullptr, 0,
                              (const bf16*)(ws + WS_VTSLC) + (size_t)g * 128 * L, L, 0, cs, smem);
          lt = l + __shfl_xor(l, 32);
          float gs = sigm(GT[(size_t)tq * 24 + head * 3 + 1]) / lt;
#pragma unroll
          for (int d = 0; d < 4; ++d)
#pragma unroll
            for (int i4 = 0; i4 < 4; ++i4) {
              int dv0 = d * 32 + 8 * i4 + 4 * h;
              float4 v = *(float4*)(orow + dv0);
              v.x += o[d][4 * i4] * gs; v.y += o[d][4 * i4 + 1] * gs; v.z += o[d][4 * i4 + 2] * gs; v.w += o[d][4 * i4 + 3] * gs;
              *(float4*)(orow + dv0) = v;
            }
        }
        {
          const int kfirst = q0 - 511 > 0 ? (q0 - 511) >> 6 : 0;
          CtxWin cwn{tq, posq, (q0 + 31) >> 6, sc, lutr, pos};
          zero_o(o);
          m = NEG; l = 0.f;
          attn_run<128, true, false>(qf, o, m, l, P + 4096 + g * 128, NPO, nullptr, 0,
                              (const bf16*)(ws + WS_VTWIN) + (size_t)g * 128 * L, L, kfirst, cwn, smem);
          lt = l + __shfl_xor(l, 32);
          float gs = sigm(GT[(size_t)tq * 24 + head * 3 + 2]) / lt;
          const bf16* grow = P + (size_t)tq * NPO + 4608 + head * 128;
          bf16* mrow = MIXED + (size_t)tq * MIXW + 1024 + head * 128;
#pragma unroll
          for (int d = 0; d < 4; ++d)
#pragma unroll
            for (int i4 = 0; i4 < 4; ++i4) {
              int dv0 = d * 32 + 8 * i4 + 4 * h;
              float4 v = *(float4*)(orow + dv0);
              v.x += o[d][4 * i4] * gs; v.y += o[d][4 * i4 + 1] * gs; v.z += o[d][4 * i4 + 2] * gs; v.w += o[d][4 * i4 + 3] * gs;
              uint2 gu = *(const uint2*)(grow + dv0);
              uint2 ou;
              ou.x = pack2(v.x * silu(bflo(gu.x)), v.y * silu(bfhi(gu.x)));
              ou.y = pack2(v.z * silu(bflo(gu.y)), v.w * silu(bfhi(gu.y)));
              *(uint2*)(mrow + dv0) = ou;
            }
        }
      }
    }
    if ((PHM & 512) && sub == 4) {
      const float* hin = layer == 0 ? p.x : hbuf;
      for (int t = vb; t < 64 * 16; t += nb) {
        int tm, tn;
        tile_map(t, 16, tm, tn);
        const int m0 = tm * 128, n0 = tn * 128;
        ALin af{MIXED + (size_t)m0 * MIXW, MIXW};
        gemm_tile(af, (const bf16*)(ws + WS_WOUT) + (size_t)n0 * MIXW, MIXW, MIXW, smem, [&](const float* Cs) {
          const int tid2 = otid();
#pragma unroll
          for (int j = 0; j < 16; ++j) {
            int c = tid2 + 256 * j;
            int row = c >> 5, cc = (c & 31) * 4;
            float4 a = *(const float4*)(Cs + row * 132 + cc);
            float4 hv = *(const float4*)(hin + (size_t)(m0 + row) * DM + n0 + cc);
            hv.x += a.x; hv.y += a.y; hv.z += a.z; hv.w += a.w;
            *(float4*)(hbuf + (size_t)(m0 + row) * DM + n0 + cc) = hv;
          }
        });
      }
    }
    }
  }
}

extern "C" void kernel_launch(void* const* d_in, const int* in_sizes, int n_in, void* d_out, int out_size, void* d_ws,
                              size_t ws_size, hipStream_t stream) {
  Params p{};
  p.x = (const float*)d_in[0]; p.mem = (const float*)d_in[1]; p.pos = (const int*)d_in[2];
  p.norm_g = (const float*)d_in[3]; p.mem_norm_g = (const float*)d_in[4]; p.final_norm_g = (const float*)d_in[5];
  p.t5 = (const float*)d_in[6]; p.w_out = (const float*)d_in[7]; p.mem_w_kv = (const float*)d_in[8];
  p.even_w_in = (const float*)d_in[9]; p.lam_re = (const float*)d_in[10]; p.lam_im = (const float*)d_in[11];
  p.log_dt = (const float*)d_in[12]; p.b_re = (const float*)d_in[13]; p.b_im = (const float*)d_in[14];
  p.c_re = (const float*)d_in[15]; p.c_im = (const float*)d_in[16]; p.s5_d = (const float*)d_in[17];
  p.w_glu = (const float*)d_in[18]; p.fox_b_f = (const float*)d_in[19]; p.odd_w_in = (const float*)d_in[20];
  p.g_cq = (const float*)d_in[21]; p.g_ckv = (const float*)d_in[22]; p.w_uq = (const float*)d_in[23];
  p.w_ukv = (const float*)d_in[24]; p.cmp_pe = (const float*)d_in[25]; p.cmp_w1 = (const float*)d_in[26];
  p.cmp_w2 = (const float*)d_in[27];
  p.out = (float*)d_out; p.ws = (char*)d_ws;
  if (ws_size < WS_END) fprintf(stderr, "workspace too small: %zu < %zu\n", ws_size, (size_t)WS_END);
  static int grid_blocks = 0;
  if (!grid_blocks) {
    int dev = 0, cus = 0, per_cu = 0;
    hipGetDevice(&dev);
    hipDeviceGetAttribute(&cus, hipDeviceAttributeMultiprocessorCount, dev);
    hipOccupancyMaxActiveBlocksPerMultiprocessor(&per_cu, mega, 256, 0);
    if (per_cu > 2) per_cu = 2;
    if (per_cu < 1) per_cu = 1;
    grid_blocks = cus * per_cu;
  }
#if MULTI_LAUNCH
  for (int ph = 0; ph <= 24; ++ph) {
    int lo = ph, hi = ph;
    void* args[] = {&p, &lo, &hi};
    hipLaunchCooperativeKernel((void*)mega, dim3(grid_blocks), dim3(256), args, 0, stream);
  }
#else
  int lo = 0, hi = 24;
  void* args[] = {&p, &lo, &hi};
  hipError_t e = hipLaunchCooperativeKernel((void*)mega, dim3(grid_blocks), dim3(256), args, 0, stream);
  if (e != hipSuccess) fprintf(stderr, "cooperative launch failed: %s (grid %d)\n", hipGetErrorString(e), grid_blocks);
#endif
}
```

```cpp
#include <hip/hip_runtime.h>
#include <hip/hip_cooperative_groups.h>
#include <cstdio>
#include <cstdint>
namespace cg = cooperative_groups;

typedef unsigned short bf16;
typedef short bf16x8 __attribute__((ext_vector_type(8)));
typedef float f32x16 __attribute__((ext_vector_type(16)));
typedef float f32x4 __attribute__((ext_vector_type(4)));
typedef __bf16 bf2v __attribute__((ext_vector_type(2)));
typedef float f2v __attribute__((ext_vector_type(2)));

#define DI __device__ __forceinline__
#define MFMA32(a, b, c) __builtin_amdgcn_mfma_f32_32x32x16_bf16((a), (b), (c), 0, 0, 0)

#ifndef LB2
#define LB2 2
#endif
#ifndef REP_PH
#define REP_PH -1
#endif
#ifndef PHM
#define PHM 1023
#endif
#ifndef MULTI_LAUNCH
#define MULTI_LAUNCH 0
#endif

constexpr int L = 8192;
constexpr int DM = 2048;
constexpr int NPE = 7296;
constexpr int NPO = 6784;
constexpr int EVEN_IN = 7176;
constexpr int ODD_IN = 6744;
constexpr int MIXW = 2560;
constexpr float LOG2E = 1.4426950408889634f;
constexpr float NEG = -1e30f;
constexpr float EPS = 1e-6f;

constexpr size_t MB = 1024 * 1024;
constexpr size_t WS_WIN = 0;
constexpr size_t WS_WOUT = WS_WIN + 30 * MB;
constexpr size_t WS_WMEM = WS_WOUT + 10 * MB;
constexpr size_t WS_WMISC = WS_WMEM + 4 * MB;
constexpr size_t WS_XN = WS_WMISC + 8 * MB;
constexpr size_t WS_MEMN = WS_XN + 32 * MB;
constexpr size_t WS_P = WS_MEMN + 1 * MB;
constexpr size_t WS_MIXED = WS_P + 114 * MB;
constexpr size_t WS_MEMK = WS_MIXED + 40 * MB;
constexpr size_t WS_MEMVT = WS_MEMK + 256 * 1024;
constexpr size_t WS_ROPEC = WS_MEMVT + 256 * 1024;
constexpr size_t WS_ROPES = WS_ROPEC + 1 * MB;
constexpr size_t WS_FLOG = WS_ROPES + 1 * MB;
constexpr size_t WS_CUML = WS_FLOG + 1 * MB;
constexpr size_t WS_CT = WS_CUML + 256 * 1024;
constexpr size_t WS_S5P = WS_CT + 4096;
constexpr size_t WS_S5E = WS_S5P + 1 * MB;
constexpr size_t WS_CMPB = WS_S5E + 2 * MB;
constexpr size_t WS_CTR = WS_CMPB + 64 * 1024;
constexpr size_t WS_BAR = WS_CTR + 4096;
constexpr size_t WS_VAR = WS_BAR + 16384;
constexpr size_t WS_Z = WS_VAR;
constexpr size_t WS_VTFOX = WS_Z + 16 * MB;
constexpr size_t WS_QMLA = WS_VAR;
constexpr size_t WS_KMLA = WS_QMLA + 24 * MB;
constexpr size_t WS_VTMLA = WS_KMLA + 16 * MB;
constexpr size_t WS_VTSLC = WS_VTMLA + 16 * MB;
constexpr size_t WS_VTWIN = WS_VTSLC + 4 * MB;
constexpr size_t WS_HID = WS_VTWIN + 4 * MB;
constexpr size_t WS_KC = WS_HID + 1 * MB;
constexpr size_t WS_VCT = WS_KC + 256 * 1024;
constexpr size_t WS_NSAO = WS_VCT + 256 * 1024;
constexpr size_t WS_END = WS_NSAO + 32 * MB;
constexpr size_t WM_GLU = 0;
constexpr size_t WM_UQ = 0;
constexpr size_t WM_UKV = WM_UQ + 1536 * 512 * 2;
constexpr size_t WM_W1 = WM_UKV + 2048 * 512 * 2;
constexpr size_t WM_W2 = WM_W1 + 2 * 256 * 4096 * 2;

constexpr int SM_EXTRA = 73728;
constexpr int SM_TOTAL = 73728 + 1024;

struct Params {
  const float *x, *mem;
  const int* pos;
  const float *norm_g, *mem_norm_g, *final_norm_g, *t5, *w_out, *mem_w_kv, *even_w_in, *lam_re, *lam_im, *log_dt,
      *b_re, *b_im, *c_re, *c_im, *s5_d, *w_glu, *fox_b_f, *odd_w_in, *g_cq, *g_ckv, *w_uq, *w_ukv, *cmp_pe,
      *cmp_w1, *cmp_w2;
  float* out;
  char* ws;
};

DI unsigned pack2(float a, float b) {
  f2v v = {a, b};
  bf2v r = __builtin_convertvector(v, bf2v);
  return __builtin_bit_cast(unsigned, r);
}
DI float bflo(unsigned u) { return __uint_as_float(u << 16); }
DI float bfhi(unsigned u) { return __uint_as_float(u & 0xffff0000u); }
DI float bf2f(bf16 v) { return __uint_as_float(((unsigned)v) << 16); }
DI bf16 f2bf(float f) { return (bf16)(pack2(f, 0.f) & 0xffffu); }
DI int otid() { int z; asm volatile("s_mov_b32 %0, 0" : "=s"(z)); return (int)threadIdx.x + z; }
DI int crow(int i, int h) { return (i & 3) + 8 * (i >> 2) + 4 * h; }
DI float sigm(float x) { return 1.f / (1.f + __expf(-x)); }
DI float silu(float x) { return x * sigm(x); }
DI float gelu_t(float x) {
  float u = 0.7978845608028654f * (x + 0.044715f * x * x * x);
  float e = __expf(2.f * u);
  float t = 1.f - 2.f / (e + 1.f);
  return 0.5f * x * (1.f + t);
}
DI float ex2(float x) { return __builtin_amdgcn_exp2f(x); }
DI float wave_sum(float v) {
#pragma unroll
  for (int o = 32; o > 0; o >>= 1) v += __shfl_xor(v, o);
  return v;
}
DI uint4 pack8(const float* v) {
  uint4 u;
  u.x = pack2(v[0], v[1]); u.y = pack2(v[2], v[3]); u.z = pack2(v[4], v[5]); u.w = pack2(v[6], v[7]);
  return u;
}

struct CvtSeg {
  const float* src; int lds; int sc0; bf16* dst; int dr0; int ncols; int npad; int K; const float* kscale;
};
DI int cvt_count(const CvtSeg& s) { return (s.K >> 6) * (s.npad >> 6); }
DI void cvt_tile(const CvtSeg& s, int tile, char* smem) {
  float* T = (float*)smem;
  const int tid = otid();
  const int nkt = s.K >> 6;
  const int kt = tile % nkt, nt = tile / nkt;
  const int k0 = kt * 64, n0 = nt * 64;
  __syncthreads();
#pragma unroll
  for (int i = 0; i < 16; ++i) {
    int idx = tid + 256 * i;
    int k = idx >> 6, n = idx & 63;
    float v = 0.f;
    if (n0 + n < s.ncols) {
      v = s.src[(size_t)(k0 + k) * s.lds + s.sc0 + n0 + n];
      if (s.kscale) v *= s.kscale[k0 + k];
    }
    T[k * 65 + n] = v;
  }
  __syncthreads();
#pragma unroll
  for (int j = 0; j < 2; ++j) {
    int c = tid + 256 * j;
    int n = c >> 3, kc = (c & 7) * 8;
    float v[8];
#pragma unroll
    for (int e = 0; e < 8; ++e) v[e] = T[(kc + e) * 65 + n];
    *(uint4*)(s.dst + (size_t)(s.dr0 + n0 + n) * s.K + k0 + kc) = pack8(v);
  }
}

enum { SET_IN_EVEN = 0, SET_IN_ODD, SET_OUT, SET_MEM, SET_MISC_EVEN, SET_MISC_ODD };
DI int cvt_nseg(int set) {
  switch (set) {
    case SET_IN_EVEN: return 3;
    case SET_IN_ODD: return 5;
    case SET_OUT: return 1;
    case SET_MEM: return 1;
    case SET_MISC_EVEN: return 1;
    default: return 6;
  }
}
DI CvtSeg cvt_get(const Params& p, int set, int li, int s) {
  CvtSeg r;
  r.kscale = nullptr;
  char* ws = p.ws;
  if (set == SET_IN_EVEN) {
    r.src = p.even_w_in + (size_t)li * DM * EVEN_IN; r.lds = EVEN_IN; r.K = DM; r.dst = (bf16*)(ws + WS_WIN);
    if (s == 0) { r.sc0 = 0; r.dr0 = 0; r.ncols = 5120; r.npad = 5120; }
    else if (s == 1) { r.sc0 = 5128; r.dr0 = 5120; r.ncols = 2048; r.npad = 2048; }
    else { r.sc0 = 5120; r.dr0 = 7168; r.ncols = 8; r.npad = 128; }
  } else if (set == SET_IN_ODD) {
    r.src = p.odd_w_in + (size_t)li * DM * ODD_IN; r.lds = ODD_IN; r.K = DM; r.dst = (bf16*)(ws + WS_WIN);
    if (s == 0) { r.sc0 = 0; r.dr0 = 0; r.ncols = 1024; r.npad = 1024; }
    else if (s == 1) { r.sc0 = 1088; r.dr0 = 1024; r.ncols = 3584; r.npad = 3584; }
    else if (s == 2) { r.sc0 = 4696; r.dr0 = 4608; r.ncols = 2048; r.npad = 2048; }
    else if (s == 3) { r.sc0 = 1024; r.dr0 = 6656; r.ncols = 64; r.npad = 64; }
    else { r.sc0 = 4672; r.dr0 = 6720; r.ncols = 24; r.npad = 64; }
  } else if (set == SET_OUT) {
    r.src = p.w_out + (size_t)li * MIXW * DM; r.lds = DM; r.K = MIXW; r.dst = (bf16*)(ws + WS_WOUT);
    r.sc0 = 0; r.dr0 = 0; r.ncols = DM; r.npad = DM;
  } else if (set == SET_MEM) {
    r.src = p.mem_w_kv + (size_t)li * DM * 1024; r.lds = 1024; r.K = DM; r.dst = (bf16*)(ws + WS_WMEM);
    r.sc0 = 0; r.dr0 = 0; r.ncols = 1024; r.npad = 1024;
  } else if (set == SET_MISC_EVEN) {
    r.src = p.w_glu + (size_t)li * 1024 * 1024; r.lds = 1024; r.K = 1024; r.dst = (bf16*)(ws + WS_WMISC + WM_GLU);
    r.sc0 = 0; r.dr0 = 0; r.ncols = 1024; r.npad = 1024;
  } else {
    r.sc0 = 0; r.dr0 = 0;
    if (s == 0) {
      r.src = p.w_uq + (size_t)li * 512 * 1536; r.lds = 1536; r.K = 512; r.dst = (bf16*)(ws + WS_WMISC + WM_UQ);
      r.ncols = 1536; r.npad = 1536; r.kscale = p.g_cq + li * 512;
    } else if (s == 1) {
      r.src = p.w_ukv + (size_t)li * 512 * 2048; r.lds = 2048; r.K = 512; r.dst = (bf16*)(ws + WS_WMISC + WM_UKV);
      r.ncols = 2048; r.npad = 2048; r.kscale = p.g_ckv + li * 512;
    } else if (s < 4) {
      int which = s - 2;
      r.src = p.cmp_w1 + (size_t)(li * 2 + which) * 4096 * 256; r.lds = 256; r.K = 4096;
      r.dst = (bf16*)(ws + WS_WMISC + WM_W1) + (size_t)which * 256 * 4096; r.ncols = 256; r.npad = 256;
    } else {
      int which = s - 4;
      r.src = p.cmp_w2 + (size_t)(li * 2 + which) * 256 * 128; r.lds = 128; r.K = 256;
      r.dst = (bf16*)(ws + WS_WMISC + WM_W2) + (size_t)which * 128 * 256; r.ncols = 128; r.npad = 128;
    }
  }
  return r;
}
DI int cvt_set_count(const Params& p, int set, int li) {
  int n = 0;
  for (int s = 0; s < cvt_nseg(set); ++s) n += cvt_count(cvt_get(p, set, li, s));
  return n;
}
DI void cvt_set_task(const Params& p, int set, int li, int t, char* smem) {
  const int ns = cvt_nseg(set);
  for (int s = 0; s < ns; ++s) {
    CvtSeg sg = cvt_get(p, set, li, s);
    int c = cvt_count(sg);
    if (t < c) { cvt_tile(sg, t, smem); return; }
    t -= c;
  }
}

DI void norm_row_bf16(const float* __restrict__ src, const float* __restrict__ g, bf16* __restrict__ dst, int lane) {
  float4 v[8];
  float ss = 0.f;
#pragma unroll
  for (int i = 0; i < 8; ++i) {
    v[i] = *(const float4*)(src + (i * 64 + lane) * 4);
    ss += v[i].x * v[i].x + v[i].y * v[i].y + v[i].z * v[i].z + v[i].w * v[i].w;
  }
  ss = wave_sum(ss);
  float r = rsqrtf(ss * (1.f / DM) + EPS);
#pragma unroll
  for (int i = 0; i < 8; ++i) {
    float4 gg = *(const float4*)(g + (i * 64 + lane) * 4);
    uint2 u;
    u.x = pack2(v[i].x * r * gg.x, v[i].y * r * gg.y);
    u.y = pack2(v[i].z * r * gg.z, v[i].w * r * gg.w);
    *(uint2*)(dst + (i * 64 + lane) * 4) = u;
  }
}
DI void norm_row_f32(float* __restrict__ io, const float* __restrict__ g, int lane) {
  float4 v[8];
  float ss = 0.f;
#pragma unroll
  for (int i = 0; i < 8; ++i) {
    v[i] = *(const float4*)(io + (i * 64 + lane) * 4);
    ss += v[i].x * v[i].x + v[i].y * v[i].y + v[i].z * v[i].z + v[i].w * v[i].w;
  }
  ss = wave_sum(ss);
  float r = rsqrtf(ss * (1.f / DM) + EPS);
#pragma unroll
  for (int i = 0; i < 8; ++i) {
    float4 gg = *(const float4*)(g + (i * 64 + lane) * 4);
    float4 o;
    o.x = v[i].x * r * gg.x; o.y = v[i].y * r * gg.y; o.z = v[i].z * r * gg.z; o.w = v[i].w * r * gg.w;
    *(float4*)(io + (i * 64 + lane) * 4) = o;
  }
}

struct ALin {
  const bf16* p; int ld;
  DI const bf16* operator()(int row, int k) const { return p + (size_t)row * ld + k; }
};
struct ACmp {
  const bf16* p; int m0;
  DI const bf16* operator()(int row, int k) const {
    int gr = m0 + row;
    if (gr > 1021) gr = 1021;
    int n = gr >> 1, g = gr & 1;
    return p + (size_t)(16 * n + (k >> 7)) * NPO + g * 128 + (k & 127);
  }
};

template <class AF, class Epi>
DI void gemm_tile(AF af, const bf16* __restrict__ Bt, int ldb, int K, char* smem, Epi epi) {
  const int tid = otid(), lane = tid & 63, w = tid >> 6, r = lane & 31, h = lane >> 5;
  const int wm = w >> 1, wn = w & 1;
  bf16* As = (bf16*)smem;
  bf16* Bs = As + 2 * 128 * 72;
  f32x16 acc[2][2];
#pragma unroll
  for (int a = 0; a < 2; ++a)
#pragma unroll
    for (int b = 0; b < 2; ++b)
#pragma unroll
      for (int i = 0; i < 16; ++i) acc[a][b][i] = 0.f;
  uint4 ra0_0, ra0_1, ra0_2, ra0_3, rb0_0, rb0_1, rb0_2, rb0_3, ra1_0, ra1_1, ra1_2, ra1_3, rb1_0, rb1_1, rb1_2, rb1_3;
#define LD1(S, I, K0)                                                                  \
  {                                                                                    \
    int c = tl + 256 * I;                                                              \
    int row = c >> 3, kc = (c & 7) * 8;                                                \
    ra##S##_##I = *(const uint4*)af(row, (K0) + kc);                                   \
    rb##S##_##I = *(const uint4*)(Bt + (size_t)row * ldb + (K0) + kc);                 \
  }
#define ST1(S, I, BUF)                                                                 \
  {                                                                                    \
    int c = tid + 256 * I;                                                             \
    int row = c >> 3, kc = (c & 7) * 8;                                                \
    *(uint4*)(As + (BUF) * 9216 + row * 72 + kc) = ra##S##_##I;                        \
    *(uint4*)(Bs + (BUF) * 9216 + row * 72 + kc) = rb##S##_##I;                        \
  }
#define GLOAD(S, K0) { const int tl = otid(); LD1(S, 0, K0) LD1(S, 1, K0) LD1(S, 2, K0) LD1(S, 3, K0) }
#define SSTORE(S, BUF) { ST1(S, 0, BUF) ST1(S, 1, BUF) ST1(S, 2, BUF) ST1(S, 3, BUF) }
  auto compute = [&](int buf) {
    const bf16* a_ = As + buf * 9216;
    const bf16* b_ = Bs + buf * 9216;
#pragma unroll
    for (int ks = 0; ks < 4; ++ks) {
      bf16x8 fa[2], fb[2];
#pragma unroll
      for (int mb = 0; mb < 2; ++mb) fa[mb] = *(const bf16x8*)(a_ + (wm * 64 + mb * 32 + r) * 72 + ks * 16 + h * 8);
#pragma unroll
      for (int nb = 0; nb < 2; ++nb) fb[nb] = *(const bf16x8*)(b_ + (wn * 64 + nb * 32 + r) * 72 + ks * 16 + h * 8);
#pragma unroll
      for (int mb = 0; mb < 2; ++mb)
#pragma unroll
        for (int nb = 0; nb < 2; ++nb) acc[mb][nb] = MFMA32(fa[mb], fb[nb], acc[mb][nb]);
    }
  };
  __syncthreads();
  const int nk = K >> 6;
  GLOAD(0, 0);
  SSTORE(0, 0);
  GLOAD(0, 64);
  __syncthreads();
  for (int kt = 0; kt < nk; kt += 2) {
    if (kt + 2 < nk) GLOAD(1, (kt + 2) * 64);
    compute(0);
    SSTORE(0, 1);
    __syncthreads();
    if (kt + 3 < nk) GLOAD(0, (kt + 3) * 64);
    compute(1);
    if (kt + 2 < nk) SSTORE(1, 0);
    __syncthreads();
  }
#undef GLOAD
#undef SSTORE
#undef LD1
#undef ST1
  float* Cs = (float*)smem;
#pragma unroll
  for (int mb = 0; mb < 2; ++mb)
#pragma unroll
    for (int nb = 0; nb < 2; ++nb)
#pragma unroll
      for (int i = 0; i < 16; ++i)
        Cs[(wm * 64 + mb * 32 + crow(i, h)) * 132 + wn * 64 + nb * 32 + r] = acc[mb][nb][i];
  __syncthreads();
  epi(Cs);
}

DI void tile_map(int t, int ntn, int& tm, int& tn) {
  const int per = 8 * ntn;
  const int grp = t / per, rem = t - grp * per;
  tm = grp * 8 + (rem & 7);
  tn = rem >> 3;
}
template <class F>
DI void epi_rows(const float* Cs, F f) {
  const int tid = otid();
#pragma unroll
  for (int j = 0; j < 8; ++j) {
    int c = tid + 256 * j;
    int row = c >> 4, cc = (c & 15) * 8;
    float v[8];
    float4 a = *(const float4*)(Cs + row * 132 + cc);
    float4 b = *(const float4*)(Cs + row * 132 + cc + 4);
    v[0] = a.x; v[1] = a.y; v[2] = a.z; v[3] = a.w; v[4] = b.x; v[5] = b.y; v[6] = b.z; v[7] = b.w;
    f(row, cc, v);
  }
}
template <class F>
DI void epi_cols(const float* Cs, F f) {
  const int tid = otid();
#pragma unroll
  for (int j = 0; j < 8; ++j) {
    int c = tid + 256 * j;
    int col = c & 127, r8 = (c >> 7) * 8;
    float v[8];
#pragma unroll
    for (int e = 0; e < 8; ++e) v[e] = Cs[(r8 + e) * 132 + col];
    f(col, r8, v);
  }
}
template <class F>
DI void epi_rope(const float* Cs, int cb, int m0, const float* rc, const float* rs, float scale_unused, F f) {
  const int tid = otid();
#pragma unroll
  for (int j = 0; j < 2; ++j) {
    int c = tid + 256 * j;
    int row = c >> 2, cc = (c & 3) * 8;
    float x1[8], x2[8], o1[8], o2[8];
#pragma unroll
    for (int e = 0; e < 8; ++e) {
      x1[e] = Cs[row * 132 + cb + cc + e];
      x2[e] = Cs[row * 132 + cb + 32 + cc + e];
    }
    const float* pc = rc + (size_t)(m0 + row) * 32 + cc;
    const float* ps = rs + (size_t)(m0 + row) * 32 + cc;
#pragma unroll
    for (int e = 0; e < 8; ++e) {
      float cs = pc[e], sn = ps[e];
      o1[e] = x1[e] * cs - x2[e] * sn;
      o2[e] = x1[e] * sn + x2[e] * cs;
    }
    f(row, cc, o1);
    f(row, cc + 32, o2);
  }
}

template <int DK>
struct KVPre {
  uint4 k[DK / 32];
  uint4 v[4];
  float aux;
};
constexpr int AT_VS = 25600;
constexpr int AT_AUX = 43008;
constexpr int AT_X0 = 43264;
constexpr int AT_IMP = AT_X0 + 12800;
constexpr int AT_SEL = AT_IMP + 16896;

template <int DK, bool PV, class SF, class PH>
DI void attn_tile(const bf16x8 (&qf)[DK / 16], f32x16 (&o)[4], float& m, float& l, const char* smem, SF sf, PH ph) {
  const int lane = otid() & 63, r = lane & 31, h = lane >> 5;
  const bf16* Ks = (const bf16*)smem;
  const bf16* Vs = (const bf16*)(smem + AT_VS);
  const float* auxs = (const float*)(smem + AT_AUX);
  f32x16 s[2];
#pragma unroll
  for (int kb = 0; kb < 2; ++kb) {
#pragma unroll
    for (int i = 0; i < 16; ++i) s[kb][i] = 0.f;
#pragma unroll
    for (int ks = 0; ks < DK / 16; ++ks) {
      bf16x8 a = *(const bf16x8*)(Ks + (kb * 32 + r) * (DK + 8) + ks * 16 + h * 8);
      s[kb] = MFMA32(a, qf[ks], s[kb]);
    }
  }
  float mx = m;
#pragma unroll
  for (int kb = 0; kb < 2; ++kb)
#pragma unroll
    for (int i = 0; i < 16; ++i) {
      int kl = kb * 32 + crow(i, h);
      float v = sf(s[kb][i], kl, auxs[kl]);
      s[kb][i] = v;
      mx = fmaxf(mx, v);
    }
  mx = fmaxf(mx, __shfl_xor(mx, 32));
  float alpha = ex2(m - mx);
  m = mx;
  float psum = 0.f;
#pragma unroll
  for (int kb = 0; kb < 2; ++kb)
#pragma unroll
    for (int i = 0; i < 16; ++i) {
      float pv = ex2(s[kb][i] - mx);
      s[kb][i] = pv;
      psum += pv;
    }
  l = l * alpha + psum;
  ph(0, s[0]);
  ph(1, s[1]);
  if (PV) {
#pragma unroll
    for (int d = 0; d < 4; ++d)
#pragma unroll
      for (int i = 0; i < 16; ++i) o[d][i] *= alpha;
#pragma unroll
    for (int st = 0; st < 4; ++st) {
      const int kb = st >> 1, s2 = st & 1;
      uint4 pu;
      pu.x = pack2(s[kb][8 * s2 + 0], s[kb][8 * s2 + 1]);
      pu.y = pack2(s[kb][8 * s2 + 2], s[kb][8 * s2 + 3]);
      pu.z = pack2(s[kb][8 * s2 + 4], s[kb][8 * s2 + 5]);
      pu.w = pack2(s[kb][8 * s2 + 6], s[kb][8 * s2 + 7]);
      bf16x8 pf = __builtin_bit_cast(bf16x8, pu);
#pragma unroll
      for (int d = 0; d < 4; ++d) {
        const bf16* vp = Vs + (d * 32 + r) * 68 + st * 16 + 4 * h;
        uint2 lo = *(const uint2*)vp;
        uint2 hi = *(const uint2*)(vp + 8);
        uint4 vu = make_uint4(lo.x, lo.y, hi.x, hi.y);
        bf16x8 vf = __builtin_bit_cast(bf16x8, vu);
        o[d] = MFMA32(vf, pf, o[d]);
      }
    }
  }
}

struct NoHook { DI void operator()(int, const f32x16&) const {} };

template <int DK, bool PV, bool PF, class Ctx>
DI void attn_run(const bf16x8 (&qf)[DK / 16], f32x16 (&o)[4], float& m, float& l, const bf16* K1, int ldk1,
                 const bf16* K2, int ldk2, const bf16* Vt, int ldv, int first, Ctx& ctx, char* smem) {
  const int tid = otid();
  int tcur = first;
  if (tcur < 0) return;
  constexpr int CPR = DK / 8;
  constexpr int NKC = DK / 32;
  uint4 rk0, rk1, rk2, rk3, rk4 = make_uint4(0, 0, 0, 0), rk5 = make_uint4(0, 0, 0, 0), rv[4];
  float raux;
  bf16* Ks = (bf16*)smem;
  bf16* Vs = (bf16*)(smem + AT_VS);
  auto ldk = [&](int i, int key0) -> uint4 {
    int c = otid() + 256 * i;
    int row = c / CPR, cc = c % CPR;
    const bf16* src;
    if (DK == 128 || cc < 16) src = K1 + (size_t)(key0 + row) * ldk1 + cc * 8;
    else src = K2 + (size_t)(key0 + row) * ldk2 + (cc - 16) * 8;
    return *(const uint4*)src;
  };
  auto stk = [&](int i, const uint4& v) {
    int c = tid + 256 * i;
    int row = c / CPR, cc = c % CPR;
    *(uint4*)(Ks + row * (DK + 8) + cc * 8) = v;
  };
  auto gload = [&](int key0) {
    rk0 = ldk(0, key0); rk1 = ldk(1, key0); rk2 = ldk(2, key0); rk3 = ldk(3, key0);
    if (NKC > 4) { rk4 = ldk(4, key0); rk5 = ldk(5, key0); }
    const int tl = otid();
#pragma unroll
    for (int i = 0; i < 4; ++i) {
      int c = tl + 256 * i;
      int d = c >> 3, cc = c & 7;
      rv[i] = *(const uint4*)(Vt + (size_t)d * ldv + key0 + cc * 8);
    }
    raux = (tid < 64) ? ctx.aux(key0 + tid) : 0.f;
  };
  auto sstore = [&]() {
    stk(0, rk0); stk(1, rk1); stk(2, rk2); stk(3, rk3);
    if (NKC > 4) { stk(4, rk4); stk(5, rk5); }
#pragma unroll
    for (int i = 0; i < 4; ++i) {
      int c = tid + 256 * i;
      int d = c >> 3, cc = c & 7;
      uint2* dst = (uint2*)(Vs + d * 68 + cc * 8);
      dst[0] = make_uint2(rv[i].x, rv[i].y);
      dst[1] = make_uint2(rv[i].z, rv[i].w);
    }
    if (tid < 64) ((float*)(smem + AT_AUX))[tid] = raux;
  };
  if (PF) gload(tcur * 64);
  while (tcur >= 0) {
    __syncthreads();
    if (!PF) gload(tcur * 64);
    sstore();
    __syncthreads();
    int tnext = ctx.next(tcur);
    if (PF && tnext >= 0) gload(tnext * 64);
    if (!ctx.skip(tcur)) {
      const int tc = tcur;
      attn_tile<DK, PV>(qf, o, m, l, smem,
                        [&](float s, int kl, float ax) { return ctx.score(s, tc * 64 + kl, ax, tc); },
                        [&](int kb, const f32x16& pt) { ctx.hook(kb, pt, tc); });
    }
    tcur = tnext;
  }
}

template <int DK>
DI void load_q(bf16x8 (&qf)[DK / 16], const bf16* qrow, int h) {
#pragma unroll
  for (int ks = 0; ks < DK / 16; ++ks) qf[ks] = *(const bf16x8*)(qrow + ks * 16 + h * 8);
}
DI void zero_o(f32x16 (&o)[4]) {
#pragma unroll
  for (int d = 0; d < 4; ++d)
#pragma unroll
    for (int i = 0; i < 16; ++i) o[d][i] = 0.f;
}

struct CtxCausal {
  int tq, q0w, last; float sc;
  DI int next(int t) const { return t + 1 <= last ? t + 1 : -1; }
  DI float aux(int) const { return 0.f; }
  DI bool skip(int t) const { return t * 64 > q0w + 31; }
  DI float score(float s, int key, float, int) const { return key <= tq ? s * sc : NEG; }
  DI void hook(int, const f32x16&, int) const {}
};
struct CtxFox {
  int tq, q0w, last; float sc, cq; const float* cuml; const float* cpre;
  DI int next(int t) const { return t + 1 <= last ? t + 1 : -1; }
  DI float aux(int key) const { return cuml[key] + cpre[key >> 7]; }
  DI bool skip(int t) const { return t * 64 > q0w + 31; }
  DI float score(float s, int key, float ax, int) const { return key <= tq ? s * sc + (cq - ax) * LOG2E : NEG; }
  DI void hook(int, const f32x16&, int) const {}
};
struct CtxMem {
  float sc;
  DI int next(int t) const { return t + 1 < 4 ? t + 1 : -1; }
  DI float aux(int) const { return 0.f; }
  DI bool skip(int) const { return false; }
  DI float score(float s, int, float, int) const { return s * sc; }
  DI void hook(int, const f32x16&, int) const {}
};

DI void store_out_A(const f32x16 (&o)[4], float inv_l, const bf16* grow, bf16* orow, int h) {
#pragma unroll
  for (int d = 0; d < 4; ++d)
#pragma unroll
    for (int i4 = 0; i4 < 4; ++i4) {
      int dv0 = d * 32 + 8 * i4 + 4 * h;
      uint2 gu = *(const uint2*)(grow + dv0);
      float g0 = bflo(gu.x), g1 = bfhi(gu.x), g2 = bflo(gu.y), g3 = bfhi(gu.y);
      uint2 ou;
      ou.x = pack2(o[d][4 * i4 + 0] * inv_l * silu(g0), o[d][4 * i4 + 1] * inv_l * silu(g1));
      ou.y = pack2(o[d][4 * i4 + 2] * inv_l * silu(g2), o[d][4 * i4 + 3] * inv_l * silu(g3));
      *(uint2*)(orow + dv0) = ou;
    }
}

        struct CtxCmp {
          int tq, posq, last; float sc; const float* lutr; const int* pos; float invl; float* imp; int ql; bool p2;
          DI int next(int t) const { return t + 1 <= last ? t + 1 : -1; }
          DI float aux(int key) const { int n = key < 511 ? key : 510; return __int_as_float(pos[16 * n + 31]); }
          DI bool skip(int) const { return false; }
          DI float score(float s, int key, float ax, int) const {
            bool valid = (16 * key + 31 <= tq) && key < 511;
            int d = posq - __float_as_int(ax);
            d = d < 0 ? 0 : (d > 799 ? 799 : d);
            return valid ? s * sc + lutr[d] : NEG;
          }
          DI void hook(int kb, const f32x16& pt, int tc) const {
            if (!p2) return;
            const int lane = otid() & 63, h = lane >> 5, r = lane & 31;
#pragma unroll
            for (int gq = 0; gq < 4; ++gq) {
              float p3 = 0.5f * pt[4 * gq + 3];
              float vm = (pt[4 * gq] + pt[4 * gq + 1] + pt[4 * gq + 2] + p3) * invl;
              float vs = p3 * invl;
              vm += __shfl_xor(vm, 8); vm += __shfl_xor(vm, 16);
              vs += __shfl_xor(vs, 8); vs += __shfl_xor(vs, 16);
              int j = tc * 16 + kb * 8 + 2 * gq + h;
              if (r < 8) { atomicAdd(&imp[ql * 132 + j], vm); atomicAdd(&imp[ql * 132 + j + 1], vs); }
            }
          }
        };
struct CtxSlc {
  int tq, posq; float sc; const float* lutr; const int* pos; unsigned long long ulo, uhi, mlo, mhi;
  DI bool inu(int j) const {
    unsigned long long a = (ulo >> (j & 63)) & (j < 64 ? 1ull : 0ull);
    unsigned long long b = (uhi >> (j & 63)) & (j >= 64 ? 1ull : 0ull);
    return (a | b) != 0ull;
  }
  DI bool mine(int j) const {
    unsigned long long a = (mlo >> (j & 63)) & (j < 64 ? 1ull : 0ull);
    unsigned long long b = (mhi >> (j & 63)) & (j >= 64 ? 1ull : 0ull);
    return (a | b) != 0ull;
  }
  DI int next(int t) const { for (int j = t + 1; j < 128; ++j) if (inu(j)) return j; return -1; }
  DI float aux(int key) const { return __int_as_float(pos[key]); }
  DI bool skip(int) const { return false; }
  DI float score(float s, int key, float ax, int t) const {
    bool valid = mine(t) && key <= tq;
    int d = posq - __float_as_int(ax);
    d = d < 0 ? 0 : (d > 799 ? 799 : d);
    return valid ? s * sc + lutr[d] : NEG;
  }
  DI void hook(int, const f32x16&, int) const {}
};
struct CtxWin {
  int tq, posq, last; float sc; const float* lutr; const int* pos;
  DI int next(int t) const { return t + 1 <= last ? t + 1 : -1; }
  DI float aux(int key) const { return __int_as_float(pos[key]); }
  DI bool skip(int) const { return false; }
  DI float score(float s, int key, float ax, int) const {
    bool valid = key <= tq && (tq - key) < 512;
    int d = posq - __float_as_int(ax);
    d = d < 0 ? 0 : (d > 799 ? 799 : d);
    return valid ? s * sc + lutr[d] : NEG;
  }
  DI void hook(int, const f32x16&, int) const {}
};

#define XB_TMO      128
#define XB_XCNT(j)  (256  + 64 * (j))
#define XB_XSUB(j)  (1280 + 64 * (j))
#define XB_XGEN(j)  (2304 + 64 * (j))
#define XB_TOP      3328
#define XB_TOPGEN   3392
#define XCD_BAR_WORDS 3456
#define XB_SPIN_CAP (1u << 18)
#define LAS __attribute__((address_space(3)))

__device__ __forceinline__ unsigned xb_ld(unsigned* p)              { return __hip_atomic_load(p, __ATOMIC_RELAXED, __HIP_MEMORY_SCOPE_AGENT); }
__device__ __forceinline__ unsigned xb_add(unsigned* p, unsigned v) { return __hip_atomic_fetch_add(p, v, __ATOMIC_RELAXED, __HIP_MEMORY_SCOPE_AGENT); }
__device__ __forceinline__ unsigned xb_xcc_id() { return (unsigned)__builtin_amdgcn_s_getreg((3 << 11) | 20) & 0xFu; }
#define XB_SPIN(cond, bar) do { unsigned _sp = 0; while (cond) { __builtin_amdgcn_s_sleep(1); \
    if ((++_sp & 255u) == 0u) { if (xb_ld(&(bar)[XB_TMO])) break; if (_sp > XB_SPIN_CAP) { atomicAdd(&(bar)[XB_TMO], 1u); break; } } } } while (0)

struct XcdBarrier {
    unsigned* bar; unsigned x;
    volatile LAS unsigned* st;
};

__device__ __forceinline__ XcdBarrier xcd_barrier_post(unsigned* bar, volatile LAS unsigned* st) {
    XcdBarrier b; b.bar = bar; b.x = xb_xcc_id(); b.st = st;
    if (threadIdx.x == 0) (void)xb_add(&bar[XB_XCNT(b.x)], 1u);
    return b;
}
__device__ __forceinline__ void xcd_barrier_complete(unsigned* bar, unsigned x, unsigned& nloc, unsigned& nx) {
    const unsigned G = gridDim.x * gridDim.y * gridDim.z;
    unsigned sum, cnt, mine, sp = 0u;
    for (;;) {
        sum = 0u; cnt = 0u; mine = 0u;
#pragma unroll
        for (unsigned j = 0; j < 16; ++j) { const unsigned c = xb_ld(&bar[XB_XCNT(j)]); sum += c; cnt += (c > 0u) ? 1u : 0u; mine = (j == x) ? c : mine; }
        if (sum == G) break;
        __builtin_amdgcn_s_sleep(1);
        if ((++sp & 255u) == 0u) { if (xb_ld(&bar[XB_TMO])) break; if (sp > XB_SPIN_CAP) { atomicAdd(&bar[XB_TMO], 1u); break; } }
    }
    nloc = mine > 0u ? mine : 1u; nx = cnt > 0u ? cnt : 1u;
}

__device__ __forceinline__ void xcd_barrier(const XcdBarrier& b) {
    asm volatile("s_waitcnt vmcnt(0)" ::: "memory");
    __syncthreads();
    if (threadIdx.x == 0) {
        unsigned* bar = b.bar;
        __builtin_amdgcn_s_waitcnt(0);
        unsigned nloc = b.st[0], nx = b.st[1];
        if (nloc == 0u) { xcd_barrier_complete(bar, b.x, nloc, nx); b.st[0] = nloc; b.st[1] = nx; }
        const unsigned old = xb_add(&bar[XB_XSUB(b.x)], 1u);
        const unsigned gen = old / nloc;
        if (old + 1u == (gen + 1u) * nloc) {
            __builtin_amdgcn_fence(__ATOMIC_RELEASE, "agent");
            asm volatile("s_waitcnt vmcnt(0)" ::: "memory");
            const unsigned og = xb_add(&bar[XB_TOP], 1u);
            const unsigned tg = og / nx;
            if (og + 1u == (tg + 1u) * nx) xb_add(&bar[XB_TOPGEN], 1u);
            else XB_SPIN(xb_ld(&bar[XB_TOPGEN]) == tg, bar);
            __builtin_amdgcn_fence(__ATOMIC_ACQUIRE, "agent");
            xb_add(&bar[XB_XGEN(b.x)], 1u);
            asm volatile("s_waitcnt vmcnt(0)" ::: "memory");
        } else {
            XB_SPIN(xb_ld(&bar[XB_XGEN(b.x)]) == gen, bar);
            __builtin_amdgcn_fence(__ATOMIC_ACQUIRE, "agent");
            asm volatile("s_waitcnt vmcnt(0)" ::: "memory");
        }
    }
    __syncthreads();
}


__global__ void __launch_bounds__(256, LB2) mega(Params p, int ph_lo, int ph_hi) {
  __shared__ __attribute__((aligned(16))) char smem[SM_TOTAL];
  __shared__ int s_task;
  __shared__ uint4 xb_words;
  if (threadIdx.x == 0) xb_words = make_uint4(0u, 0u, 0u, 0u);
  __syncthreads();
  XcdBarrier xbar = xcd_barrier_post((unsigned*)(p.ws + WS_BAR), (volatile LAS unsigned*)&xb_words);
  const int bid = blockIdx.x, nb = gridDim.x;

  for (int ph = ph_lo; ph <= ph_hi; ++ph) {
    if (ph > ph_lo) {
      if (ph == ph_lo + 1) cg::this_grid().sync();
      else xcd_barrier(xbar);
    }
    const int nrep = (ph == REP_PH) ? 2 : 1;
    for (int rep = 0; rep < nrep; ++rep) {
    if (rep) cg::this_grid().sync();
    const int tid = otid(), lane = tid & 63, w = tid >> 6, r = lane & 31, h = lane >> 5;
    const int vb = (bid & 7) * (nb >> 3) + (bid >> 3);
    char* ws = p.ws + (tid - (int)threadIdx.x);
    bf16* XN = (bf16*)(ws + WS_XN);
    bf16* P = (bf16*)(ws + WS_P);
    bf16* MIXED = (bf16*)(ws + WS_MIXED);
    float* ROPEC = (float*)(ws + WS_ROPEC);
    float* ROPES = (float*)(ws + WS_ROPES);
    float* hbuf = p.out;
    int* CTR = (int*)(ws + WS_CTR);
    auto fetch_task = [&](int* ctr) {
      __syncthreads();
      if (tid == 0) s_task = atomicAdd(ctr, 1);
      __syncthreads();
      return s_task;
    };
    const int layer = ph == 0 ? 0 : (ph - 1) / 6;
    const int sub = ph == 0 ? -1 : (ph - 1) % 6;
    const bool even = (layer & 1) == 0;
    const int li = layer >> 1;
    const int NP = even ? NPE : NPO;

    if ((PHM & 1) && (ph == 0 || sub == 5)) {
      if (ph == 0) {
        if (bid == 0 && tid < 64) CTR[tid] = 0;
        for (int i = bid * 256 + tid; i < L * 32; i += nb * 256) {
          int t = i >> 5, f = i & 31;
          float inv = powf(10000.f, -(float)f / 32.f);
          float ang = (float)p.pos[t] * inv;
          ROPEC[i] = cosf(ang);
          ROPES[i] = sinf(ang);
        }
        for (int row = bid * 4 + w; row < 256; row += nb * 4)
          norm_row_bf16(p.mem + (size_t)row * DM, p.mem_norm_g, (bf16*)(ws + WS_MEMN) + (size_t)row * DM, lane);
      }
      const int nl = ph == 0 ? 0 : layer + 1;
      if (nl < 4) {
        const float* src = ph == 0 ? p.x : hbuf;
        for (int row = bid * 4 + w; row < L; row += nb * 4)
          norm_row_bf16(src + (size_t)row * DM, p.norm_g + nl * DM, XN + (size_t)row * DM, lane);
      } else {
        for (int row = bid * 4 + w; row < L; row += nb * 4) norm_row_f32(hbuf + (size_t)row * DM, p.final_norm_g, lane);
      }
    }
    if ((PHM & 2) && (ph == 0 || sub == 4)) {
      const int nl = ph == 0 ? 0 : layer + 1;
      if (nl < 4) {
        const bool ne = (nl & 1) == 0;
        const int nli = nl >> 1;
        const int s0 = ne ? SET_IN_EVEN : SET_IN_ODD, s2 = ne ? SET_MISC_EVEN : SET_MISC_ODD;
        const int c0 = cvt_set_count(p, s0, nli), c1 = cvt_set_count(p, SET_MEM, nl), c2 = cvt_set_count(p, s2, nli);
        const int cx = ne ? 16 : 32;
        for (int t = bid; t < c0 + c1 + c2 + cx; t += nb) {
          if (t < c0) cvt_set_task(p, s0, nli, t, smem);
          else if (t < c0 + c1) cvt_set_task(p, SET_MEM, nl, t - c0, smem);
          else if (t < c0 + c1 + c2) cvt_set_task(p, s2, nli, t - c0 - c1, smem);
          else {
            int e = t - c0 - c1 - c2;
            if (ne) {
              float* S5P = (float*)(ws + WS_S5P);
              int gp = e * 256 + tid;
              int g = gp >> 6;
              float dt = expf(p.log_dt[nli * 64 + g]);
              float lr = p.lam_re[nli * 4096 + gp], lim = p.lam_im[nli * 4096 + gp];
              float mag = expf(lr * dt);
              float abr = mag * cosf(lim * dt), abi = mag * sinf(lim * dt);
              float den = lr * lr + lim * lim;
              float nr = abr - 1.f;
              float fre = (nr * lr + abi * lim) / den;
              float fim = (abi * lr - nr * lim) / den;
              S5P[gp] = abr;
              S5P[4096 + gp] = abi;
              float ar = abr, ai = abi;
#pragma unroll
              for (int q = 0; q < 7; ++q) { float nr2 = ar * ar - ai * ai; ai = 2.f * ar * ai; ar = nr2; }
              S5P[8192 + gp] = ar;
              S5P[12288 + gp] = ai;
              const float* br = p.b_re + (size_t)nli * 65536 + gp * 16;
              const float* bi = p.b_im + (size_t)nli * 65536 + gp * 16;
#pragma unroll
              for (int c = 0; c < 16; ++c) {
                S5P[16384 + gp * 16 + c] = fre * br[c] - fim * bi[c];
                S5P[16384 + 65536 + gp * 16 + c] = fre * bi[c] + fim * br[c];
              }
            } else {
              int which = e >> 4, part = e & 15;
              const float* pe = p.cmp_pe + (size_t)(nli * 2 + which) * 4096 + part * 256;
              const float* w1 = p.cmp_w1 + ((size_t)(nli * 2 + which) * 4096 + part * 256) * 256 + tid;
              float acc = 0.f;
#pragma unroll 8
              for (int k = 0; k < 256; ++k) acc += pe[k] * w1[(size_t)k * 256];
              ((float*)(ws + WS_CMPB))[(which * 16 + part) * 256 + tid] = acc;
            }
          }
        }
      }
    }
    if ((PHM & 4) && sub == 0) {
      const int ntn = NP / 128;
      const int n_in = 64 * ntn;
      const bf16* Win = (const bf16*)(ws + WS_WIN);
      for (int t = vb; t < n_in + 16; t += nb) {
        if (t < n_in) {
          int tm, tn;
          tile_map(t, ntn, tm, tn);
          const int m0 = tm * 128, n0 = tn * 128;
          ALin af{XN + (size_t)m0 * DM, DM};
          if (even) {
            gemm_tile(af, Win + (size_t)n0 * DM, DM, DM, smem, [&](const float* Cs) {
              if (n0 >= 4096 && n0 < 5120) {
                bf16* VT = (bf16*)(ws + WS_VTFOX);
                epi_cols(Cs, [&](int col, int r8, const float* v) {
                  *(uint4*)(VT + (size_t)(n0 - 4096 + col) * L + m0 + r8) = pack8(v);
                });
              } else if (n0 == 7168) {
                float* FL = (float*)(ws + WS_FLOG);
                for (int i = tid; i < 128 * 8; i += 256) {
                  int row = i >> 3, c = i & 7;
                  FL[(size_t)(m0 + row) * 8 + c] = Cs[row * 132 + c];
                }
              } else {
                epi_rows(Cs, [&](int row, int cc, const float* v) {
                  *(uint4*)(P + (size_t)(m0 + row) * NPE + n0 + cc) = pack8(v);
                });
              }
            });
          } else {
            gemm_tile(af, Win + (size_t)n0 * DM, DM, DM, smem, [&](const float* Cs) {
              if (n0 == 3840 || n0 == 3968 || n0 == 4352 || n0 == 4480) {
                bf16* VT = (n0 < 4096) ? (bf16*)(ws + WS_VTSLC) + (size_t)(n0 - 3840) * L
                                       : (bf16*)(ws + WS_VTWIN) + (size_t)(n0 - 4352) * L;
                epi_cols(Cs, [&](int col, int r8, const float* v) {
                  *(uint4*)(VT + (size_t)col * L + m0 + r8) = pack8(v);
                });
              } else if (n0 == 6656) {
                epi_rope(Cs, 0, m0, ROPEC, ROPES, 1.f, [&](int row, int cl, const float* v) {
                  *(uint4*)(P + (size_t)(m0 + row) * NPO + 6656 + cl) = pack8(v);
                });
                float* GT = (float*)(ws + WS_FLOG);
                for (int i = tid; i < 128 * 24; i += 256) {
                  int row = i / 24, c = i % 24;
                  GT[(size_t)(m0 + row) * 24 + c] = Cs[row * 132 + 64 + c];
                }
              } else {
                epi_rows(Cs, [&](int row, int cc, const float* v) {
                  *(uint4*)(P + (size_t)(m0 + row) * NPO + n0 + cc) = pack8(v);
                });
              }
            });
          }
        } else {
          const int t2 = t - n_in;
          const int m0 = (t2 >> 3) * 128, n0 = (t2 & 7) * 128;
          ALin af{(const bf16*)(ws + WS_MEMN) + (size_t)m0 * DM, DM};
          gemm_tile(af, (const bf16*)(ws + WS_WMEM) + (size_t)n0 * DM, DM, DM, smem, [&](const float* Cs) {
            if (n0 < 512) {
              bf16* MK = (bf16*)(ws + WS_MEMK);
              epi_rows(Cs, [&](int row, int cc, const float* v) {
                *(uint4*)(MK + (size_t)(m0 + row) * 512 + n0 + cc) = pack8(v);
              });
            } else {
              bf16* MV = (bf16*)(ws + WS_MEMVT);
              epi_cols(Cs, [&](int col, int r8, const float* v) {
                *(uint4*)(MV + (size_t)(n0 - 512 + col) * 256 + m0 + r8) = pack8(v);
              });
            }
          });
        }
      }
    }

    auto mem_attn_task = [&](int t) {
      const int qt = t >> 2, head = t & 3;
      const int tq = qt * 128 + w * 32 + r;
      const int qcol = even ? 6144 : 5632, gcol = even ? 6656 : 6144;
      bf16x8 qf[8];
      load_q<128>(qf, P + (size_t)tq * NP + qcol + head * 128, h);
      f32x16 o[4];
      zero_o(o);
      float m = NEG, l = 0.f;
      CtxMem ctx{0.08838834764831845f * LOG2E};
      attn_run<128, true, true>(qf, o, m, l, (const bf16*)(ws + WS_MEMK) + head * 128, 512, nullptr, 0,
                          (const bf16*)(ws + WS_MEMVT) + (size_t)head * 128 * 256, 256, 0, ctx, smem);
      float lt = l + __shfl_xor(l, 32);
      store_out_A(o, 1.f / lt, P + (size_t)tq * NP + gcol + head * 128, MIXED + (size_t)tq * MIXW + 2048 + head * 128, h);
    };

    if ((PHM & 8) && sub == 1 && even) {
      const int cw = cvt_set_count(p, SET_OUT, layer);
      const int n_s5 = 1024, n_cum = 64, n_mem = 256;
      for (int t = bid; t < n_mem + n_s5 + n_cum + cw; t += nb) {
        if (t < n_mem) {
          mem_attn_task(t);
        } else if (t < n_mem + n_s5) {
          const int t2 = t - n_mem;
          const int ch = t2 >> 4, gq = t2 & 15;
          float* us = (float*)smem;
          __syncthreads();
          for (int i = tid; i < 128 * 8; i += 256) {
            int tt = i >> 3, c8 = (i & 7) * 8;
            uint4 u = *(const uint4*)(P + (size_t)(ch * 128 + tt) * NPE + gq * 64 + c8);
            float* d = us + tt * 64 + c8;
            d[0] = bflo(u.x); d[1] = bfhi(u.x); d[2] = bflo(u.y); d[3] = bfhi(u.y);
            d[4] = bflo(u.z); d[5] = bfhi(u.z); d[6] = bflo(u.w); d[7] = bfhi(u.w);
          }
          __syncthreads();
          const float* S5P = (const float*)(ws + WS_S5P);
          const int gp = (gq * 4 + w) * 64 + lane;
          const float ar = S5P[gp], ai = S5P[4096 + gp];
          float bbr[16], bbi[16];
#pragma unroll
          for (int c = 0; c < 16; ++c) { bbr[c] = S5P[16384 + gp * 16 + c]; bbi[c] = S5P[16384 + 65536 + gp * 16 + c]; }
          float xr = 0.f, xi = 0.f;
          for (int tt = 0; tt < 128; ++tt) {
            const float* up = us + tt * 64 + w * 16;
            float bur = 0.f, bui = 0.f;
#pragma unroll
            for (int c = 0; c < 16; ++c) { float uv = up[c]; bur += bbr[c] * uv; bui += bbi[c] * uv; }
            float nxr = ar * xr - ai * xi + bur;
            float nxi = ar * xi + ai * xr + bui;
            xr = nxr; xi = nxi;
          }
          float2* E = (float2*)(ws + WS_S5E);
          E[(size_t)ch * 4096 + gp] = make_float2(xr, xi);
        } else if (t < n_mem + n_s5 + n_cum) {
          const int ch = t - n_mem - n_s5;
          const float* FL = (const float*)(ws + WS_FLOG);
          float* CUML = (float*)(ws + WS_CUML);
          float* CT = (float*)(ws + WS_CT);
#pragma unroll
          for (int hh = 0; hh < 2; ++hh) {
            const int head = w * 2 + hh;
            const float bf = p.fox_b_f[li * 8 + head];
            const int t0 = ch * 128 + lane * 2;
            float x0 = FL[(size_t)t0 * 8 + head] + bf, x1 = FL[(size_t)(t0 + 1) * 8 + head] + bf;
            float v0 = x0 >= 0.f ? -log1pf(expf(-x0)) : x0 - log1pf(expf(x0));
            float v1 = x1 >= 0.f ? -log1pf(expf(-x1)) : x1 - log1pf(expf(x1));
            float s = v0 + v1;
            float inc = s;
#pragma unroll
            for (int o = 1; o < 64; o <<= 1) {
              float n = __shfl_up(inc, o);
              if (lane >= o) inc += n;
            }
            float excl = inc - s;
            CUML[(size_t)head * L + t0] = excl + v0;
            CUML[(size_t)head * L + t0 + 1] = excl + v0 + v1;
            if (lane == 63) CT[head * 64 + ch] = inc;
          }
        } else {
          cvt_set_task(p, SET_OUT, layer, t - n_mem - n_s5 - n_cum, smem);
        }
      }
    }
    if ((PHM & 16) && sub == 2 && even) {
      const int n_fox = 512, n_s5 = 1024;
      for (;;) {
        const int t = fetch_task(CTR + ph);
        if (t >= n_fox + n_s5) break;
        if (t < n_fox) {
          const int qt = 63 - (t >> 3), head = t & 7;
          const int q0w = qt * 128 + w * 32, tq = q0w + r;
          float* cpre = (float*)(smem + AT_X0);
          __syncthreads();
          if (tid < 64) {
            const float* CT = (const float*)(ws + WS_CT) + head * 64;
            float acc = 0.f;
            for (int c = 0; c < tid; ++c) acc += CT[c];
            cpre[tid] = acc;
          }
          __syncthreads();
          const float* cuml = (const float*)(ws + WS_CUML) + (size_t)head * L;
          bf16x8 qf[8];
          load_q<128>(qf, P + (size_t)tq * NPE + 2048 + head * 128, h);
          f32x16 o[4];
          zero_o(o);
          float m = NEG, l = 0.f;
          CtxFox ctx{tq, q0w, 2 * qt + 1, 0.08838834764831845f * LOG2E, cuml[tq] + cpre[tq >> 7], cuml, cpre};
          attn_run<128, true, true>(qf, o, m, l, P + 3072 + head * 128, NPE, nullptr, 0,
                              (const bf16*)(ws + WS_VTFOX) + (size_t)head * 128 * L, L, 0, ctx, smem);
          float lt = l + __shfl_xor(l, 32);
          store_out_A(o, 1.f / lt, P + (size_t)tq * NPE + 5120 + head * 128, MIXED + (size_t)tq * MIXW + 1024 + head * 128, h);
        } else {
          const int t2 = t - n_fox;
          const int ch = t2 >> 4, gq = t2 & 15;
          float* us = (float*)smem;
          float* xs = (float*)(smem + 32768) + w * 16 * 132;
          __syncthreads();
          for (int i = tid; i < 128 * 8; i += 256) {
            int tt = i >> 3, c8 = (i & 7) * 8;
            uint4 u = *(const uint4*)(P + (size_t)(ch * 128 + tt) * NPE + gq * 64 + c8);
            float* d = us + tt * 64 + c8;
            d[0] = bflo(u.x); d[1] = bfhi(u.x); d[2] = bflo(u.y); d[3] = bfhi(u.y);
            d[4] = bflo(u.z); d[5] = bfhi(u.z); d[6] = bflo(u.w); d[7] = bfhi(u.w);
          }
          __syncthreads();
          const float* S5P = (const float*)(ws + WS_S5P);
          const int g = gq * 4 + w;
          const int gp = g * 64 + lane;
          const float ar = S5P[gp], ai = S5P[4096 + gp];
          const float atr = S5P[8192 + gp], ati = S5P[12288 + gp];
          float xr = 0.f, xi = 0.f;
          {
            const float2* E = (const float2*)(ws + WS_S5E) + gp;
#define CSTEP(e) { float nxr = atr * xr - ati * xi + e.x; float nxi = atr * xi + ati * xr + e.y; xr = nxr; xi = nxi; }
            int c = 0;
            for (; c + 8 <= ch; c += 8) {
              float2 e0 = E[(size_t)(c + 0) * 4096], e1 = E[(size_t)(c + 1) * 4096], e2 = E[(size_t)(c + 2) * 4096],
                     e3 = E[(size_t)(c + 3) * 4096], e4 = E[(size_t)(c + 4) * 4096], e5 = E[(size_t)(c + 5) * 4096],
                     e6 = E[(size_t)(c + 6) * 4096], e7 = E[(size_t)(c + 7) * 4096];
              CSTEP(e0) CSTEP(e1) CSTEP(e2) CSTEP(e3) CSTEP(e4) CSTEP(e5) CSTEP(e6) CSTEP(e7)
            }
            for (; c < ch; ++c) {
              float2 e = E[(size_t)c * 4096];
              CSTEP(e)
            }
#undef CSTEP
          }
          float bbr[16], bbi[16];
#pragma unroll
          for (int c = 0; c < 16; ++c) { bbr[c] = S5P[16384 + gp * 16 + c]; bbi[c] = S5P[16384 + 65536 + gp * 16 + c]; }
          const int chn = lane & 15, kq = lane >> 4;
          float cb[32];
          {
            const float* cre = p.c_re + ((size_t)li * 64 + g) * 1024 + chn * 64;
            const float* cim = p.c_im + ((size_t)li * 64 + g) * 1024 + chn * 64;
#pragma unroll
            for (int ks = 0; ks < 16; ++ks) { cb[ks] = cre[4 * ks + kq]; cb[16 + ks] = -cim[4 * ks + kq]; }
          }
          const float dsk = p.s5_d[li * 1024 + g * 16 + chn];
          bf16* Z = (bf16*)(ws + WS_Z);
          for (int sc = 0; sc < 8; ++sc) {
#pragma unroll 4
            for (int tt = 0; tt < 16; ++tt) {
              const float* up = us + (sc * 16 + tt) * 64 + w * 16;
              float bur = 0.f, bui = 0.f;
#pragma unroll
              for (int c = 0; c < 16; ++c) { float uv = up[c]; bur += bbr[c] * uv; bui += bbi[c] * uv; }
              float nxr = ar * xr - ai * xi + bur;
              float nxi = ar * xi + ai * xr + bui;
              xr = nxr; xi = nxi;
              xs[tt * 132 + lane] = xr;
              xs[tt * 132 + 64 + lane] = xi;
            }
            __syncthreads();
            f32x4 y = {0.f, 0.f, 0.f, 0.f};
#pragma unroll
            for (int ks = 0; ks < 32; ++ks) {
              float a = xs[chn * 132 + 4 * ks + kq];
              y = __builtin_amdgcn_mfma_f32_16x16x4f32(a, cb[ks], y, 0, 0, 0);
            }
#pragma unroll
            for (int i = 0; i < 4; ++i) {
              int tt = 4 * kq + i;
              float uv = us[(sc * 16 + tt) * 64 + w * 16 + chn];
              float yy = y[i] + dsk * uv;
              Z[(size_t)(ch * 128 + sc * 16 + tt) * 1024 + g * 16 + chn] = f2bf(gelu_t(yy));
            }
            __syncthreads();
          }
        }
      }
    }
    if ((PHM & 32) && sub == 3 && even) {
      const bf16* Z = (const bf16*)(ws + WS_Z);
      for (int t = vb; t < 64 * 8; t += nb) {
        int tm, tn;
        tile_map(t, 8, tm, tn);
        const int m0 = tm * 128, n0 = tn * 128;
        ALin af{Z + (size_t)m0 * 1024, 1024};
        gemm_tile(af, (const bf16*)(ws + WS_WMISC + WM_GLU) + (size_t)n0 * 1024, 1024, 1024, smem, [&](const float* Cs) {
          epi_rows(Cs, [&](int row, int cc, const float* v) {
            uint4 zu = *(const uint4*)(Z + (size_t)(m0 + row) * 1024 + n0 + cc);
            uint4 gu = *(const uint4*)(P + (size_t)(m0 + row) * NPE + 1024 + n0 + cc);
            float zz[8] = {bflo(zu.x), bfhi(zu.x), bflo(zu.y), bfhi(zu.y), bflo(zu.z), bfhi(zu.z), bflo(zu.w), bfhi(zu.w)};
            float gg[8] = {bflo(gu.x), bfhi(gu.x), bflo(gu.y), bfhi(gu.y), bflo(gu.z), bfhi(gu.z), bflo(gu.w), bfhi(gu.w)};
            float o[8];
#pragma unroll
            for (int e = 0; e < 8; ++e) o[e] = zz[e] * sigm(v[e]) * silu(gg[e]);
            *(uint4*)(MIXED + (size_t)(m0 + row) * MIXW + n0 + cc) = pack8(o);
          });
        });
      }
    }
    if ((PHM & 64) && sub == 1 && !even) {
      const int cw = cvt_set_count(p, SET_OUT, layer);
      const int n_c1 = 32, n_q = 64 * 12, n_kv = 64 * 16, n_mem = 0;
      float* rsx = (float*)(smem + SM_EXTRA);
      for (int t = vb; t < n_c1 + n_q + n_kv + n_mem + cw; t += nb) {
        if (t < n_c1) {
          const int which = t >> 4, tm = (t >> 1) & 7, tn = t & 1;
          const int m0 = tm * 128, n0 = tn * 128;
          __syncthreads();
          if (tid < 128) {
            const float* CB = (const float*)(ws + WS_CMPB) + which * 16 * 256 + n0 + tid;
            float b = 0.f;
            for (int q = 0; q < 16; ++q) b += CB[q * 256];
            rsx[tid] = b;
          }
          ACmp af{P + (which ? 3328 : 3072), m0};
          bf16* HID = (bf16*)(ws + WS_HID) + (size_t)which * 1024 * 256;
          gemm_tile(af, (const bf16*)(ws + WS_WMISC + WM_W1) + (size_t)which * 256 * 4096 + (size_t)n0 * 4096, 4096, 4096,
                    smem, [&](const float* Cs) {
                      epi_rows(Cs, [&](int row, int cc, const float* v) {
                        float o[8];
#pragma unroll
                        for (int e = 0; e < 8; ++e) o[e] = gelu_t(v[e] + rsx[cc + e]);
                        *(uint4*)(HID + (size_t)(m0 + row) * 256 + n0 + cc) = pack8(o);
                      });
                    });
        } else if (t < n_c1 + n_q + n_kv) {
          const int t2 = t - n_c1;
          const bool isq = t2 < n_q;
          const int t3 = isq ? t2 : t2 - n_q;
          const int ntn = isq ? 12 : 16;
          int tm, tn;
          tile_map(t3, ntn, tm, tn);
          const int m0 = tm * 128, n0 = tn * 128;
          const bf16* Ab = P + (size_t)m0 * NPO + (isq ? 0 : 512);
          __syncthreads();
          for (int rr = 0; rr < 32; ++rr) {
            int row = w * 32 + rr;
            uint4 u = *(const uint4*)(Ab + (size_t)row * NPO + lane * 8);
            float a0 = bflo(u.x), a1 = bfhi(u.x), a2 = bflo(u.y), a3 = bfhi(u.y), a4 = bflo(u.z), a5 = bfhi(u.z),
                  a6 = bflo(u.w), a7 = bfhi(u.w);
            float ss = a0 * a0 + a1 * a1 + a2 * a2 + a3 * a3 + a4 * a4 + a5 * a5 + a6 * a6 + a7 * a7;
            ss = wave_sum(ss);
            if (lane == 0) rsx[row] = rsqrtf(ss * (1.f / 512.f) + EPS);
          }
          ALin af{Ab, NPO};
          if (isq) {
            bf16* QM = (bf16*)(ws + WS_QMLA);
            gemm_tile(af, (const bf16*)(ws + WS_WMISC + WM_UQ) + (size_t)n0 * 512, 512, 512, smem, [&](const float* Cs) {
              const int md = n0 % 192;
              const int ropehalf = md == 128 ? 0 : (md == 64 ? 1 : -1);
              epi_rows(Cs, [&](int row, int cc, const float* v) {
                if ((cc >> 6) == ropehalf) return;
                float o[8];
                float sc = rsx[row];
#pragma unroll
                for (int e = 0; e < 8; ++e) o[e] = v[e] * sc;
                *(uint4*)(QM + (size_t)(m0 + row) * 1536 + n0 + cc) = pack8(o);
              });
              if (ropehalf >= 0) {
                epi_rope(Cs, ropehalf * 64, m0, ROPEC, ROPES, 1.f, [&](int row, int cl, const float* v) {
                  float o[8];
                  float sc = rsx[row];
#pragma unroll
                  for (int e = 0; e < 8; ++e) o[e] = v[e] * sc;
                  *(uint4*)(QM + (size_t)(m0 + row) * 1536 + n0 + ropehalf * 64 + cl) = pack8(o);
                });
              }
            });
          } else {
            gemm_tile(af, (const bf16*)(ws + WS_WMISC + WM_UKV) + (size_t)n0 * 512, 512, 512, smem, [&](const float* Cs) {
              const int head = n0 >> 8, part = (n0 >> 7) & 1;
              if (part == 0) {
                bf16* KM = (bf16*)(ws + WS_KMLA);
                epi_rows(Cs, [&](int row, int cc, const float* v) {
                  float o[8];
                  float sc = rsx[row];
#pragma unroll
                  for (int e = 0; e < 8; ++e) o[e] = v[e] * sc;
                  *(uint4*)(KM + (size_t)(m0 + row) * 1024 + head * 128 + cc) = pack8(o);
                });
              } else {
                bf16* VT = (bf16*)(ws + WS_VTMLA);
                epi_cols(Cs, [&](int col, int r8, const float* v) {
                  float o[8];
#pragma unroll
                  for (int e = 0; e < 8; ++e) o[e] = v[e] * rsx[r8 + e];
                  *(uint4*)(VT + (size_t)(head * 128 + col) * L + m0 + r8) = pack8(o);
                });
              }
            });
          }
        } else if (t < n_c1 + n_q + n_kv + n_mem) {
          mem_attn_task(t - n_c1 - n_q - n_kv);
        } else {
          cvt_set_task(p, SET_OUT, layer, t - n_c1 - n_q - n_kv - n_mem, smem);
        }
      }
    }
    if ((PHM & 128) && sub == 2 && !even) {
      const int n_c2 = 16, n_mem2 = 256;
      for (int t = bid; t < n_c2 + n_mem2; t += nb) {
        if (t >= n_c2) {
          mem_attn_task(t - n_c2);
        } else {
          const int t2 = t;
          const int which = t2 >> 3, m0 = (t2 & 7) * 128;
          ALin af{(const bf16*)(ws + WS_HID) + (size_t)which * 1024 * 256 + (size_t)m0 * 256, 256};
          gemm_tile(af, (const bf16*)(ws + WS_WMISC + WM_W2) + (size_t)which * 128 * 256, 256, 256, smem, [&](const float* Cs) {
            if (which == 0) {
              bf16* KC = (bf16*)(ws + WS_KC);
              epi_rows(Cs, [&](int row, int cc, const float* v) {
                int gr = m0 + row;
                int n = gr >> 1, g = gr & 1;
                *(uint4*)(KC + ((size_t)g * 512 + n) * 128 + cc) = pack8(v);
              });
            } else {
              bf16* VC = (bf16*)(ws + WS_VCT);
              for (int i = tid; i < 128 * 128; i += 256) {
                int row = i & 127, col = i >> 7;
                int gr = m0 + row;
                int n = gr >> 1, g = gr & 1;
                VC[((size_t)g * 128 + col) * 512 + n] = f2bf(Cs[row * 132 + col]);
              }
            }
          });
        }
      }
    }
    if ((PHM & 256) && sub == 3 && !even) {
      const int* pos = p.pos;
      float* lut = (float*)(smem + AT_X0);
      float* imp = (float*)(smem + AT_IMP);
      unsigned* sel = (unsigned*)(smem + AT_SEL);
      const float* GT = (const float*)(ws + WS_FLOG);
      float* NSAO = (float*)(ws + WS_NSAO);
      for (;;) {
        const int tt_ = fetch_task(CTR + ph);
        if (tt_ >= 1024) break;
        const int t = tt_ >> 1;
        const int tid = otid(), lane = tid & 63, w = tid >> 6, r = lane & 31, h = lane >> 5;
        if ((tt_ & 1) == 0) {
          const int qt = 63 - (t >> 3), head = t & 7;
          const int q0w = qt * 128 + w * 32, tq = q0w + r;
          bf16x8 qf[12];
          load_q<192>(qf, (const bf16*)(ws + WS_QMLA) + (size_t)tq * 1536 + head * 192, h);
          f32x16 o[4];
          zero_o(o);
          float m = NEG, l = 0.f;
          CtxCausal ctx{tq, q0w, 2 * qt + 1, 0.07216878364870322f * LOG2E};
          attn_run<192, true, true>(qf, o, m, l, (const bf16*)(ws + WS_KMLA) + head * 128, 1024, P + 6656, NPO,
                              (const bf16*)(ws + WS_VTMLA) + (size_t)head * 128 * L, L, 0, ctx, smem);
          float lt = l + __shfl_xor(l, 32);
          store_out_A(o, 1.f / lt, P + (size_t)tq * NPO + 1024 + head * 128, MIXED + (size_t)tq * MIXW + head * 128, h);
          continue;
        }
        const int qt = 255 - (t >> 1), g = t & 1;
        const int q0 = qt * 32;
        const int hr = r >> 3, qi = r & 7;
        const int ql = w * 8 + qi;
        const int tq = q0 + ql;
        const int head = g * 4 + hr;
        const int posq = pos[tq];
        __syncthreads();
        for (int i = tid; i < 4 * 800; i += 256) {
          int rr = i / 800, n = i % 800;
          int b;
          if (n < 16) b = n;
          else {
            float lr = logf((float)n / 16.f) / 4.1588830833596715f;
            b = 16 + (int)(lr * 16.f);
            if (b > 31) b = 31;
          }
          lut[i] = p.t5[b * 8 + g * 4 + rr] * LOG2E;
        }
        for (int i = tid; i < 32 * 132; i += 256) imp[i] = 0.f;
        __syncthreads();
        const float* lutr = lut + hr * 800;
        bf16x8 qf[8];
        load_q<128>(qf, P + (size_t)tq * NPO + 2048 + head * 128, h);
        const float sc = 0.08838834764831845f * LOG2E;
        f32x16 o[4];
        float* orow = NSAO + (size_t)tq * 1024 + head * 128;

        const int ncv = min(q0 / 16 + 1, 511);
        const int last_c = (ncv - 1) >> 6;
        float m = NEG, l = 0.f;
        CtxCmp cc{tq, posq, last_c, sc, lutr, pos, 0.f, imp, ql, false};
        zero_o(o);
        const bf16* KCg = (const bf16*)(ws + WS_KC) + (size_t)g * 512 * 128;
        const bf16* VCg = (const bf16*)(ws + WS_VCT) + (size_t)g * 128 * 512;
        attn_run<128, false, false>(qf, o, m, l, KCg, 128, nullptr, 0, VCg, 512, 0, cc, smem);
        float lt = l + __shfl_xor(l, 32);
        const bool has_c = m > -1e29f;
        float m2 = has_c ? m : 0.f;
        float invl = has_c ? 1.f / lt : 0.f;
        cc.invl = invl; cc.p2 = true;
        float l2 = 0.f;
        attn_run<128, true, false>(qf, o, m2, l2, KCg, 128, nullptr, 0, VCg, 512, 0, cc, smem);
        {
          float gs = sigm(GT[(size_t)tq * 24 + head * 3 + 0]) * invl;
#pragma unroll
          for (int d = 0; d < 4; ++d)
#pragma unroll
            for (int i4 = 0; i4 < 4; ++i4) {
              int dv0 = d * 32 + 8 * i4 + 4 * h;
              float4 v = make_float4(o[d][4 * i4] * gs, o[d][4 * i4 + 1] * gs, o[d][4 * i4 + 2] * gs, o[d][4 * i4 + 3] * gs);
              *(float4*)(orow + dv0) = v;
            }
        }
        __syncthreads();
        for (int q8 = 0; q8 < 8; ++q8) {
          const int qq = w * 8 + q8;
          const int tt = q0 + qq;
          const int cur = tt >> 6;
          const float* ip = imp + qq * 132;
          const int j0 = lane, j1 = lane + 64;
          const bool v0 = j0 <= cur, v1 = j1 <= cur;
          const bool f0 = (j0 == 0) || (j0 == cur) || (j0 == cur - 1);
          const bool f1 = (j1 == cur) || (j1 == cur - 1);
          const int nforced = cur == 0 ? 1 : (cur == 1 ? 2 : 3);
          const int nfree = 16 - nforced;
          const float a0 = ip[j0], a1 = ip[j1];
          int r0 = 0, r1 = 0;
          for (int jj = 0; jj <= cur; ++jj) {
            bool fj = (jj == 0) || (jj == cur) || (jj == cur - 1);
            if (fj) continue;
            float vj = ip[jj];
            r0 += (vj > a0 || (vj == a0 && jj < j0)) ? 1 : 0;
            r1 += (vj > a1 || (vj == a1 && jj < j1)) ? 1 : 0;
          }
          bool s0 = v0 && (f0 || r0 < nfree);
          bool s1 = v1 && (f1 || r1 < nfree);
          unsigned long long b0 = __ballot(s0), b1 = __ballot(s1);
          if (lane == 0) {
            sel[qq * 4 + 0] = (unsigned)b0; sel[qq * 4 + 1] = (unsigned)(b0 >> 32);
            sel[qq * 4 + 2] = (unsigned)b1; sel[qq * 4 + 3] = (unsigned)(b1 >> 32);
          }
        }
        __syncthreads();
        unsigned un0, un1, un2, un3;
        {
          un0 = sel[r * 4 + 0]; un1 = sel[r * 4 + 1]; un2 = sel[r * 4 + 2]; un3 = sel[r * 4 + 3];
#pragma unroll
          for (int of = 1; of < 32; of <<= 1) {
            un0 |= __shfl_xor(un0, of); un1 |= __shfl_xor(un1, of); un2 |= __shfl_xor(un2, of); un3 |= __shfl_xor(un3, of);
          }
          un0 = __builtin_amdgcn_readfirstlane(un0); un1 = __builtin_amdgcn_readfirstlane(un1);
          un2 = __builtin_amdgcn_readfirstlane(un2); un3 = __builtin_amdgcn_readfirstlane(un3);
        }
        {
          CtxSlc cs{tq, posq, sc, lutr, pos, (unsigned long long)un0 | ((unsigned long long)un1 << 32),
                    (unsigned long long)un2 | ((unsigned long long)un3 << 32),
                    (unsigned long long)sel[ql * 4] | ((unsigned long long)sel[ql * 4 + 1] << 32),
                    (unsigned long long)sel[ql * 4 + 2] | ((unsigned long long)sel[ql * 4 + 3] << 32)};
          zero_o(o);
          m = NEG; l = 0.f;
          attn_run<128, true, false>(qf, o, m, l, P + 3584 + g * 128, NPO, nullptr, 0,
                              (const bf16*)(ws + WS_VTSLC) + (size_t)g * 128 * L, L, 0, cs, smem);
          lt = l + __shfl_xor(l, 32);
          float gs = sigm(GT[(size_t)tq * 24 + head * 3 + 1]) / lt;
#pragma unroll
          for (int d = 0; d < 4; ++d)
#pragma unroll
            for (int i4 = 0; i4 < 4; ++i4) {
              int dv0 = d * 32 + 8 * i4 + 4 * h;
              float4 v = *(float4*)(orow + dv0);
              v.x += o[d][4 * i4] * gs; v.y += o[d][4 * i4 + 1] * gs; v.z += o[d][4 * i4 + 2] * gs; v.w += o[d][4 * i4 + 3] * gs;
              *(float4*)(orow + dv0) = v;
            }
        }
        {
          const int kfirst = q0 - 511 > 0 ? (q0 - 511) >> 6 : 0;
          CtxWin cwn{tq, posq, (q0 + 31) >> 6, sc, lutr, pos};
          zero_o(o);
          m = NEG; l = 0.f;
          attn_run<128, true, false>(qf, o, m, l, P + 4096 + g * 128, NPO, nullptr, 0,
                              (const bf16*)(ws + WS_VTWIN) + (size_t)g * 128 * L, L, kfirst, cwn, smem);
          lt = l + __shfl_xor(l, 32);
          float gs = sigm(GT[(size_t)tq * 24 + head * 3 + 2]) / lt;
          const bf16* grow = P + (size_t)tq * NPO + 4608 + head * 128;
          bf16* mrow = MIXED + (size_t)tq * MIXW + 1024 + head * 128;
#pragma unroll
          for (int d = 0; d < 4; ++d)
#pragma unroll
            for (int i4 = 0; i4 < 4; ++i4) {
              int dv0 = d * 32 + 8 * i4 + 4 * h;
              float4 v = *(float4*)(orow + dv0);
              v.x += o[d][4 * i4] * gs; v.y += o[d][4 * i4 + 1] * gs; v.z += o[d][4 * i4 + 2] * gs; v.w += o[d][4 * i4 + 3] * gs;
              uint2 gu = *(const uint2*)(grow + dv0);
              uint2 ou;
              ou.x = pack2(v.x * silu(bflo(gu.x)), v.y * silu(bfhi(gu.x)));
              ou.y = pack2(v.z * silu(bflo(gu.y)), v.w * silu(bfhi(gu.y)));
              *(uint2*)(mrow + dv0) = ou;
            }
        }
      }
    }
    if ((PHM & 512) && sub == 4) {
      const float* hin = layer == 0 ? p.x : hbuf;
      for (int t = vb; t < 64 * 16; t += nb) {
        int tm, tn;
        tile_map(t, 16, tm, tn);
        const int m0 = tm * 128, n0 = tn * 128;
        ALin af{MIXED + (size_t)m0 * MIXW, MIXW};
        gemm_tile(af, (const bf16*)(ws + WS_WOUT) + (size_t)n0 * MIXW, MIXW, MIXW, smem, [&](const float* Cs) {
          const int tid2 = otid();
#pragma unroll
          for (int j = 0; j < 16; ++j) {
            int c = tid2 + 256 * j;
            int row = c >> 5, cc = (c & 31) * 4;
            float4 a = *(const float4*)(Cs + row * 132 + cc);
            float4 hv = *(const float4*)(hin + (size_t)(m0 + row) * DM + n0 + cc);
            hv.x += a.x; hv.y += a.y; hv.z += a.z; hv.w += a.w;
            *(float4*)(hbuf + (size_t)(m0 + row) * DM + n0 + cc) = hv;
          }
        });
      }
    }
    }
  }
}

extern "C" void kernel_launch(void* const* d_in, const int* in_sizes, int n_in, void* d_out, int out_size, void* d_ws,
                              size_t ws_size, hipStream_t stream) {
  Params p{};
  p.x = (const float*)d_in[0]; p.mem = (const float*)d_in[1]; p.pos = (const int*)d_in[2];
  p.norm_g = (const float*)d_in[3]; p.mem_norm_g = (const float*)d_in[4]; p.final_norm_g = (const float*)d_in[5];
  p.t5 = (const float*)d_in[6]; p.w_out = (const float*)d_in[7]; p.mem_w_kv = (const float*)d_in[8];
  p.even_w_in = (const float*)d_in[9]; p.lam_re = (const float*)d_in[10]; p.lam_im = (const float*)d_in[11];
  p.log_dt = (const float*)d_in[12]; p.b_re = (const float*)d_in[13]; p.b_im = (const float*)d_in[14];
  p.c_re = (const float*)d_in[15]; p.c_im = (const float*)d_in[16]; p.s5_d = (const float*)d_in[17];
  p.w_glu = (const float*)d_in[18]; p.fox_b_f = (const float*)d_in[19]; p.odd_w_in = (const float*)d_in[20];
  p.g_cq = (const float*)d_in[21]; p.g_ckv = (const float*)d_in[22]; p.w_uq = (const float*)d_in[23];
  p.w_ukv = (const float*)d_in[24]; p.cmp_pe = (const float*)d_in[25]; p.cmp_w1 = (const float*)d_in[26];
  p.cmp_w2 = (const float*)d_in[27];
  p.out = (float*)d_out; p.ws = (char*)d_ws;
  if (ws_size < WS_END) fprintf(stderr, "workspace too small: %zu < %zu\n", ws_size, (size_t)WS_END);
  static int grid_blocks = 0;
  if (!grid_blocks) {
    int dev = 0, cus = 0, per_cu = 0;
    hipGetDevice(&dev);
    hipDeviceGetAttribute(&cus, hipDeviceAttributeMultiprocessorCount, dev);
    hipOccupancyMaxActiveBlocksPerMultiprocessor(&per_cu, mega, 256, 0);
    if (per_cu > 2) per_cu = 2;
    if (per_cu < 1) per_cu = 1;
    grid_blocks = cus * per_cu;
  }
  (void)hipMemsetAsync((char*)d_ws + WS_BAR, 0, XCD_BAR_WORDS * sizeof(unsigned), stream);
#if MULTI_LAUNCH
  for (int ph = 0; ph <= 24; ++ph) {
    int lo = ph, hi = ph;
    void* args[] = {&p, &lo, &hi};
    hipLaunchCooperativeKernel((void*)mega, dim3(grid_blocks), dim3(256), args, 0, stream);
  }
#else
  int lo = 0, hi = 24;
  void* args[] = {&p, &lo, &hi};
  hipError_t e = hipLaunchCooperativeKernel((void*)mega, dim3(grid_blocks), dim3(256), args, 0, stream);
  if (e != hipSuccess) fprintf(stderr, "cooperative launch failed: %s (grid %d)\n", hipGetErrorString(e), grid_blocks);
#endif
}
```

```cpp
#include <hip/hip_runtime.h>
#include <hip/hip_cooperative_groups.h>
#include <cstdio>
#include <cstdint>
namespace cg = cooperative_groups;

typedef unsigned short bf16;
typedef short bf16x8 __attribute__((ext_vector_type(8)));
typedef float f32x16 __attribute__((ext_vector_type(16)));
typedef float f32x4 __attribute__((ext_vector_type(4)));
typedef __bf16 bf2v __attribute__((ext_vector_type(2)));
typedef float f2v __attribute__((ext_vector_type(2)));

#define DI __device__ __forceinline__
#define MFMA32(a, b, c) __builtin_amdgcn_mfma_f32_32x32x16_bf16((a), (b), (c), 0, 0, 0)

#ifndef LB2
#define LB2 2
#endif
#ifndef REP_PH
#define REP_PH -1
#endif
#ifndef PHM
#define PHM 1023
#endif
#ifndef MULTI_LAUNCH
#define MULTI_LAUNCH 0
#endif

constexpr int L = 8192;
constexpr int DM = 2048;
constexpr int NPE = 7296;
constexpr int NPO = 6784;
constexpr int EVEN_IN = 7176;
constexpr int ODD_IN = 6744;
constexpr int MIXW = 2560;
constexpr float LOG2E = 1.4426950408889634f;
constexpr float NEG = -1e30f;
constexpr float EPS = 1e-6f;

constexpr size_t MB = 1024 * 1024;
constexpr size_t WS_WIN = 0;
constexpr size_t WS_WOUT = WS_WIN + 30 * MB;
constexpr size_t WS_WMEM = WS_WOUT + 10 * MB;
constexpr size_t WS_WMISC = WS_WMEM + 4 * MB;
constexpr size_t WS_XN = WS_WMISC + 8 * MB;
constexpr size_t WS_MEMN = WS_XN + 32 * MB;
constexpr size_t WS_P = WS_MEMN + 1 * MB;
constexpr size_t WS_MIXED = WS_P + 114 * MB;
constexpr size_t WS_MEMK = WS_MIXED + 40 * MB;
constexpr size_t WS_MEMVT = WS_MEMK + 256 * 1024;
constexpr size_t WS_ROPEC = WS_MEMVT + 256 * 1024;
constexpr size_t WS_ROPES = WS_ROPEC + 1 * MB;
constexpr size_t WS_FLOG = WS_ROPES + 1 * MB;
constexpr size_t WS_CUML = WS_FLOG + 1 * MB;
constexpr size_t WS_CT = WS_CUML + 256 * 1024;
constexpr size_t WS_S5P = WS_CT + 4096;
constexpr size_t WS_S5E = WS_S5P + 1 * MB;
constexpr size_t WS_CMPB = WS_S5E + 2 * MB;
constexpr size_t WS_CTR = WS_CMPB + 64 * 1024;
constexpr size_t WS_BAR = WS_CTR + 4096;
constexpr size_t WS_POSMAX = WS_BAR + 16384;
constexpr size_t WS_VAR = WS_POSMAX + 4096;
constexpr size_t WS_Z = WS_VAR;
constexpr size_t WS_VTFOX = WS_Z + 16 * MB;
constexpr size_t WS_QMLA = WS_VAR;
constexpr size_t WS_KMLA = WS_QMLA + 24 * MB;
constexpr size_t WS_VTMLA = WS_KMLA + 16 * MB;
constexpr size_t WS_VTSLC = WS_VTMLA + 16 * MB;
constexpr size_t WS_VTWIN = WS_VTSLC + 4 * MB;
constexpr size_t WS_HID = WS_VTWIN + 4 * MB;
constexpr size_t WS_KC = WS_HID + 1 * MB;
constexpr size_t WS_VCT = WS_KC + 256 * 1024;
constexpr size_t WS_NSAO = WS_VCT + 256 * 1024;
constexpr size_t WS_END = WS_NSAO + 32 * MB;
constexpr size_t WM_GLU = 0;
constexpr size_t WM_UQ = 0;
constexpr size_t WM_UKV = WM_UQ + 1536 * 512 * 2;
constexpr size_t WM_W1 = WM_UKV + 2048 * 512 * 2;
constexpr size_t WM_W2 = WM_W1 + 2 * 256 * 4096 * 2;

constexpr int SM_EXTRA = 73728;
constexpr int SM_TOTAL = 73728 + 1024;

struct Params {
  const float *x, *mem;
  const int* pos;
  const float *norm_g, *mem_norm_g, *final_norm_g, *t5, *w_out, *mem_w_kv, *even_w_in, *lam_re, *lam_im, *log_dt,
      *b_re, *b_im, *c_re, *c_im, *s5_d, *w_glu, *fox_b_f, *odd_w_in, *g_cq, *g_ckv, *w_uq, *w_ukv, *cmp_pe,
      *cmp_w1, *cmp_w2;
  float* out;
  char* ws;
};

DI unsigned pack2(float a, float b) {
  f2v v = {a, b};
  bf2v r = __builtin_convertvector(v, bf2v);
  return __builtin_bit_cast(unsigned, r);
}
DI float bflo(unsigned u) { return __uint_as_float(u << 16); }
DI float bfhi(unsigned u) { return __uint_as_float(u & 0xffff0000u); }
DI float bf2f(bf16 v) { return __uint_as_float(((unsigned)v) << 16); }
DI bf16 f2bf(float f) { return (bf16)(pack2(f, 0.f) & 0xffffu); }
DI int otid() { int z; asm volatile("s_mov_b32 %0, 0" : "=s"(z)); return (int)threadIdx.x + z; }
DI int crow(int i, int h) { return (i & 3) + 8 * (i >> 2) + 4 * h; }
DI float sigm(float x) { return 1.f / (1.f + __expf(-x)); }
DI float silu(float x) { return x * sigm(x); }
DI float gelu_t(float x) {
  float u = 0.7978845608028654f * (x + 0.044715f * x * x * x);
  float e = __expf(2.f * u);
  float t = 1.f - 2.f / (e + 1.f);
  return 0.5f * x * (1.f + t);
}
DI float ex2(float x) { return __builtin_amdgcn_exp2f(x); }
DI float wave_sum(float v) {
#pragma unroll
  for (int o = 32; o > 0; o >>= 1) v += __shfl_xor(v, o);
  return v;
}
DI uint4 pack8(const float* v) {
  uint4 u;
  u.x = pack2(v[0], v[1]); u.y = pack2(v[2], v[3]); u.z = pack2(v[4], v[5]); u.w = pack2(v[6], v[7]);
  return u;
}

struct CvtSeg {
  const float* src; int lds; int sc0; bf16* dst; int dr0; int ncols; int npad; int K; const float* kscale;
};
DI int cvt_count(const CvtSeg& s) { return (s.K >> 6) * (s.npad >> 6); }
DI void cvt_tile(const CvtSeg& s, int tile, char* smem) {
  float* T = (float*)smem;
  const int tid = otid();
  const int nkt = s.K >> 6;
  const int kt = tile % nkt, nt = tile / nkt;
  const int k0 = kt * 64, n0 = nt * 64;
  __syncthreads();
#pragma unroll
  for (int i = 0; i < 16; ++i) {
    int idx = tid + 256 * i;
    int k = idx >> 6, n = idx & 63;
    float v = 0.f;
    if (n0 + n < s.ncols) {
      v = s.src[(size_t)(k0 + k) * s.lds + s.sc0 + n0 + n];
      if (s.kscale) v *= s.kscale[k0 + k];
    }
    T[k * 65 + n] = v;
  }
  __syncthreads();
#pragma unroll
  for (int j = 0; j < 2; ++j) {
    int c = tid + 256 * j;
    int n = c >> 3, kc = (c & 7) * 8;
    float v[8];
#pragma unroll
    for (int e = 0; e < 8; ++e) v[e] = T[(kc + e) * 65 + n];
    *(uint4*)(s.dst + (size_t)(s.dr0 + n0 + n) * s.K + k0 + kc) = pack8(v);
  }
}

enum { SET_IN_EVEN = 0, SET_IN_ODD, SET_OUT, SET_MEM, SET_MISC_EVEN, SET_MISC_ODD };
DI int cvt_nseg(int set) {
  switch (set) {
    case SET_IN_EVEN: return 3;
    case SET_IN_ODD: return 5;
    case SET_OUT: return 1;
    case SET_MEM: return 1;
    case SET_MISC_EVEN: return 1;
    default: return 6;
  }
}
DI CvtSeg cvt_get(const Params& p, int set, int li, int s) {
  CvtSeg r;
  r.kscale = nullptr;
  char* ws = p.ws;
  if (set == SET_IN_EVEN) {
    r.src = p.even_w_in + (size_t)li * DM * EVEN_IN; r.lds = EVEN_IN; r.K = DM; r.dst = (bf16*)(ws + WS_WIN);
    if (s == 0) { r.sc0 = 0; r.dr0 = 0; r.ncols = 5120; r.npad = 5120; }
    else if (s == 1) { r.sc0 = 5128; r.dr0 = 5120; r.ncols = 2048; r.npad = 2048; }
    else { r.sc0 = 5120; r.dr0 = 7168; r.ncols = 8; r.npad = 128; }
  } else if (set == SET_IN_ODD) {
    r.src = p.odd_w_in + (size_t)li * DM * ODD_IN; r.lds = ODD_IN; r.K = DM; r.dst = (bf16*)(ws + WS_WIN);
    if (s == 0) { r.sc0 = 0; r.dr0 = 0; r.ncols = 1024; r.npad = 1024; }
    else if (s == 1) { r.sc0 = 1088; r.dr0 = 1024; r.ncols = 3584; r.npad = 3584; }
    else if (s == 2) { r.sc0 = 4696; r.dr0 = 4608; r.ncols = 2048; r.npad = 2048; }
    else if (s == 3) { r.sc0 = 1024; r.dr0 = 6656; r.ncols = 64; r.npad = 64; }
    else { r.sc0 = 4672; r.dr0 = 6720; r.ncols = 24; r.npad = 64; }
  } else if (set == SET_OUT) {
    r.src = p.w_out + (size_t)li * MIXW * DM; r.lds = DM; r.K = MIXW; r.dst = (bf16*)(ws + WS_WOUT);
    r.sc0 = 0; r.dr0 = 0; r.ncols = DM; r.npad = DM;
  } else if (set == SET_MEM) {
    r.src = p.mem_w_kv + (size_t)li * DM * 1024; r.lds = 1024; r.K = DM; r.dst = (bf16*)(ws + WS_WMEM);
    r.sc0 = 0; r.dr0 = 0; r.ncols = 1024; r.npad = 1024;
  } else if (set == SET_MISC_EVEN) {
    r.src = p.w_glu + (size_t)li * 1024 * 1024; r.lds = 1024; r.K = 1024; r.dst = (bf16*)(ws + WS_WMISC + WM_GLU);
    r.sc0 = 0; r.dr0 = 0; r.ncols = 1024; r.npad = 1024;
  } else {
    r.sc0 = 0; r.dr0 = 0;
    if (s == 0) {
      r.src = p.w_uq + (size_t)li * 512 * 1536; r.lds = 1536; r.K = 512; r.dst = (bf16*)(ws + WS_WMISC + WM_UQ);
      r.ncols = 1536; r.npad = 1536; r.kscale = p.g_cq + li * 512;
    } else if (s == 1) {
      r.src = p.w_ukv + (size_t)li * 512 * 2048; r.lds = 2048; r.K = 512; r.dst = (bf16*)(ws + WS_WMISC + WM_UKV);
      r.ncols = 2048; r.npad = 2048; r.kscale = p.g_ckv + li * 512;
    } else if (s < 4) {
      int which = s - 2;
      r.src = p.cmp_w1 + (size_t)(li * 2 + which) * 4096 * 256; r.lds = 256; r.K = 4096;
      r.dst = (bf16*)(ws + WS_WMISC + WM_W1) + (size_t)which * 256 * 4096; r.ncols = 256; r.npad = 256;
    } else {
      int which = s - 4;
      r.src = p.cmp_w2 + (size_t)(li * 2 + which) * 256 * 128; r.lds = 128; r.K = 256;
      r.dst = (bf16*)(ws + WS_WMISC + WM_W2) + (size_t)which * 128 * 256; r.ncols = 128; r.npad = 128;
    }
  }
  return r;
}
DI int cvt_set_count(const Params& p, int set, int li) {
  int n = 0;
  for (int s = 0; s < cvt_nseg(set); ++s) n += cvt_count(cvt_get(p, set, li, s));
  return n;
}
DI void cvt_set_task(const Params& p, int set, int li, int t, char* smem) {
  const int ns = cvt_nseg(set);
  for (int s = 0; s < ns; ++s) {
    CvtSeg sg = cvt_get(p, set, li, s);
    int c = cvt_count(sg);
    if (t < c) { cvt_tile(sg, t, smem); return; }
    t -= c;
  }
}

DI void norm_row_bf16(const float* __restrict__ src, const float* __restrict__ g, bf16* __restrict__ dst, int lane) {
  float4 v[8];
  float ss = 0.f;
#pragma unroll
  for (int i = 0; i < 8; ++i) {
    v[i] = *(const float4*)(src + (i * 64 + lane) * 4);
    ss += v[i].x * v[i].x + v[i].y * v[i].y + v[i].z * v[i].z + v[i].w * v[i].w;
  }
  ss = wave_sum(ss);
  float r = rsqrtf(ss * (1.f / DM) + EPS);
#pragma unroll
  for (int i = 0; i < 8; ++i) {
    float4 gg = *(const float4*)(g + (i * 64 + lane) * 4);
    uint2 u;
    u.x = pack2(v[i].x * r * gg.x, v[i].y * r * gg.y);
    u.y = pack2(v[i].z * r * gg.z, v[i].w * r * gg.w);
    *(uint2*)(dst + (i * 64 + lane) * 4) = u;
  }
}
DI void norm_row_f32(float* __restrict__ io, const float* __restrict__ g, int lane) {
  float4 v[8];
  float ss = 0.f;
#pragma unroll
  for (int i = 0; i < 8; ++i) {
    v[i] = *(const float4*)(io + (i * 64 + lane) * 4);
    ss += v[i].x * v[i].x + v[i].y * v[i].y + v[i].z * v[i].z + v[i].w * v[i].w;
  }
  ss = wave_sum(ss);
  float r = rsqrtf(ss * (1.f / DM) + EPS);
#pragma unroll
  for (int i = 0; i < 8; ++i) {
    float4 gg = *(const float4*)(g + (i * 64 + lane) * 4);
    float4 o;
    o.x = v[i].x * r * gg.x; o.y = v[i].y * r * gg.y; o.z = v[i].z * r * gg.z; o.w = v[i].w * r * gg.w;
    *(float4*)(io + (i * 64 + lane) * 4) = o;
  }
}

struct ALin {
  const bf16* p; int ld;
  DI const bf16* operator()(int row, int k) const { return p + (size_t)row * ld + k; }
};
struct ACmp {
  const bf16* p; int m0;
  DI const bf16* operator()(int row, int k) const {
    int gr = m0 + row;
    if (gr > 1021) gr = 1021;
    int n = gr >> 1, g = gr & 1;
    return p + (size_t)(16 * n + (k >> 7)) * NPO + g * 128 + (k & 127);
  }
};

template <class AF, class Epi>
DI void gemm_tile(AF af, const bf16* __restrict__ Bt, int ldb, int K, char* smem, Epi epi) {
  const int tid = otid(), lane = tid & 63, w = tid >> 6, r = lane & 31, h = lane >> 5;
  const int wm = w >> 1, wn = w & 1;
  bf16* As = (bf16*)smem;
  bf16* Bs = As + 2 * 128 * 72;
  f32x16 acc[2][2];
#pragma unroll
  for (int a = 0; a < 2; ++a)
#pragma unroll
    for (int b = 0; b < 2; ++b)
#pragma unroll
      for (int i = 0; i < 16; ++i) acc[a][b][i] = 0.f;
  uint4 ra0_0, ra0_1, ra0_2, ra0_3, rb0_0, rb0_1, rb0_2, rb0_3, ra1_0, ra1_1, ra1_2, ra1_3, rb1_0, rb1_1, rb1_2, rb1_3;
#define LD1(S, I, K0)                                                                  \
  {                                                                                    \
    int c = tl + 256 * I;                                                              \
    int row = c >> 3, kc = (c & 7) * 8;                                                \
    ra##S##_##I = *(const uint4*)af(row, (K0) + kc);                                   \
    rb##S##_##I = *(const uint4*)(Bt + (size_t)row * ldb + (K0) + kc);                 \
  }
#define ST1(S, I, BUF)                                                                 \
  {                                                                                    \
    int c = tid + 256 * I;                                                             \
    int row = c >> 3, kc = (c & 7) * 8;                                                \
    *(uint4*)(As + (BUF) * 9216 + row * 72 + kc) = ra##S##_##I;                        \
    *(uint4*)(Bs + (BUF) * 9216 + row * 72 + kc) = rb##S##_##I;                        \
  }
#define GLOAD(S, K0) { const int tl = otid(); LD1(S, 0, K0) LD1(S, 1, K0) LD1(S, 2, K0) LD1(S, 3, K0) }
#define SSTORE(S, BUF) { ST1(S, 0, BUF) ST1(S, 1, BUF) ST1(S, 2, BUF) ST1(S, 3, BUF) }
  auto compute = [&](int buf) {
    const bf16* a_ = As + buf * 9216 + (wm * 64 + r) * 72 + h * 8;
    const bf16* b_ = Bs + buf * 9216 + (wn * 64 + r) * 72 + h * 8;
    bf16x8 fa0, fa1, fb0, fb1, ga0, ga1, gb0, gb1, ha0, ha1, hb0, hb1, ia0, ia1, ib0, ib1;
    fa0 = *(const bf16x8*)(a_ + 0);            fa1 = *(const bf16x8*)(a_ + 32 * 72);
    fb0 = *(const bf16x8*)(b_ + 0);            fb1 = *(const bf16x8*)(b_ + 32 * 72);
    ga0 = *(const bf16x8*)(a_ + 16);           ga1 = *(const bf16x8*)(a_ + 32 * 72 + 16);
    gb0 = *(const bf16x8*)(b_ + 16);           gb1 = *(const bf16x8*)(b_ + 32 * 72 + 16);
    ha0 = *(const bf16x8*)(a_ + 32);           ha1 = *(const bf16x8*)(a_ + 32 * 72 + 32);
    hb0 = *(const bf16x8*)(b_ + 32);           hb1 = *(const bf16x8*)(b_ + 32 * 72 + 32);
    ia0 = *(const bf16x8*)(a_ + 48);           ia1 = *(const bf16x8*)(a_ + 32 * 72 + 48);
    ib0 = *(const bf16x8*)(b_ + 48);           ib1 = *(const bf16x8*)(b_ + 32 * 72 + 48);
    __builtin_amdgcn_sched_barrier(0);
    acc[0][0] = MFMA32(fa0, fb0, acc[0][0]); acc[0][1] = MFMA32(fa0, fb1, acc[0][1]);
    acc[1][0] = MFMA32(fa1, fb0, acc[1][0]); acc[1][1] = MFMA32(fa1, fb1, acc[1][1]);
    acc[0][0] = MFMA32(ga0, gb0, acc[0][0]); acc[0][1] = MFMA32(ga0, gb1, acc[0][1]);
    acc[1][0] = MFMA32(ga1, gb0, acc[1][0]); acc[1][1] = MFMA32(ga1, gb1, acc[1][1]);
    acc[0][0] = MFMA32(ha0, hb0, acc[0][0]); acc[0][1] = MFMA32(ha0, hb1, acc[0][1]);
    acc[1][0] = MFMA32(ha1, hb0, acc[1][0]); acc[1][1] = MFMA32(ha1, hb1, acc[1][1]);
    acc[0][0] = MFMA32(ia0, ib0, acc[0][0]); acc[0][1] = MFMA32(ia0, ib1, acc[0][1]);
    acc[1][0] = MFMA32(ia1, ib0, acc[1][0]); acc[1][1] = MFMA32(ia1, ib1, acc[1][1]);
    __builtin_amdgcn_sched_barrier(0);
  };
  __syncthreads();
  const int nk = K >> 6;
  GLOAD(0, 0);
  SSTORE(0, 0);
  GLOAD(0, 64);
  __syncthreads();
  for (int kt = 0; kt < nk; kt += 2) {
    if (kt + 2 < nk) GLOAD(1, (kt + 2) * 64);
    compute(0);
    SSTORE(0, 1);
    __syncthreads();
    if (kt + 3 < nk) GLOAD(0, (kt + 3) * 64);
    compute(1);
    if (kt + 2 < nk) SSTORE(1, 0);
    __syncthreads();
  }
#undef GLOAD
#undef SSTORE
#undef LD1
#undef ST1
  float* Cs = (float*)smem;
#pragma unroll
  for (int mb = 0; mb < 2; ++mb)
#pragma unroll
    for (int nb = 0; nb < 2; ++nb)
#pragma unroll
      for (int i = 0; i < 16; ++i)
        Cs[(wm * 64 + mb * 32 + crow(i, h)) * 132 + wn * 64 + nb * 32 + r] = acc[mb][nb][i];
  __syncthreads();
  epi(Cs);
}


template <class AF, class Epi>
DI void gemm_tile2(AF af, const bf16* __restrict__ Bt, int ldb, int K, char* smem, int& n0ref, int nhalf, Epi epi) {
  const int tid = otid(), lane = tid & 63, w = tid >> 6, r = lane & 31, h = lane >> 5;
  const int wm = w >> 1, wn = w & 1;
  bf16* As = (bf16*)smem;
  bf16* Bs = As + 128 * 72;
  f32x16 acc[2][4];
#pragma unroll
  for (int a = 0; a < 2; ++a)
#pragma unroll
    for (int b = 0; b < 4; ++b)
#pragma unroll
      for (int i = 0; i < 16; ++i) acc[a][b][i] = 0.f;
  uint4 pa_0, pa_1, pa_2, pa_3, pb_0, pb_1, pb_2, pb_3, pb_4, pb_5, pb_6, pb_7;
#define LDA2(I, K0) { int c = tl + 256 * I; int row = c >> 3, kc = (c & 7) * 8; pa_##I = *(const uint4*)af(row, (K0) + kc); }
#define LDB2(I, K0) { int c = tl + 256 * I; int row = c >> 3, kc = (c & 7) * 8; pb_##I = *(const uint4*)(Bt + (size_t)row * ldb + (K0) + kc); }
#define STA2(I) { int c = tid + 256 * I; int row = c >> 3, kc = (c & 7) * 8; *(uint4*)(As + row * 72 + kc) = pa_##I; }
#define STB2(I) { int c = tid + 256 * I; int row = c >> 3, kc = (c & 7) * 8; *(uint4*)(Bs + row * 72 + kc) = pb_##I; }
#define GLOAD2(K0) { const int tl = otid(); LDA2(0, K0) LDA2(1, K0) LDA2(2, K0) LDA2(3, K0) LDB2(0, K0) LDB2(1, K0) LDB2(2, K0) LDB2(3, K0) LDB2(4, K0) LDB2(5, K0) LDB2(6, K0) LDB2(7, K0) }
#define SSTORE2() { STA2(0) STA2(1) STA2(2) STA2(3) STB2(0) STB2(1) STB2(2) STB2(3) STB2(4) STB2(5) STB2(6) STB2(7) }
  const int nk = K >> 6;
  GLOAD2(0);
  const bf16* a_ = As + (wm * 64 + r) * 72 + h * 8;
  const bf16* b_ = Bs + (wn * 128 + r) * 72 + h * 8;
  for (int kt = 0; kt < nk; ++kt) {
    __syncthreads();
    SSTORE2();
    __syncthreads();
    if (kt + 1 < nk) GLOAD2((kt + 1) * 64);
#pragma unroll
    for (int ks = 0; ks < 4; ++ks) {
      bf16x8 fa[2], fb[4];
#pragma unroll
      for (int mb = 0; mb < 2; ++mb) fa[mb] = *(const bf16x8*)(a_ + mb * 32 * 72 + ks * 16);
#pragma unroll
      for (int nb = 0; nb < 4; ++nb) fb[nb] = *(const bf16x8*)(b_ + nb * 32 * 72 + ks * 16);
#pragma unroll
      for (int mb = 0; mb < 2; ++mb)
#pragma unroll
        for (int nb = 0; nb < 4; ++nb) acc[mb][nb] = MFMA32(fa[mb], fb[nb], acc[mb][nb]);
    }
  }
#undef LDA2
#undef LDB2
#undef STA2
#undef STB2
#undef GLOAD2
#undef SSTORE2
  float* Cs = (float*)smem;
#pragma unroll
  for (int hf = 0; hf < 2; ++hf) {
    if (hf < nhalf) {
      __syncthreads();
      if (wn == hf) {
#pragma unroll
        for (int mb = 0; mb < 2; ++mb)
#pragma unroll
          for (int nb = 0; nb < 4; ++nb)
#pragma unroll
            for (int i = 0; i < 16; ++i) Cs[(wm * 64 + mb * 32 + crow(i, h)) * 132 + nb * 32 + r] = acc[mb][nb][i];
      }
      __syncthreads();
      epi(Cs);
      n0ref += 128;
    }
  }
}

DI void tile_map(int t, int ntn, int& tm, int& tn) {
  const int per = 8 * ntn;
  const int grp = t / per, rem = t - grp * per;
  tm = grp * 8 + (rem & 7);
  tn = rem >> 3;
}
template <class F>
DI void epi_rows(const float* Cs, F f) {
  const int tid = otid();
#pragma unroll
  for (int j = 0; j < 8; ++j) {
    int c = tid + 256 * j;
    int row = c >> 4, cc = (c & 15) * 8;
    float v[8];
    float4 a = *(const float4*)(Cs + row * 132 + cc);
    float4 b = *(const float4*)(Cs + row * 132 + cc + 4);
    v[0] = a.x; v[1] = a.y; v[2] = a.z; v[3] = a.w; v[4] = b.x; v[5] = b.y; v[6] = b.z; v[7] = b.w;
    f(row, cc, v);
  }
}
template <class F>
DI void epi_cols(const float* Cs, F f) {
  const int tid = otid();
#pragma unroll
  for (int j = 0; j < 8; ++j) {
    int c = tid + 256 * j;
    int col = c & 127, r8 = (c >> 7) * 8;
    float v[8];
#pragma unroll
    for (int e = 0; e < 8; ++e) v[e] = Cs[(r8 + e) * 132 + col];
    f(col, r8, v);
  }
}
template <class F>
DI void epi_rope(const float* Cs, int cb, int m0, const float* rc, const float* rs, float scale_unused, F f) {
  const int tid = otid();
#pragma unroll
  for (int j = 0; j < 2; ++j) {
    int c = tid + 256 * j;
    int row = c >> 2, cc = (c & 3) * 8;
    float x1[8], x2[8], o1[8], o2[8];
#pragma unroll
    for (int e = 0; e < 8; ++e) {
      x1[e] = Cs[row * 132 + cb + cc + e];
      x2[e] = Cs[row * 132 + cb + 32 + cc + e];
    }
    const float* pc = rc + (size_t)(m0 + row) * 32 + cc;
    const float* ps = rs + (size_t)(m0 + row) * 32 + cc;
#pragma unroll
    for (int e = 0; e < 8; ++e) {
      float cs = pc[e], sn = ps[e];
      o1[e] = x1[e] * cs - x2[e] * sn;
      o2[e] = x1[e] * sn + x2[e] * cs;
    }
    f(row, cc, o1);
    f(row, cc + 32, o2);
  }
}

template <int DK>
struct KVPre {
  uint4 k[DK / 32];
  uint4 v[4];
  float aux;
};
constexpr int AT_VS = 25600;
constexpr int AT_AUX = 43008;
constexpr int AT_X0 = 43264;
constexpr int AT_IMP = AT_X0 + 12800;
constexpr int AT_SEL = AT_IMP + 16896;

template <int DK, bool PV, class SF, class PH>
DI void attn_tile(const bf16x8 (&qf)[DK / 16], f32x16 (&o)[4], float& m, float& l, const char* smem, SF sf, PH ph) {
  const int lane = otid() & 63, r = lane & 31, h = lane >> 5;
  const bf16* Ks = (const bf16*)smem;
  const bf16* Vs = (const bf16*)(smem + AT_VS);
  const float* auxs = (const float*)(smem + AT_AUX);
  f32x16 s[2];
#pragma unroll
  for (int kb = 0; kb < 2; ++kb) {
#pragma unroll
    for (int i = 0; i < 16; ++i) s[kb][i] = 0.f;
#pragma unroll
    for (int ks = 0; ks < DK / 16; ++ks) {
      bf16x8 a = *(const bf16x8*)(Ks + (kb * 32 + r) * (DK + 8) + ks * 16 + h * 8);
      s[kb] = MFMA32(a, qf[ks], s[kb]);
    }
  }
  float mx = m;
#pragma unroll
  for (int kb = 0; kb < 2; ++kb)
#pragma unroll
    for (int i = 0; i < 16; ++i) {
      int kl = kb * 32 + crow(i, h);
      float v = sf(s[kb][i], kl, auxs[kl]);
      s[kb][i] = v;
      mx = fmaxf(mx, v);
    }
  mx = fmaxf(mx, __shfl_xor(mx, 32));
  float alpha = ex2(m - mx);
  m = mx;
  float psum = 0.f;
#pragma unroll
  for (int kb = 0; kb < 2; ++kb)
#pragma unroll
    for (int i = 0; i < 16; ++i) {
      float pv = ex2(s[kb][i] - mx);
      s[kb][i] = pv;
      psum += pv;
    }
  l = l * alpha + psum;
  ph(0, s[0]);
  ph(1, s[1]);
  if (PV) {
    if (__builtin_amdgcn_ballot_w64(alpha != 1.f) != 0ull) {
#pragma unroll
      for (int d = 0; d < 4; ++d)
#pragma unroll
        for (int i = 0; i < 16; ++i) o[d][i] *= alpha;
    }
#pragma unroll
    for (int st = 0; st < 4; ++st) {
      const int kb = st >> 1, s2 = st & 1;
      uint4 pu;
      pu.x = pack2(s[kb][8 * s2 + 0], s[kb][8 * s2 + 1]);
      pu.y = pack2(s[kb][8 * s2 + 2], s[kb][8 * s2 + 3]);
      pu.z = pack2(s[kb][8 * s2 + 4], s[kb][8 * s2 + 5]);
      pu.w = pack2(s[kb][8 * s2 + 6], s[kb][8 * s2 + 7]);
      bf16x8 pf = __builtin_bit_cast(bf16x8, pu);
#pragma unroll
      for (int d = 0; d < 4; ++d) {
        const bf16* vp = Vs + (d * 32 + r) * 68 + st * 16 + 4 * h;
        uint2 lo = *(const uint2*)vp;
        uint2 hi = *(const uint2*)(vp + 8);
        uint4 vu = make_uint4(lo.x, lo.y, hi.x, hi.y);
        bf16x8 vf = __builtin_bit_cast(bf16x8, vu);
        o[d] = MFMA32(vf, pf, o[d]);
      }
    }
  }
}

struct NoHook { DI void operator()(int, const f32x16&) const {} };

template <int DK, bool PV, bool PF, class Ctx>
DI void attn_run(const bf16x8 (&qf)[DK / 16], f32x16 (&o)[4], float& m, float& l, const bf16* K1, int ldk1,
                 const bf16* K2, int ldk2, const bf16* Vt, int ldv, int first, Ctx& ctx, char* smem) {
  const int tid = otid();
  int tcur = first;
  if (tcur < 0) return;
  constexpr int CPR = DK / 8;
  constexpr int NKC = DK / 32;
  uint4 rk0, rk1, rk2, rk3, rk4 = make_uint4(0, 0, 0, 0), rk5 = make_uint4(0, 0, 0, 0), rv[4];
  float raux;
  bf16* Ks = (bf16*)smem;
  bf16* Vs = (bf16*)(smem + AT_VS);
  auto ldk = [&](int i, int key0) -> uint4 {
    int c = otid() + 256 * i;
    int row = c / CPR, cc = c % CPR;
    const bf16* src;
    if (DK == 128 || cc < 16) src = K1 + (size_t)(key0 + row) * ldk1 + cc * 8;
    else src = K2 + (size_t)(key0 + row) * ldk2 + (cc - 16) * 8;
    return *(const uint4*)src;
  };
  auto stk = [&](int i, const uint4& v) {
    int c = tid + 256 * i;
    int row = c / CPR, cc = c % CPR;
    *(uint4*)(Ks + row * (DK + 8) + cc * 8) = v;
  };
  auto gload = [&](int key0) {
    rk0 = ldk(0, key0); rk1 = ldk(1, key0); rk2 = ldk(2, key0); rk3 = ldk(3, key0);
    if (NKC > 4) { rk4 = ldk(4, key0); rk5 = ldk(5, key0); }
    const int tl = otid();
#pragma unroll
    for (int i = 0; i < 4; ++i) {
      int c = tl + 256 * i;
      int d = c >> 3, cc = c & 7;
      rv[i] = *(const uint4*)(Vt + (size_t)d * ldv + key0 + cc * 8);
    }
    raux = (tid < 64) ? ctx.aux(key0 + tid) : 0.f;
  };
  auto sstore = [&]() {
    stk(0, rk0); stk(1, rk1); stk(2, rk2); stk(3, rk3);
    if (NKC > 4) { stk(4, rk4); stk(5, rk5); }
#pragma unroll
    for (int i = 0; i < 4; ++i) {
      int c = tid + 256 * i;
      int d = c >> 3, cc = c & 7;
      uint2* dst = (uint2*)(Vs + d * 68 + cc * 8);
      dst[0] = make_uint2(rv[i].x, rv[i].y);
      dst[1] = make_uint2(rv[i].z, rv[i].w);
    }
    if (tid < 64) ((float*)(smem + AT_AUX))[tid] = raux;
  };
  if (PF) gload(tcur * 64);
  while (tcur >= 0) {
    __syncthreads();
    if (!PF) gload(tcur * 64);
    sstore();
    __syncthreads();
    int tnext = ctx.next(tcur);
    if (PF && tnext >= 0) gload(tnext * 64);
    if (!ctx.skip(tcur)) {
      const int tc = tcur;
      if (Ctx::HAS_FAST && ctx.fast(tc)) {
        attn_tile<DK, PV>(qf, o, m, l, smem,
                          [&](float s, int kl, float ax) { return ctx.score_fast(s, tc * 64 + kl, ax, tc); },
                          [&](int kb, const f32x16& pt) { ctx.hook(kb, pt, tc); });
      } else {
        attn_tile<DK, PV>(qf, o, m, l, smem,
                          [&](float s, int kl, float ax) { return ctx.score(s, tc * 64 + kl, ax, tc); },
                          [&](int kb, const f32x16& pt) { ctx.hook(kb, pt, tc); });
      }
    }
    tcur = tnext;
  }
}

template <int DK>
DI void load_q(bf16x8 (&qf)[DK / 16], const bf16* qrow, int h) {
#pragma unroll
  for (int ks = 0; ks < DK / 16; ++ks) qf[ks] = *(const bf16x8*)(qrow + ks * 16 + h * 8);
}
DI void zero_o(f32x16 (&o)[4]) {
#pragma unroll
  for (int d = 0; d < 4; ++d)
#pragma unroll
    for (int i = 0; i < 16; ++i) o[d][i] = 0.f;
}

struct CtxCausal {
  int tq, q0w, last; float sc;
  DI int next(int t) const { return t + 1 <= last ? t + 1 : -1; }
  DI float aux(int) const { return 0.f; }
  DI bool skip(int t) const { return t * 64 > q0w + 31; }
  DI float score(float s, int key, float, int) const { return key <= tq ? s * sc : NEG; }
  static constexpr bool HAS_FAST = true;
  DI bool fast(int t) const { return t * 64 + 63 <= q0w; }
  DI float score_fast(float s, int, float, int) const { return s * sc; }
  DI void hook(int, const f32x16&, int) const {}
};
struct CtxFox {
  int tq, q0w, last; float sc, cq; const float* cuml; const float* cpre;
  DI int next(int t) const { return t + 1 <= last ? t + 1 : -1; }
  DI float aux(int key) const { return cuml[key] + cpre[key >> 7]; }
  DI bool skip(int t) const { return t * 64 > q0w + 31; }
  DI float score(float s, int key, float ax, int) const { return key <= tq ? s * sc + (cq - ax) * LOG2E : NEG; }
  static constexpr bool HAS_FAST = true;
  DI bool fast(int t) const { return t * 64 + 63 <= q0w; }
  DI float score_fast(float s, int, float ax, int) const { return s * sc + (cq - ax) * LOG2E; }
  DI void hook(int, const f32x16&, int) const {}
};
struct CtxMem {
  float sc;
  DI int next(int t) const { return t + 1 < 4 ? t + 1 : -1; }
  DI float aux(int) const { return 0.f; }
  DI bool skip(int) const { return false; }
  DI float score(float s, int, float, int) const { return s * sc; }
  static constexpr bool HAS_FAST = false;
  DI bool fast(int) const { return false; }
  DI float score_fast(float s, int, float, int) const { return s * sc; }
  DI void hook(int, const f32x16&, int) const {}
};

DI void store_out_A(const f32x16 (&o)[4], float inv_l, const bf16* grow, bf16* orow, int h) {
#pragma unroll
  for (int d = 0; d < 4; ++d)
#pragma unroll
    for (int i4 = 0; i4 < 4; ++i4) {
      int dv0 = d * 32 + 8 * i4 + 4 * h;
      uint2 gu = *(const uint2*)(grow + dv0);
      float g0 = bflo(gu.x), g1 = bfhi(gu.x), g2 = bflo(gu.y), g3 = bfhi(gu.y);
      uint2 ou;
      ou.x = pack2(o[d][4 * i4 + 0] * inv_l * silu(g0), o[d][4 * i4 + 1] * inv_l * silu(g1));
      ou.y = pack2(o[d][4 * i4 + 2] * inv_l * silu(g2), o[d][4 * i4 + 3] * inv_l * silu(g3));
      *(uint2*)(orow + dv0) = ou;
    }
}

        struct CtxCmp {
          int tq, posq, last; float sc; const float* lutr; const int* pos; float invl; float* imp; int ql; bool p2;
          DI int next(int t) const { return t + 1 <= last ? t + 1 : -1; }
          DI float aux(int key) const { int n = key < 511 ? key : 510; return __int_as_float(pos[16 * n + 31]); }
          DI bool skip(int) const { return false; }
          DI float score(float s, int key, float ax, int) const {
            bool valid = (16 * key + 31 <= tq) && key < 511;
            int d = posq - __float_as_int(ax);
            d = d < 0 ? 0 : (d > 799 ? 799 : d);
            return valid ? s * sc + lutr[d] : NEG;
          }
          static constexpr bool HAS_FAST = false;
          DI bool fast(int) const { return false; }
          DI float score_fast(float s, int key, float ax, int t) const { return score(s, key, ax, t); }
          DI void hook(int kb, const f32x16& pt, int tc) const {
            if (!p2) return;
            const int lane = otid() & 63, h = lane >> 5, r = lane & 31;
#pragma unroll
            for (int gq = 0; gq < 4; ++gq) {
              float p3 = 0.5f * pt[4 * gq + 3];
              float vm = (pt[4 * gq] + pt[4 * gq + 1] + pt[4 * gq + 2] + p3) * invl;
              float vs = p3 * invl;
              vm += __shfl_xor(vm, 8); vm += __shfl_xor(vm, 16);
              vs += __shfl_xor(vs, 8); vs += __shfl_xor(vs, 16);
              int j = tc * 16 + kb * 8 + 2 * gq + h;
              if (r < 8) { atomicAdd(&imp[ql * 132 + j], vm); atomicAdd(&imp[ql * 132 + j + 1], vs); }
            }
          }
        };
struct CtxSlc {
  int tq, posq; float sc; const float* lutr; const int* pos; unsigned long long ulo, uhi, mlo, mhi;
  const int* posmax; float bfar; int q0;
  static constexpr bool HAS_FAST = false;
  DI bool fast(int t) const {
    return (t * 64 + 63 < q0) && (__builtin_amdgcn_ballot_w64(posq - posmax[t] < 799) == 0ull);
  }
  DI float score_fast(float s, int, float, int t) const { return mine(t) ? s * sc + bfar : NEG; }
  DI bool inu(int j) const {
    unsigned long long a = (ulo >> (j & 63)) & (j < 64 ? 1ull : 0ull);
    unsigned long long b = (uhi >> (j & 63)) & (j >= 64 ? 1ull : 0ull);
    return (a | b) != 0ull;
  }
  DI bool mine(int j) const {
    unsigned long long a = (mlo >> (j & 63)) & (j < 64 ? 1ull : 0ull);
    unsigned long long b = (mhi >> (j & 63)) & (j >= 64 ? 1ull : 0ull);
    return (a | b) != 0ull;
  }
  DI int next(int t) const { for (int j = t + 1; j < 128; ++j) if (inu(j)) return j; return -1; }
  DI float aux(int key) const { return __int_as_float(pos[key]); }
  DI bool skip(int t) const { return __builtin_amdgcn_ballot_w64(mine(t)) == 0ull; }
  DI float score(float s, int key, float ax, int t) const {
    bool valid = mine(t) && key <= tq;
    int d = posq - __float_as_int(ax);
    d = d < 0 ? 0 : (d > 799 ? 799 : d);
    return valid ? s * sc + lutr[d] : NEG;
  }
  DI void hook(int, const f32x16&, int) const {}
};
struct CtxWin {
  int tq, posq, last; float sc; const float* lutr; const int* pos;
  DI int next(int t) const { return t + 1 <= last ? t + 1 : -1; }
  DI float aux(int key) const { return __int_as_float(pos[key]); }
  DI bool skip(int) const { return false; }
  DI float score(float s, int key, float ax, int) const {
    bool valid = key <= tq && (tq - key) < 512;
    int d = posq - __float_as_int(ax);
    d = d < 0 ? 0 : (d > 799 ? 799 : d);
    return valid ? s * sc + lutr[d] : NEG;
  }
  static constexpr bool HAS_FAST = false;
  DI bool fast(int) const { return false; }
  DI float score_fast(float s, int key, float ax, int t) const { return score(s, key, ax, t); }
  DI void hook(int, const f32x16&, int) const {}
};

#define XB_TMO      128
#define XB_XCNT(j)  (256  + 64 * (j))
#define XB_XSUB(j)  (1280 + 64 * (j))
#define XB_XGEN(j)  (2304 + 64 * (j))
#define XB_TOP      3328
#define XB_TOPGEN   3392
#define XCD_BAR_WORDS 3456
#define XB_SPIN_CAP (1u << 18)
#define LAS __attribute__((address_space(3)))

__device__ __forceinline__ unsigned xb_ld(unsigned* p)              { return __hip_atomic_load(p, __ATOMIC_RELAXED, __HIP_MEMORY_SCOPE_AGENT); }
__device__ __forceinline__ unsigned xb_add(unsigned* p, unsigned v) { return __hip_atomic_fetch_add(p, v, __ATOMIC_RELAXED, __HIP_MEMORY_SCOPE_AGENT); }
__device__ __forceinline__ unsigned xb_xcc_id() { return (unsigned)__builtin_amdgcn_s_getreg((3 << 11) | 20) & 0xFu; }
#define XB_SPIN(cond, bar) do { unsigned _sp = 0; while (cond) { __builtin_amdgcn_s_sleep(1); \
    if ((++_sp & 255u) == 0u) { if (xb_ld(&(bar)[XB_TMO])) break; if (_sp > XB_SPIN_CAP) { atomicAdd(&(bar)[XB_TMO], 1u); break; } } } } while (0)

struct XcdBarrier {
    unsigned* bar; unsigned x;
    volatile LAS unsigned* st;
};

__device__ __forceinline__ XcdBarrier xcd_barrier_post(unsigned* bar, volatile LAS unsigned* st) {
    XcdBarrier b; b.bar = bar; b.x = xb_xcc_id(); b.st = st;
    if (threadIdx.x == 0) (void)xb_add(&bar[XB_XCNT(b.x)], 1u);
    return b;
}
__device__ __forceinline__ void xcd_barrier_complete(unsigned* bar, unsigned x, unsigned& nloc, unsigned& nx) {
    const unsigned G = gridDim.x * gridDim.y * gridDim.z;
    unsigned sum, cnt, mine, sp = 0u;
    for (;;) {
        sum = 0u; cnt = 0u; mine = 0u;
#pragma unroll
        for (unsigned j = 0; j < 16; ++j) { const unsigned c = xb_ld(&bar[XB_XCNT(j)]); sum += c; cnt += (c > 0u) ? 1u : 0u; mine = (j == x) ? c : mine; }
        if (sum == G) break;
        __builtin_amdgcn_s_sleep(1);
        if ((++sp & 255u) == 0u) { if (xb_ld(&bar[XB_TMO])) break; if (sp > XB_SPIN_CAP) { atomicAdd(&bar[XB_TMO], 1u); break; } }
    }
    nloc = mine > 0u ? mine : 1u; nx = cnt > 0u ? cnt : 1u;
}

__device__ __forceinline__ void xcd_barrier(const XcdBarrier& b) {
    asm volatile("s_waitcnt vmcnt(0)" ::: "memory");
    __syncthreads();
    if (threadIdx.x == 0) {
        unsigned* bar = b.bar;
        __builtin_amdgcn_s_waitcnt(0);
        unsigned nloc = b.st[0], nx = b.st[1];
        if (nloc == 0u) { xcd_barrier_complete(bar, b.x, nloc, nx); b.st[0] = nloc; b.st[1] = nx; }
        const unsigned old = xb_add(&bar[XB_XSUB(b.x)], 1u);
        const unsigned gen = old / nloc;
        if (old + 1u == (gen + 1u) * nloc) {
            __builtin_amdgcn_fence(__ATOMIC_RELEASE, "agent");
            asm volatile("s_waitcnt vmcnt(0)" ::: "memory");
            const unsigned og = xb_add(&bar[XB_TOP], 1u);
            const unsigned tg = og / nx;
            if (og + 1u == (tg + 1u) * nx) xb_add(&bar[XB_TOPGEN], 1u);
            else XB_SPIN(xb_ld(&bar[XB_TOPGEN]) == tg, bar);
            __builtin_amdgcn_fence(__ATOMIC_ACQUIRE, "agent");
            xb_add(&bar[XB_XGEN(b.x)], 1u);
            asm volatile("s_waitcnt vmcnt(0)" ::: "memory");
        } else {
            XB_SPIN(xb_ld(&bar[XB_XGEN(b.x)]) == gen, bar);
            __builtin_amdgcn_fence(__ATOMIC_ACQUIRE, "agent");
            asm volatile("s_waitcnt vmcnt(0)" ::: "memory");
        }
    }
    __syncthreads();
}


__global__ void __launch_bounds__(256, LB2) mega(Params p, int ph_lo, int ph_hi) {
  __shared__ __attribute__((aligned(16))) char smem[SM_TOTAL];
  __shared__ int s_task;
  __shared__ uint4 xb_words;
  if (threadIdx.x == 0) xb_words = make_uint4(0u, 0u, 0u, 0u);
  __syncthreads();
  XcdBarrier xbar = xcd_barrier_post((unsigned*)(p.ws + WS_BAR), (volatile LAS unsigned*)&xb_words);
  const int bid = blockIdx.x, nb = gridDim.x;

  for (int ph = ph_lo; ph <= ph_hi; ++ph) {
    if (ph > ph_lo) {
      if (ph == ph_lo + 1) cg::this_grid().sync();
      else xcd_barrier(xbar);
    }
    const int nrep = (ph == REP_PH) ? 2 : 1;
    for (int rep = 0; rep < nrep; ++rep) {
    if (rep) cg::this_grid().sync();
    const int tid = otid(), lane = tid & 63, w = tid >> 6, r = lane & 31, h = lane >> 5;
    const int vb = (bid & 7) * (nb >> 3) + (bid >> 3);
    char* ws = p.ws + (tid - (int)threadIdx.x);
    bf16* XN = (bf16*)(ws + WS_XN);
    bf16* P = (bf16*)(ws + WS_P);
    bf16* MIXED = (bf16*)(ws + WS_MIXED);
    float* ROPEC = (float*)(ws + WS_ROPEC);
    float* ROPES = (float*)(ws + WS_ROPES);
    float* hbuf = p.out;
    int* CTR = (int*)(ws + WS_CTR);
    auto fetch_task = [&](int* ctr) {
      __syncthreads();
      if (tid == 0) s_task = atomicAdd(ctr, 1);
      __syncthreads();
      return s_task;
    };
    const int layer = ph == 0 ? 0 : (ph - 1) / 6;
    const int sub = ph == 0 ? -1 : (ph - 1) % 6;
    const bool even = (layer & 1) == 0;
    const int li = layer >> 1;
    const int NP = even ? NPE : NPO;

    if ((PHM & 1) && (ph == 0 || sub == 5)) {
      if (ph == 0) {
        if (bid == 0 && tid < 64) CTR[tid] = 0;
        if (bid == 1 % nb && tid < 128) {
          int mx = p.pos[tid * 64];
          for (int q = 1; q < 64; ++q) mx = max(mx, p.pos[tid * 64 + q]);
          ((int*)(ws + WS_POSMAX))[tid] = mx;
        }
        for (int i = bid * 256 + tid; i < L * 32; i += nb * 256) {
          int t = i >> 5, f = i & 31;
          float inv = powf(10000.f, -(float)f / 32.f);
          float ang = (float)p.pos[t] * inv;
          ROPEC[i] = cosf(ang);
          ROPES[i] = sinf(ang);
        }
        for (int row = bid * 4 + w; row < 256; row += nb * 4)
          norm_row_bf16(p.mem + (size_t)row * DM, p.mem_norm_g, (bf16*)(ws + WS_MEMN) + (size_t)row * DM, lane);
      }
      const int nl = ph == 0 ? 0 : layer + 1;
      if (nl < 4) {
        const float* src = ph == 0 ? p.x : hbuf;
        for (int row = bid * 4 + w; row < L; row += nb * 4)
          norm_row_bf16(src + (size_t)row * DM, p.norm_g + nl * DM, XN + (size_t)row * DM, lane);
      } else {
        for (int row = bid * 4 + w; row < L; row += nb * 4) norm_row_f32(hbuf + (size_t)row * DM, p.final_norm_g, lane);
      }
    }
    if ((PHM & 2) && (ph == 0 || sub == 4)) {
      const int nl = ph == 0 ? 0 : layer + 1;
      if (nl < 4) {
        const bool ne = (nl & 1) == 0;
        const int nli = nl >> 1;
        const int s0 = ne ? SET_IN_EVEN : SET_IN_ODD, s2 = ne ? SET_MISC_EVEN : SET_MISC_ODD;
        const int c0 = cvt_set_count(p, s0, nli), c1 = cvt_set_count(p, SET_MEM, nl), c2 = cvt_set_count(p, s2, nli);
        const int cx = ne ? 16 : 32;
        for (int t = bid; t < c0 + c1 + c2 + cx; t += nb) {
          if (t < c0) cvt_set_task(p, s0, nli, t, smem);
          else if (t < c0 + c1) cvt_set_task(p, SET_MEM, nl, t - c0, smem);
          else if (t < c0 + c1 + c2) cvt_set_task(p, s2, nli, t - c0 - c1, smem);
          else {
            int e = t - c0 - c1 - c2;
            if (ne) {
              float* S5P = (float*)(ws + WS_S5P);
              int gp = e * 256 + tid;
              int g = gp >> 6;
              float dt = expf(p.log_dt[nli * 64 + g]);
              float lr = p.lam_re[nli * 4096 + gp], lim = p.lam_im[nli * 4096 + gp];
              float mag = expf(lr * dt);
              float abr = mag * cosf(lim * dt), abi = mag * sinf(lim * dt);
              float den = lr * lr + lim * lim;
              float nr = abr - 1.f;
              float fre = (nr * lr + abi * lim) / den;
              float fim = (abi * lr - nr * lim) / den;
              S5P[gp] = abr;
              S5P[4096 + gp] = abi;
              float ar = abr, ai = abi;
#pragma unroll
              for (int q = 0; q < 7; ++q) { float nr2 = ar * ar - ai * ai; ai = 2.f * ar * ai; ar = nr2; }
              S5P[8192 + gp] = ar;
              S5P[12288 + gp] = ai;
              const float* br = p.b_re + (size_t)nli * 65536 + gp * 16;
              const float* bi = p.b_im + (size_t)nli * 65536 + gp * 16;
#pragma unroll
              for (int c = 0; c < 16; ++c) {
                S5P[16384 + gp * 16 + c] = fre * br[c] - fim * bi[c];
                S5P[16384 + 65536 + gp * 16 + c] = fre * bi[c] + fim * br[c];
              }
            } else {
              int which = e >> 4, part = e & 15;
              const float* pe = p.cmp_pe + (size_t)(nli * 2 + which) * 4096 + part * 256;
              const float* w1 = p.cmp_w1 + ((size_t)(nli * 2 + which) * 4096 + part * 256) * 256 + tid;
              float acc = 0.f;
#pragma unroll 8
              for (int k = 0; k < 256; ++k) acc += pe[k] * w1[(size_t)k * 256];
              ((float*)(ws + WS_CMPB))[(which * 16 + part) * 256 + tid] = acc;
            }
          }
        }
      }
    }
    if ((PHM & 4) && sub == 0) {
      const int ntn = (NP / 128 + 1) / 2;
      const int n_in = 64 * ntn;
      const bf16* Win = (const bf16*)(ws + WS_WIN);
      for (int t = vb; t < n_in + 16; t += nb) {
        if (t < n_in) {
          int tm, tn;
          tile_map(t, ntn, tm, tn);
          const int m0 = tm * 128;
          int n0 = tn * 256;
          const int nhalf = (n0 + 128 < NP) ? 2 : 1;
          ALin af{XN + (size_t)m0 * DM, DM};
          if (even) {
            gemm_tile2(af, Win + (size_t)n0 * DM, DM, DM, smem, n0, nhalf, [&](const float* Cs) {
              if (n0 >= 4096 && n0 < 5120) {
                bf16* VT = (bf16*)(ws + WS_VTFOX);
                epi_cols(Cs, [&](int col, int r8, const float* v) {
                  *(uint4*)(VT + (size_t)(n0 - 4096 + col) * L + m0 + r8) = pack8(v);
                });
              } else if (n0 == 7168) {
                float* FL = (float*)(ws + WS_FLOG);
                for (int i = tid; i < 128 * 8; i += 256) {
                  int row = i >> 3, c = i & 7;
                  FL[(size_t)(m0 + row) * 8 + c] = Cs[row * 132 + c];
                }
              } else {
                epi_rows(Cs, [&](int row, int cc, const float* v) {
                  *(uint4*)(P + (size_t)(m0 + row) * NPE + n0 + cc) = pack8(v);
                });
              }
            });
          } else {
            gemm_tile2(af, Win + (size_t)n0 * DM, DM, DM, smem, n0, nhalf, [&](const float* Cs) {
              if (n0 == 3840 || n0 == 3968 || n0 == 4352 || n0 == 4480) {
                bf16* VT = (n0 < 4096) ? (bf16*)(ws + WS_VTSLC) + (size_t)(n0 - 3840) * L
                                       : (bf16*)(ws + WS_VTWIN) + (size_t)(n0 - 4352) * L;
                epi_cols(Cs, [&](int col, int r8, const float* v) {
                  *(uint4*)(VT + (size_t)col * L + m0 + r8) = pack8(v);
                });
              } else if (n0 == 6656) {
                epi_rope(Cs, 0, m0, ROPEC, ROPES, 1.f, [&](int row, int cl, const float* v) {
                  *(uint4*)(P + (size_t)(m0 + row) * NPO + 6656 + cl) = pack8(v);
                });
                float* GT = (float*)(ws + WS_FLOG);
                for (int i = tid; i < 128 * 24; i += 256) {
                  int row = i / 24, c = i % 24;
                  GT[(size_t)(m0 + row) * 24 + c] = Cs[row * 132 + 64 + c];
                }
              } else {
                epi_rows(Cs, [&](int row, int cc, const float* v) {
                  *(uint4*)(P + (size_t)(m0 + row) * NPO + n0 + cc) = pack8(v);
                });
              }
            });
          }
        } else {
          const int t2 = t - n_in;
          const int m0 = (t2 >> 3) * 128, n0 = (t2 & 7) * 128;
          ALin af{(const bf16*)(ws + WS_MEMN) + (size_t)m0 * DM, DM};
          gemm_tile(af, (const bf16*)(ws + WS_WMEM) + (size_t)n0 * DM, DM, DM, smem, [&](const float* Cs) {
            if (n0 < 512) {
              bf16* MK = (bf16*)(ws + WS_MEMK);
              epi_rows(Cs, [&](int row, int cc, const float* v) {
                *(uint4*)(MK + (size_t)(m0 + row) * 512 + n0 + cc) = pack8(v);
              });
            } else {
              bf16* MV = (bf16*)(ws + WS_MEMVT);
              epi_cols(Cs, [&](int col, int r8, const float* v) {
                *(uint4*)(MV + (size_t)(n0 - 512 + col) * 256 + m0 + r8) = pack8(v);
              });
            }
          });
        }
      }
    }

    auto mem_attn_task = [&](int t) {
      const int qt = t >> 2, head = t & 3;
      const int tq = qt * 128 + w * 32 + r;
      const int qcol = even ? 6144 : 5632, gcol = even ? 6656 : 6144;
      bf16x8 qf[8];
      load_q<128>(qf, P + (size_t)tq * NP + qcol + head * 128, h);
      f32x16 o[4];
      zero_o(o);
      float m = NEG, l = 0.f;
      CtxMem ctx{0.08838834764831845f * LOG2E};
      attn_run<128, true, true>(qf, o, m, l, (const bf16*)(ws + WS_MEMK) + head * 128, 512, nullptr, 0,
                          (const bf16*)(ws + WS_MEMVT) + (size_t)head * 128 * 256, 256, 0, ctx, smem);
      float lt = l + __shfl_xor(l, 32);
      store_out_A(o, 1.f / lt, P + (size_t)tq * NP + gcol + head * 128, MIXED + (size_t)tq * MIXW + 2048 + head * 128, h);
    };

    if ((PHM & 8) && sub == 1 && even) {
      const int cw = cvt_set_count(p, SET_OUT, layer);
      const int n_s5 = 1024, n_cum = 64, n_mem = 256;
      for (int t = bid; t < n_mem + n_s5 + n_cum + cw; t += nb) {
        if (t < n_mem) {
          mem_attn_task(t);
        } else if (t < n_mem + n_s5) {
          const int t2 = t - n_mem;
          const int ch = t2 >> 4, gq = t2 & 15;
          float* us = (float*)smem;
          __syncthreads();
          for (int i = tid; i < 128 * 8; i += 256) {
            int tt = i >> 3, c8 = (i & 7) * 8;
            uint4 u = *(const uint4*)(P + (size_t)(ch * 128 + tt) * NPE + gq * 64 + c8);
            float* d = us + tt * 64 + c8;
            d[0] = bflo(u.x); d[1] = bfhi(u.x); d[2] = bflo(u.y); d[3] = bfhi(u.y);
            d[4] = bflo(u.z); d[5] = bfhi(u.z); d[6] = bflo(u.w); d[7] = bfhi(u.w);
          }
          __syncthreads();
          const float* S5P = (const float*)(ws + WS_S5P);
          const int gp = (gq * 4 + w) * 64 + lane;
          const float ar = S5P[gp], ai = S5P[4096 + gp];
          float bbr[16], bbi[16];
#pragma unroll
          for (int c = 0; c < 16; ++c) { bbr[c] = S5P[16384 + gp * 16 + c]; bbi[c] = S5P[16384 + 65536 + gp * 16 + c]; }
          float xr = 0.f, xi = 0.f;
          for (int tt = 0; tt < 128; ++tt) {
            const float* up = us + tt * 64 + w * 16;
            float bur = 0.f, bui = 0.f;
#pragma unroll
            for (int c = 0; c < 16; ++c) { float uv = up[c]; bur += bbr[c] * uv; bui += bbi[c] * uv; }
            float nxr = ar * xr - ai * xi + bur;
            float nxi = ar * xi + ai * xr + bui;
            xr = nxr; xi = nxi;
          }
          float2* E = (float2*)(ws + WS_S5E);
          E[(size_t)ch * 4096 + gp] = make_float2(xr, xi);
        } else if (t < n_mem + n_s5 + n_cum) {
          const int ch = t - n_mem - n_s5;
          const float* FL = (const float*)(ws + WS_FLOG);
          float* CUML = (float*)(ws + WS_CUML);
          float* CT = (float*)(ws + WS_CT);
#pragma unroll
          for (int hh = 0; hh < 2; ++hh) {
            const int head = w * 2 + hh;
            const float bf = p.fox_b_f[li * 8 + head];
            const int t0 = ch * 128 + lane * 2;
            float x0 = FL[(size_t)t0 * 8 + head] + bf, x1 = FL[(size_t)(t0 + 1) * 8 + head] + bf;
            float v0 = x0 >= 0.f ? -log1pf(expf(-x0)) : x0 - log1pf(expf(x0));
            float v1 = x1 >= 0.f ? -log1pf(expf(-x1)) : x1 - log1pf(expf(x1));
            float s = v0 + v1;
            float inc = s;
#pragma unroll
            for (int o = 1; o < 64; o <<= 1) {
              float n = __shfl_up(inc, o);
              if (lane >= o) inc += n;
            }
            float excl = inc - s;
            CUML[(size_t)head * L + t0] = excl + v0;
            CUML[(size_t)head * L + t0 + 1] = excl + v0 + v1;
            if (lane == 63) CT[head * 64 + ch] = inc;
          }
        } else {
          cvt_set_task(p, SET_OUT, layer, t - n_mem - n_s5 - n_cum, smem);
        }
      }
    }
    if ((PHM & 16) && sub == 2 && even) {
      const int n_fox = 512, n_s5 = 1024;
      for (;;) {
        const int t = fetch_task(CTR + ph);
        if (t >= n_fox + n_s5) break;
        if (t < n_fox) {
          const int qt = 63 - (t >> 3), head = t & 7;
          const int q0w = qt * 128 + w * 32, tq = q0w + r;
          float* cpre = (float*)(smem + AT_X0);
          __syncthreads();
          if (tid < 64) {
            const float* CT = (const float*)(ws + WS_CT) + head * 64;
            float acc = 0.f;
            for (int c = 0; c < tid; ++c) acc += CT[c];
            cpre[tid] = acc;
          }
          __syncthreads();
          const float* cuml = (const float*)(ws + WS_CUML) + (size_t)head * L;
          bf16x8 qf[8];
          load_q<128>(qf, P + (size_t)tq * NPE + 2048 + head * 128, h);
          f32x16 o[4];
          zero_o(o);
          float m = NEG, l = 0.f;
          CtxFox ctx{tq, q0w, 2 * qt + 1, 0.08838834764831845f * LOG2E, cuml[tq] + cpre[tq >> 7], cuml, cpre};
          attn_run<128, true, true>(qf, o, m, l, P + 3072 + head * 128, NPE, nullptr, 0,
                              (const bf16*)(ws + WS_VTFOX) + (size_t)head * 128 * L, L, 0, ctx, smem);
          float lt = l + __shfl_xor(l, 32);
          store_out_A(o, 1.f / lt, P + (size_t)tq * NPE + 5120 + head * 128, MIXED + (size_t)tq * MIXW + 1024 + head * 128, h);
        } else {
          const int t2 = t - n_fox;
          const int ch = t2 >> 4, gq = t2 & 15;
          float* us = (float*)smem;
          float* xs = (float*)(smem + 32768) + w * 16 * 132;
          __syncthreads();
          for (int i = tid; i < 128 * 8; i += 256) {
            int tt = i >> 3, c8 = (i & 7) * 8;
            uint4 u = *(const uint4*)(P + (size_t)(ch * 128 + tt) * NPE + gq * 64 + c8);
            float* d = us + tt * 64 + c8;
            d[0] = bflo(u.x); d[1] = bfhi(u.x); d[2] = bflo(u.y); d[3] = bfhi(u.y);
            d[4] = bflo(u.z); d[5] = bfhi(u.z); d[6] = bflo(u.w); d[7] = bfhi(u.w);
          }
          __syncthreads();
          const float* S5P = (const float*)(ws + WS_S5P);
          const int g = gq * 4 + w;
          const int gp = g * 64 + lane;
          const float ar = S5P[gp], ai = S5P[4096 + gp];
          const float atr = S5P[8192 + gp], ati = S5P[12288 + gp];
          float xr = 0.f, xi = 0.f;
          {
            const float2* E = (const float2*)(ws + WS_S5E) + gp;
#define CSTEP(e) { float nxr = atr * xr - ati * xi + e.x; float nxi = atr * xi + ati * xr + e.y; xr = nxr; xi = nxi; }
            int c = 0;
            for (; c + 8 <= ch; c += 8) {
              float2 e0 = E[(size_t)(c + 0) * 4096], e1 = E[(size_t)(c + 1) * 4096], e2 = E[(size_t)(c + 2) * 4096],
                     e3 = E[(size_t)(c + 3) * 4096], e4 = E[(size_t)(c + 4) * 4096], e5 = E[(size_t)(c + 5) * 4096],
                     e6 = E[(size_t)(c + 6) * 4096], e7 = E[(size_t)(c + 7) * 4096];
              CSTEP(e0) CSTEP(e1) CSTEP(e2) CSTEP(e3) CSTEP(e4) CSTEP(e5) CSTEP(e6) CSTEP(e7)
            }
            for (; c < ch; ++c) {
              float2 e = E[(size_t)c * 4096];
              CSTEP(e)
            }
#undef CSTEP
          }
          float bbr[16], bbi[16];
#pragma unroll
          for (int c = 0; c < 16; ++c) { bbr[c] = S5P[16384 + gp * 16 + c]; bbi[c] = S5P[16384 + 65536 + gp * 16 + c]; }
          const int chn = lane & 15, kq = lane >> 4;
          float cb[32];
          {
            const float* cre = p.c_re + ((size_t)li * 64 + g) * 1024 + chn * 64;
            const float* cim = p.c_im + ((size_t)li * 64 + g) * 1024 + chn * 64;
#pragma unroll
            for (int ks = 0; ks < 16; ++ks) { cb[ks] = cre[4 * ks + kq]; cb[16 + ks] = -cim[4 * ks + kq]; }
          }
          const float dsk = p.s5_d[li * 1024 + g * 16 + chn];
          bf16* Z = (bf16*)(ws + WS_Z);
          for (int sc = 0; sc < 8; ++sc) {
#pragma unroll 4
            for (int tt = 0; tt < 16; ++tt) {
              const float* up = us + (sc * 16 + tt) * 64 + w * 16;
              float bur = 0.f, bui = 0.f;
#pragma unroll
              for (int c = 0; c < 16; ++c) { float uv = up[c]; bur += bbr[c] * uv; bui += bbi[c] * uv; }
              float nxr = ar * xr - ai * xi + bur;
              float nxi = ar * xi + ai * xr + bui;
              xr = nxr; xi = nxi;
              xs[tt * 132 + lane] = xr;
              xs[tt * 132 + 64 + lane] = xi;
            }
            __syncthreads();
            f32x4 y = {0.f, 0.f, 0.f, 0.f};
#pragma unroll
            for (int ks = 0; ks < 32; ++ks) {
              float a = xs[chn * 132 + 4 * ks + kq];
              y = __builtin_amdgcn_mfma_f32_16x16x4f32(a, cb[ks], y, 0, 0, 0);
            }
#pragma unroll
            for (int i = 0; i < 4; ++i) {
              int tt = 4 * kq + i;
              float uv = us[(sc * 16 + tt) * 64 + w * 16 + chn];
              float yy = y[i] + dsk * uv;
              Z[(size_t)(ch * 128 + sc * 16 + tt) * 1024 + g * 16 + chn] = f2bf(gelu_t(yy));
            }
            __syncthreads();
          }
        }
      }
    }
    if ((PHM & 32) && sub == 3 && even) {
      const bf16* Z = (const bf16*)(ws + WS_Z);
      for (int t = vb; t < 64 * 8; t += nb) {
        int tm, tn;
        tile_map(t, 8, tm, tn);
        const int m0 = tm * 128, n0 = tn * 128;
        ALin af{Z + (size_t)m0 * 1024, 1024};
        gemm_tile(af, (const bf16*)(ws + WS_WMISC + WM_GLU) + (size_t)n0 * 1024, 1024, 1024, smem, [&](const float* Cs) {
          epi_rows(Cs, [&](int row, int cc, const float* v) {
            uint4 zu = *(const uint4*)(Z + (size_t)(m0 + row) * 1024 + n0 + cc);
            uint4 gu = *(const uint4*)(P + (size_t)(m0 + row) * NPE + 1024 + n0 + cc);
            float zz[8] = {bflo(zu.x), bfhi(zu.x), bflo(zu.y), bfhi(zu.y), bflo(zu.z), bfhi(zu.z), bflo(zu.w), bfhi(zu.w)};
            float gg[8] = {bflo(gu.x), bfhi(gu.x), bflo(gu.y), bfhi(gu.y), bflo(gu.z), bfhi(gu.z), bflo(gu.w), bfhi(gu.w)};
            float o[8];
#pragma unroll
            for (int e = 0; e < 8; ++e) o[e] = zz[e] * sigm(v[e]) * silu(gg[e]);
            *(uint4*)(MIXED + (size_t)(m0 + row) * MIXW + n0 + cc) = pack8(o);
          });
        });
      }
    }
    if ((PHM & 64) && sub == 1 && !even) {
      const int cw = cvt_set_count(p, SET_OUT, layer);
      const int n_c1 = 32, n_q = 64 * 12, n_kv = 64 * 16, n_mem = 0;
      float* rsx = (float*)(smem + SM_EXTRA);
      for (int t = vb; t < n_c1 + n_q + n_kv + n_mem + cw; t += nb) {
        if (t < n_c1) {
          const int which = t >> 4, tm = (t >> 1) & 7, tn = t & 1;
          const int m0 = tm * 128, n0 = tn * 128;
          __syncthreads();
          if (tid < 128) {
            const float* CB = (const float*)(ws + WS_CMPB) + which * 16 * 256 + n0 + tid;
            float b = 0.f;
            for (int q = 0; q < 16; ++q) b += CB[q * 256];
            rsx[tid] = b;
          }
          ACmp af{P + (which ? 3328 : 3072), m0};
          bf16* HID = (bf16*)(ws + WS_HID) + (size_t)which * 1024 * 256;
          gemm_tile(af, (const bf16*)(ws + WS_WMISC + WM_W1) + (size_t)which * 256 * 4096 + (size_t)n0 * 4096, 4096, 4096,
                    smem, [&](const float* Cs) {
                      epi_rows(Cs, [&](int row, int cc, const float* v) {
                        float o[8];
#pragma unroll
                        for (int e = 0; e < 8; ++e) o[e] = gelu_t(v[e] + rsx[cc + e]);
                        *(uint4*)(HID + (size_t)(m0 + row) * 256 + n0 + cc) = pack8(o);
                      });
                    });
        } else if (t < n_c1 + n_q + n_kv) {
          const int t2 = t - n_c1;
          const bool isq = t2 < n_q;
          const int t3 = isq ? t2 : t2 - n_q;
          const int ntn = isq ? 12 : 16;
          int tm, tn;
          tile_map(t3, ntn, tm, tn);
          const int m0 = tm * 128, n0 = tn * 128;
          const bf16* Ab = P + (size_t)m0 * NPO + (isq ? 0 : 512);
          __syncthreads();
          for (int rr = 0; rr < 32; ++rr) {
            int row = w * 32 + rr;
            uint4 u = *(const uint4*)(Ab + (size_t)row * NPO + lane * 8);
            float a0 = bflo(u.x), a1 = bfhi(u.x), a2 = bflo(u.y), a3 = bfhi(u.y), a4 = bflo(u.z), a5 = bfhi(u.z),
                  a6 = bflo(u.w), a7 = bfhi(u.w);
            float ss = a0 * a0 + a1 * a1 + a2 * a2 + a3 * a3 + a4 * a4 + a5 * a5 + a6 * a6 + a7 * a7;
            ss = wave_sum(ss);
            if (lane == 0) rsx[row] = rsqrtf(ss * (1.f / 512.f) + EPS);
          }
          ALin af{Ab, NPO};
          if (isq) {
            bf16* QM = (bf16*)(ws + WS_QMLA);
            gemm_tile(af, (const bf16*)(ws + WS_WMISC + WM_UQ) + (size_t)n0 * 512, 512, 512, smem, [&](const float* Cs) {
              const int md = n0 % 192;
              const int ropehalf = md == 128 ? 0 : (md == 64 ? 1 : -1);
              epi_rows(Cs, [&](int row, int cc, const float* v) {
                if ((cc >> 6) == ropehalf) return;
                float o[8];
                float sc = rsx[row];
#pragma unroll
                for (int e = 0; e < 8; ++e) o[e] = v[e] * sc;
                *(uint4*)(QM + (size_t)(m0 + row) * 1536 + n0 + cc) = pack8(o);
              });
              if (ropehalf >= 0) {
                epi_rope(Cs, ropehalf * 64, m0, ROPEC, ROPES, 1.f, [&](int row, int cl, const float* v) {
                  float o[8];
                  float sc = rsx[row];
#pragma unroll
                  for (int e = 0; e < 8; ++e) o[e] = v[e] * sc;
                  *(uint4*)(QM + (size_t)(m0 + row) * 1536 + n0 + ropehalf * 64 + cl) = pack8(o);
                });
              }
            });
          } else {
            gemm_tile(af, (const bf16*)(ws + WS_WMISC + WM_UKV) + (size_t)n0 * 512, 512, 512, smem, [&](const float* Cs) {
              const int head = n0 >> 8, part = (n0 >> 7) & 1;
              if (part == 0) {
                bf16* KM = (bf16*)(ws + WS_KMLA);
                epi_rows(Cs, [&](int row, int cc, const float* v) {
                  float o[8];
                  float sc = rsx[row];
#pragma unroll
                  for (int e = 0; e < 8; ++e) o[e] = v[e] * sc;
                  *(uint4*)(KM + (size_t)(m0 + row) * 1024 + head * 128 + cc) = pack8(o);
                });
              } else {
                bf16* VT = (bf16*)(ws + WS_VTMLA);
                epi_cols(Cs, [&](int col, int r8, const float* v) {
                  float o[8];
#pragma unroll
                  for (int e = 0; e < 8; ++e) o[e] = v[e] * rsx[r8 + e];
                  *(uint4*)(VT + (size_t)(head * 128 + col) * L + m0 + r8) = pack8(o);
                });
              }
            });
          }
        } else if (t < n_c1 + n_q + n_kv + n_mem) {
          mem_attn_task(t - n_c1 - n_q - n_kv);
        } else {
          cvt_set_task(p, SET_OUT, layer, t - n_c1 - n_q - n_kv - n_mem, smem);
        }
      }
    }
    if ((PHM & 128) && sub == 2 && !even) {
      const int n_c2 = 16, n_mem2 = 256;
      for (int t = bid; t < n_c2 + n_mem2; t += nb) {
        if (t >= n_c2) {
          mem_attn_task(t - n_c2);
        } else {
          const int t2 = t;
          const int which = t2 >> 3, m0 = (t2 & 7) * 128;
          ALin af{(const bf16*)(ws + WS_HID) + (size_t)which * 1024 * 256 + (size_t)m0 * 256, 256};
          gemm_tile(af, (const bf16*)(ws + WS_WMISC + WM_W2) + (size_t)which * 128 * 256, 256, 256, smem, [&](const float* Cs) {
            if (which == 0) {
              bf16* KC = (bf16*)(ws + WS_KC);
              epi_rows(Cs, [&](int row, int cc, const float* v) {
                int gr = m0 + row;
                int n = gr >> 1, g = gr & 1;
                *(uint4*)(KC + ((size_t)g * 512 + n) * 128 + cc) = pack8(v);
              });
            } else {
              bf16* VC = (bf16*)(ws + WS_VCT);
              for (int i = tid; i < 128 * 128; i += 256) {
                int row = i & 127, col = i >> 7;
                int gr = m0 + row;
                int n = gr >> 1, g = gr & 1;
                VC[((size_t)g * 128 + col) * 512 + n] = f2bf(Cs[row * 132 + col]);
              }
            }
          });
        }
      }
    }
    if ((PHM & 256) && sub == 3 && !even) {
      const int* pos = p.pos;
      float* lut = (float*)(smem + AT_X0);
      float* imp = (float*)(smem + AT_IMP);
      unsigned* sel = (unsigned*)(smem + AT_SEL);
      const float* GT = (const float*)(ws + WS_FLOG);
      float* NSAO = (float*)(ws + WS_NSAO);
      for (;;) {
        const int tt_ = fetch_task(CTR + ph);
        if (tt_ >= 1024) break;
        const int t = tt_ >> 1;
        const int tid = otid(), lane = tid & 63, w = tid >> 6, r = lane & 31, h = lane >> 5;
        if ((tt_ & 1) == 0) {
          const int qt = 63 - (t >> 3), head = t & 7;
          const int q0w = qt * 128 + w * 32, tq = q0w + r;
          bf16x8 qf[12];
          load_q<192>(qf, (const bf16*)(ws + WS_QMLA) + (size_t)tq * 1536 + head * 192, h);
          f32x16 o[4];
          zero_o(o);
          float m = NEG, l = 0.f;
          CtxCausal ctx{tq, q0w, 2 * qt + 1, 0.07216878364870322f * LOG2E};
          attn_run<192, true, true>(qf, o, m, l, (const bf16*)(ws + WS_KMLA) + head * 128, 1024, P + 6656, NPO,
                              (const bf16*)(ws + WS_VTMLA) + (size_t)head * 128 * L, L, 0, ctx, smem);
          float lt = l + __shfl_xor(l, 32);
          store_out_A(o, 1.f / lt, P + (size_t)tq * NPO + 1024 + head * 128, MIXED + (size_t)tq * MIXW + head * 128, h);
          continue;
        }
        const int qt = 255 - (t >> 1), g = t & 1;
        const int q0 = qt * 32;
        const int hr = r >> 3, qi = r & 7;
        const int ql = w * 8 + qi;
        const int tq = q0 + ql;
        const int head = g * 4 + hr;
        const int posq = pos[tq];
        __syncthreads();
        for (int i = tid; i < 4 * 800; i += 256) {
          int rr = i / 800, n = i % 800;
          int b;
          if (n < 16) b = n;
          else {
            float lr = logf((float)n / 16.f) / 4.1588830833596715f;
            b = 16 + (int)(lr * 16.f);
            if (b > 31) b = 31;
          }
          lut[i] = p.t5[b * 8 + g * 4 + rr] * LOG2E;
        }
        for (int i = tid; i < 32 * 132; i += 256) imp[i] = 0.f;
        __syncthreads();
        const float* lutr = lut + hr * 800;
        bf16x8 qf[8];
        load_q<128>(qf, P + (size_t)tq * NPO + 2048 + head * 128, h);
        const float sc = 0.08838834764831845f * LOG2E;
        f32x16 o[4];
        float* orow = NSAO + (size_t)tq * 1024 + head * 128;

        const int ncv = min(q0 / 16 + 1, 511);
        const int last_c = (ncv - 1) >> 6;
        float m = NEG, l = 0.f;
        CtxCmp cc{tq, posq, last_c, sc, lutr, pos, 0.f, imp, ql, false};
        zero_o(o);
        const bf16* KCg = (const bf16*)(ws + WS_KC) + (size_t)g * 512 * 128;
        const bf16* VCg = (const bf16*)(ws + WS_VCT) + (size_t)g * 128 * 512;
        attn_run<128, false, false>(qf, o, m, l, KCg, 128, nullptr, 0, VCg, 512, 0, cc, smem);
        float lt = l + __shfl_xor(l, 32);
        const bool has_c = m > -1e29f;
        float m2 = has_c ? m : 0.f;
        float invl = has_c ? 1.f / lt : 0.f;
        cc.invl = invl; cc.p2 = true;
        float l2 = 0.f;
        attn_run<128, true, false>(qf, o, m2, l2, KCg, 128, nullptr, 0, VCg, 512, 0, cc, smem);
        {
          float gs = sigm(GT[(size_t)tq * 24 + head * 3 + 0]) * invl;
#pragma unroll
          for (int d = 0; d < 4; ++d)
#pragma unroll
            for (int i4 = 0; i4 < 4; ++i4) {
              int dv0 = d * 32 + 8 * i4 + 4 * h;
              float4 v = make_float4(o[d][4 * i4] * gs, o[d][4 * i4 + 1] * gs, o[d][4 * i4 + 2] * gs, o[d][4 * i4 + 3] * gs);
              *(float4*)(orow + dv0) = v;
            }
        }
        __syncthreads();
        for (int q8 = 0; q8 < 8; ++q8) {
          const int qq = w * 8 + q8;
          const int tt = q0 + qq;
          const int cur = tt >> 6;
          const float* ip = imp + qq * 132;
          const int j0 = lane, j1 = lane + 64;
          const bool v0 = j0 <= cur, v1 = j1 <= cur;
          const bool f0 = (j0 == 0) || (j0 == cur) || (j0 == cur - 1);
          const bool f1 = (j1 == cur) || (j1 == cur - 1);
          const int nforced = cur == 0 ? 1 : (cur == 1 ? 2 : 3);
          const int nfree = 16 - nforced;
          const float a0 = ip[j0], a1 = ip[j1];
          int r0 = 0, r1 = 0;
          for (int jj = 0; jj <= cur; ++jj) {
            bool fj = (jj == 0) || (jj == cur) || (jj == cur - 1);
            if (fj) continue;
            float vj = ip[jj];
            r0 += (vj > a0 || (vj == a0 && jj < j0)) ? 1 : 0;
            r1 += (vj > a1 || (vj == a1 && jj < j1)) ? 1 : 0;
          }
          bool s0 = v0 && (f0 || r0 < nfree);
          bool s1 = v1 && (f1 || r1 < nfree);
          unsigned long long b0 = __ballot(s0), b1 = __ballot(s1);
          if (lane == 0) {
            sel[qq * 4 + 0] = (unsigned)b0; sel[qq * 4 + 1] = (unsigned)(b0 >> 32);
            sel[qq * 4 + 2] = (unsigned)b1; sel[qq * 4 + 3] = (unsigned)(b1 >> 32);
          }
        }
        __syncthreads();
        unsigned un0, un1, un2, un3;
        {
          un0 = sel[r * 4 + 0]; un1 = sel[r * 4 + 1]; un2 = sel[r * 4 + 2]; un3 = sel[r * 4 + 3];
#pragma unroll
          for (int of = 1; of < 32; of <<= 1) {
            un0 |= __shfl_xor(un0, of); un1 |= __shfl_xor(un1, of); un2 |= __shfl_xor(un2, of); un3 |= __shfl_xor(un3, of);
          }
          un0 = __builtin_amdgcn_readfirstlane(un0); un1 = __builtin_amdgcn_readfirstlane(un1);
          un2 = __builtin_amdgcn_readfirstlane(un2); un3 = __builtin_amdgcn_readfirstlane(un3);
        }
        {
          CtxSlc cs{tq, posq, sc, lutr, pos, (unsigned long long)un0 | ((unsigned long long)un1 << 32),
                    (unsigned long long)un2 | ((unsigned long long)un3 << 32),
                    (unsigned long long)sel[ql * 4] | ((unsigned long long)sel[ql * 4 + 1] << 32),
                    (unsigned long long)sel[ql * 4 + 2] | ((unsigned long long)sel[ql * 4 + 3] << 32),
                    (const int*)(ws + WS_POSMAX), lutr[799], q0};
          zero_o(o);
          m = NEG; l = 0.f;
          attn_run<128, true, false>(qf, o, m, l, P + 3584 + g * 128, NPO, nullptr, 0,
                              (const bf16*)(ws + WS_VTSLC) + (size_t)g * 128 * L, L, 0, cs, smem);
          lt = l + __shfl_xor(l, 32);
          float gs = sigm(GT[(size_t)tq * 24 + head * 3 + 1]) / lt;
#pragma unroll
          for (int d = 0; d < 4; ++d)
#pragma unroll
            for (int i4 = 0; i4 < 4; ++i4) {
              int dv0 = d * 32 + 8 * i4 + 4 * h;
              float4 v = *(float4*)(orow + dv0);
              v.x += o[d][4 * i4] * gs; v.y += o[d][4 * i4 + 1] * gs; v.z += o[d][4 * i4 + 2] * gs; v.w += o[d][4 * i4 + 3] * gs;
              *(float4*)(orow + dv0) = v;
            }
        }
        {
          const int kfirst = q0 - 511 > 0 ? (q0 - 511) >> 6 : 0;
          CtxWin cwn{tq, posq, (q0 + 31) >> 6, sc, lutr, pos};
          zero_o(o);
          m = NEG; l = 0.f;
          attn_run<128, true, false>(qf, o, m, l, P + 4096 + g * 128, NPO, nullptr, 0,
                              (const bf16*)(ws + WS_VTWIN) + (size_t)g * 128 * L, L, kfirst, cwn, smem);
          lt = l + __shfl_xor(l, 32);
          float gs = sigm(GT[(size_t)tq * 24 + head * 3 + 2]) / lt;
          const bf16* grow = P + (size_t)tq * NPO + 4608 + head * 128;
          bf16* mrow = MIXED + (size_t)tq * MIXW + 1024 + head * 128;
#pragma unroll
          for (int d = 0; d < 4; ++d)
#pragma unroll
            for (int i4 = 0; i4 < 4; ++i4) {
              int dv0 = d * 32 + 8 * i4 + 4 * h;
              float4 v = *(float4*)(orow + dv0);
              v.x += o[d][4 * i4] * gs; v.y += o[d][4 * i4 + 1] * gs; v.z += o[d][4 * i4 + 2] * gs; v.w += o[d][4 * i4 + 3] * gs;
              uint2 gu = *(const uint2*)(grow + dv0);
              uint2 ou;
              ou.x = pack2(v.x * silu(bflo(gu.x)), v.y * silu(bfhi(gu.x)));
              ou.y = pack2(v.z * silu(bflo(gu.y)), v.w * silu(bfhi(gu.y)));
              *(uint2*)(mrow + dv0) = ou;
            }
        }
      }
    }
    if ((PHM & 512) && sub == 4) {
      const float* hin = layer == 0 ? p.x : hbuf;
      for (int t = vb; t < 64 * 8; t += nb) {
        int tm, tn;
        tile_map(t, 8, tm, tn);
        const int m0 = tm * 128;
        int n0 = tn * 256;
        ALin af{MIXED + (size_t)m0 * MIXW, MIXW};
        gemm_tile2(af, (const bf16*)(ws + WS_WOUT) + (size_t)n0 * MIXW, MIXW, MIXW, smem, n0, 2, [&](const float* Cs) {
          const int tid2 = otid();
#pragma unroll
          for (int j = 0; j < 16; ++j) {
            int c = tid2 + 256 * j;
            int row = c >> 5, cc = (c & 31) * 4;
            float4 a = *(const float4*)(Cs + row * 132 + cc);
            float4 hv = *(const float4*)(hin + (size_t)(m0 + row) * DM + n0 + cc);
            hv.x += a.x; hv.y += a.y; hv.z += a.z; hv.w += a.w;
            *(float4*)(hbuf + (size_t)(m0 + row) * DM + n0 + cc) = hv;
          }
        });
      }
    }
    }
  }
}

extern "C" void kernel_launch(void* const* d_in, const int* in_sizes, int n_in, void* d_out, int out_size, void* d_ws,
                              size_t ws_size, hipStream_t stream) {
  Params p{};
  p.x = (const float*)d_in[0]; p.mem = (const float*)d_in[1]; p.pos = (const int*)d_in[2];
  p.norm_g = (const float*)d_in[3]; p.mem_norm_g = (const float*)d_in[4]; p.final_norm_g = (const float*)d_in[5];
  p.t5 = (const float*)d_in[6]; p.w_out = (const float*)d_in[7]; p.mem_w_kv = (const float*)d_in[8];
  p.even_w_in = (const float*)d_in[9]; p.lam_re = (const float*)d_in[10]; p.lam_im = (const float*)d_in[11];
  p.log_dt = (const float*)d_in[12]; p.b_re = (const float*)d_in[13]; p.b_im = (const float*)d_in[14];
  p.c_re = (const float*)d_in[15]; p.c_im = (const float*)d_in[16]; p.s5_d = (const float*)d_in[17];
  p.w_glu = (const float*)d_in[18]; p.fox_b_f = (const float*)d_in[19]; p.odd_w_in = (const float*)d_in[20];
  p.g_cq = (const float*)d_in[21]; p.g_ckv = (const float*)d_in[22]; p.w_uq = (const float*)d_in[23];
  p.w_ukv = (const float*)d_in[24]; p.cmp_pe = (const float*)d_in[25]; p.cmp_w1 = (const float*)d_in[26];
  p.cmp_w2 = (const float*)d_in[27];
  p.out = (float*)d_out; p.ws = (char*)d_ws;
  if (ws_size < WS_END) fprintf(stderr, "workspace too small: %zu < %zu\n", ws_size, (size_t)WS_END);
  static int grid_blocks = 0;
  if (!grid_blocks) {
    int dev = 0, cus = 0, per_cu = 0;
    hipGetDevice(&dev);
    hipDeviceGetAttribute(&cus, hipDeviceAttributeMultiprocessorCount, dev);
    hipOccupancyMaxActiveBlocksPerMultiprocessor(&per_cu, mega, 256, 0);
    if (per_cu > 2) per_cu = 2;
    if (per_cu < 1) per_cu = 1;
    grid_blocks = cus * per_cu;
  }
  (void)hipMemsetAsync((char*)d_ws + WS_BAR, 0, XCD_BAR_WORDS * sizeof(unsigned), stream);
#if MULTI_LAUNCH
  for (int ph = 0; ph <= 24; ++ph) {
    int lo = ph, hi = ph;
    void* args[] = {&p, &lo, &hi};
    hipLaunchCooperativeKernel((void*)mega, dim3(grid_blocks), dim3(256), args, 0, stream);
  }
#else
  int lo = 0, hi = 24;
  void* args[] = {&p, &lo, &hi};
  hipError_t e = hipLaunchCooperativeKernel((void*)mega, dim3(grid_blocks), dim3(256), args, 0, stream);
  if (e != hipSuccess) fprintf(stderr, "cooperative launch failed: %s (grid %d)\n", hipGetErrorString(e), grid_blocks);
#endif
}
```

```cpp
#include <hip/hip_runtime.h>
#include <hip/hip_cooperative_groups.h>
#include <cstdio>
#include <cstdint>
namespace cg = cooperative_groups;

typedef unsigned short bf16;
typedef short bf16x8 __attribute__((ext_vector_type(8)));
typedef float f32x16 __attribute__((ext_vector_type(16)));
typedef float f32x4 __attribute__((ext_vector_type(4)));
typedef __bf16 bf2v __attribute__((ext_vector_type(2)));
typedef float f2v __attribute__((ext_vector_type(2)));

#define DI __device__ __forceinline__
#define MFMA32(a, b, c) __builtin_amdgcn_mfma_f32_32x32x16_bf16((a), (b), (c), 0, 0, 0)

#ifndef LB2
#define LB2 2
#endif
#ifndef REP_PH
#define REP_PH -1
#endif
#ifndef PHM
#define PHM 1023
#endif
#ifndef MULTI_LAUNCH
#define MULTI_LAUNCH 0
#endif

constexpr int L = 8192;
constexpr int DM = 2048;
constexpr int NPE = 7296;
constexpr int NPO = 6784;
constexpr int EVEN_IN = 7176;
constexpr int ODD_IN = 6744;
constexpr int MIXW = 2560;
constexpr float LOG2E = 1.4426950408889634f;
constexpr float NEG = -1e30f;
constexpr float EPS = 1e-6f;

constexpr size_t MB = 1024 * 1024;
constexpr size_t WS_WIN = 0;
constexpr size_t WS_WOUT = WS_WIN + 30 * MB;
constexpr size_t WS_WMEM = WS_WOUT + 10 * MB;
constexpr size_t WS_WMISC = WS_WMEM + 4 * MB;
constexpr size_t WS_XN = WS_WMISC + 8 * MB;
constexpr size_t WS_MEMN = WS_XN + 32 * MB;
constexpr size_t WS_P = WS_MEMN + 1 * MB;
constexpr size_t WS_MIXED = WS_P + 114 * MB;
constexpr size_t WS_MEMK = WS_MIXED + 40 * MB;
constexpr size_t WS_MEMVT = WS_MEMK + 256 * 1024;
constexpr size_t WS_ROPEC = WS_MEMVT + 256 * 1024;
constexpr size_t WS_ROPES = WS_ROPEC + 1 * MB;
constexpr size_t WS_FLOG = WS_ROPES + 1 * MB;
constexpr size_t WS_CUML = WS_FLOG + 1 * MB;
constexpr size_t WS_CT = WS_CUML + 256 * 1024;
constexpr size_t WS_S5P = WS_CT + 4096;
constexpr size_t WS_S5E = WS_S5P + 1 * MB;
constexpr size_t WS_CMPB = WS_S5E + 2 * MB;
constexpr size_t WS_CTR = WS_CMPB + 64 * 1024;
constexpr size_t WS_BAR = WS_CTR + 4096;
constexpr size_t WS_POSMAX = WS_BAR + 16384;
constexpr size_t WS_VAR = WS_POSMAX + 4096;
constexpr size_t WS_Z = WS_VAR;
constexpr size_t WS_VTFOX = WS_Z + 16 * MB;
constexpr size_t WS_QMLA = WS_VAR;
constexpr size_t WS_KMLA = WS_QMLA + 24 * MB;
constexpr size_t WS_VTMLA = WS_KMLA + 16 * MB;
constexpr size_t WS_VTSLC = WS_VTMLA + 16 * MB;
constexpr size_t WS_VTWIN = WS_VTSLC + 4 * MB;
constexpr size_t WS_HID = WS_VTWIN + 4 * MB;
constexpr size_t WS_KC = WS_HID + 1 * MB;
constexpr size_t WS_VCT = WS_KC + 256 * 1024;
constexpr size_t WS_NSAO = WS_VCT + 256 * 1024;
constexpr size_t WS_END = WS_NSAO + 32 * MB;
constexpr size_t WM_GLU = 0;
constexpr size_t WM_UQ = 0;
constexpr size_t WM_UKV = WM_UQ + 1536 * 512 * 2;
constexpr size_t WM_W1 = WM_UKV + 2048 * 512 * 2;
constexpr size_t WM_W2 = WM_W1 + 2 * 256 * 4096 * 2;

constexpr int SM_EXTRA = 73728;
constexpr int SM_TOTAL = 73728 + 1024;

struct Params {
  const float *x, *mem;
  const int* pos;
  const float *norm_g, *mem_norm_g, *final_norm_g, *t5, *w_out, *mem_w_kv, *even_w_in, *lam_re, *lam_im, *log_dt,
      *b_re, *b_im, *c_re, *c_im, *s5_d, *w_glu, *fox_b_f, *odd_w_in, *g_cq, *g_ckv, *w_uq, *w_ukv, *cmp_pe,
      *cmp_w1, *cmp_w2;
  float* out;
  char* ws;
};

DI unsigned pack2(float a, float b) {
  f2v v = {a, b};
  bf2v r = __builtin_convertvector(v, bf2v);
  return __builtin_bit_cast(unsigned, r);
}
DI float bflo(unsigned u) { return __uint_as_float(u << 16); }
DI float bfhi(unsigned u) { return __uint_as_float(u & 0xffff0000u); }
DI float bf2f(bf16 v) { return __uint_as_float(((unsigned)v) << 16); }
DI bf16 f2bf(float f) { return (bf16)(pack2(f, 0.f) & 0xffffu); }
DI int otid() { int z; asm volatile("s_mov_b32 %0, 0" : "=s"(z)); return (int)threadIdx.x + z; }
DI int crow(int i, int h) { return (i & 3) + 8 * (i >> 2) + 4 * h; }
DI float sigm(float x) { return 1.f / (1.f + __expf(-x)); }
DI float silu(float x) { return x * sigm(x); }
DI float gelu_t(float x) {
  float u = 0.7978845608028654f * (x + 0.044715f * x * x * x);
  float e = __expf(2.f * u);
  float t = 1.f - 2.f / (e + 1.f);
  return 0.5f * x * (1.f + t);
}
DI float ex2(float x) { return __builtin_amdgcn_exp2f(x); }
DI float wave_sum(float v) {
#pragma unroll
  for (int o = 32; o > 0; o >>= 1) v += __shfl_xor(v, o);
  return v;
}
DI uint4 pack8(const float* v) {
  uint4 u;
  u.x = pack2(v[0], v[1]); u.y = pack2(v[2], v[3]); u.z = pack2(v[4], v[5]); u.w = pack2(v[6], v[7]);
  return u;
}

struct CvtSeg {
  const float* src; int lds; int sc0; bf16* dst; int dr0; int ncols; int npad; int K; const float* kscale;
};
DI int cvt_count(const CvtSeg& s) { return (s.K >> 6) * (s.npad >> 6); }
DI void cvt_tile(const CvtSeg& s, int tile, char* smem) {
  float* T = (float*)smem;
  const int tid = otid();
  const int nkt = s.K >> 6;
  const int kt = tile % nkt, nt = tile / nkt;
  const int k0 = kt * 64, n0 = nt * 64;
  __syncthreads();
#pragma unroll
  for (int i = 0; i < 16; ++i) {
    int idx = tid + 256 * i;
    int k = idx >> 6, n = idx & 63;
    float v = 0.f;
    if (n0 + n < s.ncols) {
      v = s.src[(size_t)(k0 + k) * s.lds + s.sc0 + n0 + n];
      if (s.kscale) v *= s.kscale[k0 + k];
    }
    T[k * 65 + n] = v;
  }
  __syncthreads();
#pragma unroll
  for (int j = 0; j < 2; ++j) {
    int c = tid + 256 * j;
    int n = c >> 3, kc = (c & 7) * 8;
    float v[8];
#pragma unroll
    for (int e = 0; e < 8; ++e) v[e] = T[(kc + e) * 65 + n];
    *(uint4*)(s.dst + (size_t)(s.dr0 + n0 + n) * s.K + k0 + kc) = pack8(v);
  }
}

enum { SET_IN_EVEN = 0, SET_IN_ODD, SET_OUT, SET_MEM, SET_MISC_EVEN, SET_MISC_ODD };
DI int cvt_nseg(int set) {
  switch (set) {
    case SET_IN_EVEN: return 3;
    case SET_IN_ODD: return 5;
    case SET_OUT: return 1;
    case SET_MEM: return 1;
    case SET_MISC_EVEN: return 1;
    default: return 6;
  }
}
DI CvtSeg cvt_get(const Params& p, int set, int li, int s) {
  CvtSeg r;
  r.kscale = nullptr;
  char* ws = p.ws;
  if (set == SET_IN_EVEN) {
    r.src = p.even_w_in + (size_t)li * DM * EVEN_IN; r.lds = EVEN_IN; r.K = DM; r.dst = (bf16*)(ws + WS_WIN);
    if (s == 0) { r.sc0 = 0; r.dr0 = 0; r.ncols = 5120; r.npad = 5120; }
    else if (s == 1) { r.sc0 = 5128; r.dr0 = 5120; r.ncols = 2048; r.npad = 2048; }
    else { r.sc0 = 5120; r.dr0 = 7168; r.ncols = 8; r.npad = 128; }
  } else if (set == SET_IN_ODD) {
    r.src = p.odd_w_in + (size_t)li * DM * ODD_IN; r.lds = ODD_IN; r.K = DM; r.dst = (bf16*)(ws + WS_WIN);
    if (s == 0) { r.sc0 = 0; r.dr0 = 0; r.ncols = 1024; r.npad = 1024; }
    else if (s == 1) { r.sc0 = 1088; r.dr0 = 1024; r.ncols = 3584; r.npad = 3584; }
    else if (s == 2) { r.sc0 = 4696; r.dr0 = 4608; r.ncols = 2048; r.npad = 2048; }
    else if (s == 3) { r.sc0 = 1024; r.dr0 = 6656; r.ncols = 64; r.npad = 64; }
    else { r.sc0 = 4672; r.dr0 = 6720; r.ncols = 24; r.npad = 64; }
  } else if (set == SET_OUT) {
    r.src = p.w_out + (size_t)li * MIXW * DM; r.lds = DM; r.K = MIXW; r.dst = (bf16*)(ws + WS_WOUT);
    r.sc0 = 0; r.dr0 = 0; r.ncols = DM; r.npad = DM;
  } else if (set == SET_MEM) {
    r.src = p.mem_w_kv + (size_t)li * DM * 1024; r.lds = 1024; r.K = DM; r.dst = (bf16*)(ws + WS_WMEM);
    r.sc0 = 0; r.dr0 = 0; r.ncols = 1024; r.npad = 1024;
  } else if (set == SET_MISC_EVEN) {
    r.src = p.w_glu + (size_t)li * 1024 * 1024; r.lds = 1024; r.K = 1024; r.dst = (bf16*)(ws + WS_WMISC + WM_GLU);
    r.sc0 = 0; r.dr0 = 0; r.ncols = 1024; r.npad = 1024;
  } else {
    r.sc0 = 0; r.dr0 = 0;
    if (s == 0) {
      r.src = p.w_uq + (size_t)li * 512 * 1536; r.lds = 1536; r.K = 512; r.dst = (bf16*)(ws + WS_WMISC + WM_UQ);
      r.ncols = 1536; r.npad = 1536; r.kscale = p.g_cq + li * 512;
    } else if (s == 1) {
      r.src = p.w_ukv + (size_t)li * 512 * 2048; r.lds = 2048; r.K = 512; r.dst = (bf16*)(ws + WS_WMISC + WM_UKV);
      r.ncols = 2048; r.npad = 2048; r.kscale = p.g_ckv + li * 512;
    } else if (s < 4) {
      int which = s - 2;
      r.src = p.cmp_w1 + (size_t)(li * 2 + which) * 4096 * 256; r.lds = 256; r.K = 4096;
      r.dst = (bf16*)(ws + WS_WMISC + WM_W1) + (size_t)which * 256 * 4096; r.ncols = 256; r.npad = 256;
    } else {
      int which = s - 4;
      r.src = p.cmp_w2 + (size_t)(li * 2 + which) * 256 * 128; r.lds = 128; r.K = 256;
      r.dst = (bf16*)(ws + WS_WMISC + WM_W2) + (size_t)which * 128 * 256; r.ncols = 128; r.npad = 128;
    }
  }
  return r;
}
DI int cvt_set_count(const Params& p, int set, int li) {
  int n = 0;
  for (int s = 0; s < cvt_nseg(set); ++s) n += cvt_count(cvt_get(p, set, li, s));
  return n;
}
DI void cvt_set_task(const Params& p, int set, int li, int t, char* smem) {
  const int ns = cvt_nseg(set);
  for (int s = 0; s < ns; ++s) {
    CvtSeg sg = cvt_get(p, set, li, s);
    int c = cvt_count(sg);
    if (t < c) { cvt_tile(sg, t, smem); return; }
    t -= c;
  }
}

DI void norm_row_bf16(const float* __restrict__ src, const float* __restrict__ g, bf16* __restrict__ dst, int lane) {
  float4 v[8];
  float ss = 0.f;
#pragma unroll
  for (int i = 0; i < 8; ++i) {
    v[i] = *(const float4*)(src + (i * 64 + lane) * 4);
    ss += v[i].x * v[i].x + v[i].y * v[i].y + v[i].z * v[i].z + v[i].w * v[i].w;
  }
  ss = wave_sum(ss);
  float r = rsqrtf(ss * (1.f / DM) + EPS);
#pragma unroll
  for (int i = 0; i < 8; ++i) {
    float4 gg = *(const float4*)(g + (i * 64 + lane) * 4);
    uint2 u;
    u.x = pack2(v[i].x * r * gg.x, v[i].y * r * gg.y);
    u.y = pack2(v[i].z * r * gg.z, v[i].w * r * gg.w);
    *(uint2*)(dst + (i * 64 + lane) * 4) = u;
  }
}
DI void norm_row_f32(float* __restrict__ io, const float* __restrict__ g, int lane) {
  float4 v[8];
  float ss = 0.f;
#pragma unroll
  for (int i = 0; i < 8; ++i) {
    v[i] = *(const float4*)(io + (i * 64 + lane) * 4);
    ss += v[i].x * v[i].x + v[i].y * v[i].y + v[i].z * v[i].z + v[i].w * v[i].w;
  }
  ss = wave_sum(ss);
  float r = rsqrtf(ss * (1.f / DM) + EPS);
#pragma unroll
  for (int i = 0; i < 8; ++i) {
    float4 gg = *(const float4*)(g + (i * 64 + lane) * 4);
    float4 o;
    o.x = v[i].x * r * gg.x; o.y = v[i].y * r * gg.y; o.z = v[i].z * r * gg.z; o.w = v[i].w * r * gg.w;
    *(float4*)(io + (i * 64 + lane) * 4) = o;
  }
}

struct ALin {
  const bf16* p; int ld;
  DI const bf16* operator()(int row, int k) const { return p + (size_t)row * ld + k; }
};
struct ACmp {
  const bf16* p; int m0;
  DI const bf16* operator()(int row, int k) const {
    int gr = m0 + row;
    if (gr > 1021) gr = 1021;
    int n = gr >> 1, g = gr & 1;
    return p + (size_t)(16 * n + (k >> 7)) * NPO + g * 128 + (k & 127);
  }
};

template <class AF, class Epi>
DI void gemm_tile(AF af, const bf16* __restrict__ Bt, int ldb, int K, char* smem, Epi epi) {
  const int tid = otid(), lane = tid & 63, w = tid >> 6, r = lane & 31, h = lane >> 5;
  const int wm = w >> 1, wn = w & 1;
  bf16* As = (bf16*)smem;
  bf16* Bs = As + 2 * 128 * 72;
  f32x16 acc[2][2];
#pragma unroll
  for (int a = 0; a < 2; ++a)
#pragma unroll
    for (int b = 0; b < 2; ++b)
#pragma unroll
      for (int i = 0; i < 16; ++i) acc[a][b][i] = 0.f;
  uint4 ra0_0, ra0_1, ra0_2, ra0_3, rb0_0, rb0_1, rb0_2, rb0_3, ra1_0, ra1_1, ra1_2, ra1_3, rb1_0, rb1_1, rb1_2, rb1_3;
#define LD1(S, I, K0)                                                                  \
  {                                                                                    \
    int c = tl + 256 * I;                                                              \
    int row = c >> 3, kc = (c & 7) * 8;                                                \
    ra##S##_##I = *(const uint4*)af(row, (K0) + kc);                                   \
    rb##S##_##I = *(const uint4*)(Bt + (size_t)row * ldb + (K0) + kc);                 \
  }
#define ST1(S, I, BUF)                                                                 \
  {                                                                                    \
    int c = tid + 256 * I;                                                             \
    int row = c >> 3, kc = (c & 7) * 8;                                                \
    *(uint4*)(As + (BUF) * 9216 + row * 72 + kc) = ra##S##_##I;                        \
    *(uint4*)(Bs + (BUF) * 9216 + row * 72 + kc) = rb##S##_##I;                        \
  }
#define GLOAD(S, K0) { const int tl = otid(); LD1(S, 0, K0) LD1(S, 1, K0) LD1(S, 2, K0) LD1(S, 3, K0) }
#define SSTORE(S, BUF) { ST1(S, 0, BUF) ST1(S, 1, BUF) ST1(S, 2, BUF) ST1(S, 3, BUF) }
  auto compute = [&](int buf) {
    const bf16* a_ = As + buf * 9216 + (wm * 64 + r) * 72 + h * 8;
    const bf16* b_ = Bs + buf * 9216 + (wn * 64 + r) * 72 + h * 8;
    bf16x8 fa0, fa1, fb0, fb1, ga0, ga1, gb0, gb1, ha0, ha1, hb0, hb1, ia0, ia1, ib0, ib1;
    fa0 = *(const bf16x8*)(a_ + 0);            fa1 = *(const bf16x8*)(a_ + 32 * 72);
    fb0 = *(const bf16x8*)(b_ + 0);            fb1 = *(const bf16x8*)(b_ + 32 * 72);
    ga0 = *(const bf16x8*)(a_ + 16);           ga1 = *(const bf16x8*)(a_ + 32 * 72 + 16);
    gb0 = *(const bf16x8*)(b_ + 16);           gb1 = *(const bf16x8*)(b_ + 32 * 72 + 16);
    ha0 = *(const bf16x8*)(a_ + 32);           ha1 = *(const bf16x8*)(a_ + 32 * 72 + 32);
    hb0 = *(const bf16x8*)(b_ + 32);           hb1 = *(const bf16x8*)(b_ + 32 * 72 + 32);
    ia0 = *(const bf16x8*)(a_ + 48);           ia1 = *(const bf16x8*)(a_ + 32 * 72 + 48);
    ib0 = *(const bf16x8*)(b_ + 48);           ib1 = *(const bf16x8*)(b_ + 32 * 72 + 48);
    __builtin_amdgcn_sched_barrier(0);
    acc[0][0] = MFMA32(fa0, fb0, acc[0][0]); acc[0][1] = MFMA32(fa0, fb1, acc[0][1]);
    acc[1][0] = MFMA32(fa1, fb0, acc[1][0]); acc[1][1] = MFMA32(fa1, fb1, acc[1][1]);
    acc[0][0] = MFMA32(ga0, gb0, acc[0][0]); acc[0][1] = MFMA32(ga0, gb1, acc[0][1]);
    acc[1][0] = MFMA32(ga1, gb0, acc[1][0]); acc[1][1] = MFMA32(ga1, gb1, acc[1][1]);
    acc[0][0] = MFMA32(ha0, hb0, acc[0][0]); acc[0][1] = MFMA32(ha0, hb1, acc[0][1]);
    acc[1][0] = MFMA32(ha1, hb0, acc[1][0]); acc[1][1] = MFMA32(ha1, hb1, acc[1][1]);
    acc[0][0] = MFMA32(ia0, ib0, acc[0][0]); acc[0][1] = MFMA32(ia0, ib1, acc[0][1]);
    acc[1][0] = MFMA32(ia1, ib0, acc[1][0]); acc[1][1] = MFMA32(ia1, ib1, acc[1][1]);
    __builtin_amdgcn_sched_barrier(0);
  };
  __syncthreads();
  const int nk = K >> 6;
  GLOAD(0, 0);
  SSTORE(0, 0);
  GLOAD(0, 64);
  __syncthreads();
  for (int kt = 0; kt < nk; kt += 2) {
    if (kt + 2 < nk) GLOAD(1, (kt + 2) * 64);
    compute(0);
    SSTORE(0, 1);
    __syncthreads();
    if (kt + 3 < nk) GLOAD(0, (kt + 3) * 64);
    compute(1);
    if (kt + 2 < nk) SSTORE(1, 0);
    __syncthreads();
  }
#undef GLOAD
#undef SSTORE
#undef LD1
#undef ST1
  float* Cs = (float*)smem;
#pragma unroll
  for (int mb = 0; mb < 2; ++mb)
#pragma unroll
    for (int nb = 0; nb < 2; ++nb)
#pragma unroll
      for (int i = 0; i < 16; ++i)
        Cs[(wm * 64 + mb * 32 + crow(i, h)) * 132 + wn * 64 + nb * 32 + r] = acc[mb][nb][i];
  __syncthreads();
  epi(Cs);
}


template <class AF, class Epi>
DI void gemm_tile2(AF af, const bf16* __restrict__ Bt, int ldb, int K, char* smem, int& n0ref, int nhalf, Epi epi) {
  const int tid = otid(), lane = tid & 63, w = tid >> 6, r = lane & 31, h = lane >> 5;
  const int wm = w >> 1, wn = w & 1;
  bf16* As = (bf16*)smem;
  bf16* Bs = As + 128 * 72;
  f32x16 acc[2][4];
#pragma unroll
  for (int a = 0; a < 2; ++a)
#pragma unroll
    for (int b = 0; b < 4; ++b)
#pragma unroll
      for (int i = 0; i < 16; ++i) acc[a][b][i] = 0.f;
  uint4 pa_0, pa_1, pa_2, pa_3, pb_0, pb_1, pb_2, pb_3, pb_4, pb_5, pb_6, pb_7;
#define LDA2(I, K0) { int c = tl + 256 * I; int row = c >> 3, kc = (c & 7) * 8; pa_##I = *(const uint4*)af(row, (K0) + kc); }
#define LDB2(I, K0) { int c = tl + 256 * I; int row = c >> 3, kc = (c & 7) * 8; pb_##I = *(const uint4*)(Bt + (size_t)row * ldb + (K0) + kc); }
#define STA2(I) { int c = tid + 256 * I; int row = c >> 3, kc = (c & 7) * 8; *(uint4*)(As + row * 72 + kc) = pa_##I; }
#define STB2(I) { int c = tid + 256 * I; int row = c >> 3, kc = (c & 7) * 8; *(uint4*)(Bs + row * 72 + kc) = pb_##I; }
#define GLOAD2(K0) { const int tl = otid(); LDA2(0, K0) LDA2(1, K0) LDA2(2, K0) LDA2(3, K0) LDB2(0, K0) LDB2(1, K0) LDB2(2, K0) LDB2(3, K0) LDB2(4, K0) LDB2(5, K0) LDB2(6, K0) LDB2(7, K0) }
#define SSTORE2() { STA2(0) STA2(1) STA2(2) STA2(3) STB2(0) STB2(1) STB2(2) STB2(3) STB2(4) STB2(5) STB2(6) STB2(7) }
  const int nk = K >> 6;
  GLOAD2(0);
  const bf16* a_ = As + (wm * 64 + r) * 72 + h * 8;
  const bf16* b_ = Bs + (wn * 128 + r) * 72 + h * 8;
  for (int kt = 0; kt < nk; ++kt) {
    __syncthreads();
    SSTORE2();
    __syncthreads();
    if (kt + 1 < nk) GLOAD2((kt + 1) * 64);
#pragma unroll
    for (int ks = 0; ks < 4; ++ks) {
      bf16x8 fa[2], fb[4];
#pragma unroll
      for (int mb = 0; mb < 2; ++mb) fa[mb] = *(const bf16x8*)(a_ + mb * 32 * 72 + ks * 16);
#pragma unroll
      for (int nb = 0; nb < 4; ++nb) fb[nb] = *(const bf16x8*)(b_ + nb * 32 * 72 + ks * 16);
#pragma unroll
      for (int mb = 0; mb < 2; ++mb)
#pragma unroll
        for (int nb = 0; nb < 4; ++nb) acc[mb][nb] = MFMA32(fa[mb], fb[nb], acc[mb][nb]);
    }
  }
#undef LDA2
#undef LDB2
#undef STA2
#undef STB2
#undef GLOAD2
#undef SSTORE2
  float* Cs = (float*)smem;
#pragma unroll
  for (int hf = 0; hf < 2; ++hf) {
    if (hf < nhalf) {
      __syncthreads();
      if (wn == hf) {
#pragma unroll
        for (int mb = 0; mb < 2; ++mb)
#pragma unroll
          for (int nb = 0; nb < 4; ++nb)
#pragma unroll
            for (int i = 0; i < 16; ++i) Cs[(wm * 64 + mb * 32 + crow(i, h)) * 132 + nb * 32 + r] = acc[mb][nb][i];
      }
      __syncthreads();
      epi(Cs);
      n0ref += 128;
    }
  }
}

DI void tile_map(int t, int ntn, int& tm, int& tn) {
  const int per = 8 * ntn;
  const int grp = t / per, rem = t - grp * per;
  tm = grp * 8 + (rem & 7);
  tn = rem >> 3;
}
template <class F>
DI void epi_rows(const float* Cs, F f) {
  const int tid = otid();
#pragma unroll
  for (int j = 0; j < 8; ++j) {
    int c = tid + 256 * j;
    int row = c >> 4, cc = (c & 15) * 8;
    float v[8];
    float4 a = *(const float4*)(Cs + row * 132 + cc);
    float4 b = *(const float4*)(Cs + row * 132 + cc + 4);
    v[0] = a.x; v[1] = a.y; v[2] = a.z; v[3] = a.w; v[4] = b.x; v[5] = b.y; v[6] = b.z; v[7] = b.w;
    f(row, cc, v);
  }
}
template <class F>
DI void epi_cols(const float* Cs, F f) {
  const int tid = otid();
#pragma unroll
  for (int j = 0; j < 8; ++j) {
    int c = tid + 256 * j;
    int col = c & 127, r8 = (c >> 7) * 8;
    float v[8];
#pragma unroll
    for (int e = 0; e < 8; ++e) v[e] = Cs[(r8 + e) * 132 + col];
    f(col, r8, v);
  }
}
template <class F>
DI void epi_rope(const float* Cs, int cb, int m0, const float* rc, const float* rs, float scale_unused, F f) {
  const int tid = otid();
#pragma unroll
  for (int j = 0; j < 2; ++j) {
    int c = tid + 256 * j;
    int row = c >> 2, cc = (c & 3) * 8;
    float x1[8], x2[8], o1[8], o2[8];
#pragma unroll
    for (int e = 0; e < 8; ++e) {
      x1[e] = Cs[row * 132 + cb + cc + e];
      x2[e] = Cs[row * 132 + cb + 32 + cc + e];
    }
    const float* pc = rc + (size_t)(m0 + row) * 32 + cc;
    const float* ps = rs + (size_t)(m0 + row) * 32 + cc;
#pragma unroll
    for (int e = 0; e < 8; ++e) {
      float cs = pc[e], sn = ps[e];
      o1[e] = x1[e] * cs - x2[e] * sn;
      o2[e] = x1[e] * sn + x2[e] * cs;
    }
    f(row, cc, o1);
    f(row, cc + 32, o2);
  }
}

template <int DK>
struct KVPre {
  uint4 k[DK / 32];
  uint4 v[4];
  float aux;
};
constexpr int AT_VS = 25600;
constexpr int AT_AUX = 43008;
constexpr int AT_X0 = 43264;
constexpr int AT_IMP = AT_X0 + 12800;
constexpr int AT_SEL = AT_IMP + 16896;

template <int DK, bool PV, class SF, class PH>
DI void attn_tile(const bf16x8 (&qf)[DK / 16], f32x16 (&o)[4], float& m, float& l, const char* smem, SF sf, PH ph) {
  const int lane = otid() & 63, r = lane & 31, h = lane >> 5;
  const bf16* Ks = (const bf16*)smem;
  const bf16* Vs = (const bf16*)(smem + AT_VS);
  const float* auxs = (const float*)(smem + AT_AUX);
  f32x16 s[2];
#pragma unroll
  for (int kb = 0; kb < 2; ++kb) {
#pragma unroll
    for (int i = 0; i < 16; ++i) s[kb][i] = 0.f;
#pragma unroll
    for (int ks = 0; ks < DK / 16; ++ks) {
      bf16x8 a = *(const bf16x8*)(Ks + (kb * 32 + r) * (DK + 8) + ks * 16 + h * 8);
      s[kb] = MFMA32(a, qf[ks], s[kb]);
    }
  }
  float mx = m;
#pragma unroll
  for (int kb = 0; kb < 2; ++kb)
#pragma unroll
    for (int i = 0; i < 16; ++i) {
      int kl = kb * 32 + crow(i, h);
      float v = sf(s[kb][i], kl, auxs[kl]);
      s[kb][i] = v;
      mx = fmaxf(mx, v);
    }
  mx = fmaxf(mx, __shfl_xor(mx, 32));
  float alpha = ex2(m - mx);
  m = mx;
  float psum = 0.f;
#pragma unroll
  for (int kb = 0; kb < 2; ++kb)
#pragma unroll
    for (int i = 0; i < 16; ++i) {
      float pv = ex2(s[kb][i] - mx);
      s[kb][i] = pv;
      psum += pv;
    }
  l = l * alpha + psum;
  ph(0, s[0]);
  ph(1, s[1]);
  if (PV) {
    if (__builtin_amdgcn_ballot_w64(alpha != 1.f) != 0ull) {
#pragma unroll
      for (int d = 0; d < 4; ++d)
#pragma unroll
        for (int i = 0; i < 16; ++i) o[d][i] *= alpha;
    }
#pragma unroll
    for (int st = 0; st < 4; ++st) {
      const int kb = st >> 1, s2 = st & 1;
      uint4 pu;
      pu.x = pack2(s[kb][8 * s2 + 0], s[kb][8 * s2 + 1]);
      pu.y = pack2(s[kb][8 * s2 + 2], s[kb][8 * s2 + 3]);
      pu.z = pack2(s[kb][8 * s2 + 4], s[kb][8 * s2 + 5]);
      pu.w = pack2(s[kb][8 * s2 + 6], s[kb][8 * s2 + 7]);
      bf16x8 pf = __builtin_bit_cast(bf16x8, pu);
#pragma unroll
      for (int d = 0; d < 4; ++d) {
        const bf16* vp = Vs + (d * 32 + r) * 68 + st * 16 + 4 * h;
        uint2 lo = *(const uint2*)vp;
        uint2 hi = *(const uint2*)(vp + 8);
        uint4 vu = make_uint4(lo.x, lo.y, hi.x, hi.y);
        bf16x8 vf = __builtin_bit_cast(bf16x8, vu);
        o[d] = MFMA32(vf, pf, o[d]);
      }
    }
  }
}

template <int DK, int FM>
DI void attn_tile_c(const bf16x8 (&qf)[DK / 16], f32x16 (&o)[4], float& m, float& l, const char* smem, float sc, float c) {
  const int lane = otid() & 63, r = lane & 31, h = lane >> 5;
  const bf16* Ks = (const bf16*)smem;
  const bf16* Vs = (const bf16*)(smem + AT_VS);
  const float* auxs = (const float*)(smem + AT_AUX);
  f32x16 s[2];
#pragma unroll
  for (int kb = 0; kb < 2; ++kb) {
#pragma unroll
    for (int i = 0; i < 16; ++i) s[kb][i] = 0.f;
#pragma unroll
    for (int ks = 0; ks < DK / 16; ++ks) {
      bf16x8 a = *(const bf16x8*)(Ks + (kb * 32 + r) * (DK + 8) + ks * 16 + h * 8);
      s[kb] = MFMA32(a, qf[ks], s[kb]);
    }
  }
  float mx;
  if (FM == 2) {
    mx = m;
#pragma unroll
    for (int kb = 0; kb < 2; ++kb)
#pragma unroll
      for (int i = 0; i < 16; ++i) {
        float v = __builtin_fmaf(s[kb][i], sc, -auxs[kb * 32 + crow(i, h)]);
        s[kb][i] = v;
        mx = fmaxf(mx, v);
      }
  } else {
    float rm = s[0][0];
#pragma unroll
    for (int kb = 0; kb < 2; ++kb)
#pragma unroll
      for (int i = 0; i < 16; ++i) rm = fmaxf(rm, s[kb][i]);
    mx = fmaxf(m, __builtin_fmaf(rm, sc, c));
  }
  mx = fmaxf(mx, __shfl_xor(mx, 32));
  const float alpha = ex2(m - mx);
  m = mx;
  float psum = 0.f;
  const float off = c - mx;
#pragma unroll
  for (int kb = 0; kb < 2; ++kb)
#pragma unroll
    for (int i = 0; i < 16; ++i) {
      float pv = (FM == 2) ? ex2(s[kb][i] - mx) : ex2(__builtin_fmaf(s[kb][i], sc, off));
      s[kb][i] = pv;
      psum += pv;
    }
  l = l * alpha + psum;
  if (__builtin_amdgcn_ballot_w64(alpha != 1.f) != 0ull) {
#pragma unroll
    for (int d = 0; d < 4; ++d)
#pragma unroll
      for (int i = 0; i < 16; ++i) o[d][i] *= alpha;
  }
#pragma unroll
  for (int st = 0; st < 4; ++st) {
    const int kb = st >> 1, s2 = st & 1;
    uint4 pu;
    pu.x = pack2(s[kb][8 * s2 + 0], s[kb][8 * s2 + 1]);
    pu.y = pack2(s[kb][8 * s2 + 2], s[kb][8 * s2 + 3]);
    pu.z = pack2(s[kb][8 * s2 + 4], s[kb][8 * s2 + 5]);
    pu.w = pack2(s[kb][8 * s2 + 6], s[kb][8 * s2 + 7]);
    bf16x8 pf = __builtin_bit_cast(bf16x8, pu);
#pragma unroll
    for (int d = 0; d < 4; ++d) {
      const bf16* vp = Vs + (d * 32 + r) * 68 + st * 16 + 4 * h;
      uint2 lo = *(const uint2*)vp;
      uint2 hi = *(const uint2*)(vp + 8);
      uint4 vu = make_uint4(lo.x, lo.y, hi.x, hi.y);
      bf16x8 vf = __builtin_bit_cast(bf16x8, vu);
      o[d] = MFMA32(vf, pf, o[d]);
    }
  }
}

struct NoHook { DI void operator()(int, const f32x16&) const {} };

template <int DK, bool PV, bool PF, class Ctx>
DI void attn_run(const bf16x8 (&qf)[DK / 16], f32x16 (&o)[4], float& m, float& l, const bf16* K1, int ldk1,
                 const bf16* K2, int ldk2, const bf16* Vt, int ldv, int first, Ctx& ctx, char* smem) {
  const int tid = otid();
  int tcur = first;
  if (tcur < 0) return;
  constexpr int CPR = DK / 8;
  constexpr int NKC = DK / 32;
  uint4 rk0, rk1, rk2, rk3, rk4 = make_uint4(0, 0, 0, 0), rk5 = make_uint4(0, 0, 0, 0), rv[4];
  float raux;
  bf16* Ks = (bf16*)smem;
  bf16* Vs = (bf16*)(smem + AT_VS);
  auto ldk = [&](int i, int key0) -> uint4 {
    int c = otid() + 256 * i;
    int row = c / CPR, cc = c % CPR;
    const bf16* src;
    if (DK == 128 || cc < 16) src = K1 + (size_t)(key0 + row) * ldk1 + cc * 8;
    else src = K2 + (size_t)(key0 + row) * ldk2 + (cc - 16) * 8;
    return *(const uint4*)src;
  };
  auto stk = [&](int i, const uint4& v) {
    int c = tid + 256 * i;
    int row = c / CPR, cc = c % CPR;
    *(uint4*)(Ks + row * (DK + 8) + cc * 8) = v;
  };
  auto gload = [&](int key0) {
    rk0 = ldk(0, key0); rk1 = ldk(1, key0); rk2 = ldk(2, key0); rk3 = ldk(3, key0);
    if (NKC > 4) { rk4 = ldk(4, key0); rk5 = ldk(5, key0); }
    const int tl = otid();
#pragma unroll
    for (int i = 0; i < 4; ++i) {
      int c = tl + 256 * i;
      int d = c >> 3, cc = c & 7;
      rv[i] = *(const uint4*)(Vt + (size_t)d * ldv + key0 + cc * 8);
    }
    raux = (tid < 64) ? ctx.aux(key0 + tid) : 0.f;
  };
  auto sstore = [&]() {
    stk(0, rk0); stk(1, rk1); stk(2, rk2); stk(3, rk3);
    if (NKC > 4) { stk(4, rk4); stk(5, rk5); }
#pragma unroll
    for (int i = 0; i < 4; ++i) {
      int c = tid + 256 * i;
      int d = c >> 3, cc = c & 7;
      uint2* dst = (uint2*)(Vs + d * 68 + cc * 8);
      dst[0] = make_uint2(rv[i].x, rv[i].y);
      dst[1] = make_uint2(rv[i].z, rv[i].w);
    }
    if (tid < 64) ((float*)(smem + AT_AUX))[tid] = raux;
  };
  if (PF) gload(tcur * 64);
  while (tcur >= 0) {
    __syncthreads();
    if (!PF) gload(tcur * 64);
    sstore();
    __syncthreads();
    int tnext = ctx.next(tcur);
    if (PF && tnext >= 0) gload(tnext * 64);
    if (!ctx.skip(tcur)) {
      const int tc = tcur;
      if (Ctx::FMODE != 0 && (Ctx::ALWAYS_FAST || ctx.fast(tc))) {
        attn_tile_c<DK, (Ctx::FMODE == 2 ? 2 : 1)>(qf, o, m, l, smem, ctx.sc, ctx.fconst(tc));
      } else if (!Ctx::ALWAYS_FAST) {
        attn_tile<DK, PV>(qf, o, m, l, smem,
                          [&](float s, int kl, float ax) { return ctx.score(s, tc * 64 + kl, ax, tc); },
                          [&](int kb, const f32x16& pt) { ctx.hook(kb, pt, tc); });
      }
    }
    tcur = tnext;
  }
}

template <int DK>
DI void load_q(bf16x8 (&qf)[DK / 16], const bf16* qrow, int h) {
#pragma unroll
  for (int ks = 0; ks < DK / 16; ++ks) qf[ks] = *(const bf16x8*)(qrow + ks * 16 + h * 8);
}
DI void zero_o(f32x16 (&o)[4]) {
#pragma unroll
  for (int d = 0; d < 4; ++d)
#pragma unroll
    for (int i = 0; i < 16; ++i) o[d][i] = 0.f;
}

struct CtxCausal {
  int tq, q0w, last; float sc;
  DI int next(int t) const { return t + 1 <= last ? t + 1 : -1; }
  DI float aux(int) const { return 0.f; }
  DI bool skip(int t) const { return t * 64 > q0w + 31; }
  DI float score(float s, int key, float, int) const { return key <= tq ? s * sc : NEG; }
  static constexpr int FMODE = 1;
  static constexpr bool ALWAYS_FAST = false;
  DI bool fast(int t) const { return t * 64 + 63 <= q0w; }
  DI float fconst(int) const { return 0.f; }
  DI void hook(int, const f32x16&, int) const {}
};
struct CtxFox {
  int tq, q0w, last; float sc; const float* cuml; const float* cpre;
  DI int next(int t) const { return t + 1 <= last ? t + 1 : -1; }
  DI float aux(int key) const { return (cuml[key] + cpre[key >> 7]) * LOG2E; }
  DI bool skip(int t) const { return t * 64 > q0w + 31; }
  DI float score(float s, int key, float ax, int) const { return key <= tq ? s * sc - ax : NEG; }
  static constexpr int FMODE = 2;
  static constexpr bool ALWAYS_FAST = false;
  DI bool fast(int t) const { return t * 64 + 63 <= q0w; }
  DI float fconst(int) const { return 0.f; }
  DI void hook(int, const f32x16&, int) const {}
};
struct CtxMem {
  float sc;
  DI int next(int t) const { return t + 1 < 4 ? t + 1 : -1; }
  DI float aux(int) const { return 0.f; }
  DI bool skip(int) const { return false; }
  DI float score(float s, int, float, int) const { return s * sc; }
  static constexpr int FMODE = 1;
  static constexpr bool ALWAYS_FAST = true;
  DI bool fast(int) const { return true; }
  DI float fconst(int) const { return 0.f; }
  DI void hook(int, const f32x16&, int) const {}
};

DI void store_out_A(const f32x16 (&o)[4], float inv_l, const bf16* grow, bf16* orow, int h) {
#pragma unroll
  for (int d = 0; d < 4; ++d)
#pragma unroll
    for (int i4 = 0; i4 < 4; ++i4) {
      int dv0 = d * 32 + 8 * i4 + 4 * h;
      uint2 gu = *(const uint2*)(grow + dv0);
      float g0 = bflo(gu.x), g1 = bfhi(gu.x), g2 = bflo(gu.y), g3 = bfhi(gu.y);
      uint2 ou;
      ou.x = pack2(o[d][4 * i4 + 0] * inv_l * silu(g0), o[d][4 * i4 + 1] * inv_l * silu(g1));
      ou.y = pack2(o[d][4 * i4 + 2] * inv_l * silu(g2), o[d][4 * i4 + 3] * inv_l * silu(g3));
      *(uint2*)(orow + dv0) = ou;
    }
}

        struct CtxCmp {
          int tq, posq, last; float sc; const float* lutr; const int* pos; float invl; float* imp; int ql; bool p2;
          DI int next(int t) const { return t + 1 <= last ? t + 1 : -1; }
          DI float aux(int key) const { int n = key < 511 ? key : 510; return __int_as_float(pos[16 * n + 31]); }
          DI bool skip(int) const { return false; }
          DI float score(float s, int key, float ax, int) const {
            bool valid = (16 * key + 31 <= tq) && key < 511;
            int d = posq - __float_as_int(ax);
            d = d < 0 ? 0 : (d > 799 ? 799 : d);
            return valid ? s * sc + lutr[d] : NEG;
          }
          static constexpr int FMODE = 0;
          static constexpr bool ALWAYS_FAST = false;
          DI bool fast(int) const { return false; }
          DI float fconst(int) const { return 0.f; }
          DI void hook(int kb, const f32x16& pt, int tc) const {
            if (!p2) return;
            const int lane = otid() & 63, h = lane >> 5, r = lane & 31;
#pragma unroll
            for (int gq = 0; gq < 4; ++gq) {
              float p3 = 0.5f * pt[4 * gq + 3];
              float vm = (pt[4 * gq] + pt[4 * gq + 1] + pt[4 * gq + 2] + p3) * invl;
              float vs = p3 * invl;
              vm += __shfl_xor(vm, 8); vm += __shfl_xor(vm, 16);
              vs += __shfl_xor(vs, 8); vs += __shfl_xor(vs, 16);
              int j = tc * 16 + kb * 8 + 2 * gq + h;
              if (r < 8) { atomicAdd(&imp[ql * 132 + j], vm); atomicAdd(&imp[ql * 132 + j + 1], vs); }
            }
          }
        };
struct CtxSlc {
  int tq, posq; float sc; const float* lutr; const int* pos; unsigned long long ulo, uhi, mlo, mhi;
  const int* posmax; int pqmin, q0;
  DI bool farj(int j) const { return (j * 64 + 63 < q0) && (pqmin - posmax[j] >= 799); }
  DI bool inu(int j) const {
    unsigned long long a = (ulo >> (j & 63)) & (j < 64 ? 1ull : 0ull);
    unsigned long long b = (uhi >> (j & 63)) & (j >= 64 ? 1ull : 0ull);
    return (a | b) != 0ull;
  }
  DI bool mine(int j) const {
    unsigned long long a = (mlo >> (j & 63)) & (j < 64 ? 1ull : 0ull);
    unsigned long long b = (mhi >> (j & 63)) & (j >= 64 ? 1ull : 0ull);
    return (a | b) != 0ull;
  }
  DI int next(int t) const { for (int j = t + 1; j < 128; ++j) if (inu(j) && !farj(j)) return j; return -1; }
  DI float aux(int key) const { return __int_as_float(pos[key]); }
  DI bool skip(int t) const { return __builtin_amdgcn_ballot_w64(mine(t)) == 0ull; }
  DI float score(float s, int key, float ax, int t) const {
    bool valid = mine(t) && key <= tq;
    int d = posq - __float_as_int(ax);
    d = d < 0 ? 0 : (d > 799 ? 799 : d);
    return valid ? s * sc + lutr[d] : NEG;
  }
  static constexpr int FMODE = 0;
  static constexpr bool ALWAYS_FAST = false;
  DI bool fast(int) const { return false; }
  DI float fconst(int) const { return 0.f; }
  DI void hook(int, const f32x16&, int) const {}
};
struct CtxSlcFar {
  float sc, bfar; unsigned long long ulo, uhi, mlo, mhi; const int* posmax; int pqmin, q0;
  DI bool farj(int j) const { return (j * 64 + 63 < q0) && (pqmin - posmax[j] >= 799); }
  DI bool inu(int j) const {
    unsigned long long a = (ulo >> (j & 63)) & (j < 64 ? 1ull : 0ull);
    unsigned long long b = (uhi >> (j & 63)) & (j >= 64 ? 1ull : 0ull);
    return (a | b) != 0ull;
  }
  DI bool mine(int j) const {
    unsigned long long a = (mlo >> (j & 63)) & (j < 64 ? 1ull : 0ull);
    unsigned long long b = (mhi >> (j & 63)) & (j >= 64 ? 1ull : 0ull);
    return (a | b) != 0ull;
  }
  DI int next(int t) const { for (int j = t + 1; j < 128; ++j) if (inu(j) && farj(j)) return j; return -1; }
  DI float aux(int) const { return 0.f; }
  DI bool skip(int t) const { return __builtin_amdgcn_ballot_w64(mine(t)) == 0ull; }
  DI float score(float s, int, float, int t) const { return mine(t) ? s * sc + bfar : NEG; }
  static constexpr int FMODE = 1;
  static constexpr bool ALWAYS_FAST = true;
  DI bool fast(int) const { return true; }
  DI float fconst(int t) const { return mine(t) ? bfar : NEG; }
  DI void hook(int, const f32x16&, int) const {}
};
struct CtxWin {
  int tq, posq, last; float sc; const float* lutr; const int* pos;
  DI int next(int t) const { return t + 1 <= last ? t + 1 : -1; }
  DI float aux(int key) const { return __int_as_float(pos[key]); }
  DI bool skip(int) const { return false; }
  DI float score(float s, int key, float ax, int) const {
    bool valid = key <= tq && (tq - key) < 512;
    int d = posq - __float_as_int(ax);
    d = d < 0 ? 0 : (d > 799 ? 799 : d);
    return valid ? s * sc + lutr[d] : NEG;
  }
  static constexpr int FMODE = 0;
  static constexpr bool ALWAYS_FAST = false;
  DI bool fast(int) const { return false; }
  DI float fconst(int) const { return 0.f; }
  DI void hook(int, const f32x16&, int) const {}
};

#define XB_TMO      128
#define XB_XCNT(j)  (256  + 64 * (j))
#define XB_XSUB(j)  (1280 + 64 * (j))
#define XB_XGEN(j)  (2304 + 64 * (j))
#define XB_TOP      3328
#define XB_TOPGEN   3392
#define XCD_BAR_WORDS 3456
#define XB_SPIN_CAP (1u << 18)
#define LAS __attribute__((address_space(3)))

__device__ __forceinline__ unsigned xb_ld(unsigned* p)              { return __hip_atomic_load(p, __ATOMIC_RELAXED, __HIP_MEMORY_SCOPE_AGENT); }
__device__ __forceinline__ unsigned xb_add(unsigned* p, unsigned v) { return __hip_atomic_fetch_add(p, v, __ATOMIC_RELAXED, __HIP_MEMORY_SCOPE_AGENT); }
__device__ __forceinline__ unsigned xb_xcc_id() { return (unsigned)__builtin_amdgcn_s_getreg((3 << 11) | 20) & 0xFu; }
#define XB_SPIN(cond, bar) do { unsigned _sp = 0; while (cond) { __builtin_amdgcn_s_sleep(1); \
    if ((++_sp & 255u) == 0u) { if (xb_ld(&(bar)[XB_TMO])) break; if (_sp > XB_SPIN_CAP) { atomicAdd(&(bar)[XB_TMO], 1u); break; } } } } while (0)

struct XcdBarrier {
    unsigned* bar; unsigned x;
    volatile LAS unsigned* st;
};

__device__ __forceinline__ XcdBarrier xcd_barrier_post(unsigned* bar, volatile LAS unsigned* st) {
    XcdBarrier b; b.bar = bar; b.x = xb_xcc_id(); b.st = st;
    if (threadIdx.x == 0) (void)xb_add(&bar[XB_XCNT(b.x)], 1u);
    return b;
}
__device__ __forceinline__ void xcd_barrier_complete(unsigned* bar, unsigned x, unsigned& nloc, unsigned& nx) {
    const unsigned G = gridDim.x * gridDim.y * gridDim.z;
    unsigned sum, cnt, mine, sp = 0u;
    for (;;) {
        sum = 0u; cnt = 0u; mine = 0u;
#pragma unroll
        for (unsigned j = 0; j < 16; ++j) { const unsigned c = xb_ld(&bar[XB_XCNT(j)]); sum += c; cnt += (c > 0u) ? 1u : 0u; mine = (j == x) ? c : mine; }
        if (sum == G) break;
        __builtin_amdgcn_s_sleep(1);
        if ((++sp & 255u) == 0u) { if (xb_ld(&bar[XB_TMO])) break; if (sp > XB_SPIN_CAP) { atomicAdd(&bar[XB_TMO], 1u); break; } }
    }
    nloc = mine > 0u ? mine : 1u; nx = cnt > 0u ? cnt : 1u;
}

__device__ __forceinline__ void xcd_barrier(const XcdBarrier& b) {
    asm volatile("s_waitcnt vmcnt(0)" ::: "memory");
    __syncthreads();
    if (threadIdx.x == 0) {
        unsigned* bar = b.bar;
        __builtin_amdgcn_s_waitcnt(0);
        unsigned nloc = b.st[0], nx = b.st[1];
        if (nloc == 0u) { xcd_barrier_complete(bar, b.x, nloc, nx); b.st[0] = nloc; b.st[1] = nx; }
        const unsigned old = xb_add(&bar[XB_XSUB(b.x)], 1u);
        const unsigned gen = old / nloc;
        if (old + 1u == (gen + 1u) * nloc) {
            __builtin_amdgcn_fence(__ATOMIC_RELEASE, "agent");
            asm volatile("s_waitcnt vmcnt(0)" ::: "memory");
            const unsigned og = xb_add(&bar[XB_TOP], 1u);
            const unsigned tg = og / nx;
            if (og + 1u == (tg + 1u) * nx) xb_add(&bar[XB_TOPGEN], 1u);
            else XB_SPIN(xb_ld(&bar[XB_TOPGEN]) == tg, bar);
            __builtin_amdgcn_fence(__ATOMIC_ACQUIRE, "agent");
            xb_add(&bar[XB_XGEN(b.x)], 1u);
            asm volatile("s_waitcnt vmcnt(0)" ::: "memory");
        } else {
            XB_SPIN(xb_ld(&bar[XB_XGEN(b.x)]) == gen, bar);
            __builtin_amdgcn_fence(__ATOMIC_ACQUIRE, "agent");
            asm volatile("s_waitcnt vmcnt(0)" ::: "memory");
        }
    }
    __syncthreads();
}


__global__ void __launch_bounds__(256, LB2) mega(Params p, int ph_lo, int ph_hi) {
  __shared__ __attribute__((aligned(16))) char smem[SM_TOTAL];
  __shared__ int s_task;
  __shared__ uint4 xb_words;
  if (threadIdx.x == 0) xb_words = make_uint4(0u, 0u, 0u, 0u);
  __syncthreads();
  XcdBarrier xbar = xcd_barrier_post((unsigned*)(p.ws + WS_BAR), (volatile LAS unsigned*)&xb_words);
  const int bid = blockIdx.x, nb = gridDim.x;

  for (int ph = ph_lo; ph <= ph_hi; ++ph) {
    if (ph > ph_lo) {
      if (ph == ph_lo + 1) cg::this_grid().sync();
      else xcd_barrier(xbar);
    }
    const int nrep = (ph == REP_PH) ? 2 : 1;
    for (int rep = 0; rep < nrep; ++rep) {
    if (rep) cg::this_grid().sync();
    const int tid = otid(), lane = tid & 63, w = tid >> 6, r = lane & 31, h = lane >> 5;
    const int vb = (bid & 7) * (nb >> 3) + (bid >> 3);
    char* ws = p.ws + (tid - (int)threadIdx.x);
    bf16* XN = (bf16*)(ws + WS_XN);
    bf16* P = (bf16*)(ws + WS_P);
    bf16* MIXED = (bf16*)(ws + WS_MIXED);
    float* ROPEC = (float*)(ws + WS_ROPEC);
    float* ROPES = (float*)(ws + WS_ROPES);
    float* hbuf = p.out;
    int* CTR = (int*)(ws + WS_CTR);
    auto fetch_task = [&](int* ctr) {
      __syncthreads();
      if (tid == 0) s_task = atomicAdd(ctr, 1);
      __syncthreads();
      return s_task;
    };
    const int layer = ph == 0 ? 0 : (ph - 1) / 6;
    const int sub = ph == 0 ? -1 : (ph - 1) % 6;
    const bool even = (layer & 1) == 0;
    const int li = layer >> 1;
    const int NP = even ? NPE : NPO;

    if ((PHM & 1) && (ph == 0 || sub == 5)) {
      if (ph == 0) {
        if (bid == 0 && tid < 64) CTR[tid] = 0;
        if (bid == 1 % nb && tid < 128) {
          int mx = p.pos[tid * 64];
          for (int q = 1; q < 64; ++q) mx = max(mx, p.pos[tid * 64 + q]);
          ((int*)(ws + WS_POSMAX))[tid] = mx;
        }
        for (int i = bid * 256 + tid; i < L * 32; i += nb * 256) {
          int t = i >> 5, f = i & 31;
          float inv = powf(10000.f, -(float)f / 32.f);
          float ang = (float)p.pos[t] * inv;
          ROPEC[i] = cosf(ang);
          ROPES[i] = sinf(ang);
        }
        for (int row = bid * 4 + w; row < 256; row += nb * 4)
          norm_row_bf16(p.mem + (size_t)row * DM, p.mem_norm_g, (bf16*)(ws + WS_MEMN) + (size_t)row * DM, lane);
      }
      const int nl = ph == 0 ? 0 : layer + 1;
      if (nl < 4) {
        const float* src = ph == 0 ? p.x : hbuf;
        for (int row = bid * 4 + w; row < L; row += nb * 4)
          norm_row_bf16(src + (size_t)row * DM, p.norm_g + nl * DM, XN + (size_t)row * DM, lane);
      } else {
        for (int row = bid * 4 + w; row < L; row += nb * 4) norm_row_f32(hbuf + (size_t)row * DM, p.final_norm_g, lane);
      }
    }
    if ((PHM & 2) && (ph == 0 || sub == 4)) {
      const int nl = ph == 0 ? 0 : layer + 1;
      if (nl < 4) {
        const bool ne = (nl & 1) == 0;
        const int nli = nl >> 1;
        const int s0 = ne ? SET_IN_EVEN : SET_IN_ODD, s2 = ne ? SET_MISC_EVEN : SET_MISC_ODD;
        const int c0 = cvt_set_count(p, s0, nli), c1 = cvt_set_count(p, SET_MEM, nl), c2 = cvt_set_count(p, s2, nli);
        const int cx = ne ? 16 : 32;
        for (int t = bid; t < c0 + c1 + c2 + cx; t += nb) {
          if (t < c0) cvt_set_task(p, s0, nli, t, smem);
          else if (t < c0 + c1) cvt_set_task(p, SET_MEM, nl, t - c0, smem);
          else if (t < c0 + c1 + c2) cvt_set_task(p, s2, nli, t - c0 - c1, smem);
          else {
            int e = t - c0 - c1 - c2;
            if (ne) {
              float* S5P = (float*)(ws + WS_S5P);
              int gp = e * 256 + tid;
              int g = gp >> 6;
              float dt = expf(p.log_dt[nli * 64 + g]);
              float lr = p.lam_re[nli * 4096 + gp], lim = p.lam_im[nli * 4096 + gp];
              float mag = expf(lr * dt);
              float abr = mag * cosf(lim * dt), abi = mag * sinf(lim * dt);
              float den = lr * lr + lim * lim;
              float nr = abr - 1.f;
              float fre = (nr * lr + abi * lim) / den;
              float fim = (abi * lr - nr * lim) / den;
              S5P[gp] = abr;
              S5P[4096 + gp] = abi;
              float ar = abr, ai = abi;
#pragma unroll
              for (int q = 0; q < 7; ++q) { float nr2 = ar * ar - ai * ai; ai = 2.f * ar * ai; ar = nr2; }
              S5P[8192 + gp] = ar;
              S5P[12288 + gp] = ai;
              const float* br = p.b_re + (size_t)nli * 65536 + gp * 16;
              const float* bi = p.b_im + (size_t)nli * 65536 + gp * 16;
#pragma unroll
              for (int c = 0; c < 16; ++c) {
                S5P[16384 + gp * 16 + c] = fre * br[c] - fim * bi[c];
                S5P[16384 + 65536 + gp * 16 + c] = fre * bi[c] + fim * br[c];
              }
            } else {
              int which = e >> 4, part = e & 15;
              const float* pe = p.cmp_pe + (size_t)(nli * 2 + which) * 4096 + part * 256;
              const float* w1 = p.cmp_w1 + ((size_t)(nli * 2 + which) * 4096 + part * 256) * 256 + tid;
              float acc = 0.f;
#pragma unroll 8
              for (int k = 0; k < 256; ++k) acc += pe[k] * w1[(size_t)k * 256];
              ((float*)(ws + WS_CMPB))[(which * 16 + part) * 256 + tid] = acc;
            }
          }
        }
      }
    }
    if ((PHM & 4) && sub == 0) {
      const int ntn = (NP / 128 + 1) / 2;
      const int n_in = 64 * ntn;
      const bf16* Win = (const bf16*)(ws + WS_WIN);
      for (int t = vb; t < n_in + 16; t += nb) {
        if (t < n_in) {
          int tm, tn;
          tile_map(t, ntn, tm, tn);
          const int m0 = tm * 128;
          int n0 = tn * 256;
          const int nhalf = (n0 + 128 < NP) ? 2 : 1;
          ALin af{XN + (size_t)m0 * DM, DM};
          if (even) {
            gemm_tile2(af, Win + (size_t)n0 * DM, DM, DM, smem, n0, nhalf, [&](const float* Cs) {
              if (n0 >= 4096 && n0 < 5120) {
                bf16* VT = (bf16*)(ws + WS_VTFOX);
                epi_cols(Cs, [&](int col, int r8, const float* v) {
                  *(uint4*)(VT + (size_t)(n0 - 4096 + col) * L + m0 + r8) = pack8(v);
                });
              } else if (n0 == 7168) {
                float* FL = (float*)(ws + WS_FLOG);
                for (int i = tid; i < 128 * 8; i += 256) {
                  int row = i >> 3, c = i & 7;
                  FL[(size_t)(m0 + row) * 8 + c] = Cs[row * 132 + c];
                }
              } else {
                epi_rows(Cs, [&](int row, int cc, const float* v) {
                  *(uint4*)(P + (size_t)(m0 + row) * NPE + n0 + cc) = pack8(v);
                });
              }
            });
          } else {
            gemm_tile2(af, Win + (size_t)n0 * DM, DM, DM, smem, n0, nhalf, [&](const float* Cs) {
              if (n0 == 3840 || n0 == 3968 || n0 == 4352 || n0 == 4480) {
                bf16* VT = (n0 < 4096) ? (bf16*)(ws + WS_VTSLC) + (size_t)(n0 - 3840) * L
                                       : (bf16*)(ws + WS_VTWIN) + (size_t)(n0 - 4352) * L;
                epi_cols(Cs, [&](int col, int r8, const float* v) {
                  *(uint4*)(VT + (size_t)col * L + m0 + r8) = pack8(v);
                });
              } else if (n0 == 6656) {
                epi_rope(Cs, 0, m0, ROPEC, ROPES, 1.f, [&](int row, int cl, const float* v) {
                  *(uint4*)(P + (size_t)(m0 + row) * NPO + 6656 + cl) = pack8(v);
                });
                float* GT = (float*)(ws + WS_FLOG);
                for (int i = tid; i < 128 * 24; i += 256) {
                  int row = i / 24, c = i % 24;
                  GT[(size_t)(m0 + row) * 24 + c] = Cs[row * 132 + 64 + c];
                }
              } else {
                epi_rows(Cs, [&](int row, int cc, const float* v) {
                  *(uint4*)(P + (size_t)(m0 + row) * NPO + n0 + cc) = pack8(v);
                });
              }
            });
          }
        } else {
          const int t2 = t - n_in;
          const int m0 = (t2 >> 3) * 128, n0 = (t2 & 7) * 128;
          ALin af{(const bf16*)(ws + WS_MEMN) + (size_t)m0 * DM, DM};
          gemm_tile(af, (const bf16*)(ws + WS_WMEM) + (size_t)n0 * DM, DM, DM, smem, [&](const float* Cs) {
            if (n0 < 512) {
              bf16* MK = (bf16*)(ws + WS_MEMK);
              epi_rows(Cs, [&](int row, int cc, const float* v) {
                *(uint4*)(MK + (size_t)(m0 + row) * 512 + n0 + cc) = pack8(v);
              });
            } else {
              bf16* MV = (bf16*)(ws + WS_MEMVT);
              epi_cols(Cs, [&](int col, int r8, const float* v) {
                *(uint4*)(MV + (size_t)(n0 - 512 + col) * 256 + m0 + r8) = pack8(v);
              });
            }
          });
        }
      }
    }

    auto mem_attn_task = [&](int t) {
      const int qt = t >> 2, head = t & 3;
      const int tq = qt * 128 + w * 32 + r;
      const int qcol = even ? 6144 : 5632, gcol = even ? 6656 : 6144;
      bf16x8 qf[8];
      load_q<128>(qf, P + (size_t)tq * NP + qcol + head * 128, h);
      f32x16 o[4];
      zero_o(o);
      float m = NEG, l = 0.f;
      CtxMem ctx{0.08838834764831845f * LOG2E};
      attn_run<128, true, true>(qf, o, m, l, (const bf16*)(ws + WS_MEMK) + head * 128, 512, nullptr, 0,
                          (const bf16*)(ws + WS_MEMVT) + (size_t)head * 128 * 256, 256, 0, ctx, smem);
      float lt = l + __shfl_xor(l, 32);
      store_out_A(o, 1.f / lt, P + (size_t)tq * NP + gcol + head * 128, MIXED + (size_t)tq * MIXW + 2048 + head * 128, h);
    };

    if ((PHM & 8) && sub == 1 && even) {
      const int cw = cvt_set_count(p, SET_OUT, layer);
      const int n_s5 = 1024, n_cum = 64, n_mem = 256;
      for (int t = bid; t < n_mem + n_s5 + n_cum + cw; t += nb) {
        if (t < n_mem) {
          mem_attn_task(t);
        } else if (t < n_mem + n_s5) {
          const int t2 = t - n_mem;
          const int ch = t2 >> 4, gq = t2 & 15;
          float* us = (float*)smem;
          __syncthreads();
          for (int i = tid; i < 128 * 8; i += 256) {
            int tt = i >> 3, c8 = (i & 7) * 8;
            uint4 u = *(const uint4*)(P + (size_t)(ch * 128 + tt) * NPE + gq * 64 + c8);
            float* d = us + tt * 64 + c8;
            d[0] = bflo(u.x); d[1] = bfhi(u.x); d[2] = bflo(u.y); d[3] = bfhi(u.y);
            d[4] = bflo(u.z); d[5] = bfhi(u.z); d[6] = bflo(u.w); d[7] = bfhi(u.w);
          }
          __syncthreads();
          const float* S5P = (const float*)(ws + WS_S5P);
          const int gp = (gq * 4 + w) * 64 + lane;
          const float ar = S5P[gp], ai = S5P[4096 + gp];
          float bbr[16], bbi[16];
#pragma unroll
          for (int c = 0; c < 16; ++c) { bbr[c] = S5P[16384 + gp * 16 + c]; bbi[c] = S5P[16384 + 65536 + gp * 16 + c]; }
          float xr = 0.f, xi = 0.f;
          for (int tt = 0; tt < 128; ++tt) {
            const float* up = us + tt * 64 + w * 16;
            float bur = 0.f, bui = 0.f;
#pragma unroll
            for (int c = 0; c < 16; ++c) { float uv = up[c]; bur += bbr[c] * uv; bui += bbi[c] * uv; }
            float nxr = ar * xr - ai * xi + bur;
            float nxi = ar * xi + ai * xr + bui;
            xr = nxr; xi = nxi;
          }
          float2* E = (float2*)(ws + WS_S5E);
          E[(size_t)ch * 4096 + gp] = make_float2(xr, xi);
        } else if (t < n_mem + n_s5 + n_cum) {
          const int ch = t - n_mem - n_s5;
          const float* FL = (const float*)(ws + WS_FLOG);
          float* CUML = (float*)(ws + WS_CUML);
          float* CT = (float*)(ws + WS_CT);
#pragma unroll
          for (int hh = 0; hh < 2; ++hh) {
            const int head = w * 2 + hh;
            const float bf = p.fox_b_f[li * 8 + head];
            const int t0 = ch * 128 + lane * 2;
            float x0 = FL[(size_t)t0 * 8 + head] + bf, x1 = FL[(size_t)(t0 + 1) * 8 + head] + bf;
            float v0 = x0 >= 0.f ? -log1pf(expf(-x0)) : x0 - log1pf(expf(x0));
            float v1 = x1 >= 0.f ? -log1pf(expf(-x1)) : x1 - log1pf(expf(x1));
            float s = v0 + v1;
            float inc = s;
#pragma unroll
            for (int o = 1; o < 64; o <<= 1) {
              float n = __shfl_up(inc, o);
              if (lane >= o) inc += n;
            }
            float excl = inc - s;
            CUML[(size_t)head * L + t0] = excl + v0;
            CUML[(size_t)head * L + t0 + 1] = excl + v0 + v1;
            if (lane == 63) CT[head * 64 + ch] = inc;
          }
        } else {
          cvt_set_task(p, SET_OUT, layer, t - n_mem - n_s5 - n_cum, smem);
        }
      }
    }
    if ((PHM & 16) && sub == 2 && even) {
      const int n_fox = 512, n_s5 = 1024;
      for (;;) {
        const int t = fetch_task(CTR + ph);
        if (t >= n_fox + n_s5) break;
        if (t < n_fox) {
          const int qt = 63 - (t >> 3), head = t & 7;
          const int q0w = qt * 128 + w * 32, tq = q0w + r;
          float* cpre = (float*)(smem + AT_X0);
          __syncthreads();
          if (tid < 64) {
            const float* CT = (const float*)(ws + WS_CT) + head * 64;
            float acc = 0.f;
            for (int c = 0; c < tid; ++c) acc += CT[c];
            cpre[tid] = acc;
          }
          __syncthreads();
          const float* cuml = (const float*)(ws + WS_CUML) + (size_t)head * L;
          bf16x8 qf[8];
          load_q<128>(qf, P + (size_t)tq * NPE + 2048 + head * 128, h);
          f32x16 o[4];
          zero_o(o);
          float m = NEG, l = 0.f;
          CtxFox ctx{tq, q0w, 2 * qt + 1, 0.08838834764831845f * LOG2E, cuml, cpre};
          attn_run<128, true, true>(qf, o, m, l, P + 3072 + head * 128, NPE, nullptr, 0,
                              (const bf16*)(ws + WS_VTFOX) + (size_t)head * 128 * L, L, 0, ctx, smem);
          float lt = l + __shfl_xor(l, 32);
          store_out_A(o, 1.f / lt, P + (size_t)tq * NPE + 5120 + head * 128, MIXED + (size_t)tq * MIXW + 1024 + head * 128, h);
        } else {
          const int t2 = t - n_fox;
          const int ch = t2 >> 4, gq = t2 & 15;
          float* us = (float*)smem;
          float* xs = (float*)(smem + 32768) + w * 16 * 132;
          __syncthreads();
          for (int i = tid; i < 128 * 8; i += 256) {
            int tt = i >> 3, c8 = (i & 7) * 8;
            uint4 u = *(const uint4*)(P + (size_t)(ch * 128 + tt) * NPE + gq * 64 + c8);
            float* d = us + tt * 64 + c8;
            d[0] = bflo(u.x); d[1] = bfhi(u.x); d[2] = bflo(u.y); d[3] = bfhi(u.y);
            d[4] = bflo(u.z); d[5] = bfhi(u.z); d[6] = bflo(u.w); d[7] = bfhi(u.w);
          }
          __syncthreads();
          const float* S5P = (const float*)(ws + WS_S5P);
          const int g = gq * 4 + w;
          const int gp = g * 64 + lane;
          const float ar = S5P[gp], ai = S5P[4096 + gp];
          const float atr = S5P[8192 + gp], ati = S5P[12288 + gp];
          float xr = 0.f, xi = 0.f;
          {
            const float2* E = (const float2*)(ws + WS_S5E) + gp;
#define CSTEP(e) { float nxr = atr * xr - ati * xi + e.x; float nxi = atr * xi + ati * xr + e.y; xr = nxr; xi = nxi; }
            int c = 0;
            for (; c + 8 <= ch; c += 8) {
              float2 e0 = E[(size_t)(c + 0) * 4096], e1 = E[(size_t)(c + 1) * 4096], e2 = E[(size_t)(c + 2) * 4096],
                     e3 = E[(size_t)(c + 3) * 4096], e4 = E[(size_t)(c + 4) * 4096], e5 = E[(size_t)(c + 5) * 4096],
                     e6 = E[(size_t)(c + 6) * 4096], e7 = E[(size_t)(c + 7) * 4096];
              CSTEP(e0) CSTEP(e1) CSTEP(e2) CSTEP(e3) CSTEP(e4) CSTEP(e5) CSTEP(e6) CSTEP(e7)
            }
            for (; c < ch; ++c) {
              float2 e = E[(size_t)c * 4096];
              CSTEP(e)
            }
#undef CSTEP
          }
          float bbr[16], bbi[16];
#pragma unroll
          for (int c = 0; c < 16; ++c) { bbr[c] = S5P[16384 + gp * 16 + c]; bbi[c] = S5P[16384 + 65536 + gp * 16 + c]; }
          const int chn = lane & 15, kq = lane >> 4;
          float cb[32];
          {
            const float* cre = p.c_re + ((size_t)li * 64 + g) * 1024 + chn * 64;
            const float* cim = p.c_im + ((size_t)li * 64 + g) * 1024 + chn * 64;
#pragma unroll
            for (int ks = 0; ks < 16; ++ks) { cb[ks] = cre[4 * ks + kq]; cb[16 + ks] = -cim[4 * ks + kq]; }
          }
          const float dsk = p.s5_d[li * 1024 + g * 16 + chn];
          bf16* Z = (bf16*)(ws + WS_Z);
          for (int sc = 0; sc < 8; ++sc) {
#pragma unroll 4
            for (int tt = 0; tt < 16; ++tt) {
              const float* up = us + (sc * 16 + tt) * 64 + w * 16;
              float bur = 0.f, bui = 0.f;
#pragma unroll
              for (int c = 0; c < 16; ++c) { float uv = up[c]; bur += bbr[c] * uv; bui += bbi[c] * uv; }
              float nxr = ar * xr - ai * xi + bur;
              float nxi = ar * xi + ai * xr + bui;
              xr = nxr; xi = nxi;
              xs[tt * 132 + lane] = xr;
              xs[tt * 132 + 64 + lane] = xi;
            }
            __syncthreads();
            f32x4 y = {0.f, 0.f, 0.f, 0.f};
#pragma unroll
            for (int ks = 0; ks < 32; ++ks) {
              float a = xs[chn * 132 + 4 * ks + kq];
              y = __builtin_amdgcn_mfma_f32_16x16x4f32(a, cb[ks], y, 0, 0, 0);
            }
#pragma unroll
            for (int i = 0; i < 4; ++i) {
              int tt = 4 * kq + i;
              float uv = us[(sc * 16 + tt) * 64 + w * 16 + chn];
              float yy = y[i] + dsk * uv;
              Z[(size_t)(ch * 128 + sc * 16 + tt) * 1024 + g * 16 + chn] = f2bf(gelu_t(yy));
            }
            __syncthreads();
          }
        }
      }
    }
    if ((PHM & 32) && sub == 3 && even) {
      const bf16* Z = (const bf16*)(ws + WS_Z);
      for (int t = vb; t < 64 * 8; t += nb) {
        int tm, tn;
        tile_map(t, 8, tm, tn);
        const int m0 = tm * 128, n0 = tn * 128;
        ALin af{Z + (size_t)m0 * 1024, 1024};
        gemm_tile(af, (const bf16*)(ws + WS_WMISC + WM_GLU) + (size_t)n0 * 1024, 1024, 1024, smem, [&](const float* Cs) {
          epi_rows(Cs, [&](int row, int cc, const float* v) {
            uint4 zu = *(const uint4*)(Z + (size_t)(m0 + row) * 1024 + n0 + cc);
            uint4 gu = *(const uint4*)(P + (size_t)(m0 + row) * NPE + 1024 + n0 + cc);
            float zz[8] = {bflo(zu.x), bfhi(zu.x), bflo(zu.y), bfhi(zu.y), bflo(zu.z), bfhi(zu.z), bflo(zu.w), bfhi(zu.w)};
            float gg[8] = {bflo(gu.x), bfhi(gu.x), bflo(gu.y), bfhi(gu.y), bflo(gu.z), bfhi(gu.z), bflo(gu.w), bfhi(gu.w)};
            float o[8];
#pragma unroll
            for (int e = 0; e < 8; ++e) o[e] = zz[e] * sigm(v[e]) * silu(gg[e]);
            *(uint4*)(MIXED + (size_t)(m0 + row) * MIXW + n0 + cc) = pack8(o);
          });
        });
      }
    }
    if ((PHM & 64) && sub == 1 && !even) {
      const int cw = cvt_set_count(p, SET_OUT, layer);
      const int n_c1 = 32, n_q = 64 * 12, n_kv = 64 * 16, n_mem = 0;
      float* rsx = (float*)(smem + SM_EXTRA);
      for (int t = vb; t < n_c1 + n_q + n_kv + n_mem + cw; t += nb) {
        if (t < n_c1) {
          const int which = t >> 4, tm = (t >> 1) & 7, tn = t & 1;
          const int m0 = tm * 128, n0 = tn * 128;
          __syncthreads();
          if (tid < 128) {
            const float* CB = (const float*)(ws + WS_CMPB) + which * 16 * 256 + n0 + tid;
            float b = 0.f;
            for (int q = 0; q < 16; ++q) b += CB[q * 256];
            rsx[tid] = b;
          }
          ACmp af{P + (which ? 3328 : 3072), m0};
          bf16* HID = (bf16*)(ws + WS_HID) + (size_t)which * 1024 * 256;
          gemm_tile(af, (const bf16*)(ws + WS_WMISC + WM_W1) + (size_t)which * 256 * 4096 + (size_t)n0 * 4096, 4096, 4096,
                    smem, [&](const float* Cs) {
                      epi_rows(Cs, [&](int row, int cc, const float* v) {
                        float o[8];
#pragma unroll
                        for (int e = 0; e < 8; ++e) o[e] = gelu_t(v[e] + rsx[cc + e]);
                        *(uint4*)(HID + (size_t)(m0 + row) * 256 + n0 + cc) = pack8(o);
                      });
                    });
        } else if (t < n_c1 + n_q + n_kv) {
          const int t2 = t - n_c1;
          const bool isq = t2 < n_q;
          const int t3 = isq ? t2 : t2 - n_q;
          const int ntn = isq ? 12 : 16;
          int tm, tn;
          tile_map(t3, ntn, tm, tn);
          const int m0 = tm * 128, n0 = tn * 128;
          const bf16* Ab = P + (size_t)m0 * NPO + (isq ? 0 : 512);
          __syncthreads();
          for (int rr = 0; rr < 32; ++rr) {
            int row = w * 32 + rr;
            uint4 u = *(const uint4*)(Ab + (size_t)row * NPO + lane * 8);
            float a0 = bflo(u.x), a1 = bfhi(u.x), a2 = bflo(u.y), a3 = bfhi(u.y), a4 = bflo(u.z), a5 = bfhi(u.z),
                  a6 = bflo(u.w), a7 = bfhi(u.w);
            float ss = a0 * a0 + a1 * a1 + a2 * a2 + a3 * a3 + a4 * a4 + a5 * a5 + a6 * a6 + a7 * a7;
            ss = wave_sum(ss);
            if (lane == 0) rsx[row] = rsqrtf(ss * (1.f / 512.f) + EPS);
          }
          ALin af{Ab, NPO};
          if (isq) {
            bf16* QM = (bf16*)(ws + WS_QMLA);
            gemm_tile(af, (const bf16*)(ws + WS_WMISC + WM_UQ) + (size_t)n0 * 512, 512, 512, smem, [&](const float* Cs) {
              const int md = n0 % 192;
              const int ropehalf = md == 128 ? 0 : (md == 64 ? 1 : -1);
              epi_rows(Cs, [&](int row, int cc, const float* v) {
                if ((cc >> 6) == ropehalf) return;
                float o[8];
                float sc = rsx[row];
#pragma unroll
                for (int e = 0; e < 8; ++e) o[e] = v[e] * sc;
                *(uint4*)(QM + (size_t)(m0 + row) * 1536 + n0 + cc) = pack8(o);
              });
              if (ropehalf >= 0) {
                epi_rope(Cs, ropehalf * 64, m0, ROPEC, ROPES, 1.f, [&](int row, int cl, const float* v) {
                  float o[8];
                  float sc = rsx[row];
#pragma unroll
                  for (int e = 0; e < 8; ++e) o[e] = v[e] * sc;
                  *(uint4*)(QM + (size_t)(m0 + row) * 1536 + n0 + ropehalf * 64 + cl) = pack8(o);
                });
              }
            });
          } else {
            gemm_tile(af, (const bf16*)(ws + WS_WMISC + WM_UKV) + (size_t)n0 * 512, 512, 512, smem, [&](const float* Cs) {
              const int head = n0 >> 8, part = (n0 >> 7) & 1;
              if (part == 0) {
                bf16* KM = (bf16*)(ws + WS_KMLA);
                epi_rows(Cs, [&](int row, int cc, const float* v) {
                  float o[8];
                  float sc = rsx[row];
#pragma unroll
                  for (int e = 0; e < 8; ++e) o[e] = v[e] * sc;
                  *(uint4*)(KM + (size_t)(m0 + row) * 1024 + head * 128 + cc) = pack8(o);
                });
              } else {
                bf16* VT = (bf16*)(ws + WS_VTMLA);
                epi_cols(Cs, [&](int col, int r8, const float* v) {
                  float o[8];
#pragma unroll
                  for (int e = 0; e < 8; ++e) o[e] = v[e] * rsx[r8 + e];
                  *(uint4*)(VT + (size_t)(head * 128 + col) * L + m0 + r8) = pack8(o);
                });
              }
            });
          }
        } else if (t < n_c1 + n_q + n_kv + n_mem) {
          mem_attn_task(t - n_c1 - n_q - n_kv);
        } else {
          cvt_set_task(p, SET_OUT, layer, t - n_c1 - n_q - n_kv - n_mem, smem);
        }
      }
    }
    if ((PHM & 128) && sub == 2 && !even) {
      const int n_c2 = 16, n_mem2 = 256;
      for (int t = bid; t < n_c2 + n_mem2; t += nb) {
        if (t >= n_c2) {
          mem_attn_task(t - n_c2);
        } else {
          const int t2 = t;
          const int which = t2 >> 3, m0 = (t2 & 7) * 128;
          ALin af{(const bf16*)(ws + WS_HID) + (size_t)which * 1024 * 256 + (size_t)m0 * 256, 256};
          gemm_tile(af, (const bf16*)(ws + WS_WMISC + WM_W2) + (size_t)which * 128 * 256, 256, 256, smem, [&](const float* Cs) {
            if (which == 0) {
              bf16* KC = (bf16*)(ws + WS_KC);
              epi_rows(Cs, [&](int row, int cc, const float* v) {
                int gr = m0 + row;
                int n = gr >> 1, g = gr & 1;
                *(uint4*)(KC + ((size_t)g * 512 + n) * 128 + cc) = pack8(v);
              });
            } else {
              bf16* VC = (bf16*)(ws + WS_VCT);
              for (int i = tid; i < 128 * 128; i += 256) {
                int row = i & 127, col = i >> 7;
                int gr = m0 + row;
                int n = gr >> 1, g = gr & 1;
                VC[((size_t)g * 128 + col) * 512 + n] = f2bf(Cs[row * 132 + col]);
              }
            }
          });
        }
      }
    }
    if ((PHM & 256) && sub == 3 && !even) {
      const int* pos = p.pos;
      float* lut = (float*)(smem + AT_X0);
      float* imp = (float*)(smem + AT_IMP);
      unsigned* sel = (unsigned*)(smem + AT_SEL);
      const float* GT = (const float*)(ws + WS_FLOG);
      float* NSAO = (float*)(ws + WS_NSAO);
      for (;;) {
        const int tt_ = fetch_task(CTR + ph);
        if (tt_ >= 1024) break;
        const int t = tt_ >> 1;
        const int tid = otid(), lane = tid & 63, w = tid >> 6, r = lane & 31, h = lane >> 5;
        if ((tt_ & 1) == 0) {
          const int qt = 63 - (t >> 3), head = t & 7;
          const int q0w = qt * 128 + w * 32, tq = q0w + r;
          bf16x8 qf[12];
          load_q<192>(qf, (const bf16*)(ws + WS_QMLA) + (size_t)tq * 1536 + head * 192, h);
          f32x16 o[4];
          zero_o(o);
          float m = NEG, l = 0.f;
          CtxCausal ctx{tq, q0w, 2 * qt + 1, 0.07216878364870322f * LOG2E};
          attn_run<192, true, true>(qf, o, m, l, (const bf16*)(ws + WS_KMLA) + head * 128, 1024, P + 6656, NPO,
                              (const bf16*)(ws + WS_VTMLA) + (size_t)head * 128 * L, L, 0, ctx, smem);
          float lt = l + __shfl_xor(l, 32);
          store_out_A(o, 1.f / lt, P + (size_t)tq * NPO + 1024 + head * 128, MIXED + (size_t)tq * MIXW + head * 128, h);
          continue;
        }
        const int qt = 255 - (t >> 1), g = t & 1;
        const int q0 = qt * 32;
        const int hr = r >> 3, qi = r & 7;
        const int ql = w * 8 + qi;
        const int tq = q0 + ql;
        const int head = g * 4 + hr;
        const int posq = pos[tq];
        __syncthreads();
        for (int i = tid; i < 4 * 800; i += 256) {
          int rr = i / 800, n = i % 800;
          int b;
          if (n < 16) b = n;
          else {
            float lr = logf((float)n / 16.f) / 4.1588830833596715f;
            b = 16 + (int)(lr * 16.f);
            if (b > 31) b = 31;
          }
          lut[i] = p.t5[b * 8 + g * 4 + rr] * LOG2E;
        }
        for (int i = tid; i < 32 * 132; i += 256) imp[i] = 0.f;
        __syncthreads();
        const float* lutr = lut + hr * 800;
        bf16x8 qf[8];
        load_q<128>(qf, P + (size_t)tq * NPO + 2048 + head * 128, h);
        const float sc = 0.08838834764831845f * LOG2E;
        f32x16 o[4];
        float* orow = NSAO + (size_t)tq * 1024 + head * 128;

        const int ncv = min(q0 / 16 + 1, 511);
        const int last_c = (ncv - 1) >> 6;
        float m = NEG, l = 0.f;
        CtxCmp cc{tq, posq, last_c, sc, lutr, pos, 0.f, imp, ql, false};
        zero_o(o);
        const bf16* KCg = (const bf16*)(ws + WS_KC) + (size_t)g * 512 * 128;
        const bf16* VCg = (const bf16*)(ws + WS_VCT) + (size_t)g * 128 * 512;
        attn_run<128, false, false>(qf, o, m, l, KCg, 128, nullptr, 0, VCg, 512, 0, cc, smem);
        float lt = l + __shfl_xor(l, 32);
        const bool has_c = m > -1e29f;
        float m2 = has_c ? m : 0.f;
        float invl = has_c ? 1.f / lt : 0.f;
        cc.invl = invl; cc.p2 = true;
        float l2 = 0.f;
        attn_run<128, true, false>(qf, o, m2, l2, KCg, 128, nullptr, 0, VCg, 512, 0, cc, smem);
        {
          float gs = sigm(GT[(size_t)tq * 24 + head * 3 + 0]) * invl;
#pragma unroll
          for (int d = 0; d < 4; ++d)
#pragma unroll
            for (int i4 = 0; i4 < 4; ++i4) {
              int dv0 = d * 32 + 8 * i4 + 4 * h;
              float4 v = make_float4(o[d][4 * i4] * gs, o[d][4 * i4 + 1] * gs, o[d][4 * i4 + 2] * gs, o[d][4 * i4 + 3] * gs);
              *(float4*)(orow + dv0) = v;
            }
        }
        __syncthreads();
        for (int q8 = 0; q8 < 8; ++q8) {
          const int qq = w * 8 + q8;
          const int tt = q0 + qq;
          const int cur = tt >> 6;
          const float* ip = imp + qq * 132;
          const int j0 = lane, j1 = lane + 64;
          const bool v0 = j0 <= cur, v1 = j1 <= cur;
          const bool f0 = (j0 == 0) || (j0 == cur) || (j0 == cur - 1);
          const bool f1 = (j1 == cur) || (j1 == cur - 1);
          const int nforced = cur == 0 ? 1 : (cur == 1 ? 2 : 3);
          const int nfree = 16 - nforced;
          const float a0 = ip[j0], a1 = ip[j1];
          int r0 = 0, r1 = 0;
          for (int jj = 0; jj <= cur; ++jj) {
            bool fj = (jj == 0) || (jj == cur) || (jj == cur - 1);
            if (fj) continue;
            float vj = ip[jj];
            r0 += (vj > a0 || (vj == a0 && jj < j0)) ? 1 : 0;
            r1 += (vj > a1 || (vj == a1 && jj < j1)) ? 1 : 0;
          }
          bool s0 = v0 && (f0 || r0 < nfree);
          bool s1 = v1 && (f1 || r1 < nfree);
          unsigned long long b0 = __ballot(s0), b1 = __ballot(s1);
          if (lane == 0) {
            sel[qq * 4 + 0] = (unsigned)b0; sel[qq * 4 + 1] = (unsigned)(b0 >> 32);
            sel[qq * 4 + 2] = (unsigned)b1; sel[qq * 4 + 3] = (unsigned)(b1 >> 32);
          }
        }
        __syncthreads();
        unsigned un0, un1, un2, un3;
        {
          un0 = sel[r * 4 + 0]; un1 = sel[r * 4 + 1]; un2 = sel[r * 4 + 2]; un3 = sel[r * 4 + 3];
#pragma unroll
          for (int of = 1; of < 32; of <<= 1) {
            un0 |= __shfl_xor(un0, of); un1 |= __shfl_xor(un1, of); un2 |= __shfl_xor(un2, of); un3 |= __shfl_xor(un3, of);
          }
          un0 = __builtin_amdgcn_readfirstlane(un0); un1 = __builtin_amdgcn_readfirstlane(un1);
          un2 = __builtin_amdgcn_readfirstlane(un2); un3 = __builtin_amdgcn_readfirstlane(un3);
        }
        {
          const unsigned long long ulo = (unsigned long long)un0 | ((unsigned long long)un1 << 32);
          const unsigned long long uhi = (unsigned long long)un2 | ((unsigned long long)un3 << 32);
          const unsigned long long mlo = (unsigned long long)sel[ql * 4] | ((unsigned long long)sel[ql * 4 + 1] << 32);
          const unsigned long long mhi = (unsigned long long)sel[ql * 4 + 2] | ((unsigned long long)sel[ql * 4 + 3] << 32);
          int pqmin = pos[q0];
          for (int q = 1; q < 32; ++q) pqmin = min(pqmin, pos[q0 + q]);
          const int* posmax = (const int*)(ws + WS_POSMAX);
          zero_o(o);
          m = NEG; l = 0.f;
          {
            CtxSlc cs{tq, posq, sc, lutr, pos, ulo, uhi, mlo, mhi, posmax, pqmin, q0};
            attn_run<128, true, false>(qf, o, m, l, P + 3584 + g * 128, NPO, nullptr, 0,
                                       (const bf16*)(ws + WS_VTSLC) + (size_t)g * 128 * L, L, cs.next(-1), cs, smem);
          }
          {
            CtxSlcFar cf{sc, lutr[799], ulo, uhi, mlo, mhi, posmax, pqmin, q0};
            attn_run<128, true, false>(qf, o, m, l, P + 3584 + g * 128, NPO, nullptr, 0,
                                       (const bf16*)(ws + WS_VTSLC) + (size_t)g * 128 * L, L, cf.next(-1), cf, smem);
          }
          lt = l + __shfl_xor(l, 32);
          float gs = sigm(GT[(size_t)tq * 24 + head * 3 + 1]) / lt;
#pragma unroll
          for (int d = 0; d < 4; ++d)
#pragma unroll
            for (int i4 = 0; i4 < 4; ++i4) {
              int dv0 = d * 32 + 8 * i4 + 4 * h;
              float4 v = *(float4*)(orow + dv0);
              v.x += o[d][4 * i4] * gs; v.y += o[d][4 * i4 + 1] * gs; v.z += o[d][4 * i4 + 2] * gs; v.w += o[d][4 * i4 + 3] * gs;
              *(float4*)(orow + dv0) = v;
            }
        }
        {
          const int kfirst = q0 - 511 > 0 ? (q0 - 511) >> 6 : 0;
          CtxWin cwn{tq, posq, (q0 + 31) >> 6, sc, lutr, pos};
          zero_o(o);
          m = NEG; l = 0.f;
          attn_run<128, true, false>(qf, o, m, l, P + 4096 + g * 128, NPO, nullptr, 0,
                              (const bf16*)(ws + WS_VTWIN) + (size_t)g * 128 * L, L, kfirst, cwn, smem);
          lt = l + __shfl_xor(l, 32);
          float gs = sigm(GT[(size_t)tq * 24 + head * 3 + 2]) / lt;
          const bf16* grow = P + (size_t)tq * NPO + 4608 + head * 128;
          bf16* mrow = MIXED + (size_t)tq * MIXW + 1024 + head * 128;
#pragma unroll
          for (int d = 0; d < 4; ++d)
#pragma unroll
            for (int i4 = 0; i4 < 4; ++i4) {
              int dv0 = d * 32 + 8 * i4 + 4 * h;
              float4 v = *(float4*)(orow + dv0);
              v.x += o[d][4 * i4] * gs; v.y += o[d][4 * i4 + 1] * gs; v.z += o[d][4 * i4 + 2] * gs; v.w += o[d][4 * i4 + 3] * gs;
              uint2 gu = *(const uint2*)(grow + dv0);
              uint2 ou;
              ou.x = pack2(v.x * silu(bflo(gu.x)), v.y * silu(bfhi(gu.x)));
              ou.y = pack2(v.z * silu(bflo(gu.y)), v.w * silu(bfhi(gu.y)));
              *(uint2*)(mrow + dv0) = ou;
            }
        }
      }
    }
    if ((PHM & 512) && sub == 4) {
      const float* hin = layer == 0 ? p.x : hbuf;
      for (int t = vb; t < 64 * 8; t += nb) {
        int tm, tn;
        tile_map(t, 8, tm, tn);
        const int m0 = tm * 128;
        int n0 = tn * 256;
        ALin af{MIXED + (size_t)m0 * MIXW, MIXW};
        gemm_tile2(af, (const bf16*)(ws + WS_WOUT) + (size_t)n0 * MIXW, MIXW, MIXW, smem, n0, 2, [&](const float* Cs) {
          const int tid2 = otid();
#pragma unroll
          for (int j = 0; j < 16; ++j) {
            int c = tid2 + 256 * j;
            int row = c >> 5, cc = (c & 31) * 4;
            float4 a = *(const float4*)(Cs + row * 132 + cc);
            float4 hv = *(const float4*)(hin + (size_t)(m0 + row) * DM + n0 + cc);
            hv.x += a.x; hv.y += a.y; hv.z += a.z; hv.w += a.w;
            *(float4*)(hbuf + (size_t)(m0 + row) * DM + n0 + cc) = hv;
          }
        });
      }
    }
    }
  }
}

extern "C" void kernel_launch(void* const* d_in, const int* in_sizes, int n_in, void* d_out, int out_size, void* d_ws,
                              size_t ws_size, hipStream_t stream) {
  Params p{};
  p.x = (const float*)d_in[0]; p.mem = (const float*)d_in[1]; p.pos = (const int*)d_in[2];
  p.norm_g = (const float*)d_in[3]; p.mem_norm_g = (const float*)d_in[4]; p.final_norm_g = (const float*)d_in[5];
  p.t5 = (const float*)d_in[6]; p.w_out = (const float*)d_in[7]; p.mem_w_kv = (const float*)d_in[8];
  p.even_w_in = (const float*)d_in[9]; p.lam_re = (const float*)d_in[10]; p.lam_im = (const float*)d_in[11];
  p.log_dt = (const float*)d_in[12]; p.b_re = (const float*)d_in[13]; p.b_im = (const float*)d_in[14];
  p.c_re = (const float*)d_in[15]; p.c_im = (const float*)d_in[16]; p.s5_d = (const float*)d_in[17];
  p.w_glu = (const float*)d_in[18]; p.fox_b_f = (const float*)d_in[19]; p.odd_w_in = (const float*)d_in[20];
  p.g_cq = (const float*)d_in[21]; p.g_ckv = (const float*)d_in[22]; p.w_uq = (const float*)d_in[23];
  p.w_ukv = (const float*)d_in[24]; p.cmp_pe = (const float*)d_in[25]; p.cmp_w1 = (const float*)d_in[26];
  p.cmp_w2 = (const float*)d_in[27];
  p.out = (float*)d_out; p.ws = (char*)d_ws;
  if (ws_size < WS_END) fprintf(stderr, "workspace too small: %zu < %zu\n", ws_size, (size_t)WS_END);
  static int grid_blocks = 0;
  if (!grid_blocks) {
    int dev = 0, cus = 0, per_cu = 0;
    hipGetDevice(&dev);
    hipDeviceGetAttribute(&cus, hipDeviceAttributeMultiprocessorCount, dev);
    hipOccupancyMaxActiveBlocksPerMultiprocessor(&per_cu, mega, 256, 0);
    if (per_cu > 2) per_cu = 2;
    if (per_cu < 1) per_cu = 1;
    grid_blocks = cus * per_cu;
  }
  (void)hipMemsetAsync((char*)d_ws + WS_BAR, 0, XCD_BAR_WORDS * sizeof(unsigned), stream);
#if MULTI_LAUNCH
  for (int ph = 0; ph <= 24; ++ph) {
    int lo = ph, hi = ph;
    void* args[] = {&p, &lo, &hi};
    hipLaunchCooperativeKernel((void*)mega, dim3(grid_blocks), dim3(256), args, 0, stream);
  }
#else
  int lo = 0, hi = 24;
  void* args[] = {&p, &lo, &hi};
  hipError_t e = hipLaunchCooperativeKernel((void*)mega, dim3(grid_blocks), dim3(256), args, 0, stream);
  if (e != hipSuccess) fprintf(stderr, "cooperative launch failed: %s (grid %d)\n", hipGetErrorString(e), grid_blocks);
#endif
}
```

```cpp
#include <hip/hip_runtime.h>
#include <hip/hip_cooperative_groups.h>
#include <cstdio>
#include <cstdint>
namespace cg = cooperative_groups;

typedef unsigned short bf16;
typedef short bf16x8 __attribute__((ext_vector_type(8)));
typedef float f32x16 __attribute__((ext_vector_type(16)));
typedef float f32x4 __attribute__((ext_vector_type(4)));
typedef __bf16 bf2v __attribute__((ext_vector_type(2)));
typedef float f2v __attribute__((ext_vector_type(2)));

#define DI __device__ __forceinline__
#define MFMA32(a, b, c) __builtin_amdgcn_mfma_f32_32x32x16_bf16((a), (b), (c), 0, 0, 0)

#ifndef LB2
#define LB2 2
#endif
#ifndef REP_PH
#define REP_PH -1
#endif
#ifndef PHM
#define PHM 1023
#endif
#ifndef MULTI_LAUNCH
#define MULTI_LAUNCH 0
#endif

constexpr int L = 8192;
constexpr int DM = 2048;
constexpr int NPE = 7296;
constexpr int NPO = 6784;
constexpr int EVEN_IN = 7176;
constexpr int ODD_IN = 6744;
constexpr int MIXW = 2560;
constexpr float LOG2E = 1.4426950408889634f;
constexpr float NEG = -1e30f;
constexpr float EPS = 1e-6f;

constexpr size_t MB = 1024 * 1024;
constexpr size_t WS_WIN = 0;
constexpr size_t WS_WOUT = WS_WIN + 30 * MB;
constexpr size_t WS_WMEM = WS_WOUT + 10 * MB;
constexpr size_t WS_WMISC = WS_WMEM + 4 * MB;
constexpr size_t WS_XN = WS_WMISC + 10 * MB;
constexpr size_t WS_MEMN = WS_XN + 32 * MB;
constexpr size_t WS_P = WS_MEMN + 1 * MB;
constexpr size_t WS_MIXED = WS_P + 114 * MB;
constexpr size_t WS_MEMK = WS_MIXED + 40 * MB;
constexpr size_t WS_MEMVT = WS_MEMK + 256 * 1024;
constexpr size_t WS_ROPEC = WS_MEMVT + 256 * 1024;
constexpr size_t WS_ROPES = WS_ROPEC + 1 * MB;
constexpr size_t WS_FLOG = WS_ROPES + 1 * MB;
constexpr size_t WS_CUML = WS_FLOG + 1 * MB;
constexpr size_t WS_CT = WS_CUML + 256 * 1024;
constexpr size_t WS_S5P = WS_CT + 4096;
constexpr size_t WS_S5E = WS_S5P + 1 * MB;
constexpr size_t WS_CMPB = WS_S5E + 2 * MB;
constexpr size_t WS_CTR = WS_CMPB + 64 * 1024;
constexpr size_t WS_BAR = WS_CTR + 4096;
constexpr size_t WS_POSMAX = WS_BAR + 16384;
constexpr size_t WS_VAR = WS_POSMAX + 4096;
constexpr size_t WS_Z = WS_VAR;
constexpr size_t WS_VTFOX = WS_Z + 16 * MB;
constexpr size_t WS_QMLA = WS_VAR;
constexpr size_t WS_KMLA = WS_QMLA + 24 * MB;
constexpr size_t WS_VTMLA = WS_KMLA + 16 * MB;
constexpr size_t WS_VTSLC = WS_VTMLA + 16 * MB;
constexpr size_t WS_VTWIN = WS_VTSLC + 4 * MB;
constexpr size_t WS_HID = WS_VTWIN + 4 * MB;
constexpr size_t WS_KC = WS_HID + 1 * MB;
constexpr size_t WS_VCT = WS_KC + 256 * 1024;
constexpr size_t WS_NSAO = WS_VCT + 256 * 1024;
constexpr size_t WS_END = WS_NSAO + 32 * MB;
constexpr size_t WM_GLU = 0;
constexpr size_t WM_UQ = 2 * MB;
constexpr size_t WM_UKV = WM_UQ + 1536 * 512 * 2;
constexpr size_t WM_W1 = WM_UKV + 2048 * 512 * 2;
constexpr size_t WM_W2 = WM_W1 + 2 * 256 * 4096 * 2;

constexpr int SM_EXTRA = 73728;
constexpr int SM_TOTAL = 73728 + 1024;

struct Params {
  const float *x, *mem;
  const int* pos;
  const float *norm_g, *mem_norm_g, *final_norm_g, *t5, *w_out, *mem_w_kv, *even_w_in, *lam_re, *lam_im, *log_dt,
      *b_re, *b_im, *c_re, *c_im, *s5_d, *w_glu, *fox_b_f, *odd_w_in, *g_cq, *g_ckv, *w_uq, *w_ukv, *cmp_pe,
      *cmp_w1, *cmp_w2;
  float* out;
  char* ws;
};

DI unsigned pack2(float a, float b) {
  f2v v = {a, b};
  bf2v r = __builtin_convertvector(v, bf2v);
  return __builtin_bit_cast(unsigned, r);
}
DI float bflo(unsigned u) { return __uint_as_float(u << 16); }
DI float bfhi(unsigned u) { return __uint_as_float(u & 0xffff0000u); }
DI float bf2f(bf16 v) { return __uint_as_float(((unsigned)v) << 16); }
DI bf16 f2bf(float f) { return (bf16)(pack2(f, 0.f) & 0xffffu); }
DI int otid() { int z; asm volatile("s_mov_b32 %0, 0" : "=s"(z)); return (int)threadIdx.x + z; }
DI int crow(int i, int h) { return (i & 3) + 8 * (i >> 2) + 4 * h; }
DI float sigm(float x) { return 1.f / (1.f + __expf(-x)); }
DI float silu(float x) { return x * sigm(x); }
DI float gelu_t(float x) {
  float u = 0.7978845608028654f * (x + 0.044715f * x * x * x);
  float e = __expf(2.f * u);
  float t = 1.f - 2.f / (e + 1.f);
  return 0.5f * x * (1.f + t);
}
DI float ex2(float x) { return __builtin_amdgcn_exp2f(x); }
DI float wave_sum(float v) {
#pragma unroll
  for (int o = 32; o > 0; o >>= 1) v += __shfl_xor(v, o);
  return v;
}
DI uint4 pack8(const float* v) {
  uint4 u;
  u.x = pack2(v[0], v[1]); u.y = pack2(v[2], v[3]); u.z = pack2(v[4], v[5]); u.w = pack2(v[6], v[7]);
  return u;
}

struct CvtSeg {
  const float* src; int lds; int sc0; bf16* dst; int dr0; int ncols; int npad; int K; const float* kscale;
};
DI int cvt_count(const CvtSeg& s) { return (s.K >> 6) * (s.npad >> 6); }
DI void cvt_tile(const CvtSeg& s, int tile, char* smem) {
  float* T = (float*)smem;
  const int tid = otid();
  const int nkt = s.K >> 6;
  const int kt = tile % nkt, nt = tile / nkt;
  const int k0 = kt * 64, n0 = nt * 64;
  __syncthreads();
#pragma unroll
  for (int i = 0; i < 4; ++i) {
    const int k = i * 16 + (tid >> 4), n4 = (tid & 15) * 4;
    float4 v = make_float4(0.f, 0.f, 0.f, 0.f);
    if (n0 + n4 < s.ncols) {
      v = *(const float4*)(s.src + (size_t)(k0 + k) * s.lds + s.sc0 + n0 + n4);
      if (s.kscale) { float sc = s.kscale[k0 + k]; v.x *= sc; v.y *= sc; v.z *= sc; v.w *= sc; }
    }
    float* d = T + k * 65 + n4;
    d[0] = v.x; d[1] = v.y; d[2] = v.z; d[3] = v.w;
  }
  __syncthreads();
#pragma unroll
  for (int j = 0; j < 2; ++j) {
    int c = tid + 256 * j;
    int n = c >> 3, kc = (c & 7) * 8;
    float v[8];
#pragma unroll
    for (int e = 0; e < 8; ++e) v[e] = T[(kc + e) * 65 + n];
    *(uint4*)(s.dst + (size_t)(s.dr0 + n0 + n) * s.K + k0 + kc) = pack8(v);
  }
}

enum { SET_IN_EVEN = 0, SET_IN_ODD, SET_OUT, SET_MEM, SET_MISC_EVEN, SET_MISC_ODD };
DI int cvt_nseg(int set) {
  switch (set) {
    case SET_IN_EVEN: return 3;
    case SET_IN_ODD: return 5;
    case SET_OUT: return 1;
    case SET_MEM: return 1;
    case SET_MISC_EVEN: return 1;
    default: return 6;
  }
}
DI CvtSeg cvt_get(const Params& p, int set, int li, int s) {
  CvtSeg r;
  r.kscale = nullptr;
  char* ws = p.ws;
  if (set == SET_IN_EVEN) {
    r.src = p.even_w_in + (size_t)li * DM * EVEN_IN; r.lds = EVEN_IN; r.K = DM; r.dst = (bf16*)(ws + WS_WIN);
    if (s == 0) { r.sc0 = 0; r.dr0 = 0; r.ncols = 5120; r.npad = 5120; }
    else if (s == 1) { r.sc0 = 5128; r.dr0 = 5120; r.ncols = 2048; r.npad = 2048; }
    else { r.sc0 = 5120; r.dr0 = 7168; r.ncols = 8; r.npad = 128; }
  } else if (set == SET_IN_ODD) {
    r.src = p.odd_w_in + (size_t)li * DM * ODD_IN; r.lds = ODD_IN; r.K = DM; r.dst = (bf16*)(ws + WS_WIN);
    if (s == 0) { r.sc0 = 0; r.dr0 = 0; r.ncols = 1024; r.npad = 1024; }
    else if (s == 1) { r.sc0 = 1088; r.dr0 = 1024; r.ncols = 3584; r.npad = 3584; }
    else if (s == 2) { r.sc0 = 4696; r.dr0 = 4608; r.ncols = 2048; r.npad = 2048; }
    else if (s == 3) { r.sc0 = 1024; r.dr0 = 6656; r.ncols = 64; r.npad = 64; }
    else { r.sc0 = 4672; r.dr0 = 6720; r.ncols = 24; r.npad = 64; }
  } else if (set == SET_OUT) {
    r.src = p.w_out + (size_t)li * MIXW * DM; r.lds = DM; r.K = MIXW; r.dst = (bf16*)(ws + WS_WOUT);
    r.sc0 = 0; r.dr0 = 0; r.ncols = DM; r.npad = DM;
  } else if (set == SET_MEM) {
    r.src = p.mem_w_kv + (size_t)li * DM * 1024; r.lds = 1024; r.K = DM; r.dst = (bf16*)(ws + WS_WMEM);
    r.sc0 = 0; r.dr0 = 0; r.ncols = 1024; r.npad = 1024;
  } else if (set == SET_MISC_EVEN) {
    r.src = p.w_glu + (size_t)li * 1024 * 1024; r.lds = 1024; r.K = 1024; r.dst = (bf16*)(ws + WS_WMISC + WM_GLU);
    r.sc0 = 0; r.dr0 = 0; r.ncols = 1024; r.npad = 1024;
  } else {
    r.sc0 = 0; r.dr0 = 0;
    if (s == 0) {
      r.src = p.w_uq + (size_t)li * 512 * 1536; r.lds = 1536; r.K = 512; r.dst = (bf16*)(ws + WS_WMISC + WM_UQ);
      r.ncols = 1536; r.npad = 1536; r.kscale = p.g_cq + li * 512;
    } else if (s == 1) {
      r.src = p.w_ukv + (size_t)li * 512 * 2048; r.lds = 2048; r.K = 512; r.dst = (bf16*)(ws + WS_WMISC + WM_UKV);
      r.ncols = 2048; r.npad = 2048; r.kscale = p.g_ckv + li * 512;
    } else if (s < 4) {
      int which = s - 2;
      r.src = p.cmp_w1 + (size_t)(li * 2 + which) * 4096 * 256; r.lds = 256; r.K = 4096;
      r.dst = (bf16*)(ws + WS_WMISC + WM_W1) + (size_t)which * 256 * 4096; r.ncols = 256; r.npad = 256;
    } else {
      int which = s - 4;
      r.src = p.cmp_w2 + (size_t)(li * 2 + which) * 256 * 128; r.lds = 128; r.K = 256;
      r.dst = (bf16*)(ws + WS_WMISC + WM_W2) + (size_t)which * 128 * 256; r.ncols = 128; r.npad = 128;
    }
  }
  return r;
}
DI int cvt_set_count(const Params& p, int set, int li) {
  int n = 0;
  for (int s = 0; s < cvt_nseg(set); ++s) n += cvt_count(cvt_get(p, set, li, s));
  return n;
}
DI void cvt_set_task(const Params& p, int set, int li, int t, char* smem) {
  const int ns = cvt_nseg(set);
  for (int s = 0; s < ns; ++s) {
    CvtSeg sg = cvt_get(p, set, li, s);
    int c = cvt_count(sg);
    if (t < c) { cvt_tile(sg, t, smem); return; }
    t -= c;
  }
}

DI void norm_row_bf16(const float* __restrict__ src, const float* __restrict__ g, bf16* __restrict__ dst, int lane) {
  float4 v[8];
  float ss = 0.f;
#pragma unroll
  for (int i = 0; i < 8; ++i) {
    v[i] = *(const float4*)(src + (i * 64 + lane) * 4);
    ss += v[i].x * v[i].x + v[i].y * v[i].y + v[i].z * v[i].z + v[i].w * v[i].w;
  }
  ss = wave_sum(ss);
  float r = rsqrtf(ss * (1.f / DM) + EPS);
#pragma unroll
  for (int i = 0; i < 8; ++i) {
    float4 gg = *(const float4*)(g + (i * 64 + lane) * 4);
    uint2 u;
    u.x = pack2(v[i].x * r * gg.x, v[i].y * r * gg.y);
    u.y = pack2(v[i].z * r * gg.z, v[i].w * r * gg.w);
    *(uint2*)(dst + (i * 64 + lane) * 4) = u;
  }
}
DI void norm_row_f32(float* __restrict__ io, const float* __restrict__ g, int lane) {
  float4 v[8];
  float ss = 0.f;
#pragma unroll
  for (int i = 0; i < 8; ++i) {
    v[i] = *(const float4*)(io + (i * 64 + lane) * 4);
    ss += v[i].x * v[i].x + v[i].y * v[i].y + v[i].z * v[i].z + v[i].w * v[i].w;
  }
  ss = wave_sum(ss);
  float r = rsqrtf(ss * (1.f / DM) + EPS);
#pragma unroll
  for (int i = 0; i < 8; ++i) {
    float4 gg = *(const float4*)(g + (i * 64 + lane) * 4);
    float4 o;
    o.x = v[i].x * r * gg.x; o.y = v[i].y * r * gg.y; o.z = v[i].z * r * gg.z; o.w = v[i].w * r * gg.w;
    *(float4*)(io + (i * 64 + lane) * 4) = o;
  }
}

struct ALin {
  const bf16* p; int ld;
  DI const bf16* operator()(int row, int k) const { return p + (size_t)row * ld + k; }
};
struct ACmp {
  const bf16* p; int m0;
  DI const bf16* operator()(int row, int k) const {
    int gr = m0 + row;
    if (gr > 1021) gr = 1021;
    int n = gr >> 1, g = gr & 1;
    return p + (size_t)(16 * n + (k >> 7)) * NPO + g * 128 + (k & 127);
  }
};

template <class AF, class Epi>
DI void gemm_tile(AF af, const bf16* __restrict__ Bt, int ldb, int K, char* smem, Epi epi) {
  const int tid = otid(), lane = tid & 63, w = tid >> 6, r = lane & 31, h = lane >> 5;
  const int wm = w >> 1, wn = w & 1;
  bf16* As = (bf16*)smem;
  bf16* Bs = As + 2 * 128 * 72;
  f32x16 acc[2][2];
#pragma unroll
  for (int a = 0; a < 2; ++a)
#pragma unroll
    for (int b = 0; b < 2; ++b)
#pragma unroll
      for (int i = 0; i < 16; ++i) acc[a][b][i] = 0.f;
  uint4 ra0_0, ra0_1, ra0_2, ra0_3, rb0_0, rb0_1, rb0_2, rb0_3, ra1_0, ra1_1, ra1_2, ra1_3, rb1_0, rb1_1, rb1_2, rb1_3;
#define LD1(S, I, K0)                                                                  \
  {                                                                                    \
    int c = tl + 256 * I;                                                              \
    int row = c >> 3, kc = (c & 7) * 8;                                                \
    ra##S##_##I = *(const uint4*)af(row, (K0) + kc);                                   \
    rb##S##_##I = *(const uint4*)(Bt + (size_t)row * ldb + (K0) + kc);                 \
  }
#define ST1(S, I, BUF)                                                                 \
  {                                                                                    \
    int c = tid + 256 * I;                                                             \
    int row = c >> 3, kc = (c & 7) * 8;                                                \
    *(uint4*)(As + (BUF) * 9216 + row * 72 + kc) = ra##S##_##I;                        \
    *(uint4*)(Bs + (BUF) * 9216 + row * 72 + kc) = rb##S##_##I;                        \
  }
#define GLOAD(S, K0) { const int tl = otid(); LD1(S, 0, K0) LD1(S, 1, K0) LD1(S, 2, K0) LD1(S, 3, K0) }
#define SSTORE(S, BUF) { ST1(S, 0, BUF) ST1(S, 1, BUF) ST1(S, 2, BUF) ST1(S, 3, BUF) }
  auto compute = [&](int buf) {
    const bf16* a_ = As + buf * 9216 + (wm * 64 + r) * 72 + h * 8;
    const bf16* b_ = Bs + buf * 9216 + (wn * 64 + r) * 72 + h * 8;
    bf16x8 fa0, fa1, fb0, fb1, ga0, ga1, gb0, gb1, ha0, ha1, hb0, hb1, ia0, ia1, ib0, ib1;
    fa0 = *(const bf16x8*)(a_ + 0);            fa1 = *(const bf16x8*)(a_ + 32 * 72);
    fb0 = *(const bf16x8*)(b_ + 0);            fb1 = *(const bf16x8*)(b_ + 32 * 72);
    ga0 = *(const bf16x8*)(a_ + 16);           ga1 = *(const bf16x8*)(a_ + 32 * 72 + 16);
    gb0 = *(const bf16x8*)(b_ + 16);           gb1 = *(const bf16x8*)(b_ + 32 * 72 + 16);
    ha0 = *(const bf16x8*)(a_ + 32);           ha1 = *(const bf16x8*)(a_ + 32 * 72 + 32);
    hb0 = *(const bf16x8*)(b_ + 32);           hb1 = *(const bf16x8*)(b_ + 32 * 72 + 32);
    ia0 = *(const bf16x8*)(a_ + 48);           ia1 = *(const bf16x8*)(a_ + 32 * 72 + 48);
    ib0 = *(const bf16x8*)(b_ + 48);           ib1 = *(const bf16x8*)(b_ + 32 * 72 + 48);
    __builtin_amdgcn_sched_barrier(0);
    acc[0][0] = MFMA32(fa0, fb0, acc[0][0]); acc[0][1] = MFMA32(fa0, fb1, acc[0][1]);
    acc[1][0] = MFMA32(fa1, fb0, acc[1][0]); acc[1][1] = MFMA32(fa1, fb1, acc[1][1]);
    acc[0][0] = MFMA32(ga0, gb0, acc[0][0]); acc[0][1] = MFMA32(ga0, gb1, acc[0][1]);
    acc[1][0] = MFMA32(ga1, gb0, acc[1][0]); acc[1][1] = MFMA32(ga1, gb1, acc[1][1]);
    acc[0][0] = MFMA32(ha0, hb0, acc[0][0]); acc[0][1] = MFMA32(ha0, hb1, acc[0][1]);
    acc[1][0] = MFMA32(ha1, hb0, acc[1][0]); acc[1][1] = MFMA32(ha1, hb1, acc[1][1]);
    acc[0][0] = MFMA32(ia0, ib0, acc[0][0]); acc[0][1] = MFMA32(ia0, ib1, acc[0][1]);
    acc[1][0] = MFMA32(ia1, ib0, acc[1][0]); acc[1][1] = MFMA32(ia1, ib1, acc[1][1]);
    __builtin_amdgcn_sched_barrier(0);
  };
  __syncthreads();
  const int nk = K >> 6;
  GLOAD(0, 0);
  SSTORE(0, 0);
  GLOAD(0, 64);
  __syncthreads();
  for (int kt = 0; kt < nk; kt += 2) {
    if (kt + 2 < nk) GLOAD(1, (kt + 2) * 64);
    compute(0);
    SSTORE(0, 1);
    __syncthreads();
    if (kt + 3 < nk) GLOAD(0, (kt + 3) * 64);
    compute(1);
    if (kt + 2 < nk) SSTORE(1, 0);
    __syncthreads();
  }
#undef GLOAD
#undef SSTORE
#undef LD1
#undef ST1
  float* Cs = (float*)smem;
#pragma unroll
  for (int mb = 0; mb < 2; ++mb)
#pragma unroll
    for (int nb = 0; nb < 2; ++nb)
#pragma unroll
      for (int i = 0; i < 16; ++i)
        Cs[(wm * 64 + mb * 32 + crow(i, h)) * 132 + wn * 64 + nb * 32 + r] = acc[mb][nb][i];
  __syncthreads();
  epi(Cs);
}


template <class AF, class Epi>
DI void gemm_tile2(AF af, const bf16* __restrict__ Bt, int ldb, int K, char* smem, int& n0ref, int nhalf, Epi epi) {
  const int tid = otid(), lane = tid & 63, w = tid >> 6, r = lane & 31, h = lane >> 5;
  const int wm = w >> 1, wn = w & 1;
  bf16* As = (bf16*)smem;
  bf16* Bs = As + 128 * 72;
  f32x16 acc[2][4];
#pragma unroll
  for (int a = 0; a < 2; ++a)
#pragma unroll
    for (int b = 0; b < 4; ++b)
#pragma unroll
      for (int i = 0; i < 16; ++i) acc[a][b][i] = 0.f;
  uint4 pa_0, pa_1, pa_2, pa_3, pb_0, pb_1, pb_2, pb_3, pb_4, pb_5, pb_6, pb_7;
#define LDA2(I, K0) { int c = tl + 256 * I; int row = c >> 3, kc = (c & 7) * 8; pa_##I = *(const uint4*)af(row, (K0) + kc); }
#define LDB2(I, K0) { int c = tl + 256 * I; int row = c >> 3, kc = (c & 7) * 8; pb_##I = *(const uint4*)(Bt + (size_t)row * ldb + (K0) + kc); }
#define STA2(I) { int c = tid + 256 * I; int row = c >> 3, kc = (c & 7) * 8; *(uint4*)(As + row * 72 + kc) = pa_##I; }
#define STB2(I) { int c = tid + 256 * I; int row = c >> 3, kc = (c & 7) * 8; *(uint4*)(Bs + row * 72 + kc) = pb_##I; }
#define GLOAD2(K0) { const int tl = otid(); LDA2(0, K0) LDA2(1, K0) LDA2(2, K0) LDA2(3, K0) LDB2(0, K0) LDB2(1, K0) LDB2(2, K0) LDB2(3, K0) LDB2(4, K0) LDB2(5, K0) LDB2(6, K0) LDB2(7, K0) }
#define SSTORE2() { STA2(0) STA2(1) STA2(2) STA2(3) STB2(0) STB2(1) STB2(2) STB2(3) STB2(4) STB2(5) STB2(6) STB2(7) }
  const int nk = K >> 6;
  GLOAD2(0);
  const bf16* a_ = As + (wm * 64 + r) * 72 + h * 8;
  const bf16* b_ = Bs + (wn * 128 + r) * 72 + h * 8;
  for (int kt = 0; kt < nk; ++kt) {
    __syncthreads();
    SSTORE2();
    __syncthreads();
    if (kt + 1 < nk) GLOAD2((kt + 1) * 64);
#pragma unroll
    for (int ks = 0; ks < 4; ++ks) {
      bf16x8 fa[2], fb[4];
#pragma unroll
      for (int mb = 0; mb < 2; ++mb) fa[mb] = *(const bf16x8*)(a_ + mb * 32 * 72 + ks * 16);
#pragma unroll
      for (int nb = 0; nb < 4; ++nb) fb[nb] = *(const bf16x8*)(b_ + nb * 32 * 72 + ks * 16);
#pragma unroll
      for (int mb = 0; mb < 2; ++mb)
#pragma unroll
        for (int nb = 0; nb < 4; ++nb) acc[mb][nb] = MFMA32(fa[mb], fb[nb], acc[mb][nb]);
    }
  }
#undef LDA2
#undef LDB2
#undef STA2
#undef STB2
#undef GLOAD2
#undef SSTORE2
  float* Cs = (float*)smem;
#pragma unroll
  for (int hf = 0; hf < 2; ++hf) {
    if (hf < nhalf) {
      __syncthreads();
      if (wn == hf) {
#pragma unroll
        for (int mb = 0; mb < 2; ++mb)
#pragma unroll
          for (int nb = 0; nb < 4; ++nb)
#pragma unroll
            for (int i = 0; i < 16; ++i) Cs[(wm * 64 + mb * 32 + crow(i, h)) * 132 + nb * 32 + r] = acc[mb][nb][i];
      }
      __syncthreads();
      epi(Cs);
      n0ref += 128;
    }
  }
}

DI void tile_map(int t, int ntn, int& tm, int& tn) {
  const int per = 8 * ntn;
  const int grp = t / per, rem = t - grp * per;
  tm = grp * 8 + (rem & 7);
  tn = rem >> 3;
}
template <class F>
DI void epi_rows(const float* Cs, F f) {
  const int tid = otid();
#pragma unroll
  for (int j = 0; j < 8; ++j) {
    int c = tid + 256 * j;
    int row = c >> 4, cc = (c & 15) * 8;
    float v[8];
    float4 a = *(const float4*)(Cs + row * 132 + cc);
    float4 b = *(const float4*)(Cs + row * 132 + cc + 4);
    v[0] = a.x; v[1] = a.y; v[2] = a.z; v[3] = a.w; v[4] = b.x; v[5] = b.y; v[6] = b.z; v[7] = b.w;
    f(row, cc, v);
  }
}
template <class F>
DI void epi_cols(const float* Cs, F f) {
  const int tid = otid();
#pragma unroll
  for (int j = 0; j < 8; ++j) {
    int c = tid + 256 * j;
    int col = c & 127, r8 = (c >> 7) * 8;
    float v[8];
#pragma unroll
    for (int e = 0; e < 8; ++e) v[e] = Cs[(r8 + e) * 132 + col];
    f(col, r8, v);
  }
}
template <class F>
DI void epi_rope(const float* Cs, int cb, int m0, const float* rc, const float* rs, float scale_unused, F f) {
  const int tid = otid();
#pragma unroll
  for (int j = 0; j < 2; ++j) {
    int c = tid + 256 * j;
    int row = c >> 2, cc = (c & 3) * 8;
    float x1[8], x2[8], o1[8], o2[8];
#pragma unroll
    for (int e = 0; e < 8; ++e) {
      x1[e] = Cs[row * 132 + cb + cc + e];
      x2[e] = Cs[row * 132 + cb + 32 + cc + e];
    }
    const float* pc = rc + (size_t)(m0 + row) * 32 + cc;
    const float* ps = rs + (size_t)(m0 + row) * 32 + cc;
#pragma unroll
    for (int e = 0; e < 8; ++e) {
      float cs = pc[e], sn = ps[e];
      o1[e] = x1[e] * cs - x2[e] * sn;
      o2[e] = x1[e] * sn + x2[e] * cs;
    }
    f(row, cc, o1);
    f(row, cc + 32, o2);
  }
}

template <int DK>
struct KVPre {
  uint4 k[DK / 32];
  uint4 v[4];
  float aux;
};
constexpr int AT_VS = 25600;
constexpr int AT_AUX = 43008;
constexpr int AT_X0 = 43264;
constexpr int AT_IMP = AT_X0 + 12800;
constexpr int AT_SEL = AT_IMP + 16896;

template <int DK, bool PV, class SF, class PH>
DI void attn_tile(const bf16x8 (&qf)[DK / 16], f32x16 (&o)[4], float& m, float& l, const char* smem, SF sf, PH ph) {
  const int lane = otid() & 63, r = lane & 31, h = lane >> 5;
  const bf16* Ks = (const bf16*)smem;
  const bf16* Vs = (const bf16*)(smem + AT_VS);
  const float* auxs = (const float*)(smem + AT_AUX);
  f32x16 s[2];
#pragma unroll
  for (int kb = 0; kb < 2; ++kb) {
#pragma unroll
    for (int i = 0; i < 16; ++i) s[kb][i] = 0.f;
#pragma unroll
    for (int ks = 0; ks < DK / 16; ++ks) {
      bf16x8 a = *(const bf16x8*)(Ks + (kb * 32 + r) * (DK + 8) + ks * 16 + h * 8);
      s[kb] = MFMA32(a, qf[ks], s[kb]);
    }
  }
  float mx = m;
#pragma unroll
  for (int kb = 0; kb < 2; ++kb)
#pragma unroll
    for (int i = 0; i < 16; ++i) {
      int kl = kb * 32 + crow(i, h);
      float v = sf(s[kb][i], kl, auxs[kl]);
      s[kb][i] = v;
      mx = fmaxf(mx, v);
    }
  mx = fmaxf(mx, __shfl_xor(mx, 32));
  float alpha = ex2(m - mx);
  m = mx;
  float psum = 0.f;
#pragma unroll
  for (int kb = 0; kb < 2; ++kb)
#pragma unroll
    for (int i = 0; i < 16; ++i) {
      float pv = ex2(s[kb][i] - mx);
      s[kb][i] = pv;
      psum += pv;
    }
  l = l * alpha + psum;
  ph(0, s[0]);
  ph(1, s[1]);
  if (PV) {
    if (__builtin_amdgcn_ballot_w64(alpha != 1.f) != 0ull) {
#pragma unroll
      for (int d = 0; d < 4; ++d)
#pragma unroll
        for (int i = 0; i < 16; ++i) o[d][i] *= alpha;
    }
#pragma unroll
    for (int st = 0; st < 4; ++st) {
      const int kb = st >> 1, s2 = st & 1;
      uint4 pu;
      pu.x = pack2(s[kb][8 * s2 + 0], s[kb][8 * s2 + 1]);
      pu.y = pack2(s[kb][8 * s2 + 2], s[kb][8 * s2 + 3]);
      pu.z = pack2(s[kb][8 * s2 + 4], s[kb][8 * s2 + 5]);
      pu.w = pack2(s[kb][8 * s2 + 6], s[kb][8 * s2 + 7]);
      bf16x8 pf = __builtin_bit_cast(bf16x8, pu);
#pragma unroll
      for (int d = 0; d < 4; ++d) {
        const bf16* vp = Vs + (d * 32 + r) * 68 + st * 16 + 4 * h;
        uint2 lo = *(const uint2*)vp;
        uint2 hi = *(const uint2*)(vp + 8);
        uint4 vu = make_uint4(lo.x, lo.y, hi.x, hi.y);
        bf16x8 vf = __builtin_bit_cast(bf16x8, vu);
        o[d] = MFMA32(vf, pf, o[d]);
      }
    }
  }
}

template <int DK, int FM>
DI void attn_tile_c(const bf16x8 (&qf)[DK / 16], f32x16 (&o)[4], float& m, float& l, const char* smem, float sc, float c) {
  const int lane = otid() & 63, r = lane & 31, h = lane >> 5;
  const bf16* Ks = (const bf16*)smem;
  const bf16* Vs = (const bf16*)(smem + AT_VS);
  const float* auxs = (const float*)(smem + AT_AUX);
  f32x16 s0, s1;
#pragma unroll
  for (int i = 0; i < 16; ++i) { s0[i] = 0.f; s1[i] = 0.f; }
#pragma unroll
  for (int ks = 0; ks < DK / 16; ++ks) {
    bf16x8 a = *(const bf16x8*)(Ks + r * (DK + 8) + ks * 16 + h * 8);
    s0 = MFMA32(a, qf[ks], s0);
  }
#pragma unroll
  for (int ks = 0; ks < DK / 16; ++ks) {
    bf16x8 a = *(const bf16x8*)(Ks + (32 + r) * (DK + 8) + ks * 16 + h * 8);
    s1 = MFMA32(a, qf[ks], s1);
  }
  float mx;
  if (FM == 2) {
    mx = m;
#pragma unroll
    for (int i = 0; i < 16; ++i) {
      float v = __builtin_fmaf(s0[i], sc, -auxs[crow(i, h)]);
      s0[i] = v;
      mx = fmaxf(mx, v);
    }
  } else {
    float rm = s0[0];
#pragma unroll
    for (int i = 1; i < 16; ++i) rm = fmaxf(rm, s0[i]);
    mx = fmaxf(m, __builtin_fmaf(rm, sc, c));
  }
  mx = fmaxf(mx, __shfl_xor(mx, 32));
  const float alpha = ex2(m - mx);
  m = mx;
  const float off = c - mx;
#pragma unroll
  for (int d = 0; d < 4; ++d)
#pragma unroll
    for (int i = 0; i < 16; ++i) o[d][i] *= alpha;
  l *= alpha;
  float psum = 0.f;
#pragma unroll
  for (int i = 0; i < 16; ++i) {
    float pv = (FM == 2) ? ex2(s0[i] - mx) : ex2(__builtin_fmaf(s0[i], sc, off));
    s0[i] = pv;
    psum += pv;
  }
#pragma unroll
  for (int s2 = 0; s2 < 2; ++s2) {
    uint4 pu;
    pu.x = pack2(s0[8 * s2 + 0], s0[8 * s2 + 1]);
    pu.y = pack2(s0[8 * s2 + 2], s0[8 * s2 + 3]);
    pu.z = pack2(s0[8 * s2 + 4], s0[8 * s2 + 5]);
    pu.w = pack2(s0[8 * s2 + 6], s0[8 * s2 + 7]);
    bf16x8 pf = __builtin_bit_cast(bf16x8, pu);
#pragma unroll
    for (int d = 0; d < 4; ++d) {
      const bf16* vp = Vs + (d * 32 + r) * 68 + s2 * 16 + 4 * h;
      uint2 lo = *(const uint2*)vp;
      uint2 hi = *(const uint2*)(vp + 8);
      uint4 vu = make_uint4(lo.x, lo.y, hi.x, hi.y);
      o[d] = MFMA32(__builtin_bit_cast(bf16x8, vu), pf, o[d]);
    }
  }
#pragma unroll
  for (int i = 0; i < 16; ++i) {
    float pv;
    if (FM == 2) pv = ex2(__builtin_fmaf(s1[i], sc, -auxs[32 + crow(i, h)]) - mx);
    else pv = ex2(__builtin_fmaf(s1[i], sc, off));
    s1[i] = pv;
    psum += pv;
  }
  l += psum;
#pragma unroll
  for (int s2 = 0; s2 < 2; ++s2) {
    uint4 pu;
    pu.x = pack2(s1[8 * s2 + 0], s1[8 * s2 + 1]);
    pu.y = pack2(s1[8 * s2 + 2], s1[8 * s2 + 3]);
    pu.z = pack2(s1[8 * s2 + 4], s1[8 * s2 + 5]);
    pu.w = pack2(s1[8 * s2 + 6], s1[8 * s2 + 7]);
    bf16x8 pf = __builtin_bit_cast(bf16x8, pu);
#pragma unroll
    for (int d = 0; d < 4; ++d) {
      const bf16* vp = Vs + (d * 32 + r) * 68 + (2 + s2) * 16 + 4 * h;
      uint2 lo = *(const uint2*)vp;
      uint2 hi = *(const uint2*)(vp + 8);
      uint4 vu = make_uint4(lo.x, lo.y, hi.x, hi.y);
      o[d] = MFMA32(__builtin_bit_cast(bf16x8, vu), pf, o[d]);
    }
  }
}

struct NoHook { DI void operator()(int, const f32x16&) const {} };

template <int DK, bool PV, bool PF, class Ctx>
DI void attn_run(const bf16x8 (&qf)[DK / 16], f32x16 (&o)[4], float& m, float& l, const bf16* K1, int ldk1,
                 const bf16* K2, int ldk2, const bf16* Vt, int ldv, int first, Ctx& ctx, char* smem) {
  const int tid = otid();
  int tcur = first;
  if (tcur < 0) return;
  constexpr int CPR = DK / 8;
  constexpr int NKC = DK / 32;
  uint4 rk0, rk1, rk2, rk3, rk4 = make_uint4(0, 0, 0, 0), rk5 = make_uint4(0, 0, 0, 0), rv[4];
  float raux;
  bf16* Ks = (bf16*)smem;
  bf16* Vs = (bf16*)(smem + AT_VS);
  auto ldk = [&](int i, int key0) -> uint4 {
    int c = otid() + 256 * i;
    int row = c / CPR, cc = c % CPR;
    const bf16* src;
    if (DK == 128 || cc < 16) src = K1 + (size_t)(key0 + row) * ldk1 + cc * 8;
    else src = K2 + (size_t)(key0 + row) * ldk2 + (cc - 16) * 8;
    return *(const uint4*)src;
  };
  auto stk = [&](int i, const uint4& v) {
    int c = tid + 256 * i;
    int row = c / CPR, cc = c % CPR;
    *(uint4*)(Ks + row * (DK + 8) + cc * 8) = v;
  };
  auto gload = [&](int key0) {
    rk0 = ldk(0, key0); rk1 = ldk(1, key0); rk2 = ldk(2, key0); rk3 = ldk(3, key0);
    if (NKC > 4) { rk4 = ldk(4, key0); rk5 = ldk(5, key0); }
    const int tl = otid();
#pragma unroll
    for (int i = 0; i < 4; ++i) {
      int c = tl + 256 * i;
      int d = c >> 3, cc = c & 7;
      rv[i] = *(const uint4*)(Vt + (size_t)d * ldv + key0 + cc * 8);
    }
    raux = (tid < 64) ? ctx.aux(key0 + tid) : 0.f;
  };
  auto sstore = [&]() {
    stk(0, rk0); stk(1, rk1); stk(2, rk2); stk(3, rk3);
    if (NKC > 4) { stk(4, rk4); stk(5, rk5); }
#pragma unroll
    for (int i = 0; i < 4; ++i) {
      int c = tid + 256 * i;
      int d = c >> 3, cc = c & 7;
      uint2* dst = (uint2*)(Vs + d * 68 + cc * 8);
      dst[0] = make_uint2(rv[i].x, rv[i].y);
      dst[1] = make_uint2(rv[i].z, rv[i].w);
    }
    if (tid < 64) ((float*)(smem + AT_AUX))[tid] = raux;
  };
  if (PF) gload(tcur * 64);
  while (tcur >= 0) {
    __syncthreads();
    if (!PF) gload(tcur * 64);
    sstore();
    __syncthreads();
    int tnext = ctx.next(tcur);
    if (PF && tnext >= 0) gload(tnext * 64);
    if (!ctx.skip(tcur)) {
      const int tc = tcur;
      if (Ctx::FMODE != 0 && (Ctx::ALWAYS_FAST || ctx.fast(tc))) {
        attn_tile_c<DK, (Ctx::FMODE == 2 ? 2 : 1)>(qf, o, m, l, smem, ctx.sc, ctx.fconst(tc));
      } else if (!Ctx::ALWAYS_FAST) {
        attn_tile<DK, PV>(qf, o, m, l, smem,
                          [&](float s, int kl, float ax) { return ctx.score(s, tc * 64 + kl, ax, tc); },
                          [&](int kb, const f32x16& pt) { ctx.hook(kb, pt, tc); });
      }
    }
    tcur = tnext;
  }
}

template <int DK>
DI void load_q(bf16x8 (&qf)[DK / 16], const bf16* qrow, int h) {
#pragma unroll
  for (int ks = 0; ks < DK / 16; ++ks) qf[ks] = *(const bf16x8*)(qrow + ks * 16 + h * 8);
}
DI void zero_o(f32x16 (&o)[4]) {
#pragma unroll
  for (int d = 0; d < 4; ++d)
#pragma unroll
    for (int i = 0; i < 16; ++i) o[d][i] = 0.f;
}

struct CtxCausal {
  int tq, q0w, last; float sc;
  DI int next(int t) const { return t + 1 <= last ? t + 1 : -1; }
  DI float aux(int) const { return 0.f; }
  DI bool skip(int t) const { return t * 64 > q0w + 31; }
  DI float score(float s, int key, float, int) const { return key <= tq ? s * sc : NEG; }
  static constexpr int FMODE = 1;
  static constexpr bool ALWAYS_FAST = false;
  DI bool fast(int t) const { return t * 64 + 63 <= q0w; }
  DI float fconst(int) const { return 0.f; }
  DI void hook(int, const f32x16&, int) const {}
};
struct CtxFox {
  int tq, q0w, last; float sc; const float* cuml; const float* cpre;
  DI int next(int t) const { return t + 1 <= last ? t + 1 : -1; }
  DI float aux(int key) const { return (cuml[key] + cpre[key >> 7]) * LOG2E; }
  DI bool skip(int t) const { return t * 64 > q0w + 31; }
  DI float score(float s, int key, float ax, int) const { return key <= tq ? s * sc - ax : NEG; }
  static constexpr int FMODE = 2;
  static constexpr bool ALWAYS_FAST = false;
  DI bool fast(int t) const { return t * 64 + 63 <= q0w; }
  DI float fconst(int) const { return 0.f; }
  DI void hook(int, const f32x16&, int) const {}
};
struct CtxMem {
  float sc;
  DI int next(int t) const { return t + 1 < 4 ? t + 1 : -1; }
  DI float aux(int) const { return 0.f; }
  DI bool skip(int) const { return false; }
  DI float score(float s, int, float, int) const { return s * sc; }
  static constexpr int FMODE = 1;
  static constexpr bool ALWAYS_FAST = true;
  DI bool fast(int) const { return true; }
  DI float fconst(int) const { return 0.f; }
  DI void hook(int, const f32x16&, int) const {}
};

DI void store_out_A(const f32x16 (&o)[4], float inv_l, const bf16* grow, bf16* orow, int h) {
#pragma unroll
  for (int d = 0; d < 4; ++d)
#pragma unroll
    for (int i4 = 0; i4 < 4; ++i4) {
      int dv0 = d * 32 + 8 * i4 + 4 * h;
      uint2 gu = *(const uint2*)(grow + dv0);
      float g0 = bflo(gu.x), g1 = bfhi(gu.x), g2 = bflo(gu.y), g3 = bfhi(gu.y);
      uint2 ou;
      ou.x = pack2(o[d][4 * i4 + 0] * inv_l * silu(g0), o[d][4 * i4 + 1] * inv_l * silu(g1));
      ou.y = pack2(o[d][4 * i4 + 2] * inv_l * silu(g2), o[d][4 * i4 + 3] * inv_l * silu(g3));
      *(uint2*)(orow + dv0) = ou;
    }
}

        struct CtxCmp {
          int tq, posq, last; float sc; const float* lutr; const int* pos; float invl; float* imp; int ql; bool p2;
          DI int next(int t) const { return t + 1 <= last ? t + 1 : -1; }
          DI float aux(int key) const { int n = key < 511 ? key : 510; return __int_as_float(pos[16 * n + 31]); }
          DI bool skip(int) const { return false; }
          DI float score(float s, int key, float ax, int) const {
            bool valid = (16 * key + 31 <= tq) && key < 511;
            int d = posq - __float_as_int(ax);
            d = d < 0 ? 0 : (d > 799 ? 799 : d);
            return valid ? s * sc + lutr[d] : NEG;
          }
          static constexpr int FMODE = 0;
          static constexpr bool ALWAYS_FAST = false;
          DI bool fast(int) const { return false; }
          DI float fconst(int) const { return 0.f; }
          DI void hook(int kb, const f32x16& pt, int tc) const {
            if (!p2) return;
            const int lane = otid() & 63, h = lane >> 5, r = lane & 31;
#pragma unroll
            for (int gq = 0; gq < 4; ++gq) {
              float p3 = 0.5f * pt[4 * gq + 3];
              float vm = (pt[4 * gq] + pt[4 * gq + 1] + pt[4 * gq + 2] + p3) * invl;
              float vs = p3 * invl;
              vm += __shfl_xor(vm, 8); vm += __shfl_xor(vm, 16);
              vs += __shfl_xor(vs, 8); vs += __shfl_xor(vs, 16);
              int j = tc * 16 + kb * 8 + 2 * gq + h;
              if (r < 8) { atomicAdd(&imp[ql * 132 + j], vm); atomicAdd(&imp[ql * 132 + j + 1], vs); }
            }
          }
        };
struct CtxSlc {
  int tq, posq; float sc; const float* lutr; const int* pos; unsigned long long ulo, uhi, mlo, mhi;
  const int* posmax; int pqmin, q0;
  DI bool farj(int j) const { return (j * 64 + 63 < q0) && (pqmin - posmax[j] >= 799); }
  DI bool inu(int j) const {
    unsigned long long a = (ulo >> (j & 63)) & (j < 64 ? 1ull : 0ull);
    unsigned long long b = (uhi >> (j & 63)) & (j >= 64 ? 1ull : 0ull);
    return (a | b) != 0ull;
  }
  DI bool mine(int j) const {
    unsigned long long a = (mlo >> (j & 63)) & (j < 64 ? 1ull : 0ull);
    unsigned long long b = (mhi >> (j & 63)) & (j >= 64 ? 1ull : 0ull);
    return (a | b) != 0ull;
  }
  DI int next(int t) const { for (int j = t + 1; j < 128; ++j) if (inu(j) && !farj(j)) return j; return -1; }
  DI float aux(int key) const { return __int_as_float(pos[key]); }
  DI bool skip(int t) const { return __builtin_amdgcn_ballot_w64(mine(t)) == 0ull; }
  DI float score(float s, int key, float ax, int t) const {
    bool valid = mine(t) && key <= tq;
    int d = posq - __float_as_int(ax);
    d = d < 0 ? 0 : (d > 799 ? 799 : d);
    return valid ? s * sc + lutr[d] : NEG;
  }
  static constexpr int FMODE = 0;
  static constexpr bool ALWAYS_FAST = false;
  DI bool fast(int) const { return false; }
  DI float fconst(int) const { return 0.f; }
  DI void hook(int, const f32x16&, int) const {}
};
struct CtxSlcFar {
  float sc, bfar; unsigned long long ulo, uhi, mlo, mhi; const int* posmax; int pqmin, q0;
  DI bool farj(int j) const { return (j * 64 + 63 < q0) && (pqmin - posmax[j] >= 799); }
  DI bool inu(int j) const {
    unsigned long long a = (ulo >> (j & 63)) & (j < 64 ? 1ull : 0ull);
    unsigned long long b = (uhi >> (j & 63)) & (j >= 64 ? 1ull : 0ull);
    return (a | b) != 0ull;
  }
  DI bool mine(int j) const {
    unsigned long long a = (mlo >> (j & 63)) & (j < 64 ? 1ull : 0ull);
    unsigned long long b = (mhi >> (j & 63)) & (j >= 64 ? 1ull : 0ull);
    return (a | b) != 0ull;
  }
  DI int next(int t) const { for (int j = t + 1; j < 128; ++j) if (inu(j) && farj(j)) return j; return -1; }
  DI float aux(int) const { return 0.f; }
  DI bool skip(int t) const { return __builtin_amdgcn_ballot_w64(mine(t)) == 0ull; }
  DI float score(float s, int, float, int t) const { return mine(t) ? s * sc + bfar : NEG; }
  static constexpr int FMODE = 1;
  static constexpr bool ALWAYS_FAST = true;
  DI bool fast(int) const { return true; }
  DI float fconst(int t) const { return mine(t) ? bfar : NEG; }
  DI void hook(int, const f32x16&, int) const {}
};
struct CtxWin {
  int tq, posq, last; float sc; const float* lutr; const int* pos;
  DI int next(int t) const { return t + 1 <= last ? t + 1 : -1; }
  DI float aux(int key) const { return __int_as_float(pos[key]); }
  DI bool skip(int) const { return false; }
  DI float score(float s, int key, float ax, int) const {
    bool valid = key <= tq && (tq - key) < 512;
    int d = posq - __float_as_int(ax);
    d = d < 0 ? 0 : (d > 799 ? 799 : d);
    return valid ? s * sc + lutr[d] : NEG;
  }
  static constexpr int FMODE = 0;
  static constexpr bool ALWAYS_FAST = false;
  DI bool fast(int) const { return false; }
  DI float fconst(int) const { return 0.f; }
  DI void hook(int, const f32x16&, int) const {}
};

DI int cvt_next_count(const Params& p, int nl) {
      const bool ne = (nl & 1) == 0;
      const int nli = nl >> 1;
      return cvt_set_count(p, ne ? SET_IN_EVEN : SET_IN_ODD, nli) + cvt_set_count(p, SET_MEM, nl) +
             cvt_set_count(p, ne ? SET_MISC_EVEN : SET_MISC_ODD, nli) + (ne ? 16 : 32);
}
DI void cvt_next(const Params& p, char* smem, int nl, int t) {
  char* ws = p.ws;
      const bool ne = (nl & 1) == 0;
      const int nli = nl >> 1;
      const int s0 = ne ? SET_IN_EVEN : SET_IN_ODD, s2 = ne ? SET_MISC_EVEN : SET_MISC_ODD;
      const int c0 = cvt_set_count(p, s0, nli), c1 = cvt_set_count(p, SET_MEM, nl), c2 = cvt_set_count(p, s2, nli);
      if (t < c0) cvt_set_task(p, s0, nli, t, smem);
      else if (t < c0 + c1) cvt_set_task(p, SET_MEM, nl, t - c0, smem);
      else if (t < c0 + c1 + c2) cvt_set_task(p, s2, nli, t - c0 - c1, smem);
      else {
            const int tid = otid();
            int e = t - c0 - c1 - c2;
            if (ne) {
              float* S5P = (float*)(ws + WS_S5P);
              int gp = e * 256 + tid;
              int g = gp >> 6;
              float dt = expf(p.log_dt[nli * 64 + g]);
              float lr = p.lam_re[nli * 4096 + gp], lim = p.lam_im[nli * 4096 + gp];
              float mag = expf(lr * dt);
              float abr = mag * cosf(lim * dt), abi = mag * sinf(lim * dt);
              float den = lr * lr + lim * lim;
              float nr = abr - 1.f;
              float fre = (nr * lr + abi * lim) / den;
              float fim = (abi * lr - nr * lim) / den;
              S5P[gp] = abr;
              S5P[4096 + gp] = abi;
              float ar = abr, ai = abi;
#pragma unroll
              for (int q = 0; q < 7; ++q) { float nr2 = ar * ar - ai * ai; ai = 2.f * ar * ai; ar = nr2; }
              S5P[8192 + gp] = ar;
              S5P[12288 + gp] = ai;
              const float* br = p.b_re + (size_t)nli * 65536 + gp * 16;
              const float* bi = p.b_im + (size_t)nli * 65536 + gp * 16;
#pragma unroll
              for (int c = 0; c < 16; ++c) {
                S5P[16384 + gp * 16 + c] = fre * br[c] - fim * bi[c];
                S5P[16384 + 65536 + gp * 16 + c] = fre * bi[c] + fim * br[c];
              }
            } else {
              int which = e >> 4, part = e & 15;
              const float* pe = p.cmp_pe + (size_t)(nli * 2 + which) * 4096 + part * 256;
              const float* w1 = p.cmp_w1 + ((size_t)(nli * 2 + which) * 4096 + part * 256) * 256 + tid;
              float acc = 0.f;
#pragma unroll 8
              for (int k = 0; k < 256; ++k) acc += pe[k] * w1[(size_t)k * 256];
              ((float*)(ws + WS_CMPB))[(which * 16 + part) * 256 + tid] = acc;
            }
      }
}

#define XB_TMO      128
#define XB_XCNT(j)  (256  + 64 * (j))
#define XB_XSUB(j)  (1280 + 64 * (j))
#define XB_XGEN(j)  (2304 + 64 * (j))
#define XB_TOP      3328
#define XB_TOPGEN   3392
#define XCD_BAR_WORDS 3456
#define XB_SPIN_CAP (1u << 18)
#define LAS __attribute__((address_space(3)))

__device__ __forceinline__ unsigned xb_ld(unsigned* p)              { return __hip_atomic_load(p, __ATOMIC_RELAXED, __HIP_MEMORY_SCOPE_AGENT); }
__device__ __forceinline__ unsigned xb_add(unsigned* p, unsigned v) { return __hip_atomic_fetch_add(p, v, __ATOMIC_RELAXED, __HIP_MEMORY_SCOPE_AGENT); }
__device__ __forceinline__ unsigned xb_xcc_id() { return (unsigned)__builtin_amdgcn_s_getreg((3 << 11) | 20) & 0xFu; }
#define XB_SPIN(cond, bar) do { unsigned _sp = 0; while (cond) { __builtin_amdgcn_s_sleep(1); \
    if ((++_sp & 255u) == 0u) { if (xb_ld(&(bar)[XB_TMO])) break; if (_sp > XB_SPIN_CAP) { atomicAdd(&(bar)[XB_TMO], 1u); break; } } } } while (0)

struct XcdBarrier {
    unsigned* bar; unsigned x;
    volatile LAS unsigned* st;
};

__device__ __forceinline__ XcdBarrier xcd_barrier_post(unsigned* bar, volatile LAS unsigned* st) {
    XcdBarrier b; b.bar = bar; b.x = xb_xcc_id(); b.st = st;
    if (threadIdx.x == 0) (void)xb_add(&bar[XB_XCNT(b.x)], 1u);
    return b;
}
__device__ __forceinline__ void xcd_barrier_complete(unsigned* bar, unsigned x, unsigned& nloc, unsigned& nx) {
    const unsigned G = gridDim.x * gridDim.y * gridDim.z;
    unsigned sum, cnt, mine, sp = 0u;
    for (;;) {
        sum = 0u; cnt = 0u; mine = 0u;
#pragma unroll
        for (unsigned j = 0; j < 16; ++j) { const unsigned c = xb_ld(&bar[XB_XCNT(j)]); sum += c; cnt += (c > 0u) ? 1u : 0u; mine = (j == x) ? c : mine; }
        if (sum == G) break;
        __builtin_amdgcn_s_sleep(1);
        if ((++sp & 255u) == 0u) { if (xb_ld(&bar[XB_TMO])) break; if (sp > XB_SPIN_CAP) { atomicAdd(&bar[XB_TMO], 1u); break; } }
    }
    nloc = mine > 0u ? mine : 1u; nx = cnt > 0u ? cnt : 1u;
}

__device__ __forceinline__ void xcd_barrier(const XcdBarrier& b) {
    asm volatile("s_waitcnt vmcnt(0)" ::: "memory");
    __syncthreads();
    if (threadIdx.x == 0) {
        unsigned* bar = b.bar;
        __builtin_amdgcn_s_waitcnt(0);
        unsigned nloc = b.st[0], nx = b.st[1];
        if (nloc == 0u) { xcd_barrier_complete(bar, b.x, nloc, nx); b.st[0] = nloc; b.st[1] = nx; }
        const unsigned old = xb_add(&bar[XB_XSUB(b.x)], 1u);
        const unsigned gen = old / nloc;
        if (old + 1u == (gen + 1u) * nloc) {
            __builtin_amdgcn_fence(__ATOMIC_RELEASE, "agent");
            asm volatile("s_waitcnt vmcnt(0)" ::: "memory");
            const unsigned og = xb_add(&bar[XB_TOP], 1u);
            const unsigned tg = og / nx;
            if (og + 1u == (tg + 1u) * nx) xb_add(&bar[XB_TOPGEN], 1u);
            else XB_SPIN(xb_ld(&bar[XB_TOPGEN]) == tg, bar);
            __builtin_amdgcn_fence(__ATOMIC_ACQUIRE, "agent");
            xb_add(&bar[XB_XGEN(b.x)], 1u);
            asm volatile("s_waitcnt vmcnt(0)" ::: "memory");
        } else {
            XB_SPIN(xb_ld(&bar[XB_XGEN(b.x)]) == gen, bar);
            __builtin_amdgcn_fence(__ATOMIC_ACQUIRE, "agent");
            asm volatile("s_waitcnt vmcnt(0)" ::: "memory");
        }
    }
    __syncthreads();
}


__global__ void __launch_bounds__(256, LB2) mega(Params p, int ph_lo, int ph_hi) {
  __shared__ __attribute__((aligned(16))) char smem[SM_TOTAL];
  __shared__ int s_task;
  __shared__ uint4 xb_words;
  if (threadIdx.x == 0) xb_words = make_uint4(0u, 0u, 0u, 0u);
  __syncthreads();
  (void)xcd_barrier_post((unsigned*)(p.ws + WS_BAR), (volatile LAS unsigned*)&xb_words);
  const int bid = blockIdx.x, nb = gridDim.x;

  for (int ph = ph_lo; ph <= ph_hi; ++ph) {
    if (ph > ph_lo) {
      if (ph == ph_lo + 1) cg::this_grid().sync();
      else {
        XcdBarrier xb2;
        xb2.bar = (unsigned*)(((const Params*)__builtin_amdgcn_kernarg_segment_ptr())->ws + WS_BAR);
        xb2.x = xb_xcc_id();
        xb2.st = (volatile LAS unsigned*)&xb_words;
        xcd_barrier(xb2);
      }
    }
    const int nrep = (REP_PH >= 0 && ph == REP_PH) ? 2 : 1;
    for (int rep = 0; rep < nrep; ++rep) {
    if (rep) cg::this_grid().sync();
    const int tid = otid(), lane = tid & 63, w = tid >> 6, r = lane & 31, h = lane >> 5;
    const int vb = (bid & 7) * (nb >> 3) + (bid >> 3);
    int zoff_;
    asm volatile("s_mov_b32 %0, 0" : "=s"(zoff_));
    const Params& p = *(const Params*)((const char*)__builtin_amdgcn_kernarg_segment_ptr() + zoff_);
    char* ws = p.ws;
    char* const ws_ph = ws;
    bf16* XN = (bf16*)(ws + WS_XN);
    bf16* P = (bf16*)(ws + WS_P);
    bf16* MIXED = (bf16*)(ws + WS_MIXED);
    float* ROPEC = (float*)(ws + WS_ROPEC);
    float* ROPES = (float*)(ws + WS_ROPES);
    float* hbuf = p.out;
    int* CTR = (int*)(ws + WS_CTR);
    auto fetch_task = [&](int* ctr) {
      __syncthreads();
      if (tid == 0) s_task = atomicAdd(ctr, 1);
      __syncthreads();
      return s_task;
    };
    const int layer = ph == 0 ? 0 : (ph - 1) / 6;
    const int sub = ph == 0 ? -1 : (ph - 1) % 6;
    const bool even = (layer & 1) == 0;
    const int li = layer >> 1;
    const int NP = even ? NPE : NPO;

    if ((PHM & 1) && (ph == 0 || sub == 5)) {
      if (ph == 0) {
        if (bid == 0 && tid < 64) CTR[tid] = 0;
        if (bid == 1 % nb && tid < 128) {
          int mx = p.pos[tid * 64];
          for (int q = 1; q < 64; ++q) mx = max(mx, p.pos[tid * 64 + q]);
          ((int*)(ws + WS_POSMAX))[tid] = mx;
        }
        for (int i = bid * 256 + tid; i < L * 32; i += nb * 256) {
          int t = i >> 5, f = i & 31;
          float inv = powf(10000.f, -(float)f / 32.f);
          float ang = (float)p.pos[t] * inv;
          ROPEC[i] = cosf(ang);
          ROPES[i] = sinf(ang);
        }
        for (int row = bid * 4 + w; row < 256; row += nb * 4)
          norm_row_bf16(p.mem + (size_t)row * DM, p.mem_norm_g, (bf16*)(ws + WS_MEMN) + (size_t)row * DM, lane);
      }
      const int nl = ph == 0 ? 0 : layer + 1;
      if (nl < 4) {
        const float* src = ph == 0 ? p.x : hbuf;
        for (int row = bid * 4 + w; row < L; row += nb * 4)
          norm_row_bf16(src + (size_t)row * DM, p.norm_g + nl * DM, XN + (size_t)row * DM, lane);
      } else {
        for (int row = bid * 4 + w; row < L; row += nb * 4) norm_row_f32(hbuf + (size_t)row * DM, p.final_norm_g, lane);
      }
    }
    if ((PHM & 4) && sub == 0) {
      const int ntn = (NP / 128 + 1) / 2;
      const int n_in = 64 * ntn;
      const bf16* Win = (const bf16*)(ws + WS_WIN);
      for (int t = vb; t < n_in + 16; t += nb) {
        if (t < n_in) {
          int tm, tn;
          tile_map(t, ntn, tm, tn);
          const int m0 = tm * 128;
          int n0 = tn * 256;
          const int nhalf = (n0 + 128 < NP) ? 2 : 1;
          ALin af{XN + (size_t)m0 * DM, DM};
          if (even) {
            gemm_tile2(af, Win + (size_t)n0 * DM, DM, DM, smem, n0, nhalf, [&](const float* Cs) {
              if (n0 >= 4096 && n0 < 5120) {
                bf16* VT = (bf16*)(ws + WS_VTFOX);
                epi_cols(Cs, [&](int col, int r8, const float* v) {
                  *(uint4*)(VT + (size_t)(n0 - 4096 + col) * L + m0 + r8) = pack8(v);
                });
              } else if (n0 == 7168) {
                float* FL = (float*)(ws + WS_FLOG);
                for (int i = tid; i < 128 * 8; i += 256) {
                  int row = i >> 3, c = i & 7;
                  FL[(size_t)(m0 + row) * 8 + c] = Cs[row * 132 + c];
                }
              } else {
                epi_rows(Cs, [&](int row, int cc, const float* v) {
                  *(uint4*)(P + (size_t)(m0 + row) * NPE + n0 + cc) = pack8(v);
                });
              }
            });
          } else {
            gemm_tile2(af, Win + (size_t)n0 * DM, DM, DM, smem, n0, nhalf, [&](const float* Cs) {
              if (n0 == 3840 || n0 == 3968 || n0 == 4352 || n0 == 4480) {
                bf16* VT = (n0 < 4096) ? (bf16*)(ws + WS_VTSLC) + (size_t)(n0 - 3840) * L
                                       : (bf16*)(ws + WS_VTWIN) + (size_t)(n0 - 4352) * L;
                epi_cols(Cs, [&](int col, int r8, const float* v) {
                  *(uint4*)(VT + (size_t)col * L + m0 + r8) = pack8(v);
                });
              } else if (n0 == 6656) {
                epi_rope(Cs, 0, m0, ROPEC, ROPES, 1.f, [&](int row, int cl, const float* v) {
                  *(uint4*)(P + (size_t)(m0 + row) * NPO + 6656 + cl) = pack8(v);
                });
                float* GT = (float*)(ws + WS_FLOG);
                for (int i = tid; i < 128 * 24; i += 256) {
                  int row = i / 24, c = i % 24;
                  GT[(size_t)(m0 + row) * 24 + c] = Cs[row * 132 + 64 + c];
                }
              } else {
                epi_rows(Cs, [&](int row, int cc, const float* v) {
                  *(uint4*)(P + (size_t)(m0 + row) * NPO + n0 + cc) = pack8(v);
                });
              }
            });
          }
        } else {
          const int t2 = t - n_in;
          const int m0 = (t2 >> 3) * 128, n0 = (t2 & 7) * 128;
          ALin af{(const bf16*)(ws + WS_MEMN) + (size_t)m0 * DM, DM};
          gemm_tile(af, (const bf16*)(ws + WS_WMEM) + (size_t)n0 * DM, DM, DM, smem, [&](const float* Cs) {
            if (n0 < 512) {
              bf16* MK = (bf16*)(ws + WS_MEMK);
              epi_rows(Cs, [&](int row, int cc, const float* v) {
                *(uint4*)(MK + (size_t)(m0 + row) * 512 + n0 + cc) = pack8(v);
              });
            } else {
              bf16* MV = (bf16*)(ws + WS_MEMVT);
              epi_cols(Cs, [&](int col, int r8, const float* v) {
                *(uint4*)(MV + (size_t)(n0 - 512 + col) * 256 + m0 + r8) = pack8(v);
              });
            }
          });
        }
      }
    }

    auto mem_attn_task = [&](int t) {
      const int tid = otid(), lane = tid & 63, w = tid >> 6, r = lane & 31, h = lane >> 5;
      (void)tid;
      const int qt = t >> 2, head = t & 3;
      const int tq = qt * 128 + w * 32 + r;
      const int qcol = even ? 6144 : 5632, gcol = even ? 6656 : 6144;
      bf16x8 qf[8];
      load_q<128>(qf, P + (size_t)tq * NP + qcol + head * 128, h);
      f32x16 o[4];
      zero_o(o);
      float m = NEG, l = 0.f;
      CtxMem ctx{0.08838834764831845f * LOG2E};
      attn_run<128, true, true>(qf, o, m, l, (const bf16*)(ws + WS_MEMK) + head * 128, 512, nullptr, 0,
                          (const bf16*)(ws + WS_MEMVT) + (size_t)head * 128 * 256, 256, 0, ctx, smem);
      float lt = l + __shfl_xor(l, 32);
      store_out_A(o, 1.f / lt, P + (size_t)tq * NP + gcol + head * 128, MIXED + (size_t)tq * MIXW + 2048 + head * 128, h);
    };

    if ((PHM & 8) && sub == 1 && even) {
      const int cw = cvt_set_count(p, SET_OUT, layer);
      const int n_s5 = 1024, n_cum = 64, n_mem = 256;
      for (int t = bid; t < n_mem + n_s5 + n_cum + cw; t += nb) {
        if (t < n_mem) {
          mem_attn_task(t);
        } else if (t < n_mem + n_s5) {
          const int t2 = t - n_mem;
          const int ch = t2 >> 4, gq = t2 & 15;
          float* us = (float*)smem;
          __syncthreads();
          for (int i = tid; i < 128 * 8; i += 256) {
            int tt = i >> 3, c8 = (i & 7) * 8;
            uint4 u = *(const uint4*)(P + (size_t)(ch * 128 + tt) * NPE + gq * 64 + c8);
            float* d = us + tt * 64 + c8;
            d[0] = bflo(u.x); d[1] = bfhi(u.x); d[2] = bflo(u.y); d[3] = bfhi(u.y);
            d[4] = bflo(u.z); d[5] = bfhi(u.z); d[6] = bflo(u.w); d[7] = bfhi(u.w);
          }
          __syncthreads();
          const float* S5P = (const float*)(ws + WS_S5P);
          const int gp = (gq * 4 + w) * 64 + lane;
          const float ar = S5P[gp], ai = S5P[4096 + gp];
          float bbr[16], bbi[16];
#pragma unroll
          for (int c = 0; c < 16; ++c) { bbr[c] = S5P[16384 + gp * 16 + c]; bbi[c] = S5P[16384 + 65536 + gp * 16 + c]; }
          float xr = 0.f, xi = 0.f;
          for (int tt = 0; tt < 128; ++tt) {
            const float* up = us + tt * 64 + w * 16;
            float bur = 0.f, bui = 0.f;
#pragma unroll
            for (int c = 0; c < 16; ++c) { float uv = up[c]; bur += bbr[c] * uv; bui += bbi[c] * uv; }
            float nxr = ar * xr - ai * xi + bur;
            float nxi = ar * xi + ai * xr + bui;
            xr = nxr; xi = nxi;
          }
          float2* E = (float2*)(ws + WS_S5E);
          E[(size_t)ch * 4096 + gp] = make_float2(xr, xi);
        } else if (t < n_mem + n_s5 + n_cum) {
          const int ch = t - n_mem - n_s5;
          const float* FL = (const float*)(ws + WS_FLOG);
          float* CUML = (float*)(ws + WS_CUML);
          float* CT = (float*)(ws + WS_CT);
#pragma unroll
          for (int hh = 0; hh < 2; ++hh) {
            const int head = w * 2 + hh;
            const float bf = p.fox_b_f[li * 8 + head];
            const int t0 = ch * 128 + lane * 2;
            float x0 = FL[(size_t)t0 * 8 + head] + bf, x1 = FL[(size_t)(t0 + 1) * 8 + head] + bf;
            float v0 = x0 >= 0.f ? -log1pf(expf(-x0)) : x0 - log1pf(expf(x0));
            float v1 = x1 >= 0.f ? -log1pf(expf(-x1)) : x1 - log1pf(expf(x1));
            float s = v0 + v1;
            float inc = s;
#pragma unroll
            for (int o = 1; o < 64; o <<= 1) {
              float n = __shfl_up(inc, o);
              if (lane >= o) inc += n;
            }
            float excl = inc - s;
            CUML[(size_t)head * L + t0] = excl + v0;
            CUML[(size_t)head * L + t0 + 1] = excl + v0 + v1;
            if (lane == 63) CT[head * 64 + ch] = inc;
          }
        } else {
          cvt_set_task(p, SET_OUT, layer, t - n_mem - n_s5 - n_cum, smem);
        }
      }
    }
    if ((PHM & 16) && sub == 2 && even) {
      const int n_fox = 512, n_s5 = 1024;
      for (;;) {
        const int t = fetch_task(CTR + ph);
        if (t >= n_fox + n_s5) break;
        const int tid = otid(), lane = tid & 63, w = tid >> 6, r = lane & 31, h = lane >> 5;
        int zt_;
        asm volatile("s_mov_b32 %0, 0" : "=s"(zt_));
        char* const ws = ws_ph + zt_;
        if (t < n_fox) {
          const int qt = 63 - (t >> 3), head = t & 7;
          const int q0w = qt * 128 + w * 32, tq = q0w + r;
          float* cpre = (float*)(smem + AT_X0);
          __syncthreads();
          if (tid < 64) {
            const float v0 = ((const float*)(ws + WS_CT))[head * 64 + tid];
            float inc = v0;
#pragma unroll
            for (int of = 1; of < 64; of <<= 1) {
              float n = __shfl_up(inc, of);
              if (tid >= of) inc += n;
            }
            cpre[tid] = inc - v0;
          }
          __syncthreads();
          const float* cuml = (const float*)(ws + WS_CUML) + (size_t)head * L;
          bf16x8 qf[8];
          load_q<128>(qf, P + (size_t)tq * NPE + 2048 + head * 128, h);
          f32x16 o[4];
          zero_o(o);
          float m = NEG, l = 0.f;
          CtxFox ctx{tq, q0w, 2 * qt + 1, 0.08838834764831845f * LOG2E, cuml, cpre};
          attn_run<128, true, true>(qf, o, m, l, P + 3072 + head * 128, NPE, nullptr, 0,
                              (const bf16*)(ws + WS_VTFOX) + (size_t)head * 128 * L, L, 0, ctx, smem);
          float lt = l + __shfl_xor(l, 32);
          store_out_A(o, 1.f / lt, P + (size_t)tq * NPE + 5120 + head * 128, MIXED + (size_t)tq * MIXW + 1024 + head * 128, h);
        } else {
          const int t2 = t - n_fox;
          const int ch = t2 >> 4, gq = t2 & 15;
          float* us = (float*)smem;
          float* xs = (float*)(smem + 32768) + w * 16 * 132;
          __syncthreads();
          for (int i = tid; i < 128 * 8; i += 256) {
            int tt = i >> 3, c8 = (i & 7) * 8;
            uint4 u = *(const uint4*)(P + (size_t)(ch * 128 + tt) * NPE + gq * 64 + c8);
            float* d = us + tt * 64 + c8;
            d[0] = bflo(u.x); d[1] = bfhi(u.x); d[2] = bflo(u.y); d[3] = bfhi(u.y);
            d[4] = bflo(u.z); d[5] = bfhi(u.z); d[6] = bflo(u.w); d[7] = bfhi(u.w);
          }
          __syncthreads();
          const float* S5P = (const float*)(ws + WS_S5P);
          const int g = gq * 4 + w;
          const int gp = g * 64 + lane;
          const float ar = S5P[gp], ai = S5P[4096 + gp];
          const float atr = S5P[8192 + gp], ati = S5P[12288 + gp];
          float xr = 0.f, xi = 0.f;
          {
            const float2* E = (const float2*)(ws + WS_S5E) + gp;
#define CSTEP(e) { float nxr = atr * xr - ati * xi + e.x; float nxi = atr * xi + ati * xr + e.y; xr = nxr; xi = nxi; }
            int c = 0;
            for (; c + 8 <= ch; c += 8) {
              float2 e0 = E[(size_t)(c + 0) * 4096], e1 = E[(size_t)(c + 1) * 4096], e2 = E[(size_t)(c + 2) * 4096],
                     e3 = E[(size_t)(c + 3) * 4096], e4 = E[(size_t)(c + 4) * 4096], e5 = E[(size_t)(c + 5) * 4096],
                     e6 = E[(size_t)(c + 6) * 4096], e7 = E[(size_t)(c + 7) * 4096];
              CSTEP(e0) CSTEP(e1) CSTEP(e2) CSTEP(e3) CSTEP(e4) CSTEP(e5) CSTEP(e6) CSTEP(e7)
            }
            for (; c < ch; ++c) {
              float2 e = E[(size_t)c * 4096];
              CSTEP(e)
            }
#undef CSTEP
          }
          float bbr[16], bbi[16];
#pragma unroll
          for (int c = 0; c < 16; ++c) { bbr[c] = S5P[16384 + gp * 16 + c]; bbi[c] = S5P[16384 + 65536 + gp * 16 + c]; }
          const int chn = lane & 15, kq = lane >> 4;
          float cb[32];
          {
            const float* cre = p.c_re + ((size_t)li * 64 + g) * 1024 + chn * 64;
            const float* cim = p.c_im + ((size_t)li * 64 + g) * 1024 + chn * 64;
#pragma unroll
            for (int ks = 0; ks < 16; ++ks) { cb[ks] = cre[4 * ks + kq]; cb[16 + ks] = -cim[4 * ks + kq]; }
          }
          const float dsk = p.s5_d[li * 1024 + g * 16 + chn];
          bf16* Z = (bf16*)(ws + WS_Z);
          for (int sc = 0; sc < 8; ++sc) {
#pragma unroll 4
            for (int tt = 0; tt < 16; ++tt) {
              const float* up = us + (sc * 16 + tt) * 64 + w * 16;
              float bur = 0.f, bui = 0.f;
#pragma unroll
              for (int c = 0; c < 16; ++c) { float uv = up[c]; bur += bbr[c] * uv; bui += bbi[c] * uv; }
              float nxr = ar * xr - ai * xi + bur;
              float nxi = ar * xi + ai * xr + bui;
              xr = nxr; xi = nxi;
              xs[tt * 132 + lane] = xr;
              xs[tt * 132 + 64 + lane] = xi;
            }
            __syncthreads();
            f32x4 y = {0.f, 0.f, 0.f, 0.f};
#pragma unroll
            for (int ks = 0; ks < 32; ++ks) {
              float a = xs[chn * 132 + 4 * ks + kq];
              y = __builtin_amdgcn_mfma_f32_16x16x4f32(a, cb[ks], y, 0, 0, 0);
            }
#pragma unroll
            for (int i = 0; i < 4; ++i) {
              int tt = 4 * kq + i;
              float uv = us[(sc * 16 + tt) * 64 + w * 16 + chn];
              float yy = y[i] + dsk * uv;
              Z[(size_t)(ch * 128 + sc * 16 + tt) * 1024 + g * 16 + chn] = f2bf(gelu_t(yy));
            }
            __syncthreads();
          }
        }
      }
    }
    if ((PHM & 32) && sub == 3 && even) {
      const bf16* Z = (const bf16*)(ws + WS_Z);
      for (int t = vb; t < 64 * 8; t += nb) {
        int tm, tn;
        tile_map(t, 8, tm, tn);
        const int m0 = tm * 128, n0 = tn * 128;
        ALin af{Z + (size_t)m0 * 1024, 1024};
        gemm_tile(af, (const bf16*)(ws + WS_WMISC + WM_GLU) + (size_t)n0 * 1024, 1024, 1024, smem, [&](const float* Cs) {
          epi_rows(Cs, [&](int row, int cc, const float* v) {
            uint4 zu = *(const uint4*)(Z + (size_t)(m0 + row) * 1024 + n0 + cc);
            uint4 gu = *(const uint4*)(P + (size_t)(m0 + row) * NPE + 1024 + n0 + cc);
            float zz[8] = {bflo(zu.x), bfhi(zu.x), bflo(zu.y), bfhi(zu.y), bflo(zu.z), bfhi(zu.z), bflo(zu.w), bfhi(zu.w)};
            float gg[8] = {bflo(gu.x), bfhi(gu.x), bflo(gu.y), bfhi(gu.y), bflo(gu.z), bfhi(gu.z), bflo(gu.w), bfhi(gu.w)};
            float o[8];
#pragma unroll
            for (int e = 0; e < 8; ++e) o[e] = zz[e] * sigm(v[e]) * silu(gg[e]);
            *(uint4*)(MIXED + (size_t)(m0 + row) * MIXW + n0 + cc) = pack8(o);
          });
        });
      }
    }
    if ((PHM & 64) && sub == 1 && !even) {
      const int cw = cvt_set_count(p, SET_OUT, layer);
      const int n_c1 = 32, n_q = 64 * 12, n_kv = 64 * 16, n_mem = 0;
      float* rsx = (float*)(smem + SM_EXTRA);
      for (int t = vb; t < n_c1 + n_q + n_kv + n_mem + cw; t += nb) {
        if (t < n_c1) {
          const int which = t >> 4, tm = (t >> 1) & 7, tn = t & 1;
          const int m0 = tm * 128, n0 = tn * 128;
          __syncthreads();
          if (tid < 128) {
            const float* CB = (const float*)(ws + WS_CMPB) + which * 16 * 256 + n0 + tid;
            float b = 0.f;
            for (int q = 0; q < 16; ++q) b += CB[q * 256];
            rsx[tid] = b;
          }
          ACmp af{P + (which ? 3328 : 3072), m0};
          bf16* HID = (bf16*)(ws + WS_HID) + (size_t)which * 1024 * 256;
          gemm_tile(af, (const bf16*)(ws + WS_WMISC + WM_W1) + (size_t)which * 256 * 4096 + (size_t)n0 * 4096, 4096, 4096,
                    smem, [&](const float* Cs) {
                      epi_rows(Cs, [&](int row, int cc, const float* v) {
                        float o[8];
#pragma unroll
                        for (int e = 0; e < 8; ++e) o[e] = gelu_t(v[e] + rsx[cc + e]);
                        *(uint4*)(HID + (size_t)(m0 + row) * 256 + n0 + cc) = pack8(o);
                      });
                    });
        } else if (t < n_c1 + n_q + n_kv) {
          const int t2 = t - n_c1;
          const bool isq = t2 < n_q;
          const int t3 = isq ? t2 : t2 - n_q;
          const int ntn = isq ? 12 : 16;
          int tm, tn;
          tile_map(t3, ntn, tm, tn);
          const int m0 = tm * 128, n0 = tn * 128;
          const bf16* Ab = P + (size_t)m0 * NPO + (isq ? 0 : 512);
          __syncthreads();
          for (int r8 = 0; r8 < 4; ++r8) {
            float ssq[8];
#pragma unroll
            for (int q = 0; q < 8; ++q) {
              int row = w * 32 + r8 * 8 + q;
              uint4 u = *(const uint4*)(Ab + (size_t)row * NPO + lane * 8);
              float a0 = bflo(u.x), a1 = bfhi(u.x), a2 = bflo(u.y), a3 = bfhi(u.y), a4 = bflo(u.z), a5 = bfhi(u.z),
                    a6 = bflo(u.w), a7 = bfhi(u.w);
              ssq[q] = a0 * a0 + a1 * a1 + a2 * a2 + a3 * a3 + a4 * a4 + a5 * a5 + a6 * a6 + a7 * a7;
            }
#pragma unroll
            for (int q = 0; q < 8; ++q) {
              float ss = wave_sum(ssq[q]);
              if (lane == 0) rsx[w * 32 + r8 * 8 + q] = rsqrtf(ss * (1.f / 512.f) + EPS);
            }
          }
          ALin af{Ab, NPO};
          if (isq) {
            bf16* QM = (bf16*)(ws + WS_QMLA);
            gemm_tile(af, (const bf16*)(ws + WS_WMISC + WM_UQ) + (size_t)n0 * 512, 512, 512, smem, [&](const float* Cs) {
              const int md = n0 % 192;
              const int ropehalf = md == 128 ? 0 : (md == 64 ? 1 : -1);
              epi_rows(Cs, [&](int row, int cc, const float* v) {
                if ((cc >> 6) == ropehalf) return;
                float o[8];
                float sc = rsx[row];
#pragma unroll
                for (int e = 0; e < 8; ++e) o[e] = v[e] * sc;
                *(uint4*)(QM + (size_t)(m0 + row) * 1536 + n0 + cc) = pack8(o);
              });
              if (ropehalf >= 0) {
                epi_rope(Cs, ropehalf * 64, m0, ROPEC, ROPES, 1.f, [&](int row, int cl, const float* v) {
                  float o[8];
                  float sc = rsx[row];
#pragma unroll
                  for (int e = 0; e < 8; ++e) o[e] = v[e] * sc;
                  *(uint4*)(QM + (size_t)(m0 + row) * 1536 + n0 + ropehalf * 64 + cl) = pack8(o);
                });
              }
            });
          } else {
            gemm_tile(af, (const bf16*)(ws + WS_WMISC + WM_UKV) + (size_t)n0 * 512, 512, 512, smem, [&](const float* Cs) {
              const int head = n0 >> 8, part = (n0 >> 7) & 1;
              if (part == 0) {
                bf16* KM = (bf16*)(ws + WS_KMLA);
                epi_rows(Cs, [&](int row, int cc, const float* v) {
                  float o[8];
                  float sc = rsx[row];
#pragma unroll
                  for (int e = 0; e < 8; ++e) o[e] = v[e] * sc;
                  *(uint4*)(KM + (size_t)(m0 + row) * 1024 + head * 128 + cc) = pack8(o);
                });
              } else {
                bf16* VT = (bf16*)(ws + WS_VTMLA);
                epi_cols(Cs, [&](int col, int r8, const float* v) {
                  float o[8];
#pragma unroll
                  for (int e = 0; e < 8; ++e) o[e] = v[e] * rsx[r8 + e];
                  *(uint4*)(VT + (size_t)(head * 128 + col) * L + m0 + r8) = pack8(o);
                });
              }
            });
          }
        } else if (t < n_c1 + n_q + n_kv + n_mem) {
          mem_attn_task(t - n_c1 - n_q - n_kv);
        } else {
          cvt_set_task(p, SET_OUT, layer, t - n_c1 - n_q - n_kv - n_mem, smem);
        }
      }
    }
    if ((PHM & 128) && sub == 2 && !even) {
      const int n_c2 = 16, n_mem2 = 256;
      for (int t = bid; t < n_c2 + n_mem2; t += nb) {
        if (t >= n_c2) {
          mem_attn_task(t - n_c2);
        } else {
          const int t2 = t;
          const int which = t2 >> 3, m0 = (t2 & 7) * 128;
          ALin af{(const bf16*)(ws + WS_HID) + (size_t)which * 1024 * 256 + (size_t)m0 * 256, 256};
          gemm_tile(af, (const bf16*)(ws + WS_WMISC + WM_W2) + (size_t)which * 128 * 256, 256, 256, smem, [&](const float* Cs) {
            if (which == 0) {
              bf16* KC = (bf16*)(ws + WS_KC);
              epi_rows(Cs, [&](int row, int cc, const float* v) {
                int gr = m0 + row;
                int n = gr >> 1, g = gr & 1;
                *(uint4*)(KC + ((size_t)g * 512 + n) * 128 + cc) = pack8(v);
              });
            } else {
              bf16* VC = (bf16*)(ws + WS_VCT);
              for (int i = tid; i < 128 * 128; i += 256) {
                int row = i & 127, col = i >> 7;
                int gr = m0 + row;
                int n = gr >> 1, g = gr & 1;
                VC[((size_t)g * 128 + col) * 512 + n] = f2bf(Cs[row * 132 + col]);
              }
            }
          });
        }
      }
    }
    if ((PHM & 256) && sub == 3 && !even) {
      const int* pos = p.pos;
      float* lut = (float*)(smem + AT_X0);
      float* imp = (float*)(smem + AT_IMP);
      unsigned* sel = (unsigned*)(smem + AT_SEL);
      const float* GT = (const float*)(ws + WS_FLOG);
      float* NSAO = (float*)(ws + WS_NSAO);
      for (;;) {
        const int tt_ = fetch_task(CTR + ph);
        if (tt_ >= 1024) break;
        const int t = tt_ >> 1;
        const int tid = otid(), lane = tid & 63, w = tid >> 6, r = lane & 31, h = lane >> 5;
        int zt_;
        asm volatile("s_mov_b32 %0, 0" : "=s"(zt_));
        char* const ws = ws_ph + zt_;
        if ((tt_ & 1) == 0) {
          const int qt = 63 - (t >> 3), head = t & 7;
          const int q0w = qt * 128 + w * 32, tq = q0w + r;
          bf16x8 qf[12];
          load_q<192>(qf, (const bf16*)(ws + WS_QMLA) + (size_t)tq * 1536 + head * 192, h);
          f32x16 o[4];
          zero_o(o);
          float m = NEG, l = 0.f;
          CtxCausal ctx{tq, q0w, 2 * qt + 1, 0.07216878364870322f * LOG2E};
          attn_run<192, true, true>(qf, o, m, l, (const bf16*)(ws + WS_KMLA) + head * 128, 1024, P + 6656, NPO,
                              (const bf16*)(ws + WS_VTMLA) + (size_t)head * 128 * L, L, 0, ctx, smem);
          float lt = l + __shfl_xor(l, 32);
          store_out_A(o, 1.f / lt, P + (size_t)tq * NPO + 1024 + head * 128, MIXED + (size_t)tq * MIXW + head * 128, h);
          continue;
        }
        const int qt = 255 - (t >> 1), g = t & 1;
        const int q0 = qt * 32;
        const int hr = r >> 3, qi = r & 7;
        const int ql = w * 8 + qi;
        const int tq = q0 + ql;
        const int head = g * 4 + hr;
        const int posq = pos[tq];
        __syncthreads();
        for (int i = tid; i < 4 * 800; i += 256) {
          int rr = i / 800, n = i % 800;
          int b;
          if (n < 16) b = n;
          else {
            float lr = logf((float)n / 16.f) / 4.1588830833596715f;
            b = 16 + (int)(lr * 16.f);
            if (b > 31) b = 31;
          }
          lut[i] = p.t5[b * 8 + g * 4 + rr] * LOG2E;
        }
        for (int i = tid; i < 32 * 132; i += 256) imp[i] = 0.f;
        __syncthreads();
        const float* lutr = lut + hr * 800;
        bf16x8 qf[8];
        load_q<128>(qf, P + (size_t)tq * NPO + 2048 + head * 128, h);
        const float sc = 0.08838834764831845f * LOG2E;
        f32x16 o[4];
        float* orow = NSAO + (size_t)tq * 1024 + head * 128;

        const int ncv = min(q0 / 16 + 1, 511);
        const int last_c = (ncv - 1) >> 6;
        float m = NEG, l = 0.f;
        CtxCmp cc{tq, posq, last_c, sc, lutr, pos, 0.f, imp, ql, false};
        zero_o(o);
        const bf16* KCg = (const bf16*)(ws + WS_KC) + (size_t)g * 512 * 128;
        const bf16* VCg = (const bf16*)(ws + WS_VCT) + (size_t)g * 128 * 512;
        attn_run<128, false, false>(qf, o, m, l, KCg, 128, nullptr, 0, VCg, 512, 0, cc, smem);
        float lt = l + __shfl_xor(l, 32);
        const bool has_c = m > -1e29f;
        float m2 = has_c ? m : 0.f;
        float invl = has_c ? 1.f / lt : 0.f;
        cc.invl = invl; cc.p2 = true;
        float l2 = 0.f;
        attn_run<128, true, false>(qf, o, m2, l2, KCg, 128, nullptr, 0, VCg, 512, 0, cc, smem);
        {
          float gs = sigm(GT[(size_t)tq * 24 + head * 3 + 0]) * invl;
#pragma unroll
          for (int d = 0; d < 4; ++d)
#pragma unroll
            for (int i4 = 0; i4 < 4; ++i4) {
              int dv0 = d * 32 + 8 * i4 + 4 * h;
              float4 v = make_float4(o[d][4 * i4] * gs, o[d][4 * i4 + 1] * gs, o[d][4 * i4 + 2] * gs, o[d][4 * i4 + 3] * gs);
              *(float4*)(orow + dv0) = v;
            }
        }
        __syncthreads();
        for (int q8 = 0; q8 < 8; ++q8) {
          const int qq = w * 8 + q8;
          const int tt = q0 + qq;
          const int cur = tt >> 6;
          const float* ip = imp + qq * 132;
          const int j0 = lane, j1 = lane + 64;
          const bool v0 = j0 <= cur, v1 = j1 <= cur;
          const bool f0 = (j0 == 0) || (j0 == cur) || (j0 == cur - 1);
          const bool f1 = (j1 == cur) || (j1 == cur - 1);
          const int nforced = cur == 0 ? 1 : (cur == 1 ? 2 : 3);
          const int nfree = 16 - nforced;
          const float a0 = ip[j0], a1 = ip[j1];
          int r0 = 0, r1 = 0;
          for (int jj = 0; jj <= cur; ++jj) {
            bool fj = (jj == 0) || (jj == cur) || (jj == cur - 1);
            if (fj) continue;
            float vj = ip[jj];
            r0 += (vj > a0 || (vj == a0 && jj < j0)) ? 1 : 0;
            r1 += (vj > a1 || (vj == a1 && jj < j1)) ? 1 : 0;
          }
          bool s0 = v0 && (f0 || r0 < nfree);
          bool s1 = v1 && (f1 || r1 < nfree);
          unsigned long long b0 = __ballot(s0), b1 = __ballot(s1);
          if (lane == 0) {
            sel[qq * 4 + 0] = (unsigned)b0; sel[qq * 4 + 1] = (unsigned)(b0 >> 32);
            sel[qq * 4 + 2] = (unsigned)b1; sel[qq * 4 + 3] = (unsigned)(b1 >> 32);
          }
        }
        __syncthreads();
        unsigned un0, un1, un2, un3;
        {
          un0 = sel[r * 4 + 0]; un1 = sel[r * 4 + 1]; un2 = sel[r * 4 + 2]; un3 = sel[r * 4 + 3];
#pragma unroll
          for (int of = 1; of < 32; of <<= 1) {
            un0 |= __shfl_xor(un0, of); un1 |= __shfl_xor(un1, of); un2 |= __shfl_xor(un2, of); un3 |= __shfl_xor(un3, of);
          }
          un0 = __builtin_amdgcn_readfirstlane(un0); un1 = __builtin_amdgcn_readfirstlane(un1);
          un2 = __builtin_amdgcn_readfirstlane(un2); un3 = __builtin_amdgcn_readfirstlane(un3);
        }
        {
          const unsigned long long ulo = (unsigned long long)un0 | ((unsigned long long)un1 << 32);
          const unsigned long long uhi = (unsigned long long)un2 | ((unsigned long long)un3 << 32);
          const unsigned long long mlo = (unsigned long long)sel[ql * 4] | ((unsigned long long)sel[ql * 4 + 1] << 32);
          const unsigned long long mhi = (unsigned long long)sel[ql * 4 + 2] | ((unsigned long long)sel[ql * 4 + 3] << 32);
          int pqmin = pos[q0];
          for (int q = 1; q < 32; ++q) pqmin = min(pqmin, pos[q0 + q]);
          const int* posmax = (const int*)(ws + WS_POSMAX);
          zero_o(o);
          m = NEG; l = 0.f;
          {
            CtxSlc cs{tq, posq, sc, lutr, pos, ulo, uhi, mlo, mhi, posmax, pqmin, q0};
            attn_run<128, true, false>(qf, o, m, l, P + 3584 + g * 128, NPO, nullptr, 0,
                                       (const bf16*)(ws + WS_VTSLC) + (size_t)g * 128 * L, L, cs.next(-1), cs, smem);
          }
          {
            CtxSlcFar cf{sc, lutr[799], ulo, uhi, mlo, mhi, posmax, pqmin, q0};
            attn_run<128, true, false>(qf, o, m, l, P + 3584 + g * 128, NPO, nullptr, 0,
                                       (const bf16*)(ws + WS_VTSLC) + (size_t)g * 128 * L, L, cf.next(-1), cf, smem);
          }
          lt = l + __shfl_xor(l, 32);
          float gs = sigm(GT[(size_t)tq * 24 + head * 3 + 1]) / lt;
#pragma unroll
          for (int d = 0; d < 4; ++d)
#pragma unroll
            for (int i4 = 0; i4 < 4; ++i4) {
              int dv0 = d * 32 + 8 * i4 + 4 * h;
              float4 v = *(float4*)(orow + dv0);
              v.x += o[d][4 * i4] * gs; v.y += o[d][4 * i4 + 1] * gs; v.z += o[d][4 * i4 + 2] * gs; v.w += o[d][4 * i4 + 3] * gs;
              *(float4*)(orow + dv0) = v;
            }
        }
        {
          const int kfirst = q0 - 511 > 0 ? (q0 - 511) >> 6 : 0;
          CtxWin cwn{tq, posq, (q0 + 31) >> 6, sc, lutr, pos};
          zero_o(o);
          m = NEG; l = 0.f;
          attn_run<128, true, false>(qf, o, m, l, P + 4096 + g * 128, NPO, nullptr, 0,
                              (const bf16*)(ws + WS_VTWIN) + (size_t)g * 128 * L, L, kfirst, cwn, smem);
          lt = l + __shfl_xor(l, 32);
          float gs = sigm(GT[(size_t)tq * 24 + head * 3 + 2]) / lt;
          const bf16* grow = P + (size_t)tq * NPO + 4608 + head * 128;
          bf16* mrow = MIXED + (size_t)tq * MIXW + 1024 + head * 128;
#pragma unroll
          for (int d = 0; d < 4; ++d)
#pragma unroll
            for (int i4 = 0; i4 < 4; ++i4) {
              int dv0 = d * 32 + 8 * i4 + 4 * h;
              float4 v = *(float4*)(orow + dv0);
              v.x += o[d][4 * i4] * gs; v.y += o[d][4 * i4 + 1] * gs; v.z += o[d][4 * i4 + 2] * gs; v.w += o[d][4 * i4 + 3] * gs;
              uint2 gu = *(const uint2*)(grow + dv0);
              uint2 ou;
              ou.x = pack2(v.x * silu(bflo(gu.x)), v.y * silu(bfhi(gu.x)));
              ou.y = pack2(v.z * silu(bflo(gu.y)), v.w * silu(bfhi(gu.y)));
              *(uint2*)(mrow + dv0) = ou;
            }
        }
      }
    }
    if ((PHM & 2) && (ph == 0 || (sub == 2 && even) || (sub == 3 && !even))) {
      const int nl = ph == 0 ? 0 : layer + 1;
      if (nl < 4) {
        const int n_cv = cvt_next_count(p, nl), n_cv4 = (n_cv + 3) >> 2;
        const bool dyn = ph != 0;
        int t = dyn ? fetch_task(CTR + 32 + ph) : bid;
        while (t < n_cv4) {
          for (int q = 0; q < 4; ++q) {
            const int ci = t * 4 + q;
            if (ci < n_cv) cvt_next(p, smem, nl, ci);
          }
          t = dyn ? fetch_task(CTR + 32 + ph) : t + nb;
        }
      }
    }
    if ((PHM & 512) && sub == 4) {
      const float* hin = layer == 0 ? p.x : hbuf;
      for (int t = vb; t < 64 * 8; t += nb) {
        int tm, tn;
        tile_map(t, 8, tm, tn);
        const int m0 = tm * 128;
        int n0 = tn * 256;
        ALin af{MIXED + (size_t)m0 * MIXW, MIXW};
        gemm_tile2(af, (const bf16*)(ws + WS_WOUT) + (size_t)n0 * MIXW, MIXW, MIXW, smem, n0, 2, [&](const float* Cs) {
          const int tid2 = otid();
#pragma unroll
          for (int j = 0; j < 16; ++j) {
            int c = tid2 + 256 * j;
            int row = c >> 5, cc = (c & 31) * 4;
            float4 a = *(const float4*)(Cs + row * 132 + cc);
            float4 hv = *(const float4*)(hin + (size_t)(m0 + row) * DM + n0 + cc);
            hv.x += a.x; hv.y += a.y; hv.z += a.z; hv.w += a.w;
            *(float4*)(hbuf + (size_t)(m0 + row) * DM + n0 + cc) = hv;
          }
        });
      }
    }
    }
  }
}

extern "C" void kernel_launch(void* const* d_in, const int* in_sizes, int n_in, void* d_out, int out_size, void* d_ws,
                              size_t ws_size, hipStream_t stream) {
  Params p{};
  p.x = (const float*)d_in[0]; p.mem = (const float*)d_in[1]; p.pos = (const int*)d_in[2];
  p.norm_g = (const float*)d_in[3]; p.mem_norm_g = (const float*)d_in[4]; p.final_norm_g = (const float*)d_in[5];
  p.t5 = (const float*)d_in[6]; p.w_out = (const float*)d_in[7]; p.mem_w_kv = (const float*)d_in[8];
  p.even_w_in = (const float*)d_in[9]; p.lam_re = (const float*)d_in[10]; p.lam_im = (const float*)d_in[11];
  p.log_dt = (const float*)d_in[12]; p.b_re = (const float*)d_in[13]; p.b_im = (const float*)d_in[14];
  p.c_re = (const float*)d_in[15]; p.c_im = (const float*)d_in[16]; p.s5_d = (const float*)d_in[17];
  p.w_glu = (const float*)d_in[18]; p.fox_b_f = (const float*)d_in[19]; p.odd_w_in = (const float*)d_in[20];
  p.g_cq = (const float*)d_in[21]; p.g_ckv = (const float*)d_in[22]; p.w_uq = (const float*)d_in[23];
  p.w_ukv = (const float*)d_in[24]; p.cmp_pe = (const float*)d_in[25]; p.cmp_w1 = (const float*)d_in[26];
  p.cmp_w2 = (const float*)d_in[27];
  p.out = (float*)d_out; p.ws = (char*)d_ws;
  if (ws_size < WS_END) fprintf(stderr, "workspace too small: %zu < %zu\n", ws_size, (size_t)WS_END);
  static int grid_blocks = 0;
  if (!grid_blocks) {
    int dev = 0, cus = 0, per_cu = 0;
    hipGetDevice(&dev);
    hipDeviceGetAttribute(&cus, hipDeviceAttributeMultiprocessorCount, dev);
    hipOccupancyMaxActiveBlocksPerMultiprocessor(&per_cu, mega, 256, 0);
    if (per_cu > 2) per_cu = 2;
    if (per_cu < 1) per_cu = 1;
    grid_blocks = cus * per_cu;
  }
  (void)hipMemsetAsync((char*)d_ws + WS_BAR, 0, XCD_BAR_WORDS * sizeof(unsigned), stream);
#if MULTI_LAUNCH
  for (int ph = 0; ph <= 24; ++ph) {
    int lo = ph, hi = ph;
    void* args[] = {&p, &lo, &hi};
    hipLaunchCooperativeKernel((void*)mega, dim3(grid_blocks), dim3(256), args, 0, stream);
  }
#else
  int lo = 0, hi = 24;
  void* args[] = {&p, &lo, &hi};
  hipError_t e = hipLaunchCooperativeKernel((void*)mega, dim3(grid_blocks), dim3(256), args, 0, stream);
  if (e != hipSuccess) fprintf(stderr, "cooperative launch failed: %s (grid %d)\n", hipGetErrorString(e), grid_blocks);
#endif
}
```

```cpp
#include <hip/hip_runtime.h>
#include <hip/hip_cooperative_groups.h>
#include <cstdio>
#include <cstdint>
namespace cg = cooperative_groups;

typedef unsigned short bf16;
typedef short bf16x8 __attribute__((ext_vector_type(8)));
typedef float f32x16 __attribute__((ext_vector_type(16)));
typedef float f32x4 __attribute__((ext_vector_type(4)));
typedef __bf16 bf2v __attribute__((ext_vector_type(2)));
typedef float f2v __attribute__((ext_vector_type(2)));

#define DI __device__ __forceinline__
#define MFMA32(a, b, c) __builtin_amdgcn_mfma_f32_32x32x16_bf16((a), (b), (c), 0, 0, 0)

#ifndef LB2
#define LB2 2
#endif
#ifndef REP_PH
#define REP_PH -1
#endif
#ifndef PHM
#define PHM 1023
#endif
#ifndef MULTI_LAUNCH
#define MULTI_LAUNCH 0
#endif

constexpr int L = 8192;
constexpr int DM = 2048;
constexpr int NPE = 7296;
constexpr int NPO = 6784;
constexpr int EVEN_IN = 7176;
constexpr int ODD_IN = 6744;
constexpr int MIXW = 2560;
constexpr int LDX = 2112;
constexpr int LDZ = 1088;
constexpr float LOG2E = 1.4426950408889634f;
constexpr float NEG = -1e30f;
constexpr float EPS = 1e-6f;

constexpr size_t MB = 1024 * 1024;
constexpr size_t WS_WIN = 0;
constexpr size_t WS_WOUT = WS_WIN + 32 * MB;
constexpr size_t WS_WMEM = WS_WOUT + 10 * MB;
constexpr size_t WS_WMISC = WS_WMEM + 4 * MB;
constexpr size_t WS_XN = WS_WMISC + 11 * MB;
constexpr size_t WS_MEMN = WS_XN + 36 * MB;
constexpr size_t WS_P = WS_MEMN + 1 * MB;
constexpr size_t WS_MIXED = WS_P + 114 * MB;
constexpr size_t WS_MEMK = WS_MIXED + 40 * MB;
constexpr size_t WS_MEMVT = WS_MEMK + 256 * 1024;
constexpr size_t WS_ROPEC = WS_MEMVT + 256 * 1024;
constexpr size_t WS_ROPES = WS_ROPEC + 1 * MB;
constexpr size_t WS_FLOG = WS_ROPES + 1 * MB;
constexpr size_t WS_CUML = WS_FLOG + 1 * MB;
constexpr size_t WS_CT = WS_CUML + 256 * 1024;
constexpr size_t WS_S5P = WS_CT + 4096;
constexpr size_t WS_S5E = WS_S5P + 1 * MB;
constexpr size_t WS_CMPB = WS_S5E + 2 * MB;
constexpr size_t WS_CTR = WS_CMPB + 64 * 1024;
constexpr size_t WS_BAR = WS_CTR + 4096;
constexpr size_t WS_POSMAX = WS_BAR + 16384;
constexpr size_t WS_VAR = WS_POSMAX + 4096;
constexpr size_t WS_Z = WS_VAR;
constexpr size_t WS_VTFOX = WS_Z + 18 * MB;
constexpr size_t WS_QMLA = WS_VAR;
constexpr size_t WS_KMLA = WS_QMLA + 24 * MB;
constexpr size_t WS_VTMLA = WS_KMLA + 16 * MB;
constexpr size_t WS_VTSLC = WS_VTMLA + 16 * MB;
constexpr size_t WS_VTWIN = WS_VTSLC + 4 * MB;
constexpr size_t WS_HID = WS_VTWIN + 4 * MB;
constexpr size_t WS_KC = WS_HID + 1 * MB;
constexpr size_t WS_VCT = WS_KC + 256 * 1024;
constexpr size_t WS_NSAO = WS_VCT + 256 * 1024;
constexpr size_t WS_END = WS_NSAO + 32 * MB;
constexpr size_t WM_GLU = 0;
constexpr size_t WM_UQ = 5 * MB / 2;
constexpr size_t WM_UKV = WM_UQ + 1536 * 512 * 2;
constexpr size_t WM_W1 = WM_UKV + 2048 * 512 * 2;
constexpr size_t WM_W2 = WM_W1 + 2 * 256 * 4096 * 2;

constexpr int SM_EXTRA = 73728;
constexpr int SM_TOTAL = 73728 + 1024;

struct Params {
  const float *x, *mem;
  const int* pos;
  const float *norm_g, *mem_norm_g, *final_norm_g, *t5, *w_out, *mem_w_kv, *even_w_in, *lam_re, *lam_im, *log_dt,
      *b_re, *b_im, *c_re, *c_im, *s5_d, *w_glu, *fox_b_f, *odd_w_in, *g_cq, *g_ckv, *w_uq, *w_ukv, *cmp_pe,
      *cmp_w1, *cmp_w2;
  float* out;
  char* ws;
};

DI unsigned pack2(float a, float b) {
  f2v v = {a, b};
  bf2v r = __builtin_convertvector(v, bf2v);
  return __builtin_bit_cast(unsigned, r);
}
DI float bflo(unsigned u) { return __uint_as_float(u << 16); }
DI float bfhi(unsigned u) { return __uint_as_float(u & 0xffff0000u); }
DI float bf2f(bf16 v) { return __uint_as_float(((unsigned)v) << 16); }
DI bf16 f2bf(float f) { return (bf16)(pack2(f, 0.f) & 0xffffu); }
DI int otid() { int z; asm volatile("s_mov_b32 %0, 0" : "=s"(z)); return (int)threadIdx.x + z; }
DI int crow(int i, int h) { return (i & 3) + 8 * (i >> 2) + 4 * h; }
DI float sigm(float x) { return 1.f / (1.f + __expf(-x)); }
DI float silu(float x) { return x * sigm(x); }
DI float gelu_t(float x) {
  float u = 0.7978845608028654f * (x + 0.044715f * x * x * x);
  float e = __expf(2.f * u);
  float t = 1.f - 2.f / (e + 1.f);
  return 0.5f * x * (1.f + t);
}
DI float ex2(float x) { return __builtin_amdgcn_exp2f(x); }
DI float wave_sum(float v) {
#pragma unroll
  for (int o = 32; o > 0; o >>= 1) v += __shfl_xor(v, o);
  return v;
}
DI uint4 pack8(const float* v) {
  uint4 u;
  u.x = pack2(v[0], v[1]); u.y = pack2(v[2], v[3]); u.z = pack2(v[4], v[5]); u.w = pack2(v[6], v[7]);
  return u;
}

struct CvtSeg {
  const float* src; int lds; int sc0; bf16* dst; int dr0; int ncols; int npad; int K; const float* kscale; int ldd;
};
DI int cvt_count(const CvtSeg& s) { return (s.K >> 6) * (s.npad >> 6); }
DI void cvt_tile(const CvtSeg& s, int tile, char* smem) {
  float* T = (float*)smem;
  const int tid = otid();
  const int nkt = s.K >> 6;
  const int kt = tile % nkt, nt = tile / nkt;
  const int k0 = kt * 64, n0 = nt * 64;
  __syncthreads();
#pragma unroll
  for (int i = 0; i < 4; ++i) {
    const int k = i * 16 + (tid >> 4), n4 = (tid & 15) * 4;
    float4 v = make_float4(0.f, 0.f, 0.f, 0.f);
    if (n0 + n4 < s.ncols) {
      v = *(const float4*)(s.src + (size_t)(k0 + k) * s.lds + s.sc0 + n0 + n4);
      if (s.kscale) { float sc = s.kscale[k0 + k]; v.x *= sc; v.y *= sc; v.z *= sc; v.w *= sc; }
    }
    float* d = T + k * 65 + n4;
    d[0] = v.x; d[1] = v.y; d[2] = v.z; d[3] = v.w;
  }
  __syncthreads();
#pragma unroll
  for (int j = 0; j < 2; ++j) {
    int c = tid + 256 * j;
    int n = c >> 3, kc = (c & 7) * 8;
    float v[8];
#pragma unroll
    for (int e = 0; e < 8; ++e) v[e] = T[(kc + e) * 65 + n];
    *(uint4*)(s.dst + (size_t)(s.dr0 + n0 + n) * s.ldd + k0 + kc) = pack8(v);
  }
}

enum { SET_IN_EVEN = 0, SET_IN_ODD, SET_OUT, SET_MEM, SET_MISC_EVEN, SET_MISC_ODD };
DI int cvt_nseg(int set) {
  switch (set) {
    case SET_IN_EVEN: return 3;
    case SET_IN_ODD: return 5;
    case SET_OUT: return 1;
    case SET_MEM: return 1;
    case SET_MISC_EVEN: return 1;
    default: return 6;
  }
}
DI CvtSeg cvt_get(const Params& p, int set, int li, int s) {
  CvtSeg r;
  r.kscale = nullptr;
  char* ws = p.ws;
  if (set == SET_IN_EVEN) {
    r.src = p.even_w_in + (size_t)li * DM * EVEN_IN; r.lds = EVEN_IN; r.K = DM; r.dst = (bf16*)(ws + WS_WIN);
    if (s == 0) { r.sc0 = 0; r.dr0 = 0; r.ncols = 5120; r.npad = 5120; }
    else if (s == 1) { r.sc0 = 5128; r.dr0 = 5120; r.ncols = 2048; r.npad = 2048; }
    else { r.sc0 = 5120; r.dr0 = 7168; r.ncols = 8; r.npad = 128; }
  } else if (set == SET_IN_ODD) {
    r.src = p.odd_w_in + (size_t)li * DM * ODD_IN; r.lds = ODD_IN; r.K = DM; r.dst = (bf16*)(ws + WS_WIN);
    if (s == 0) { r.sc0 = 0; r.dr0 = 0; r.ncols = 1024; r.npad = 1024; }
    else if (s == 1) { r.sc0 = 1088; r.dr0 = 1024; r.ncols = 3584; r.npad = 3584; }
    else if (s == 2) { r.sc0 = 4696; r.dr0 = 4608; r.ncols = 2048; r.npad = 2048; }
    else if (s == 3) { r.sc0 = 1024; r.dr0 = 6656; r.ncols = 64; r.npad = 64; }
    else { r.sc0 = 4672; r.dr0 = 6720; r.ncols = 24; r.npad = 64; }
  } else if (set == SET_OUT) {
    r.src = p.w_out + (size_t)li * MIXW * DM; r.lds = DM; r.K = MIXW; r.dst = (bf16*)(ws + WS_WOUT);
    r.sc0 = 0; r.dr0 = 0; r.ncols = DM; r.npad = DM;
  } else if (set == SET_MEM) {
    r.src = p.mem_w_kv + (size_t)li * DM * 1024; r.lds = 1024; r.K = DM; r.dst = (bf16*)(ws + WS_WMEM);
    r.sc0 = 0; r.dr0 = 0; r.ncols = 1024; r.npad = 1024;
  } else if (set == SET_MISC_EVEN) {
    r.src = p.w_glu + (size_t)li * 1024 * 1024; r.lds = 1024; r.K = 1024; r.dst = (bf16*)(ws + WS_WMISC + WM_GLU);
    r.sc0 = 0; r.dr0 = 0; r.ncols = 1024; r.npad = 1024;
  } else {
    r.sc0 = 0; r.dr0 = 0;
    if (s == 0) {
      r.src = p.w_uq + (size_t)li * 512 * 1536; r.lds = 1536; r.K = 512; r.dst = (bf16*)(ws + WS_WMISC + WM_UQ);
      r.ncols = 1536; r.npad = 1536; r.kscale = p.g_cq + li * 512;
    } else if (s == 1) {
      r.src = p.w_ukv + (size_t)li * 512 * 2048; r.lds = 2048; r.K = 512; r.dst = (bf16*)(ws + WS_WMISC + WM_UKV);
      r.ncols = 2048; r.npad = 2048; r.kscale = p.g_ckv + li * 512;
    } else if (s < 4) {
      int which = s - 2;
      r.src = p.cmp_w1 + (size_t)(li * 2 + which) * 4096 * 256; r.lds = 256; r.K = 4096;
      r.dst = (bf16*)(ws + WS_WMISC + WM_W1) + (size_t)which * 256 * 4096; r.ncols = 256; r.npad = 256;
    } else {
      int which = s - 4;
      r.src = p.cmp_w2 + (size_t)(li * 2 + which) * 256 * 128; r.lds = 128; r.K = 256;
      r.dst = (bf16*)(ws + WS_WMISC + WM_W2) + (size_t)which * 128 * 256; r.ncols = 128; r.npad = 128;
    }
  }
  r.ldd = (set == SET_IN_EVEN || set == SET_IN_ODD) ? LDX : (set == SET_MISC_EVEN ? LDZ : r.K);
  return r;
}
DI int cvt_set_count(const Params& p, int set, int li) {
  int n = 0;
  for (int s = 0; s < cvt_nseg(set); ++s) n += cvt_count(cvt_get(p, set, li, s));
  return n;
}
DI void cvt_set_task(const Params& p, int set, int li, int t, char* smem) {
  const int ns = cvt_nseg(set);
  for (int s = 0; s < ns; ++s) {
    CvtSeg sg = cvt_get(p, set, li, s);
    int c = cvt_count(sg);
    if (t < c) { cvt_tile(sg, t, smem); return; }
    t -= c;
  }
}

DI void norm_row_bf16(const float* __restrict__ src, const float* __restrict__ g, bf16* __restrict__ dst, int lane) {
  float4 v[8];
  float ss = 0.f;
#pragma unroll
  for (int i = 0; i < 8; ++i) {
    v[i] = *(const float4*)(src + (i * 64 + lane) * 4);
    ss += v[i].x * v[i].x + v[i].y * v[i].y + v[i].z * v[i].z + v[i].w * v[i].w;
  }
  ss = wave_sum(ss);
  float r = rsqrtf(ss * (1.f / DM) + EPS);
#pragma unroll
  for (int i = 0; i < 8; ++i) {
    float4 gg = *(const float4*)(g + (i * 64 + lane) * 4);
    uint2 u;
    u.x = pack2(v[i].x * r * gg.x, v[i].y * r * gg.y);
    u.y = pack2(v[i].z * r * gg.z, v[i].w * r * gg.w);
    *(uint2*)(dst + (i * 64 + lane) * 4) = u;
  }
}
DI void norm_row_f32(float* __restrict__ io, const float* __restrict__ g, int lane) {
  float4 v[8];
  float ss = 0.f;
#pragma unroll
  for (int i = 0; i < 8; ++i) {
    v[i] = *(const float4*)(io + (i * 64 + lane) * 4);
    ss += v[i].x * v[i].x + v[i].y * v[i].y + v[i].z * v[i].z + v[i].w * v[i].w;
  }
  ss = wave_sum(ss);
  float r = rsqrtf(ss * (1.f / DM) + EPS);
#pragma unroll
  for (int i = 0; i < 8; ++i) {
    float4 gg = *(const float4*)(g + (i * 64 + lane) * 4);
    float4 o;
    o.x = v[i].x * r * gg.x; o.y = v[i].y * r * gg.y; o.z = v[i].z * r * gg.z; o.w = v[i].w * r * gg.w;
    *(float4*)(io + (i * 64 + lane) * 4) = o;
  }
}

struct ALin {
  const bf16* p; int ld;
  DI const bf16* operator()(int row, int k) const { return p + (size_t)row * ld + k; }
};
struct ACmp {
  const bf16* p; int m0;
  DI const bf16* operator()(int row, int k) const {
    int gr = m0 + row;
    if (gr > 1021) gr = 1021;
    int n = gr >> 1, g = gr & 1;
    return p + (size_t)(16 * n + (k >> 7)) * NPO + g * 128 + (k & 127);
  }
};

template <class AF, class Epi>
DI void gemm_tile(AF af, const bf16* __restrict__ Bt, int ldb, int K, char* smem, Epi epi) {
  const int tid = otid(), lane = tid & 63, w = tid >> 6, r = lane & 31, h = lane >> 5;
  const int wm = w >> 1, wn = w & 1;
  bf16* As = (bf16*)smem;
  bf16* Bs = As + 2 * 128 * 72;
  f32x16 acc[2][2];
#pragma unroll
  for (int a = 0; a < 2; ++a)
#pragma unroll
    for (int b = 0; b < 2; ++b)
#pragma unroll
      for (int i = 0; i < 16; ++i) acc[a][b][i] = 0.f;
  uint4 ra0_0, ra0_1, ra0_2, ra0_3, rb0_0, rb0_1, rb0_2, rb0_3, ra1_0, ra1_1, ra1_2, ra1_3, rb1_0, rb1_1, rb1_2, rb1_3;
#define LD1(S, I, K0)                                                                  \
  {                                                                                    \
    int c = tl + 256 * I;                                                              \
    int row = c >> 3, kc = (c & 7) * 8;                                                \
    ra##S##_##I = *(const uint4*)af(row, (K0) + kc);                                   \
    rb##S##_##I = *(const uint4*)(Bt + (size_t)row * ldb + (K0) + kc);                 \
  }
#define ST1(S, I, BUF)                                                                 \
  {                                                                                    \
    int c = tid + 256 * I;                                                             \
    int row = c >> 3, kc = (c & 7) * 8;                                                \
    *(uint4*)(As + (BUF) * 9216 + row * 72 + kc) = ra##S##_##I;                        \
    *(uint4*)(Bs + (BUF) * 9216 + row * 72 + kc) = rb##S##_##I;                        \
  }
#define GLOAD(S, K0) { const int tl = otid(); LD1(S, 0, K0) LD1(S, 1, K0) LD1(S, 2, K0) LD1(S, 3, K0) }
#define SSTORE(S, BUF) { ST1(S, 0, BUF) ST1(S, 1, BUF) ST1(S, 2, BUF) ST1(S, 3, BUF) }
  auto compute = [&](int buf) {
    const bf16* a_ = As + buf * 9216 + (wm * 64 + r) * 72 + h * 8;
    const bf16* b_ = Bs + buf * 9216 + (wn * 64 + r) * 72 + h * 8;
    bf16x8 fa0, fa1, fb0, fb1, ga0, ga1, gb0, gb1, ha0, ha1, hb0, hb1, ia0, ia1, ib0, ib1;
    fa0 = *(const bf16x8*)(a_ + 0);            fa1 = *(const bf16x8*)(a_ + 32 * 72);
    fb0 = *(const bf16x8*)(b_ + 0);            fb1 = *(const bf16x8*)(b_ + 32 * 72);
    ga0 = *(const bf16x8*)(a_ + 16);           ga1 = *(const bf16x8*)(a_ + 32 * 72 + 16);
    gb0 = *(const bf16x8*)(b_ + 16);           gb1 = *(const bf16x8*)(b_ + 32 * 72 + 16);
    ha0 = *(const bf16x8*)(a_ + 32);           ha1 = *(const bf16x8*)(a_ + 32 * 72 + 32);
    hb0 = *(const bf16x8*)(b_ + 32);           hb1 = *(const bf16x8*)(b_ + 32 * 72 + 32);
    ia0 = *(const bf16x8*)(a_ + 48);           ia1 = *(const bf16x8*)(a_ + 32 * 72 + 48);
    ib0 = *(const bf16x8*)(b_ + 48);           ib1 = *(const bf16x8*)(b_ + 32 * 72 + 48);
    __builtin_amdgcn_sched_barrier(0);
    acc[0][0] = MFMA32(fa0, fb0, acc[0][0]); acc[0][1] = MFMA32(fa0, fb1, acc[0][1]);
    acc[1][0] = MFMA32(fa1, fb0, acc[1][0]); acc[1][1] = MFMA32(fa1, fb1, acc[1][1]);
    acc[0][0] = MFMA32(ga0, gb0, acc[0][0]); acc[0][1] = MFMA32(ga0, gb1, acc[0][1]);
    acc[1][0] = MFMA32(ga1, gb0, acc[1][0]); acc[1][1] = MFMA32(ga1, gb1, acc[1][1]);
    acc[0][0] = MFMA32(ha0, hb0, acc[0][0]); acc[0][1] = MFMA32(ha0, hb1, acc[0][1]);
    acc[1][0] = MFMA32(ha1, hb0, acc[1][0]); acc[1][1] = MFMA32(ha1, hb1, acc[1][1]);
    acc[0][0] = MFMA32(ia0, ib0, acc[0][0]); acc[0][1] = MFMA32(ia0, ib1, acc[0][1]);
    acc[1][0] = MFMA32(ia1, ib0, acc[1][0]); acc[1][1] = MFMA32(ia1, ib1, acc[1][1]);
    __builtin_amdgcn_sched_barrier(0);
  };
  __syncthreads();
  const int nk = K >> 6;
  GLOAD(0, 0);
  SSTORE(0, 0);
  GLOAD(0, 64);
  __syncthreads();
  for (int kt = 0; kt < nk; kt += 2) {
    if (kt + 2 < nk) GLOAD(1, (kt + 2) * 64);
    compute(0);
    SSTORE(0, 1);
    __syncthreads();
    if (kt + 3 < nk) GLOAD(0, (kt + 3) * 64);
    compute(1);
    if (kt + 2 < nk) SSTORE(1, 0);
    __syncthreads();
  }
#undef GLOAD
#undef SSTORE
#undef LD1
#undef ST1
  float* Cs = (float*)smem;
#pragma unroll
  for (int mb = 0; mb < 2; ++mb)
#pragma unroll
    for (int nb = 0; nb < 2; ++nb)
#pragma unroll
      for (int i = 0; i < 16; ++i)
        Cs[(wm * 64 + mb * 32 + crow(i, h)) * 132 + wn * 64 + nb * 32 + r] = acc[mb][nb][i];
  __syncthreads();
  epi(Cs);
}


template <class AF, class Epi>
DI void gemm_tile2(AF af, const bf16* __restrict__ Bt, int ldb, int K, char* smem, int& n0ref, int nhalf, Epi epi) {
  const int tid = otid(), lane = tid & 63, w = tid >> 6, r = lane & 31, h = lane >> 5;
  const int wm = w >> 1, wn = w & 1;
  bf16* As = (bf16*)smem;
  bf16* Bs = As + 128 * 72;
  f32x16 acc[2][4];
#pragma unroll
  for (int a = 0; a < 2; ++a)
#pragma unroll
    for (int b = 0; b < 4; ++b)
#pragma unroll
      for (int i = 0; i < 16; ++i) acc[a][b][i] = 0.f;
  uint4 pa_0, pa_1, pa_2, pa_3, pb_0, pb_1, pb_2, pb_3, pb_4, pb_5, pb_6, pb_7;
#define LDA2(I, K0) { int c = tl + 256 * I; int row = c >> 3, kc = (c & 7) * 8; pa_##I = *(const uint4*)af(row, (K0) + kc); }
#define LDB2(I, K0) { int c = tl + 256 * I; int row = c >> 3, kc = (c & 7) * 8; pb_##I = *(const uint4*)(Bt + (size_t)row * ldb + (K0) + kc); }
#define STA2(I) { int c = tid + 256 * I; int row = c >> 3, kc = (c & 7) * 8; *(uint4*)(As + row * 72 + kc) = pa_##I; }
#define STB2(I) { int c = tid + 256 * I; int row = c >> 3, kc = (c & 7) * 8; *(uint4*)(Bs + row * 72 + kc) = pb_##I; }
#define GLOAD2(K0) { const int tl = otid(); LDA2(0, K0) LDA2(1, K0) LDA2(2, K0) LDA2(3, K0) LDB2(0, K0) LDB2(1, K0) LDB2(2, K0) LDB2(3, K0) LDB2(4, K0) LDB2(5, K0) LDB2(6, K0) LDB2(7, K0) }
#define SSTORE2() { STA2(0) STA2(1) STA2(2) STA2(3) STB2(0) STB2(1) STB2(2) STB2(3) STB2(4) STB2(5) STB2(6) STB2(7) }
  const int nk = K >> 6;
  GLOAD2(0);
  const bf16* a_ = As + (wm * 64 + r) * 72 + h * 8;
  const bf16* b_ = Bs + (wn * 128 + r) * 72 + h * 8;
  for (int kt = 0; kt < nk; ++kt) {
    __syncthreads();
    SSTORE2();
    __syncthreads();
    if (kt + 1 < nk) GLOAD2((kt + 1) * 64);
#pragma unroll
    for (int ks = 0; ks < 4; ++ks) {
      bf16x8 fa[2], fb[4];
#pragma unroll
      for (int mb = 0; mb < 2; ++mb) fa[mb] = *(const bf16x8*)(a_ + mb * 32 * 72 + ks * 16);
#pragma unroll
      for (int nb = 0; nb < 4; ++nb) fb[nb] = *(const bf16x8*)(b_ + nb * 32 * 72 + ks * 16);
#pragma unroll
      for (int mb = 0; mb < 2; ++mb)
#pragma unroll
        for (int nb = 0; nb < 4; ++nb) acc[mb][nb] = MFMA32(fa[mb], fb[nb], acc[mb][nb]);
    }
  }
#undef LDA2
#undef LDB2
#undef STA2
#undef STB2
#undef GLOAD2
#undef SSTORE2
  float* Cs = (float*)smem;
#pragma unroll
  for (int hf = 0; hf < 2; ++hf) {
    if (hf < nhalf) {
      __syncthreads();
      if (wn == hf) {
#pragma unroll
        for (int mb = 0; mb < 2; ++mb)
#pragma unroll
          for (int nb = 0; nb < 4; ++nb)
#pragma unroll
            for (int i = 0; i < 16; ++i) Cs[(wm * 64 + mb * 32 + crow(i, h)) * 132 + nb * 32 + r] = acc[mb][nb][i];
      }
      __syncthreads();
      epi(Cs);
      n0ref += 128;
    }
  }
}

DI void tile_map(int t, int ntn, int& tm, int& tn) {
  const int per = 8 * ntn;
  const int grp = t / per, rem = t - grp * per;
  tm = grp * 8 + (rem & 7);
  tn = rem >> 3;
}
template <class F>
DI void epi_rows(const float* Cs, F f) {
  const int tid = otid();
#pragma unroll
  for (int j = 0; j < 8; ++j) {
    int c = tid + 256 * j;
    int row = c >> 4, cc = (c & 15) * 8;
    float v[8];
    float4 a = *(const float4*)(Cs + row * 132 + cc);
    float4 b = *(const float4*)(Cs + row * 132 + cc + 4);
    v[0] = a.x; v[1] = a.y; v[2] = a.z; v[3] = a.w; v[4] = b.x; v[5] = b.y; v[6] = b.z; v[7] = b.w;
    f(row, cc, v);
  }
}
template <class F>
DI void epi_cols(const float* Cs, F f) {
  const int tid = otid();
#pragma unroll
  for (int j = 0; j < 8; ++j) {
    int c = tid + 256 * j;
    int col = c & 127, r8 = (c >> 7) * 8;
    float v[8];
#pragma unroll
    for (int e = 0; e < 8; ++e) v[e] = Cs[(r8 + e) * 132 + col];
    f(col, r8, v);
  }
}
template <class F>
DI void epi_rope(const float* Cs, int cb, int m0, const float* rc, const float* rs, float scale_unused, F f) {
  const int tid = otid();
#pragma unroll
  for (int j = 0; j < 2; ++j) {
    int c = tid + 256 * j;
    int row = c >> 2, cc = (c & 3) * 8;
    float x1[8], x2[8], o1[8], o2[8];
#pragma unroll
    for (int e = 0; e < 8; ++e) {
      x1[e] = Cs[row * 132 + cb + cc + e];
      x2[e] = Cs[row * 132 + cb + 32 + cc + e];
    }
    const float* pc = rc + (size_t)(m0 + row) * 32 + cc;
    const float* ps = rs + (size_t)(m0 + row) * 32 + cc;
#pragma unroll
    for (int e = 0; e < 8; ++e) {
      float cs = pc[e], sn = ps[e];
      o1[e] = x1[e] * cs - x2[e] * sn;
      o2[e] = x1[e] * sn + x2[e] * cs;
    }
    f(row, cc, o1);
    f(row, cc + 32, o2);
  }
}

template <int DK>
struct KVPre {
  uint4 k[DK / 32];
  uint4 v[4];
  float aux;
};
constexpr int AT_VS = 25600;
constexpr int AT_AUX = 43008;
constexpr int AT_X0 = 43264;
constexpr int AT_IMP = AT_X0 + 12800;
constexpr int AT_SEL = AT_IMP + 16896;

template <int DK, bool PV, class SF, class PH>
DI void attn_tile(const bf16x8 (&qf)[DK / 16], f32x16 (&o)[4], float& m, float& l, const char* smem, SF sf, PH ph) {
  const int lane = otid() & 63, r = lane & 31, h = lane >> 5;
  const bf16* Ks = (const bf16*)smem;
  const bf16* Vs = (const bf16*)(smem + AT_VS);
  const float* auxs = (const float*)(smem + AT_AUX);
  f32x16 s[2];
#pragma unroll
  for (int kb = 0; kb < 2; ++kb) {
#pragma unroll
    for (int i = 0; i < 16; ++i) s[kb][i] = 0.f;
#pragma unroll
    for (int ks = 0; ks < DK / 16; ++ks) {
      bf16x8 a = *(const bf16x8*)(Ks + (kb * 32 + r) * (DK + 8) + ks * 16 + h * 8);
      s[kb] = MFMA32(a, qf[ks], s[kb]);
    }
  }
  float mx = m;
#pragma unroll
  for (int kb = 0; kb < 2; ++kb)
#pragma unroll
    for (int i = 0; i < 16; ++i) {
      int kl = kb * 32 + crow(i, h);
      float v = sf(s[kb][i], kl, auxs[kl]);
      s[kb][i] = v;
      mx = fmaxf(mx, v);
    }
  mx = fmaxf(mx, __shfl_xor(mx, 32));
  float alpha = ex2(m - mx);
  m = mx;
  float psum = 0.f;
#pragma unroll
  for (int kb = 0; kb < 2; ++kb)
#pragma unroll
    for (int i = 0; i < 16; ++i) {
      float pv = ex2(s[kb][i] - mx);
      s[kb][i] = pv;
      psum += pv;
    }
  l = l * alpha + psum;
  ph(0, s[0]);
  ph(1, s[1]);
  if (PV) {
    if (__builtin_amdgcn_ballot_w64(alpha != 1.f) != 0ull) {
#pragma unroll
      for (int d = 0; d < 4; ++d)
#pragma unroll
        for (int i = 0; i < 16; ++i) o[d][i] *= alpha;
    }
#pragma unroll
    for (int st = 0; st < 4; ++st) {
      const int kb = st >> 1, s2 = st & 1;
      uint4 pu;
      pu.x = pack2(s[kb][8 * s2 + 0], s[kb][8 * s2 + 1]);
      pu.y = pack2(s[kb][8 * s2 + 2], s[kb][8 * s2 + 3]);
      pu.z = pack2(s[kb][8 * s2 + 4], s[kb][8 * s2 + 5]);
      pu.w = pack2(s[kb][8 * s2 + 6], s[kb][8 * s2 + 7]);
      bf16x8 pf = __builtin_bit_cast(bf16x8, pu);
#pragma unroll
      for (int d = 0; d < 4; ++d) {
        const bf16* vp = Vs + (d * 32 + r) * 68 + st * 16 + 4 * h;
        uint2 lo = *(const uint2*)vp;
        uint2 hi = *(const uint2*)(vp + 8);
        uint4 vu = make_uint4(lo.x, lo.y, hi.x, hi.y);
        bf16x8 vf = __builtin_bit_cast(bf16x8, vu);
        o[d] = MFMA32(vf, pf, o[d]);
      }
    }
  }
}

template <int DK, int FM>
DI void attn_tile_c(const bf16x8 (&qf)[DK / 16], f32x16 (&o)[4], float& m, float& l, const char* smem, float sc, float c) {
  const int lane = otid() & 63, r = lane & 31, h = lane >> 5;
  const bf16* Ks = (const bf16*)smem;
  const bf16* Vs = (const bf16*)(smem + AT_VS);
  const float* auxs = (const float*)(smem + AT_AUX);
  f32x16 s0, s1;
#pragma unroll
  for (int i = 0; i < 16; ++i) { s0[i] = 0.f; s1[i] = 0.f; }
#pragma unroll
  for (int ks = 0; ks < DK / 16; ++ks) {
    bf16x8 a = *(const bf16x8*)(Ks + r * (DK + 8) + ks * 16 + h * 8);
    s0 = MFMA32(a, qf[ks], s0);
  }
#pragma unroll
  for (int ks = 0; ks < DK / 16; ++ks) {
    bf16x8 a = *(const bf16x8*)(Ks + (32 + r) * (DK + 8) + ks * 16 + h * 8);
    s1 = MFMA32(a, qf[ks], s1);
  }
  float mx;
  if (FM == 2) {
    mx = m;
#pragma unroll
    for (int i = 0; i < 16; ++i) {
      float v = __builtin_fmaf(s0[i], sc, -auxs[crow(i, h)]);
      s0[i] = v;
      mx = fmaxf(mx, v);
    }
  } else {
    float rm = s0[0];
#pragma unroll
    for (int i = 1; i < 16; ++i) rm = fmaxf(rm, s0[i]);
    mx = fmaxf(m, __builtin_fmaf(rm, sc, c));
  }
  mx = fmaxf(mx, __shfl_xor(mx, 32));
  const float alpha = ex2(m - mx);
  m = mx;
  const float off = c - mx;
#pragma unroll
  for (int d = 0; d < 4; ++d)
#pragma unroll
    for (int i = 0; i < 16; ++i) o[d][i] *= alpha;
  l *= alpha;
  float psum = 0.f;
#pragma unroll
  for (int i = 0; i < 16; ++i) {
    float pv = (FM == 2) ? ex2(s0[i] - mx) : ex2(__builtin_fmaf(s0[i], sc, off));
    s0[i] = pv;
    psum += pv;
  }
#pragma unroll
  for (int s2 = 0; s2 < 2; ++s2) {
    uint4 pu;
    pu.x = pack2(s0[8 * s2 + 0], s0[8 * s2 + 1]);
    pu.y = pack2(s0[8 * s2 + 2], s0[8 * s2 + 3]);
    pu.z = pack2(s0[8 * s2 + 4], s0[8 * s2 + 5]);
    pu.w = pack2(s0[8 * s2 + 6], s0[8 * s2 + 7]);
    bf16x8 pf = __builtin_bit_cast(bf16x8, pu);
#pragma unroll
    for (int d = 0; d < 4; ++d) {
      const bf16* vp = Vs + (d * 32 + r) * 68 + s2 * 16 + 4 * h;
      uint2 lo = *(const uint2*)vp;
      uint2 hi = *(const uint2*)(vp + 8);
      uint4 vu = make_uint4(lo.x, lo.y, hi.x, hi.y);
      o[d] = MFMA32(__builtin_bit_cast(bf16x8, vu), pf, o[d]);
    }
  }
#pragma unroll
  for (int i = 0; i < 16; ++i) {
    float pv;
    if (FM == 2) pv = ex2(__builtin_fmaf(s1[i], sc, -auxs[32 + crow(i, h)]) - mx);
    else pv = ex2(__builtin_fmaf(s1[i], sc, off));
    s1[i] = pv;
    psum += pv;
  }
  l += psum;
#pragma unroll
  for (int s2 = 0; s2 < 2; ++s2) {
    uint4 pu;
    pu.x = pack2(s1[8 * s2 + 0], s1[8 * s2 + 1]);
    pu.y = pack2(s1[8 * s2 + 2], s1[8 * s2 + 3]);
    pu.z = pack2(s1[8 * s2 + 4], s1[8 * s2 + 5]);
    pu.w = pack2(s1[8 * s2 + 6], s1[8 * s2 + 7]);
    bf16x8 pf = __builtin_bit_cast(bf16x8, pu);
#pragma unroll
    for (int d = 0; d < 4; ++d) {
      const bf16* vp = Vs + (d * 32 + r) * 68 + (2 + s2) * 16 + 4 * h;
      uint2 lo = *(const uint2*)vp;
      uint2 hi = *(const uint2*)(vp + 8);
      uint4 vu = make_uint4(lo.x, lo.y, hi.x, hi.y);
      o[d] = MFMA32(__builtin_bit_cast(bf16x8, vu), pf, o[d]);
    }
  }
}

struct NoHook { DI void operator()(int, const f32x16&) const {} };

template <int DK, bool PV, bool PF, class Ctx>
DI void attn_run(const bf16x8 (&qf)[DK / 16], f32x16 (&o)[4], float& m, float& l, const bf16* K1, int ldk1,
                 const bf16* K2, int ldk2, const bf16* Vt, int ldv, int first, Ctx& ctx, char* smem) {
  const int tid = otid();
  int tcur = first;
  if (tcur < 0) return;
  constexpr int CPR = DK / 8;
  constexpr int NKC = DK / 32;
  uint4 rk0, rk1, rk2, rk3, rk4 = make_uint4(0, 0, 0, 0), rk5 = make_uint4(0, 0, 0, 0), rv[4];
  float raux;
  bf16* Ks = (bf16*)smem;
  bf16* Vs = (bf16*)(smem + AT_VS);
  auto ldk = [&](int i, int key0) -> uint4 {
    int c = otid() + 256 * i;
    int row = c / CPR, cc = c % CPR;
    const bf16* src;
    if (DK == 128 || cc < 16) src = K1 + (size_t)(key0 + row) * ldk1 + cc * 8;
    else src = K2 + (size_t)(key0 + row) * ldk2 + (cc - 16) * 8;
    return *(const uint4*)src;
  };
  auto stk = [&](int i, const uint4& v) {
    int c = tid + 256 * i;
    int row = c / CPR, cc = c % CPR;
    *(uint4*)(Ks + row * (DK + 8) + cc * 8) = v;
  };
  auto gload = [&](int key0) {
    rk0 = ldk(0, key0); rk1 = ldk(1, key0); rk2 = ldk(2, key0); rk3 = ldk(3, key0);
    if (NKC > 4) { rk4 = ldk(4, key0); rk5 = ldk(5, key0); }
    const int tl = otid();
#pragma unroll
    for (int i = 0; i < 4; ++i) {
      int c = tl + 256 * i;
      int d = c >> 3, cc = c & 7;
      rv[i] = *(const uint4*)(Vt + (size_t)d * ldv + key0 + cc * 8);
    }
    raux = (tid < 64) ? ctx.aux(key0 + tid) : 0.f;
  };
  auto sstore = [&]() {
    stk(0, rk0); stk(1, rk1); stk(2, rk2); stk(3, rk3);
    if (NKC > 4) { stk(4, rk4); stk(5, rk5); }
#pragma unroll
    for (int i = 0; i < 4; ++i) {
      int c = tid + 256 * i;
      int d = c >> 3, cc = c & 7;
      uint2* dst = (uint2*)(Vs + d * 68 + cc * 8);
      dst[0] = make_uint2(rv[i].x, rv[i].y);
      dst[1] = make_uint2(rv[i].z, rv[i].w);
    }
    if (tid < 64) ((float*)(smem + AT_AUX))[tid] = raux;
  };
  if (PF) gload(tcur * 64);
  while (tcur >= 0) {
    __syncthreads();
    if (!PF) gload(tcur * 64);
    sstore();
    __syncthreads();
    int tnext = ctx.next(tcur);
    if (PF && tnext >= 0) gload(tnext * 64);
    if (!ctx.skip(tcur)) {
      const int tc = tcur;
      if (Ctx::FMODE != 0 && (Ctx::ALWAYS_FAST || ctx.fast(tc))) {
        attn_tile_c<DK, (Ctx::FMODE == 2 ? 2 : 1)>(qf, o, m, l, smem, ctx.sc, ctx.fconst(tc));
      } else if (!Ctx::ALWAYS_FAST) {
        attn_tile<DK, PV>(qf, o, m, l, smem,
                          [&](float s, int kl, float ax) { return ctx.score(s, tc * 64 + kl, ax, tc); },
                          [&](int kb, const f32x16& pt) { ctx.hook(kb, pt, tc); });
      }
    }
    tcur = tnext;
  }
}

template <int DK>
DI void load_q(bf16x8 (&qf)[DK / 16], const bf16* qrow, int h) {
#pragma unroll
  for (int ks = 0; ks < DK / 16; ++ks) qf[ks] = *(const bf16x8*)(qrow + ks * 16 + h * 8);
}
DI void zero_o(f32x16 (&o)[4]) {
#pragma unroll
  for (int d = 0; d < 4; ++d)
#pragma unroll
    for (int i = 0; i < 16; ++i) o[d][i] = 0.f;
}

struct CtxCausal {
  int tq, q0w, last; float sc;
  DI int next(int t) const { return t + 1 <= last ? t + 1 : -1; }
  DI float aux(int) const { return 0.f; }
  DI bool skip(int t) const { return t * 64 > q0w + 31; }
  DI float score(float s, int key, float, int) const { return key <= tq ? s * sc : NEG; }
  static constexpr int FMODE = 1;
  static constexpr bool ALWAYS_FAST = false;
  DI bool fast(int t) const { return t * 64 + 63 <= q0w; }
  DI float fconst(int) const { return 0.f; }
  DI void hook(int, const f32x16&, int) const {}
};
struct CtxFox {
  int tq, q0w, last; float sc; const float* cuml; const float* cpre;
  DI int next(int t) const { return t + 1 <= last ? t + 1 : -1; }
  DI float aux(int key) const { return (cuml[key] + cpre[key >> 7]) * LOG2E; }
  DI bool skip(int t) const { return t * 64 > q0w + 31; }
  DI float score(float s, int key, float ax, int) const { return key <= tq ? s * sc - ax : NEG; }
  static constexpr int FMODE = 2;
  static constexpr bool ALWAYS_FAST = false;
  DI bool fast(int t) const { return t * 64 + 63 <= q0w; }
  DI float fconst(int) const { return 0.f; }
  DI void hook(int, const f32x16&, int) const {}
};
struct CtxMem {
  float sc;
  DI int next(int t) const { return t + 1 < 4 ? t + 1 : -1; }
  DI float aux(int) const { return 0.f; }
  DI bool skip(int) const { return false; }
  DI float score(float s, int, float, int) const { return s * sc; }
  static constexpr int FMODE = 1;
  static constexpr bool ALWAYS_FAST = true;
  DI bool fast(int) const { return true; }
  DI float fconst(int) const { return 0.f; }
  DI void hook(int, const f32x16&, int) const {}
};

DI void store_out_A(const f32x16 (&o)[4], float inv_l, const bf16* grow, bf16* orow, int h) {
#pragma unroll
  for (int d = 0; d < 4; ++d)
#pragma unroll
    for (int i4 = 0; i4 < 4; ++i4) {
      int dv0 = d * 32 + 8 * i4 + 4 * h;
      uint2 gu = *(const uint2*)(grow + dv0);
      float g0 = bflo(gu.x), g1 = bfhi(gu.x), g2 = bflo(gu.y), g3 = bfhi(gu.y);
      uint2 ou;
      ou.x = pack2(o[d][4 * i4 + 0] * inv_l * silu(g0), o[d][4 * i4 + 1] * inv_l * silu(g1));
      ou.y = pack2(o[d][4 * i4 + 2] * inv_l * silu(g2), o[d][4 * i4 + 3] * inv_l * silu(g3));
      *(uint2*)(orow + dv0) = ou;
    }
}

        struct CtxCmp {
          int tq, posq, last; float sc; const float* lutr; const int* pos; float invl; float* imp; int ql; bool p2;
          DI int next(int t) const { return t + 1 <= last ? t + 1 : -1; }
          DI float aux(int key) const { int n = key < 511 ? key : 510; return __int_as_float(pos[16 * n + 31]); }
          DI bool skip(int) const { return false; }
          DI float score(float s, int key, float ax, int) const {
            bool valid = (16 * key + 31 <= tq) && key < 511;
            int d = posq - __float_as_int(ax);
            d = d < 0 ? 0 : (d > 799 ? 799 : d);
            return valid ? s * sc + lutr[d] : NEG;
          }
          static constexpr int FMODE = 0;
          static constexpr bool ALWAYS_FAST = false;
          DI bool fast(int) const { return false; }
          DI float fconst(int) const { return 0.f; }
          DI void hook(int kb, const f32x16& pt, int tc) const {
            if (!p2) return;
            const int lane = otid() & 63, h = lane >> 5, r = lane & 31;
#pragma unroll
            for (int gq = 0; gq < 4; ++gq) {
              float p3 = 0.5f * pt[4 * gq + 3];
              float vm = (pt[4 * gq] + pt[4 * gq + 1] + pt[4 * gq + 2] + p3) * invl;
              float vs = p3 * invl;
              vm += __shfl_xor(vm, 8); vm += __shfl_xor(vm, 16);
              vs += __shfl_xor(vs, 8); vs += __shfl_xor(vs, 16);
              int j = tc * 16 + kb * 8 + 2 * gq + h;
              if (r < 8) { atomicAdd(&imp[ql * 132 + j], vm); atomicAdd(&imp[ql * 132 + j + 1], vs); }
            }
          }
        };
struct CtxSlc {
  int tq, posq; float sc; const float* lutr; const int* pos; unsigned long long ulo, uhi, mlo, mhi;
  const int* posmax; int pqmin, q0;
  DI bool farj(int j) const { return (j * 64 + 63 < q0) && (pqmin - posmax[j] >= 799); }
  DI bool inu(int j) const {
    unsigned long long a = (ulo >> (j & 63)) & (j < 64 ? 1ull : 0ull);
    unsigned long long b = (uhi >> (j & 63)) & (j >= 64 ? 1ull : 0ull);
    return (a | b) != 0ull;
  }
  DI bool mine(int j) const {
    unsigned long long a = (mlo >> (j & 63)) & (j < 64 ? 1ull : 0ull);
    unsigned long long b = (mhi >> (j & 63)) & (j >= 64 ? 1ull : 0ull);
    return (a | b) != 0ull;
  }
  DI int next(int t) const { for (int j = t + 1; j < 128; ++j) if (inu(j) && !farj(j)) return j; return -1; }
  DI float aux(int key) const { return __int_as_float(pos[key]); }
  DI bool skip(int t) const { return __builtin_amdgcn_ballot_w64(mine(t)) == 0ull; }
  DI float score(float s, int key, float ax, int t) const {
    bool valid = mine(t) && key <= tq;
    int d = posq - __float_as_int(ax);
    d = d < 0 ? 0 : (d > 799 ? 799 : d);
    return valid ? s * sc + lutr[d] : NEG;
  }
  static constexpr int FMODE = 0;
  static constexpr bool ALWAYS_FAST = false;
  DI bool fast(int) const { return false; }
  DI float fconst(int) const { return 0.f; }
  DI void hook(int, const f32x16&, int) const {}
};
struct CtxSlcFar {
  float sc, bfar; unsigned long long ulo, uhi, mlo, mhi; const int* posmax; int pqmin, q0;
  DI bool farj(int j) const { return (j * 64 + 63 < q0) && (pqmin - posmax[j] >= 799); }
  DI bool inu(int j) const {
    unsigned long long a = (ulo >> (j & 63)) & (j < 64 ? 1ull : 0ull);
    unsigned long long b = (uhi >> (j & 63)) & (j >= 64 ? 1ull : 0ull);
    return (a | b) != 0ull;
  }
  DI bool mine(int j) const {
    unsigned long long a = (mlo >> (j & 63)) & (j < 64 ? 1ull : 0ull);
    unsigned long long b = (mhi >> (j & 63)) & (j >= 64 ? 1ull : 0ull);
    return (a | b) != 0ull;
  }
  DI int next(int t) const { for (int j = t + 1; j < 128; ++j) if (inu(j) && farj(j)) return j; return -1; }
  DI float aux(int) const { return 0.f; }
  DI bool skip(int t) const { return __builtin_amdgcn_ballot_w64(mine(t)) == 0ull; }
  DI float score(float s, int, float, int t) const { return mine(t) ? s * sc + bfar : NEG; }
  static constexpr int FMODE = 1;
  static constexpr bool ALWAYS_FAST = true;
  DI bool fast(int) const { return true; }
  DI float fconst(int t) const { return mine(t) ? bfar : NEG; }
  DI void hook(int, const f32x16&, int) const {}
};
struct CtxWin {
  int tq, posq, last; float sc; const float* lutr; const int* pos;
  DI int next(int t) const { return t + 1 <= last ? t + 1 : -1; }
  DI float aux(int key) const { return __int_as_float(pos[key]); }
  DI bool skip(int) const { return false; }
  DI float score(float s, int key, float ax, int) const {
    bool valid = key <= tq && (tq - key) < 512;
    int d = posq - __float_as_int(ax);
    d = d < 0 ? 0 : (d > 799 ? 799 : d);
    return valid ? s * sc + lutr[d] : NEG;
  }
  static constexpr int FMODE = 0;
  static constexpr bool ALWAYS_FAST = false;
  DI bool fast(int) const { return false; }
  DI float fconst(int) const { return 0.f; }
  DI void hook(int, const f32x16&, int) const {}
};

DI int cvt_next_count(const Params& p, int nl) {
      const bool ne = (nl & 1) == 0;
      const int nli = nl >> 1;
      return cvt_set_count(p, ne ? SET_IN_EVEN : SET_IN_ODD, nli) + cvt_set_count(p, SET_MEM, nl) +
             cvt_set_count(p, ne ? SET_MISC_EVEN : SET_MISC_ODD, nli) + (ne ? 16 : 32);
}
DI void cvt_next(const Params& p, char* smem, int nl, int t) {
  char* ws = p.ws;
      const bool ne = (nl & 1) == 0;
      const int nli = nl >> 1;
      const int s0 = ne ? SET_IN_EVEN : SET_IN_ODD, s2 = ne ? SET_MISC_EVEN : SET_MISC_ODD;
      const int c0 = cvt_set_count(p, s0, nli), c1 = cvt_set_count(p, SET_MEM, nl), c2 = cvt_set_count(p, s2, nli);
      if (t < c0) cvt_set_task(p, s0, nli, t, smem);
      else if (t < c0 + c1) cvt_set_task(p, SET_MEM, nl, t - c0, smem);
      else if (t < c0 + c1 + c2) cvt_set_task(p, s2, nli, t - c0 - c1, smem);
      else {
            const int tid = otid();
            int e = t - c0 - c1 - c2;
            if (ne) {
              float* S5P = (float*)(ws + WS_S5P);
              int gp = e * 256 + tid;
              int g = gp >> 6;
              float dt = expf(p.log_dt[nli * 64 + g]);
              float lr = p.lam_re[nli * 4096 + gp], lim = p.lam_im[nli * 4096 + gp];
              float mag = expf(lr * dt);
              float abr = mag * cosf(lim * dt), abi = mag * sinf(lim * dt);
              float den = lr * lr + lim * lim;
              float nr = abr - 1.f;
              float fre = (nr * lr + abi * lim) / den;
              float fim = (abi * lr - nr * lim) / den;
              S5P[gp] = abr;
              S5P[4096 + gp] = abi;
              float ar = abr, ai = abi;
#pragma unroll
              for (int q = 0; q < 7; ++q) { float nr2 = ar * ar - ai * ai; ai = 2.f * ar * ai; ar = nr2; }
              S5P[8192 + gp] = ar;
              S5P[12288 + gp] = ai;
              const float* br = p.b_re + (size_t)nli * 65536 + gp * 16;
              const float* bi = p.b_im + (size_t)nli * 65536 + gp * 16;
#pragma unroll
              for (int c = 0; c < 16; ++c) {
                S5P[16384 + gp * 16 + c] = fre * br[c] - fim * bi[c];
                S5P[16384 + 65536 + gp * 16 + c] = fre * bi[c] + fim * br[c];
              }
            } else {
              int which = e >> 4, part = e & 15;
              const float* pe = p.cmp_pe + (size_t)(nli * 2 + which) * 4096 + part * 256;
              const float* w1 = p.cmp_w1 + ((size_t)(nli * 2 + which) * 4096 + part * 256) * 256 + tid;
              float acc = 0.f;
#pragma unroll 8
              for (int k = 0; k < 256; ++k) acc += pe[k] * w1[(size_t)k * 256];
              ((float*)(ws + WS_CMPB))[(which * 16 + part) * 256 + tid] = acc;
            }
      }
}

#define XB_TMO      128
#define XB_XCNT(j)  (256  + 64 * (j))
#define XB_XSUB(j)  (1280 + 64 * (j))
#define XB_XGEN(j)  (2304 + 64 * (j))
#define XB_TOP      3328
#define XB_TOPGEN   3392
#define XCD_BAR_WORDS 3456
#define XB_SPIN_CAP (1u << 18)
#define LAS __attribute__((address_space(3)))

__device__ __forceinline__ unsigned xb_ld(unsigned* p)              { return __hip_atomic_load(p, __ATOMIC_RELAXED, __HIP_MEMORY_SCOPE_AGENT); }
__device__ __forceinline__ unsigned xb_add(unsigned* p, unsigned v) { return __hip_atomic_fetch_add(p, v, __ATOMIC_RELAXED, __HIP_MEMORY_SCOPE_AGENT); }
__device__ __forceinline__ unsigned xb_xcc_id() { return (unsigned)__builtin_amdgcn_s_getreg((3 << 11) | 20) & 0xFu; }
#define XB_SPIN(cond, bar) do { unsigned _sp = 0; while (cond) { __builtin_amdgcn_s_sleep(1); \
    if ((++_sp & 255u) == 0u) { if (xb_ld(&(bar)[XB_TMO])) break; if (_sp > XB_SPIN_CAP) { atomicAdd(&(bar)[XB_TMO], 1u); break; } } } } while (0)

struct XcdBarrier {
    unsigned* bar; unsigned x;
    volatile LAS unsigned* st;
};

__device__ __forceinline__ XcdBarrier xcd_barrier_post(unsigned* bar, volatile LAS unsigned* st) {
    XcdBarrier b; b.bar = bar; b.x = xb_xcc_id(); b.st = st;
    if (threadIdx.x == 0) (void)xb_add(&bar[XB_XCNT(b.x)], 1u);
    return b;
}
__device__ __forceinline__ void xcd_barrier_complete(unsigned* bar, unsigned x, unsigned& nloc, unsigned& nx) {
    const unsigned G = gridDim.x * gridDim.y * gridDim.z;
    unsigned sum, cnt, mine, sp = 0u;
    for (;;) {
        sum = 0u; cnt = 0u; mine = 0u;
#pragma unroll
        for (unsigned j = 0; j < 16; ++j) { const unsigned c = xb_ld(&bar[XB_XCNT(j)]); sum += c; cnt += (c > 0u) ? 1u : 0u; mine = (j == x) ? c : mine; }
        if (sum == G) break;
        __builtin_amdgcn_s_sleep(1);
        if ((++sp & 255u) == 0u) { if (xb_ld(&bar[XB_TMO])) break; if (sp > XB_SPIN_CAP) { atomicAdd(&bar[XB_TMO], 1u); break; } }
    }
    nloc = mine > 0u ? mine : 1u; nx = cnt > 0u ? cnt : 1u;
}

__device__ __forceinline__ void xcd_barrier(const XcdBarrier& b) {
    asm volatile("s_waitcnt vmcnt(0)" ::: "memory");
    __syncthreads();
    if (threadIdx.x == 0) {
        unsigned* bar = b.bar;
        __builtin_amdgcn_s_waitcnt(0);
        unsigned nloc = b.st[0], nx = b.st[1];
        if (nloc == 0u) { xcd_barrier_complete(bar, b.x, nloc, nx); b.st[0] = nloc; b.st[1] = nx; }
        const unsigned old = xb_add(&bar[XB_XSUB(b.x)], 1u);
        const unsigned gen = old / nloc;
        if (old + 1u == (gen + 1u) * nloc) {
            __builtin_amdgcn_fence(__ATOMIC_RELEASE, "agent");
            asm volatile("s_waitcnt vmcnt(0)" ::: "memory");
            const unsigned og = xb_add(&bar[XB_TOP], 1u);
            const unsigned tg = og / nx;
            if (og + 1u == (tg + 1u) * nx) xb_add(&bar[XB_TOPGEN], 1u);
            else XB_SPIN(xb_ld(&bar[XB_TOPGEN]) == tg, bar);
            __builtin_amdgcn_fence(__ATOMIC_ACQUIRE, "agent");
            xb_add(&bar[XB_XGEN(b.x)], 1u);
            asm volatile("s_waitcnt vmcnt(0)" ::: "memory");
        } else {
            XB_SPIN(xb_ld(&bar[XB_XGEN(b.x)]) == gen, bar);
            __builtin_amdgcn_fence(__ATOMIC_ACQUIRE, "agent");
            asm volatile("s_waitcnt vmcnt(0)" ::: "memory");
        }
    }
    __syncthreads();
}


__global__ void __launch_bounds__(256, LB2) mega(Params p, int ph_lo, int ph_hi) {
  __shared__ __attribute__((aligned(16))) char smem[SM_TOTAL];
  __shared__ int s_task;
  __shared__ uint4 xb_words;
  if (threadIdx.x == 0) xb_words = make_uint4(0u, 0u, 0u, 0u);
  __syncthreads();
  (void)xcd_barrier_post((unsigned*)(p.ws + WS_BAR), (volatile LAS unsigned*)&xb_words);
  const int bid = blockIdx.x, nb = gridDim.x;

  for (int ph = ph_lo; ph <= ph_hi; ++ph) {
    if (ph > ph_lo) {
      if (ph == ph_lo + 1) cg::this_grid().sync();
      else {
        XcdBarrier xb2;
        xb2.bar = (unsigned*)(((const Params*)__builtin_amdgcn_kernarg_segment_ptr())->ws + WS_BAR);
        xb2.x = xb_xcc_id();
        xb2.st = (volatile LAS unsigned*)&xb_words;
        xcd_barrier(xb2);
      }
    }
    const int nrep = (REP_PH >= 0 && ph == REP_PH) ? 2 : 1;
    for (int rep = 0; rep < nrep; ++rep) {
    if (rep) cg::this_grid().sync();
    const int tid = otid(), lane = tid & 63, w = tid >> 6, r = lane & 31, h = lane >> 5;
    const int vb = (bid & 7) * (nb >> 3) + (bid >> 3);
    int zoff_;
    asm volatile("s_mov_b32 %0, 0" : "=s"(zoff_));
    const Params& p = *(const Params*)((const char*)__builtin_amdgcn_kernarg_segment_ptr() + zoff_);
    char* ws = p.ws;
    char* const ws_ph = ws;
    bf16* XN = (bf16*)(ws + WS_XN);
    bf16* P = (bf16*)(ws + WS_P);
    bf16* MIXED = (bf16*)(ws + WS_MIXED);
    float* ROPEC = (float*)(ws + WS_ROPEC);
    float* ROPES = (float*)(ws + WS_ROPES);
    float* hbuf = p.out;
    int* CTR = (int*)(ws + WS_CTR);
    auto fetch_task = [&](int* ctr) {
      __syncthreads();
      if (tid == 0) s_task = atomicAdd(ctr, 1);
      __syncthreads();
      return s_task;
    };
    const int layer = ph == 0 ? 0 : (ph - 1) / 6;
    const int sub = ph == 0 ? -1 : (ph - 1) % 6;
    const bool even = (layer & 1) == 0;
    const int li = layer >> 1;
    const int NP = even ? NPE : NPO;

    if ((PHM & 1) && (ph == 0 || sub == 5)) {
      if (ph == 0) {
        if (bid == 0 && tid < 64) CTR[tid] = 0;
        if (bid == 1 % nb && tid < 128) {
          int mx = p.pos[tid * 64];
          for (int q = 1; q < 64; ++q) mx = max(mx, p.pos[tid * 64 + q]);
          ((int*)(ws + WS_POSMAX))[tid] = mx;
        }
        for (int i = bid * 256 + tid; i < L * 32; i += nb * 256) {
          int t = i >> 5, f = i & 31;
          float inv = powf(10000.f, -(float)f / 32.f);
          float ang = (float)p.pos[t] * inv;
          ROPEC[i] = cosf(ang);
          ROPES[i] = sinf(ang);
        }
        for (int row = bid * 4 + w; row < 256; row += nb * 4)
          norm_row_bf16(p.mem + (size_t)row * DM, p.mem_norm_g, (bf16*)(ws + WS_MEMN) + (size_t)row * DM, lane);
      }
      const int nl = ph == 0 ? 0 : layer + 1;
      if (nl < 4) {
        const float* src = ph == 0 ? p.x : hbuf;
        for (int row = bid * 4 + w; row < L; row += nb * 4)
          norm_row_bf16(src + (size_t)row * DM, p.norm_g + nl * DM, XN + (size_t)row * LDX, lane);
      } else {
        for (int row = bid * 4 + w; row < L; row += nb * 4) norm_row_f32(hbuf + (size_t)row * DM, p.final_norm_g, lane);
      }
    }
    if ((PHM & 4) && sub == 0) {
      const int ntn = (NP / 128 + 1) / 2;
      const int n_in = 64 * ntn;
      const bf16* Win = (const bf16*)(ws + WS_WIN);
      for (int t = vb; t < n_in + 16; t += nb) {
        if (t < n_in) {
          int tm, tn;
          tile_map(t, ntn, tm, tn);
          const int m0 = tm * 128;
          int n0 = tn * 256;
          const int nhalf = (n0 + 128 < NP) ? 2 : 1;
          ALin af{XN + (size_t)m0 * LDX, LDX};
          if (even) {
            gemm_tile2(af, Win + (size_t)n0 * LDX, LDX, DM, smem, n0, nhalf, [&](const float* Cs) {
              if (n0 >= 4096 && n0 < 5120) {
                bf16* VT = (bf16*)(ws + WS_VTFOX);
                epi_cols(Cs, [&](int col, int r8, const float* v) {
                  *(uint4*)(VT + (size_t)(n0 - 4096 + col) * L + m0 + r8) = pack8(v);
                });
              } else if (n0 == 7168) {
                float* FL = (float*)(ws + WS_FLOG);
                for (int i = tid; i < 128 * 8; i += 256) {
                  int row = i >> 3, c = i & 7;
                  FL[(size_t)(m0 + row) * 8 + c] = Cs[row * 132 + c];
                }
              } else {
                epi_rows(Cs, [&](int row, int cc, const float* v) {
                  *(uint4*)(P + (size_t)(m0 + row) * NPE + n0 + cc) = pack8(v);
                });
              }
            });
          } else {
            gemm_tile2(af, Win + (size_t)n0 * LDX, LDX, DM, smem, n0, nhalf, [&](const float* Cs) {
              if (n0 == 3840 || n0 == 3968 || n0 == 4352 || n0 == 4480) {
                bf16* VT = (n0 < 4096) ? (bf16*)(ws + WS_VTSLC) + (size_t)(n0 - 3840) * L
                                       : (bf16*)(ws + WS_VTWIN) + (size_t)(n0 - 4352) * L;
                epi_cols(Cs, [&](int col, int r8, const float* v) {
                  *(uint4*)(VT + (size_t)col * L + m0 + r8) = pack8(v);
                });
              } else if (n0 == 6656) {
                epi_rope(Cs, 0, m0, ROPEC, ROPES, 1.f, [&](int row, int cl, const float* v) {
                  *(uint4*)(P + (size_t)(m0 + row) * NPO + 6656 + cl) = pack8(v);
                });
                float* GT = (float*)(ws + WS_FLOG);
                for (int i = tid; i < 128 * 24; i += 256) {
                  int row = i / 24, c = i % 24;
                  GT[(size_t)(m0 + row) * 24 + c] = Cs[row * 132 + 64 + c];
                }
              } else {
                epi_rows(Cs, [&](int row, int cc, const float* v) {
                  *(uint4*)(P + (size_t)(m0 + row) * NPO + n0 + cc) = pack8(v);
                });
              }
            });
          }
        } else {
          const int t2 = t - n_in;
          const int m0 = (t2 >> 3) * 128, n0 = (t2 & 7) * 128;
          ALin af{(const bf16*)(ws + WS_MEMN) + (size_t)m0 * DM, DM};
          gemm_tile(af, (const bf16*)(ws + WS_WMEM) + (size_t)n0 * DM, DM, DM, smem, [&](const float* Cs) {
            if (n0 < 512) {
              bf16* MK = (bf16*)(ws + WS_MEMK);
              epi_rows(Cs, [&](int row, int cc, const float* v) {
                *(uint4*)(MK + (size_t)(m0 + row) * 512 + n0 + cc) = pack8(v);
              });
            } else {
              bf16* MV = (bf16*)(ws + WS_MEMVT);
              epi_cols(Cs, [&](int col, int r8, const float* v) {
                *(uint4*)(MV + (size_t)(n0 - 512 + col) * 256 + m0 + r8) = pack8(v);
              });
            }
          });
        }
      }
    }

    if ((PHM & 4) && sub == 0) {
      const int cw = cvt_set_count(p, SET_OUT, layer), cw4 = (cw + 3) >> 2;
      for (;;) {
        const int t = fetch_task(CTR + 32 + ph);
        if (t >= cw4) break;
        for (int q = 0; q < 4; ++q) {
          const int ci = t * 4 + q;
          if (ci < cw) cvt_set_task(p, SET_OUT, layer, ci, smem);
        }
      }
    }
    auto mem_attn_task = [&](int t) {
      const int tid = otid(), lane = tid & 63, w = tid >> 6, r = lane & 31, h = lane >> 5;
      (void)tid;
      const int qt = t >> 2, head = t & 3;
      const int tq = qt * 128 + w * 32 + r;
      const int qcol = even ? 6144 : 5632, gcol = even ? 6656 : 6144;
      bf16x8 qf[8];
      load_q<128>(qf, P + (size_t)tq * NP + qcol + head * 128, h);
      f32x16 o[4];
      zero_o(o);
      float m = NEG, l = 0.f;
      CtxMem ctx{0.08838834764831845f * LOG2E};
      attn_run<128, true, true>(qf, o, m, l, (const bf16*)(ws + WS_MEMK) + head * 128, 512, nullptr, 0,
                          (const bf16*)(ws + WS_MEMVT) + (size_t)head * 128 * 256, 256, 0, ctx, smem);
      float lt = l + __shfl_xor(l, 32);
      store_out_A(o, 1.f / lt, P + (size_t)tq * NP + gcol + head * 128, MIXED + (size_t)tq * MIXW + 2048 + head * 128, h);
    };

    if ((PHM & 8) && sub == 1 && even) {
      const int cw = 0;
      const int n_s5 = 1024, n_cum = 64, n_mem = 256;
      for (int t = bid; t < n_mem + n_s5 + n_cum + cw; t += nb) {
        if (t < n_mem) {
          mem_attn_task(t);
        } else if (t < n_mem + n_s5) {
          const int t2 = t - n_mem;
          const int ch = t2 >> 4, gq = t2 & 15;
          float* us = (float*)smem;
          __syncthreads();
          for (int i = tid; i < 128 * 8; i += 256) {
            int tt = i >> 3, c8 = (i & 7) * 8;
            uint4 u = *(const uint4*)(P + (size_t)(ch * 128 + tt) * NPE + gq * 64 + c8);
            float* d = us + tt * 64 + c8;
            d[0] = bflo(u.x); d[1] = bfhi(u.x); d[2] = bflo(u.y); d[3] = bfhi(u.y);
            d[4] = bflo(u.z); d[5] = bfhi(u.z); d[6] = bflo(u.w); d[7] = bfhi(u.w);
          }
          __syncthreads();
          const float* S5P = (const float*)(ws + WS_S5P);
          const int gp = (gq * 4 + w) * 64 + lane;
          const float ar = S5P[gp], ai = S5P[4096 + gp];
          float bbr[16], bbi[16];
#pragma unroll
          for (int c = 0; c < 16; ++c) { bbr[c] = S5P[16384 + gp * 16 + c]; bbi[c] = S5P[16384 + 65536 + gp * 16 + c]; }
          float xr = 0.f, xi = 0.f;
          for (int tt = 0; tt < 128; ++tt) {
            const float* up = us + tt * 64 + w * 16;
            float bur = 0.f, bui = 0.f;
#pragma unroll
            for (int c = 0; c < 16; ++c) { float uv = up[c]; bur += bbr[c] * uv; bui += bbi[c] * uv; }
            float nxr = ar * xr - ai * xi + bur;
            float nxi = ar * xi + ai * xr + bui;
            xr = nxr; xi = nxi;
          }
          float2* E = (float2*)(ws + WS_S5E);
          E[(size_t)ch * 4096 + gp] = make_float2(xr, xi);
        } else if (t < n_mem + n_s5 + n_cum) {
          const int ch = t - n_mem - n_s5;
          const float* FL = (const float*)(ws + WS_FLOG);
          float* CUML = (float*)(ws + WS_CUML);
          float* CT = (float*)(ws + WS_CT);
#pragma unroll
          for (int hh = 0; hh < 2; ++hh) {
            const int head = w * 2 + hh;
            const float bf = p.fox_b_f[li * 8 + head];
            const int t0 = ch * 128 + lane * 2;
            float x0 = FL[(size_t)t0 * 8 + head] + bf, x1 = FL[(size_t)(t0 + 1) * 8 + head] + bf;
            float v0 = x0 >= 0.f ? -log1pf(expf(-x0)) : x0 - log1pf(expf(x0));
            float v1 = x1 >= 0.f ? -log1pf(expf(-x1)) : x1 - log1pf(expf(x1));
            float s = v0 + v1;
            float inc = s;
#pragma unroll
            for (int o = 1; o < 64; o <<= 1) {
              float n = __shfl_up(inc, o);
              if (lane >= o) inc += n;
            }
            float excl = inc - s;
            CUML[(size_t)head * L + t0] = excl + v0;
            CUML[(size_t)head * L + t0 + 1] = excl + v0 + v1;
            if (lane == 63) CT[head * 64 + ch] = inc;
          }
        } else {
          cvt_set_task(p, SET_OUT, layer, t - n_mem - n_s5 - n_cum, smem);
        }
      }
    }
    if ((PHM & 16) && sub == 2 && even) {
      const int n_fox = 512, n_s5 = 1024;
      for (;;) {
        const int t = fetch_task(CTR + ph);
        if (t >= n_fox + n_s5) break;
        const int tid = otid(), lane = tid & 63, w = tid >> 6, r = lane & 31, h = lane >> 5;
        int zt_;
        asm volatile("s_mov_b32 %0, 0" : "=s"(zt_));
        char* const ws = ws_ph + zt_;
        if (t < n_fox) {
          const int qt = 63 - (t >> 3), head = t & 7;
          const int q0w = qt * 128 + w * 32, tq = q0w + r;
          float* cpre = (float*)(smem + AT_X0);
          __syncthreads();
          if (tid < 64) {
            const float v0 = ((const float*)(ws + WS_CT))[head * 64 + tid];
            float inc = v0;
#pragma unroll
            for (int of = 1; of < 64; of <<= 1) {
              float n = __shfl_up(inc, of);
              if (tid >= of) inc += n;
            }
            cpre[tid] = inc - v0;
          }
          __syncthreads();
          const float* cuml = (const float*)(ws + WS_CUML) + (size_t)head * L;
          bf16x8 qf[8];
          load_q<128>(qf, P + (size_t)tq * NPE + 2048 + head * 128, h);
          f32x16 o[4];
          zero_o(o);
          float m = NEG, l = 0.f;
          CtxFox ctx{tq, q0w, 2 * qt + 1, 0.08838834764831845f * LOG2E, cuml, cpre};
          attn_run<128, true, true>(qf, o, m, l, P + 3072 + head * 128, NPE, nullptr, 0,
                              (const bf16*)(ws + WS_VTFOX) + (size_t)head * 128 * L, L, 0, ctx, smem);
          float lt = l + __shfl_xor(l, 32);
          store_out_A(o, 1.f / lt, P + (size_t)tq * NPE + 5120 + head * 128, MIXED + (size_t)tq * MIXW + 1024 + head * 128, h);
        } else {
          const int t2 = t - n_fox;
          const int ch = t2 >> 4, gq = t2 & 15;
          float* us = (float*)smem;
          float* xs = (float*)(smem + 32768) + w * 16 * 132;
          __syncthreads();
          for (int i = tid; i < 128 * 8; i += 256) {
            int tt = i >> 3, c8 = (i & 7) * 8;
            uint4 u = *(const uint4*)(P + (size_t)(ch * 128 + tt) * NPE + gq * 64 + c8);
            float* d = us + tt * 64 + c8;
            d[0] = bflo(u.x); d[1] = bfhi(u.x); d[2] = bflo(u.y); d[3] = bfhi(u.y);
            d[4] = bflo(u.z); d[5] = bfhi(u.z); d[6] = bflo(u.w); d[7] = bfhi(u.w);
          }
          __syncthreads();
          const float* S5P = (const float*)(ws + WS_S5P);
          const int g = gq * 4 + w;
          const int gp = g * 64 + lane;
          const float ar = S5P[gp], ai = S5P[4096 + gp];
          const float atr = S5P[8192 + gp], ati = S5P[12288 + gp];
          float xr = 0.f, xi = 0.f;
          {
            const float2* E = (const float2*)(ws + WS_S5E) + gp;
#define CSTEP(e) { float nxr = atr * xr - ati * xi + e.x; float nxi = atr * xi + ati * xr + e.y; xr = nxr; xi = nxi; }
            int c = 0;
            for (; c + 8 <= ch; c += 8) {
              float2 e0 = E[(size_t)(c + 0) * 4096], e1 = E[(size_t)(c + 1) * 4096], e2 = E[(size_t)(c + 2) * 4096],
                     e3 = E[(size_t)(c + 3) * 4096], e4 = E[(size_t)(c + 4) * 4096], e5 = E[(size_t)(c + 5) * 4096],
                     e6 = E[(size_t)(c + 6) * 4096], e7 = E[(size_t)(c + 7) * 4096];
              CSTEP(e0) CSTEP(e1) CSTEP(e2) CSTEP(e3) CSTEP(e4) CSTEP(e5) CSTEP(e6) CSTEP(e7)
            }
            for (; c < ch; ++c) {
              float2 e = E[(size_t)c * 4096];
              CSTEP(e)
            }
#undef CSTEP
          }
          float bbr[16], bbi[16];
#pragma unroll
          for (int c = 0; c < 16; ++c) { bbr[c] = S5P[16384 + gp * 16 + c]; bbi[c] = S5P[16384 + 65536 + gp * 16 + c]; }
          const int chn = lane & 15, kq = lane >> 4;
          float cb[32];
          {
            const float* cre = p.c_re + ((size_t)li * 64 + g) * 1024 + chn * 64;
            const float* cim = p.c_im + ((size_t)li * 64 + g) * 1024 + chn * 64;
#pragma unroll
            for (int ks = 0; ks < 16; ++ks) { cb[ks] = cre[4 * ks + kq]; cb[16 + ks] = -cim[4 * ks + kq]; }
          }
          const float dsk = p.s5_d[li * 1024 + g * 16 + chn];
          bf16* Z = (bf16*)(ws + WS_Z);
          for (int sc = 0; sc < 8; ++sc) {
#pragma unroll 4
            for (int tt = 0; tt < 16; ++tt) {
              const float* up = us + (sc * 16 + tt) * 64 + w * 16;
              float bur = 0.f, bui = 0.f;
#pragma unroll
              for (int c = 0; c < 16; ++c) { float uv = up[c]; bur += bbr[c] * uv; bui += bbi[c] * uv; }
              float nxr = ar * xr - ai * xi + bur;
              float nxi = ar * xi + ai * xr + bui;
              xr = nxr; xi = nxi;
              xs[tt * 132 + lane] = xr;
              xs[tt * 132 + 64 + lane] = xi;
            }
            __syncthreads();
            f32x4 y = {0.f, 0.f, 0.f, 0.f};
#pragma unroll
            for (int ks = 0; ks < 32; ++ks) {
              float a = xs[chn * 132 + 4 * ks + kq];
              y = __builtin_amdgcn_mfma_f32_16x16x4f32(a, cb[ks], y, 0, 0, 0);
            }
#pragma unroll
            for (int i = 0; i < 4; ++i) {
              int tt = 4 * kq + i;
              float uv = us[(sc * 16 + tt) * 64 + w * 16 + chn];
              float yy = y[i] + dsk * uv;
              Z[(size_t)(ch * 128 + sc * 16 + tt) * LDZ + g * 16 + chn] = f2bf(gelu_t(yy));
            }
            __syncthreads();
          }
        }
      }
    }
    if ((PHM & 32) && sub == 3 && even) {
      const bf16* Z = (const bf16*)(ws + WS_Z);
      for (int t = vb; t < 64 * 8; t += nb) {
        int tm, tn;
        tile_map(t, 8, tm, tn);
        const int m0 = tm * 128, n0 = tn * 128;
        ALin af{Z + (size_t)m0 * LDZ, LDZ};
        gemm_tile(af, (const bf16*)(ws + WS_WMISC + WM_GLU) + (size_t)n0 * LDZ, LDZ, 1024, smem, [&](const float* Cs) {
          epi_rows(Cs, [&](int row, int cc, const float* v) {
            uint4 zu = *(const uint4*)(Z + (size_t)(m0 + row) * LDZ + n0 + cc);
            uint4 gu = *(const uint4*)(P + (size_t)(m0 + row) * NPE + 1024 + n0 + cc);
            float zz[8] = {bflo(zu.x), bfhi(zu.x), bflo(zu.y), bfhi(zu.y), bflo(zu.z), bfhi(zu.z), bflo(zu.w), bfhi(zu.w)};
            float gg[8] = {bflo(gu.x), bfhi(gu.x), bflo(gu.y), bfhi(gu.y), bflo(gu.z), bfhi(gu.z), bflo(gu.w), bfhi(gu.w)};
            float o[8];
#pragma unroll
            for (int e = 0; e < 8; ++e) o[e] = zz[e] * sigm(v[e]) * silu(gg[e]);
            *(uint4*)(MIXED + (size_t)(m0 + row) * MIXW + n0 + cc) = pack8(o);
          });
        });
      }
    }
    if ((PHM & 64) && sub == 1 && !even) {
      const int cw = 0;
      const int n_c1 = 32, n_q = 64 * 12, n_kv = 64 * 16, n_mem = 0;
      float* rsx = (float*)(smem + SM_EXTRA);
      for (int t = vb; t < n_c1 + n_q + n_kv + n_mem + cw; t += nb) {
        if (t < n_c1) {
          const int which = t >> 4, tm = (t >> 1) & 7, tn = t & 1;
          const int m0 = tm * 128, n0 = tn * 128;
          __syncthreads();
          if (tid < 128) {
            const float* CB = (const float*)(ws + WS_CMPB) + which * 16 * 256 + n0 + tid;
            float b = 0.f;
            for (int q = 0; q < 16; ++q) b += CB[q * 256];
            rsx[tid] = b;
          }
          ACmp af{P + (which ? 3328 : 3072), m0};
          bf16* HID = (bf16*)(ws + WS_HID) + (size_t)which * 1024 * 256;
          gemm_tile(af, (const bf16*)(ws + WS_WMISC + WM_W1) + (size_t)which * 256 * 4096 + (size_t)n0 * 4096, 4096, 4096,
                    smem, [&](const float* Cs) {
                      epi_rows(Cs, [&](int row, int cc, const float* v) {
                        float o[8];
#pragma unroll
                        for (int e = 0; e < 8; ++e) o[e] = gelu_t(v[e] + rsx[cc + e]);
                        *(uint4*)(HID + (size_t)(m0 + row) * 256 + n0 + cc) = pack8(o);
                      });
                    });
        } else if (t < n_c1 + n_q + n_kv) {
          const int t2 = t - n_c1;
          const bool isq = t2 < n_q;
          const int t3 = isq ? t2 : t2 - n_q;
          const int ntn = isq ? 12 : 16;
          int tm, tn;
          tile_map(t3, ntn, tm, tn);
          const int m0 = tm * 128, n0 = tn * 128;
          const bf16* Ab = P + (size_t)m0 * NPO + (isq ? 0 : 512);
          __syncthreads();
          for (int r8 = 0; r8 < 4; ++r8) {
            float ssq[8];
#pragma unroll
            for (int q = 0; q < 8; ++q) {
              int row = w * 32 + r8 * 8 + q;
              uint4 u = *(const uint4*)(Ab + (size_t)row * NPO + lane * 8);
              float a0 = bflo(u.x), a1 = bfhi(u.x), a2 = bflo(u.y), a3 = bfhi(u.y), a4 = bflo(u.z), a5 = bfhi(u.z),
                    a6 = bflo(u.w), a7 = bfhi(u.w);
              ssq[q] = a0 * a0 + a1 * a1 + a2 * a2 + a3 * a3 + a4 * a4 + a5 * a5 + a6 * a6 + a7 * a7;
            }
#pragma unroll
            for (int q = 0; q < 8; ++q) {
              float ss = wave_sum(ssq[q]);
              if (lane == 0) rsx[w * 32 + r8 * 8 + q] = rsqrtf(ss * (1.f / 512.f) + EPS);
            }
          }
          ALin af{Ab, NPO};
          if (isq) {
            bf16* QM = (bf16*)(ws + WS_QMLA);
            gemm_tile(af, (const bf16*)(ws + WS_WMISC + WM_UQ) + (size_t)n0 * 512, 512, 512, smem, [&](const float* Cs) {
              const int md = n0 % 192;
              const int ropehalf = md == 128 ? 0 : (md == 64 ? 1 : -1);
              epi_rows(Cs, [&](int row, int cc, const float* v) {
                if ((cc >> 6) == ropehalf) return;
                float o[8];
                float sc = rsx[row];
#pragma unroll
                for (int e = 0; e < 8; ++e) o[e] = v[e] * sc;
                *(uint4*)(QM + (size_t)(m0 + row) * 1536 + n0 + cc) = pack8(o);
              });
              if (ropehalf >= 0) {
                epi_rope(Cs, ropehalf * 64, m0, ROPEC, ROPES, 1.f, [&](int row, int cl, const float* v) {
                  float o[8];
                  float sc = rsx[row];
#pragma unroll
                  for (int e = 0; e < 8; ++e) o[e] = v[e] * sc;
                  *(uint4*)(QM + (size_t)(m0 + row) * 1536 + n0 + ropehalf * 64 + cl) = pack8(o);
                });
              }
            });
          } else {
            gemm_tile(af, (const bf16*)(ws + WS_WMISC + WM_UKV) + (size_t)n0 * 512, 512, 512, smem, [&](const float* Cs) {
              const int head = n0 >> 8, part = (n0 >> 7) & 1;
              if (part == 0) {
                bf16* KM = (bf16*)(ws + WS_KMLA);
                epi_rows(Cs, [&](int row, int cc, const float* v) {
                  float o[8];
                  float sc = rsx[row];
#pragma unroll
                  for (int e = 0; e < 8; ++e) o[e] = v[e] * sc;
                  *(uint4*)(KM + (size_t)(m0 + row) * 1024 + head * 128 + cc) = pack8(o);
                });
              } else {
                bf16* VT = (bf16*)(ws + WS_VTMLA);
                epi_cols(Cs, [&](int col, int r8, const float* v) {
                  float o[8];
#pragma unroll
                  for (int e = 0; e < 8; ++e) o[e] = v[e] * rsx[r8 + e];
                  *(uint4*)(VT + (size_t)(head * 128 + col) * L + m0 + r8) = pack8(o);
                });
              }
            });
          }
        } else if (t < n_c1 + n_q + n_kv + n_mem) {
          mem_attn_task(t - n_c1 - n_q - n_kv);
        } else {
          cvt_set_task(p, SET_OUT, layer, t - n_c1 - n_q - n_kv - n_mem, smem);
        }
      }
    }
    if ((PHM & 128) && sub == 2 && !even) {
      const int n_c2 = 16, n_mem2 = 256;
      for (int t = bid; t < n_c2 + n_mem2; t += nb) {
        if (t >= n_c2) {
          mem_attn_task(t - n_c2);
        } else {
          const int t2 = t;
          const int which = t2 >> 3, m0 = (t2 & 7) * 128;
          ALin af{(const bf16*)(ws + WS_HID) + (size_t)which * 1024 * 256 + (size_t)m0 * 256, 256};
          gemm_tile(af, (const bf16*)(ws + WS_WMISC + WM_W2) + (size_t)which * 128 * 256, 256, 256, smem, [&](const float* Cs) {
            if (which == 0) {
              bf16* KC = (bf16*)(ws + WS_KC);
              epi_rows(Cs, [&](int row, int cc, const float* v) {
                int gr = m0 + row;
                int n = gr >> 1, g = gr & 1;
                *(uint4*)(KC + ((size_t)g * 512 + n) * 128 + cc) = pack8(v);
              });
            } else {
              bf16* VC = (bf16*)(ws + WS_VCT);
              for (int i = tid; i < 128 * 128; i += 256) {
                int row = i & 127, col = i >> 7;
                int gr = m0 + row;
                int n = gr >> 1, g = gr & 1;
                VC[((size_t)g * 128 + col) * 512 + n] = f2bf(Cs[row * 132 + col]);
              }
            }
          });
        }
      }
    }
    if ((PHM & 256) && sub == 3 && !even) {
      const int* pos = p.pos;
      float* lut = (float*)(smem + AT_X0);
      float* imp = (float*)(smem + AT_IMP);
      unsigned* sel = (unsigned*)(smem + AT_SEL);
      const float* GT = (const float*)(ws + WS_FLOG);
      float* NSAO = (float*)(ws + WS_NSAO);
      for (;;) {
        const int tt_ = fetch_task(CTR + ph);
        if (tt_ >= 1024) break;
        const int t = tt_ >> 1;
        const int tid = otid(), lane = tid & 63, w = tid >> 6, r = lane & 31, h = lane >> 5;
        int zt_;
        asm volatile("s_mov_b32 %0, 0" : "=s"(zt_));
        char* const ws = ws_ph + zt_;
        if ((tt_ & 1) == 0) {
          const int qt = 63 - (t >> 3), head = t & 7;
          const int q0w = qt * 128 + w * 32, tq = q0w + r;
          bf16x8 qf[12];
          load_q<192>(qf, (const bf16*)(ws + WS_QMLA) + (size_t)tq * 1536 + head * 192, h);
          f32x16 o[4];
          zero_o(o);
          float m = NEG, l = 0.f;
          CtxCausal ctx{tq, q0w, 2 * qt + 1, 0.07216878364870322f * LOG2E};
          attn_run<192, true, true>(qf, o, m, l, (const bf16*)(ws + WS_KMLA) + head * 128, 1024, P + 6656, NPO,
                              (const bf16*)(ws + WS_VTMLA) + (size_t)head * 128 * L, L, 0, ctx, smem);
          float lt = l + __shfl_xor(l, 32);
          store_out_A(o, 1.f / lt, P + (size_t)tq * NPO + 1024 + head * 128, MIXED + (size_t)tq * MIXW + head * 128, h);
          continue;
        }
        const int qt = 255 - (t >> 1), g = t & 1;
        const int q0 = qt * 32;
        const int hr = r >> 3, qi = r & 7;
        const int ql = w * 8 + qi;
        const int tq = q0 + ql;
        const int head = g * 4 + hr;
        const int posq = pos[tq];
        __syncthreads();
        for (int i = tid; i < 4 * 800; i += 256) {
          int rr = i / 800, n = i % 800;
          int b;
          if (n < 16) b = n;
          else {
            float lr = logf((float)n / 16.f) / 4.1588830833596715f;
            b = 16 + (int)(lr * 16.f);
            if (b > 31) b = 31;
          }
          lut[i] = p.t5[b * 8 + g * 4 + rr] * LOG2E;
        }
        for (int i = tid; i < 32 * 132; i += 256) imp[i] = 0.f;
        __syncthreads();
        const float* lutr = lut + hr * 800;
        bf16x8 qf[8];
        load_q<128>(qf, P + (size_t)tq * NPO + 2048 + head * 128, h);
        const float sc = 0.08838834764831845f * LOG2E;
        f32x16 o[4];
        float* orow = NSAO + (size_t)tq * 1024 + head * 128;

        const int ncv = min(q0 / 16 + 1, 511);
        const int last_c = (ncv - 1) >> 6;
        float m = NEG, l = 0.f;
        CtxCmp cc{tq, posq, last_c, sc, lutr, pos, 0.f, imp, ql, false};
        zero_o(o);
        const bf16* KCg = (const bf16*)(ws + WS_KC) + (size_t)g * 512 * 128;
        const bf16* VCg = (const bf16*)(ws + WS_VCT) + (size_t)g * 128 * 512;
        attn_run<128, false, false>(qf, o, m, l, KCg, 128, nullptr, 0, VCg, 512, 0, cc, smem);
        float lt = l + __shfl_xor(l, 32);
        const bool has_c = m > -1e29f;
        float m2 = has_c ? m : 0.f;
        float invl = has_c ? 1.f / lt : 0.f;
        cc.invl = invl; cc.p2 = true;
        float l2 = 0.f;
        attn_run<128, true, false>(qf, o, m2, l2, KCg, 128, nullptr, 0, VCg, 512, 0, cc, smem);
        {
          float gs = sigm(GT[(size_t)tq * 24 + head * 3 + 0]) * invl;
#pragma unroll
          for (int d = 0; d < 4; ++d)
#pragma unroll
            for (int i4 = 0; i4 < 4; ++i4) {
              int dv0 = d * 32 + 8 * i4 + 4 * h;
              float4 v = make_float4(o[d][4 * i4] * gs, o[d][4 * i4 + 1] * gs, o[d][4 * i4 + 2] * gs, o[d][4 * i4 + 3] * gs);
              *(float4*)(orow + dv0) = v;
            }
        }
        __syncthreads();
        for (int q8 = 0; q8 < 8; ++q8) {
          const int qq = w * 8 + q8;
          const int tt = q0 + qq;
          const int cur = tt >> 6;
          const float* ip = imp + qq * 132;
          const int j0 = lane, j1 = lane + 64;
          const bool v0 = j0 <= cur, v1 = j1 <= cur;
          const bool f0 = (j0 == 0) || (j0 == cur) || (j0 == cur - 1);
          const bool f1 = (j1 == cur) || (j1 == cur - 1);
          const int nforced = cur == 0 ? 1 : (cur == 1 ? 2 : 3);
          const int nfree = 16 - nforced;
          const bool c0 = v0 && !f0, c1 = v1 && !f1;
          const unsigned u0 = __float_as_uint(ip[j0]), u1 = __float_as_uint(ip[j1]);
          const int ncand = __popcll(__ballot(c0)) + __popcll(__ballot(c1));
          bool s0, s1;
          if (ncand <= nfree) {
            s0 = v0; s1 = v1;
          } else {
            unsigned T = 0u;
            for (int bit = 30; bit >= 0; --bit) {
              const unsigned cth = T | (1u << bit);
              const int cnt = __popcll(__ballot(c0 && u0 >= cth)) + __popcll(__ballot(c1 && u1 >= cth));
              if (cnt >= nfree) T = cth;
            }
            const bool g0 = c0 && u0 > T, g1 = c1 && u1 > T;
            const bool e0 = c0 && u0 == T, e1 = c1 && u1 == T;
            const unsigned long long me0 = __ballot(e0), me1 = __ballot(e1);
            const int need0 = nfree - (__popcll(__ballot(g0)) + __popcll(__ballot(g1)));
            const int need1 = need0 - __popcll(me0);
            const int rk0 = __builtin_amdgcn_mbcnt_hi((unsigned)(me0 >> 32), __builtin_amdgcn_mbcnt_lo((unsigned)me0, 0u));
            const int rk1 = __builtin_amdgcn_mbcnt_hi((unsigned)(me1 >> 32), __builtin_amdgcn_mbcnt_lo((unsigned)me1, 0u));
            s0 = (v0 && f0) || g0 || (e0 && rk0 < need0);
            s1 = (v1 && f1) || g1 || (e1 && rk1 < need1);
          }
          unsigned long long b0 = __ballot(s0), b1 = __ballot(s1);
          if (lane == 0) {
            sel[qq * 4 + 0] = (unsigned)b0; sel[qq * 4 + 1] = (unsigned)(b0 >> 32);
            sel[qq * 4 + 2] = (unsigned)b1; sel[qq * 4 + 3] = (unsigned)(b1 >> 32);
          }
        }
        __syncthreads();
        unsigned un0, un1, un2, un3;
        {
          un0 = sel[r * 4 + 0]; un1 = sel[r * 4 + 1]; un2 = sel[r * 4 + 2]; un3 = sel[r * 4 + 3];
#pragma unroll
          for (int of = 1; of < 32; of <<= 1) {
            un0 |= __shfl_xor(un0, of); un1 |= __shfl_xor(un1, of); un2 |= __shfl_xor(un2, of); un3 |= __shfl_xor(un3, of);
          }
          un0 = __builtin_amdgcn_readfirstlane(un0); un1 = __builtin_amdgcn_readfirstlane(un1);
          un2 = __builtin_amdgcn_readfirstlane(un2); un3 = __builtin_amdgcn_readfirstlane(un3);
        }
        {
          const unsigned long long ulo = (unsigned long long)un0 | ((unsigned long long)un1 << 32);
          const unsigned long long uhi = (unsigned long long)un2 | ((unsigned long long)un3 << 32);
          const unsigned long long mlo = (unsigned long long)sel[ql * 4] | ((unsigned long long)sel[ql * 4 + 1] << 32);
          const unsigned long long mhi = (unsigned long long)sel[ql * 4 + 2] | ((unsigned long long)sel[ql * 4 + 3] << 32);
          int pqmin = pos[q0];
          for (int q = 1; q < 32; ++q) pqmin = min(pqmin, pos[q0 + q]);
          const int* posmax = (const int*)(ws + WS_POSMAX);
          zero_o(o);
          m = NEG; l = 0.f;
          {
            CtxSlc cs{tq, posq, sc, lutr, pos, ulo, uhi, mlo, mhi, posmax, pqmin, q0};
            attn_run<128, true, false>(qf, o, m, l, P + 3584 + g * 128, NPO, nullptr, 0,
                                       (const bf16*)(ws + WS_VTSLC) + (size_t)g * 128 * L, L, cs.next(-1), cs, smem);
          }
          {
            CtxSlcFar cf{sc, lutr[799], ulo, uhi, mlo, mhi, posmax, pqmin, q0};
            attn_run<128, true, false>(qf, o, m, l, P + 3584 + g * 128, NPO, nullptr, 0,
                                       (const bf16*)(ws + WS_VTSLC) + (size_t)g * 128 * L, L, cf.next(-1), cf, smem);
          }
          lt = l + __shfl_xor(l, 32);
          float gs = sigm(GT[(size_t)tq * 24 + head * 3 + 1]) / lt;
#pragma unroll
          for (int d = 0; d < 4; ++d)
#pragma unroll
            for (int i4 = 0; i4 < 4; ++i4) {
              int dv0 = d * 32 + 8 * i4 + 4 * h;
              float4 v = *(float4*)(orow + dv0);
              v.x += o[d][4 * i4] * gs; v.y += o[d][4 * i4 + 1] * gs; v.z += o[d][4 * i4 + 2] * gs; v.w += o[d][4 * i4 + 3] * gs;
              *(float4*)(orow + dv0) = v;
            }
        }
        {
          const int kfirst = q0 - 511 > 0 ? (q0 - 511) >> 6 : 0;
          CtxWin cwn{tq, posq, (q0 + 31) >> 6, sc, lutr, pos};
          zero_o(o);
          m = NEG; l = 0.f;
          attn_run<128, true, false>(qf, o, m, l, P + 4096 + g * 128, NPO, nullptr, 0,
                              (const bf16*)(ws + WS_VTWIN) + (size_t)g * 128 * L, L, kfirst, cwn, smem);
          lt = l + __shfl_xor(l, 32);
          float gs = sigm(GT[(size_t)tq * 24 + head * 3 + 2]) / lt;
          const bf16* grow = P + (size_t)tq * NPO + 4608 + head * 128;
          bf16* mrow = MIXED + (size_t)tq * MIXW + 1024 + head * 128;
#pragma unroll
          for (int d = 0; d < 4; ++d)
#pragma unroll
            for (int i4 = 0; i4 < 4; ++i4) {
              int dv0 = d * 32 + 8 * i4 + 4 * h;
              float4 v = *(float4*)(orow + dv0);
              v.x += o[d][4 * i4] * gs; v.y += o[d][4 * i4 + 1] * gs; v.z += o[d][4 * i4 + 2] * gs; v.w += o[d][4 * i4 + 3] * gs;
              uint2 gu = *(const uint2*)(grow + dv0);
              uint2 ou;
              ou.x = pack2(v.x * silu(bflo(gu.x)), v.y * silu(bfhi(gu.x)));
              ou.y = pack2(v.z * silu(bflo(gu.y)), v.w * silu(bfhi(gu.y)));
              *(uint2*)(mrow + dv0) = ou;
            }
        }
      }
    }
    if ((PHM & 2) && (ph == 0 || (sub == 2 && even) || (sub == 3 && !even))) {
      const int nl = ph == 0 ? 0 : layer + 1;
      if (nl < 4) {
        const int n_cv = cvt_next_count(p, nl), n_cv4 = (n_cv + 3) >> 2;
        const bool dyn = ph != 0;
        int t = dyn ? fetch_task(CTR + 32 + ph) : bid;
        while (t < n_cv4) {
          for (int q = 0; q < 4; ++q) {
            const int ci = t * 4 + q;
            if (ci < n_cv) cvt_next(p, smem, nl, ci);
          }
          t = dyn ? fetch_task(CTR + 32 + ph) : t + nb;
        }
      }
    }
    if ((PHM & 512) && sub == 4) {
      const float* hin = layer == 0 ? p.x : hbuf;
      for (int t = vb; t < 64 * 8; t += nb) {
        int tm, tn;
        tile_map(t, 8, tm, tn);
        const int m0 = tm * 128;
        int n0 = tn * 256;
        ALin af{MIXED + (size_t)m0 * MIXW, MIXW};
        gemm_tile2(af, (const bf16*)(ws + WS_WOUT) + (size_t)n0 * MIXW, MIXW, MIXW, smem, n0, 2, [&](const float* Cs) {
          const int tid2 = otid();
#pragma unroll
          for (int j = 0; j < 16; ++j) {
            int c = tid2 + 256 * j;
            int row = c >> 5, cc = (c & 31) * 4;
            float4 a = *(const float4*)(Cs + row * 132 + cc);
            float4 hv = *(const float4*)(hin + (size_t)(m0 + row) * DM + n0 + cc);
            hv.x += a.x; hv.y += a.y; hv.z += a.z; hv.w += a.w;
            *(float4*)(hbuf + (size_t)(m0 + row) * DM + n0 + cc) = hv;
          }
        });
      }
    }
    }
  }
}

extern "C" void kernel_launch(void* const* d_in, const int* in_sizes, int n_in, void* d_out, int out_size, void* d_ws,
                              size_t ws_size, hipStream_t stream) {
  Params p{};
  p.x = (const float*)d_in[0]; p.mem = (const float*)d_in[1]; p.pos = (const int*)d_in[2];
  p.norm_g = (const float*)d_in[3]; p.mem_norm_g = (const float*)d_in[4]; p.final_norm_g = (const float*)d_in[5];
  p.t5 = (const float*)d_in[6]; p.w_out = (const float*)d_in[7]; p.mem_w_kv = (const float*)d_in[8];
  p.even_w_in = (const float*)d_in[9]; p.lam_re = (const float*)d_in[10]; p.lam_im = (const float*)d_in[11];
  p.log_dt = (const float*)d_in[12]; p.b_re = (const float*)d_in[13]; p.b_im = (const float*)d_in[14];
  p.c_re = (const float*)d_in[15]; p.c_im = (const float*)d_in[16]; p.s5_d = (const float*)d_in[17];
  p.w_glu = (const float*)d_in[18]; p.fox_b_f = (const float*)d_in[19]; p.odd_w_in = (const float*)d_in[20];
  p.g_cq = (const float*)d_in[21]; p.g_ckv = (const float*)d_in[22]; p.w_uq = (const float*)d_in[23];
  p.w_ukv = (const float*)d_in[24]; p.cmp_pe = (const float*)d_in[25]; p.cmp_w1 = (const float*)d_in[26];
  p.cmp_w2 = (const float*)d_in[27];
  p.out = (float*)d_out; p.ws = (char*)d_ws;
  if (ws_size < WS_END) fprintf(stderr, "workspace too small: %zu < %zu\n", ws_size, (size_t)WS_END);
  static int grid_blocks = 0;
  if (!grid_blocks) {
    int dev = 0, cus = 0, per_cu = 0;
    hipGetDevice(&dev);
    hipDeviceGetAttribute(&cus, hipDeviceAttributeMultiprocessorCount, dev);
    hipOccupancyMaxActiveBlocksPerMultiprocessor(&per_cu, mega, 256, 0);
    if (per_cu > 2) per_cu = 2;
    if (per_cu < 1) per_cu = 1;
    grid_blocks = cus * per_cu;
  }
  (void)hipMemsetAsync((char*)d_ws + WS_BAR, 0, XCD_BAR_WORDS * sizeof(unsigned), stream);
#if MULTI_LAUNCH
  for (int ph = 0; ph <= 24; ++ph) {
    int lo = ph, hi = ph;
    void* args[] = {&p, &lo, &hi};
    hipLaunchCooperativeKernel((void*)mega, dim3(grid_blocks), dim3(256), args, 0, stream);
  }
#else
  int lo = 0, hi = 24;
  void* args[] = {&p, &lo, &hi};
  hipError_t e = hipLaunchCooperativeKernel((void*)mega, dim3(grid_blocks), dim3(256), args, 0, stream);
  if (e != hipSuccess) fprintf(stderr, "cooperative launch failed: %s (grid %d)\n", hipGetErrorString(e), grid_blocks);
#endif
}
```

```cpp
#include <hip/hip_runtime.h>
#include <hip/hip_cooperative_groups.h>
#include <cstdio>
#include <cstdint>
namespace cg = cooperative_groups;

typedef unsigned short bf16;
typedef short bf16x8 __attribute__((ext_vector_type(8)));
typedef float f32x16 __attribute__((ext_vector_type(16)));
typedef float f32x4 __attribute__((ext_vector_type(4)));
typedef __bf16 bf2v __attribute__((ext_vector_type(2)));
typedef float f2v __attribute__((ext_vector_type(2)));

#define DI __device__ __forceinline__
#define MFMA32(a, b, c) __builtin_amdgcn_mfma_f32_32x32x16_bf16((a), (b), (c), 0, 0, 0)

#ifndef LB2
#define LB2 2
#endif
#ifndef REP_PH
#define REP_PH -1
#endif
#ifndef PHM
#define PHM 1023
#endif
#ifndef MULTI_LAUNCH
#define MULTI_LAUNCH 0
#endif

constexpr int L = 8192;
constexpr int DM = 2048;
constexpr int NPE = 7296;
constexpr int NPO = 6784;
constexpr int EVEN_IN = 7176;
constexpr int ODD_IN = 6744;
constexpr int MIXW = 2560;
constexpr int LDX = 2112;
constexpr int LDZ = 1088;
constexpr float LOG2E = 1.4426950408889634f;
constexpr float NEG = -1e30f;
constexpr float EPS = 1e-6f;

constexpr size_t MB = 1024 * 1024;
constexpr size_t WS_WIN = 0;
constexpr size_t WS_WOUT = WS_WIN + 32 * MB;
constexpr size_t WS_WMEM = WS_WOUT + 10 * MB;
constexpr size_t WS_WMISC = WS_WMEM + 4 * MB;
constexpr size_t WS_XN = WS_WMISC + 11 * MB;
constexpr size_t WS_MEMN = WS_XN + 36 * MB;
constexpr size_t WS_P = WS_MEMN + 1 * MB;
constexpr size_t WS_MIXED = WS_P + 114 * MB;
constexpr size_t WS_MEMK = WS_MIXED + 40 * MB;
constexpr size_t WS_MEMVT = WS_MEMK + 256 * 1024;
constexpr size_t WS_ROPEC = WS_MEMVT + 256 * 1024;
constexpr size_t WS_ROPES = WS_ROPEC + 1 * MB;
constexpr size_t WS_FLOG = WS_ROPES + 1 * MB;
constexpr size_t WS_CUML = WS_FLOG + 1 * MB;
constexpr size_t WS_CT = WS_CUML + 256 * 1024;
constexpr size_t WS_S5P = WS_CT + 4096;
constexpr size_t WS_S5E = WS_S5P + 1 * MB;
constexpr size_t WS_CMPB = WS_S5E + 2 * MB;
constexpr size_t WS_CTR = WS_CMPB + 64 * 1024;
constexpr size_t WS_BAR = WS_CTR + 4096;
constexpr size_t WS_POSMAX = WS_BAR + 16384;
constexpr size_t WS_VAR = WS_POSMAX + 4096;
constexpr size_t WS_Z = WS_VAR;
constexpr size_t WS_VTFOX = WS_Z + 18 * MB;
constexpr size_t WS_QMLA = WS_VAR;
constexpr size_t WS_KMLA = WS_QMLA + 24 * MB;
constexpr size_t WS_VTMLA = WS_KMLA + 16 * MB;
constexpr size_t WS_VTSLC = WS_VTMLA + 16 * MB;
constexpr size_t WS_VTWIN = WS_VTSLC + 4 * MB;
constexpr size_t WS_HID = WS_VTWIN + 4 * MB;
constexpr size_t WS_KC = WS_HID + 1 * MB;
constexpr size_t WS_VCT = WS_KC + 256 * 1024;
constexpr size_t WS_NSAO = WS_VCT + 256 * 1024;
constexpr size_t WS_END = WS_NSAO + 32 * MB;
constexpr size_t WM_GLU = 0;
constexpr size_t WM_UQ = 5 * MB / 2;
constexpr size_t WM_UKV = WM_UQ + 1536 * 512 * 2;
constexpr size_t WM_W1 = WM_UKV + 2048 * 512 * 2;
constexpr size_t WM_W2 = WM_W1 + 2 * 256 * 4096 * 2;

constexpr int SM_EXTRA = 73728;
constexpr int SM_TOTAL = 73728 + 1024;

struct Params {
  const float *x, *mem;
  const int* pos;
  const float *norm_g, *mem_norm_g, *final_norm_g, *t5, *w_out, *mem_w_kv, *even_w_in, *lam_re, *lam_im, *log_dt,
      *b_re, *b_im, *c_re, *c_im, *s5_d, *w_glu, *fox_b_f, *odd_w_in, *g_cq, *g_ckv, *w_uq, *w_ukv, *cmp_pe,
      *cmp_w1, *cmp_w2;
  float* out;
  char* ws;
};

DI unsigned pack2(float a, float b) {
  f2v v = {a, b};
  bf2v r = __builtin_convertvector(v, bf2v);
  return __builtin_bit_cast(unsigned, r);
}
DI float bflo(unsigned u) { return __uint_as_float(u << 16); }
DI float bfhi(unsigned u) { return __uint_as_float(u & 0xffff0000u); }
DI float bf2f(bf16 v) { return __uint_as_float(((unsigned)v) << 16); }
DI bf16 f2bf(float f) { return (bf16)(pack2(f, 0.f) & 0xffffu); }
DI int otid() { int z; asm volatile("s_mov_b32 %0, 0" : "=s"(z)); return (int)threadIdx.x + z; }
DI int crow(int i, int h) { return (i & 3) + 8 * (i >> 2) + 4 * h; }
DI float sigm(float x) { return 1.f / (1.f + __expf(-x)); }
DI float silu(float x) { return x * sigm(x); }
DI float gelu_t(float x) {
  float u = 0.7978845608028654f * (x + 0.044715f * x * x * x);
  float e = __expf(2.f * u);
  float t = 1.f - 2.f / (e + 1.f);
  return 0.5f * x * (1.f + t);
}
DI float ex2(float x) { return __builtin_amdgcn_exp2f(x); }
DI float wave_sum(float v) {
#pragma unroll
  for (int o = 32; o > 0; o >>= 1) v += __shfl_xor(v, o);
  return v;
}
DI uint4 pack8(const float* v) {
  uint4 u;
  u.x = pack2(v[0], v[1]); u.y = pack2(v[2], v[3]); u.z = pack2(v[4], v[5]); u.w = pack2(v[6], v[7]);
  return u;
}

struct CvtSeg {
  const float* src; int lds; int sc0; bf16* dst; int dr0; int ncols; int npad; int K; const float* kscale; int ldd;
};
DI int cvt_count(const CvtSeg& s) { return (s.K >> 6) * (s.npad >> 6); }
DI void cvt_tile(const CvtSeg& s, int tile, char* smem) {
  float* T = (float*)smem;
  const int tid = otid();
  const int nkt = s.K >> 6;
  const int kt = tile % nkt, nt = tile / nkt;
  const int k0 = kt * 64, n0 = nt * 64;
  __syncthreads();
#pragma unroll
  for (int i = 0; i < 4; ++i) {
    const int k = i * 16 + (tid >> 4), n4 = (tid & 15) * 4;
    float4 v = make_float4(0.f, 0.f, 0.f, 0.f);
    if (n0 + n4 < s.ncols) {
      v = *(const float4*)(s.src + (size_t)(k0 + k) * s.lds + s.sc0 + n0 + n4);
      if (s.kscale) { float sc = s.kscale[k0 + k]; v.x *= sc; v.y *= sc; v.z *= sc; v.w *= sc; }
    }
    float* d = T + k * 65 + n4;
    d[0] = v.x; d[1] = v.y; d[2] = v.z; d[3] = v.w;
  }
  __syncthreads();
#pragma unroll
  for (int j = 0; j < 2; ++j) {
    int c = tid + 256 * j;
    int n = c >> 3, kc = (c & 7) * 8;
    float v[8];
#pragma unroll
    for (int e = 0; e < 8; ++e) v[e] = T[(kc + e) * 65 + n];
    *(uint4*)(s.dst + (size_t)(s.dr0 + n0 + n) * s.ldd + k0 + kc) = pack8(v);
  }
}

enum { SET_IN_EVEN = 0, SET_IN_ODD, SET_OUT, SET_MEM, SET_MISC_EVEN, SET_MISC_ODD };
DI int cvt_nseg(int set) {
  switch (set) {
    case SET_IN_EVEN: return 3;
    case SET_IN_ODD: return 5;
    case SET_OUT: return 1;
    case SET_MEM: return 1;
    case SET_MISC_EVEN: return 1;
    default: return 6;
  }
}
DI CvtSeg cvt_get(const Params& p, int set, int li, int s) {
  CvtSeg r;
  r.kscale = nullptr;
  char* ws = p.ws;
  if (set == SET_IN_EVEN) {
    r.src = p.even_w_in + (size_t)li * DM * EVEN_IN; r.lds = EVEN_IN; r.K = DM; r.dst = (bf16*)(ws + WS_WIN);
    if (s == 0) { r.sc0 = 0; r.dr0 = 0; r.ncols = 5120; r.npad = 5120; }
    else if (s == 1) { r.sc0 = 5128; r.dr0 = 5120; r.ncols = 2048; r.npad = 2048; }
    else { r.sc0 = 5120; r.dr0 = 7168; r.ncols = 8; r.npad = 128; }
  } else if (set == SET_IN_ODD) {
    r.src = p.odd_w_in + (size_t)li * DM * ODD_IN; r.lds = ODD_IN; r.K = DM; r.dst = (bf16*)(ws + WS_WIN);
    if (s == 0) { r.sc0 = 0; r.dr0 = 0; r.ncols = 1024; r.npad = 1024; }
    else if (s == 1) { r.sc0 = 1088; r.dr0 = 1024; r.ncols = 3584; r.npad = 3584; }
    else if (s == 2) { r.sc0 = 4696; r.dr0 = 4608; r.ncols = 2048; r.npad = 2048; }
    else if (s == 3) { r.sc0 = 1024; r.dr0 = 6656; r.ncols = 64; r.npad = 64; }
    else { r.sc0 = 4672; r.dr0 = 6720; r.ncols = 24; r.npad = 64; }
  } else if (set == SET_OUT) {
    r.src = p.w_out + (size_t)li * MIXW * DM; r.lds = DM; r.K = MIXW; r.dst = (bf16*)(ws + WS_WOUT);
    r.sc0 = 0; r.dr0 = 0; r.ncols = DM; r.npad = DM;
  } else if (set == SET_MEM) {
    r.src = p.mem_w_kv + (size_t)li * DM * 1024; r.lds = 1024; r.K = DM; r.dst = (bf16*)(ws + WS_WMEM);
    r.sc0 = 0; r.dr0 = 0; r.ncols = 1024; r.npad = 1024;
  } else if (set == SET_MISC_EVEN) {
    r.src = p.w_glu + (size_t)li * 1024 * 1024; r.lds = 1024; r.K = 1024; r.dst = (bf16*)(ws + WS_WMISC + WM_GLU);
    r.sc0 = 0; r.dr0 = 0; r.ncols = 1024; r.npad = 1024;
  } else {
    r.sc0 = 0; r.dr0 = 0;
    if (s == 0) {
      r.src = p.w_uq + (size_t)li * 512 * 1536; r.lds = 1536; r.K = 512; r.dst = (bf16*)(ws + WS_WMISC + WM_UQ);
      r.ncols = 1536; r.npad = 1536; r.kscale = p.g_cq + li * 512;
    } else if (s == 1) {
      r.src = p.w_ukv + (size_t)li * 512 * 2048; r.lds = 2048; r.K = 512; r.dst = (bf16*)(ws + WS_WMISC + WM_UKV);
      r.ncols = 2048; r.npad = 2048; r.kscale = p.g_ckv + li * 512;
    } else if (s < 4) {
      int which = s - 2;
      r.src = p.cmp_w1 + (size_t)(li * 2 + which) * 4096 * 256; r.lds = 256; r.K = 4096;
      r.dst = (bf16*)(ws + WS_WMISC + WM_W1) + (size_t)which * 256 * 4096; r.ncols = 256; r.npad = 256;
    } else {
      int which = s - 4;
      r.src = p.cmp_w2 + (size_t)(li * 2 + which) * 256 * 128; r.lds = 128; r.K = 256;
      r.dst = (bf16*)(ws + WS_WMISC + WM_W2) + (size_t)which * 128 * 256; r.ncols = 128; r.npad = 128;
    }
  }
  r.ldd = (set == SET_IN_EVEN || set == SET_IN_ODD) ? LDX : (set == SET_MISC_EVEN ? LDZ : r.K);
  return r;
}
DI int cvt_set_count(const Params& p, int set, int li) {
  int n = 0;
  for (int s = 0; s < cvt_nseg(set); ++s) n += cvt_count(cvt_get(p, set, li, s));
  return n;
}
DI void cvt_set_task(const Params& p, int set, int li, int t, char* smem) {
  const int ns = cvt_nseg(set);
  for (int s = 0; s < ns; ++s) {
    CvtSeg sg = cvt_get(p, set, li, s);
    int c = cvt_count(sg);
    if (t < c) { cvt_tile(sg, t, smem); return; }
    t -= c;
  }
}

DI void norm_row_bf16(const float* __restrict__ src, const float* __restrict__ g, bf16* __restrict__ dst, int lane) {
  float4 v[8];
  float ss = 0.f;
#pragma unroll
  for (int i = 0; i < 8; ++i) {
    v[i] = *(const float4*)(src + (i * 64 + lane) * 4);
    ss += v[i].x * v[i].x + v[i].y * v[i].y + v[i].z * v[i].z + v[i].w * v[i].w;
  }
  ss = wave_sum(ss);
  float r = rsqrtf(ss * (1.f / DM) + EPS);
#pragma unroll
  for (int i = 0; i < 8; ++i) {
    float4 gg = *(const float4*)(g + (i * 64 + lane) * 4);
    uint2 u;
    u.x = pack2(v[i].x * r * gg.x, v[i].y * r * gg.y);
    u.y = pack2(v[i].z * r * gg.z, v[i].w * r * gg.w);
    *(uint2*)(dst + (i * 64 + lane) * 4) = u;
  }
}
DI void norm_row_f32(float* __restrict__ io, const float* __restrict__ g, int lane) {
  float4 v[8];
  float ss = 0.f;
#pragma unroll
  for (int i = 0; i < 8; ++i) {
    v[i] = *(const float4*)(io + (i * 64 + lane) * 4);
    ss += v[i].x * v[i].x + v[i].y * v[i].y + v[i].z * v[i].z + v[i].w * v[i].w;
  }
  ss = wave_sum(ss);
  float r = rsqrtf(ss * (1.f / DM) + EPS);
#pragma unroll
  for (int i = 0; i < 8; ++i) {
    float4 gg = *(const float4*)(g + (i * 64 + lane) * 4);
    float4 o;
    o.x = v[i].x * r * gg.x; o.y = v[i].y * r * gg.y; o.z = v[i].z * r * gg.z; o.w = v[i].w * r * gg.w;
    *(float4*)(io + (i * 64 + lane) * 4) = o;
  }
}

struct ALin {
  const bf16* p; int ld;
  DI const bf16* operator()(int row, int k) const { return p + (size_t)row * ld + k; }
};
struct ACmp {
  const bf16* p; int m0;
  DI const bf16* operator()(int row, int k) const {
    int gr = m0 + row;
    if (gr > 1021) gr = 1021;
    int n = gr >> 1, g = gr & 1;
    return p + (size_t)(16 * n + (k >> 7)) * NPO + g * 128 + (k & 127);
  }
};

template <class AF, class Epi>
DI void gemm_tile(AF af, const bf16* __restrict__ Bt, int ldb, int K, char* smem, Epi epi) {
  const int tid = otid(), lane = tid & 63, w = tid >> 6, r = lane & 31, h = lane >> 5;
  const int wm = w >> 1, wn = w & 1;
  bf16* As = (bf16*)smem;
  bf16* Bs = As + 2 * 128 * 72;
  f32x16 acc[2][2];
#pragma unroll
  for (int a = 0; a < 2; ++a)
#pragma unroll
    for (int b = 0; b < 2; ++b)
#pragma unroll
      for (int i = 0; i < 16; ++i) acc[a][b][i] = 0.f;
  uint4 ra0_0, ra0_1, ra0_2, ra0_3, rb0_0, rb0_1, rb0_2, rb0_3, ra1_0, ra1_1, ra1_2, ra1_3, rb1_0, rb1_1, rb1_2, rb1_3;
#define LD1(S, I, K0)                                                                  \
  {                                                                                    \
    int c = tl + 256 * I;                                                              \
    int row = c >> 3, kc = (c & 7) * 8;                                                \
    ra##S##_##I = *(const uint4*)af(row, (K0) + kc);                                   \
    rb##S##_##I = *(const uint4*)(Bt + (size_t)row * ldb + (K0) + kc);                 \
  }
#define ST1(S, I, BUF)                                                                 \
  {                                                                                    \
    int c = tid + 256 * I;                                                             \
    int row = c >> 3, kc = (c & 7) * 8;                                                \
    *(uint4*)(As + (BUF) * 9216 + row * 72 + kc) = ra##S##_##I;                        \
    *(uint4*)(Bs + (BUF) * 9216 + row * 72 + kc) = rb##S##_##I;                        \
  }
#define GLOAD(S, K0) { const int tl = otid(); LD1(S, 0, K0) LD1(S, 1, K0) LD1(S, 2, K0) LD1(S, 3, K0) }
#define SSTORE(S, BUF) { ST1(S, 0, BUF) ST1(S, 1, BUF) ST1(S, 2, BUF) ST1(S, 3, BUF) }
  auto compute = [&](int buf) {
    const bf16* a_ = As + buf * 9216 + (wm * 64 + r) * 72 + h * 8;
    const bf16* b_ = Bs + buf * 9216 + (wn * 64 + r) * 72 + h * 8;
    bf16x8 fa0, fa1, fb0, fb1, ga0, ga1, gb0, gb1, ha0, ha1, hb0, hb1, ia0, ia1, ib0, ib1;
    fa0 = *(const bf16x8*)(a_ + 0);            fa1 = *(const bf16x8*)(a_ + 32 * 72);
    fb0 = *(const bf16x8*)(b_ + 0);            fb1 = *(const bf16x8*)(b_ + 32 * 72);
    ga0 = *(const bf16x8*)(a_ + 16);           ga1 = *(const bf16x8*)(a_ + 32 * 72 + 16);
    gb0 = *(const bf16x8*)(b_ + 16);           gb1 = *(const bf16x8*)(b_ + 32 * 72 + 16);
    ha0 = *(const bf16x8*)(a_ + 32);           ha1 = *(const bf16x8*)(a_ + 32 * 72 + 32);
    hb0 = *(const bf16x8*)(b_ + 32);           hb1 = *(const bf16x8*)(b_ + 32 * 72 + 32);
    ia0 = *(const bf16x8*)(a_ + 48);           ia1 = *(const bf16x8*)(a_ + 32 * 72 + 48);
    ib0 = *(const bf16x8*)(b_ + 48);           ib1 = *(const bf16x8*)(b_ + 32 * 72 + 48);
    __builtin_amdgcn_sched_barrier(0);
    acc[0][0] = MFMA32(fa0, fb0, acc[0][0]); acc[0][1] = MFMA32(fa0, fb1, acc[0][1]);
    acc[1][0] = MFMA32(fa1, fb0, acc[1][0]); acc[1][1] = MFMA32(fa1, fb1, acc[1][1]);
    acc[0][0] = MFMA32(ga0, gb0, acc[0][0]); acc[0][1] = MFMA32(ga0, gb1, acc[0][1]);
    acc[1][0] = MFMA32(ga1, gb0, acc[1][0]); acc[1][1] = MFMA32(ga1, gb1, acc[1][1]);
    acc[0][0] = MFMA32(ha0, hb0, acc[0][0]); acc[0][1] = MFMA32(ha0, hb1, acc[0][1]);
    acc[1][0] = MFMA32(ha1, hb0, acc[1][0]); acc[1][1] = MFMA32(ha1, hb1, acc[1][1]);
    acc[0][0] = MFMA32(ia0, ib0, acc[0][0]); acc[0][1] = MFMA32(ia0, ib1, acc[0][1]);
    acc[1][0] = MFMA32(ia1, ib0, acc[1][0]); acc[1][1] = MFMA32(ia1, ib1, acc[1][1]);
    __builtin_amdgcn_sched_barrier(0);
  };
  __syncthreads();
  const int nk = K >> 6;
  GLOAD(0, 0);
  SSTORE(0, 0);
  GLOAD(0, 64);
  __syncthreads();
  for (int kt = 0; kt < nk; kt += 2) {
    if (kt + 2 < nk) GLOAD(1, (kt + 2) * 64);
    compute(0);
    SSTORE(0, 1);
    __syncthreads();
    if (kt + 3 < nk) GLOAD(0, (kt + 3) * 64);
    compute(1);
    if (kt + 2 < nk) SSTORE(1, 0);
    __syncthreads();
  }
#undef GLOAD
#undef SSTORE
#undef LD1
#undef ST1
  float* Cs = (float*)smem;
#pragma unroll
  for (int mb = 0; mb < 2; ++mb)
#pragma unroll
    for (int nb = 0; nb < 2; ++nb)
#pragma unroll
      for (int i = 0; i < 16; ++i)
        Cs[(wm * 64 + mb * 32 + crow(i, h)) * 132 + wn * 64 + nb * 32 + r] = acc[mb][nb][i];
  __syncthreads();
  epi(Cs);
}


template <class AF, class Epi>
DI void gemm_tile2(AF af, const bf16* __restrict__ Bt, int ldb, int K, char* smem, int& n0ref, int nhalf, Epi epi) {
  const int tid = otid(), lane = tid & 63, w = tid >> 6, r = lane & 31, h = lane >> 5;
  const int wm = w >> 1, wn = w & 1;
  bf16* As = (bf16*)smem;
  bf16* Bs = As + 128 * 72;
  f32x16 acc[2][4];
#pragma unroll
  for (int a = 0; a < 2; ++a)
#pragma unroll
    for (int b = 0; b < 4; ++b)
#pragma unroll
      for (int i = 0; i < 16; ++i) acc[a][b][i] = 0.f;
  uint4 pa_0, pa_1, pa_2, pa_3, pb_0, pb_1, pb_2, pb_3, pb_4, pb_5, pb_6, pb_7;
#define LDA2(I, K0) { int c = tl + 256 * I; int row = c >> 3, kc = (c & 7) * 8; pa_##I = *(const uint4*)af(row, (K0) + kc); }
#define LDB2(I, K0) { int c = tl + 256 * I; int row = c >> 3, kc = (c & 7) * 8; pb_##I = *(const uint4*)(Bt + (size_t)row * ldb + (K0) + kc); }
#define STA2(I) { int c = tid + 256 * I; int row = c >> 3, kc = (c & 7) * 8; *(uint4*)(As + row * 72 + kc) = pa_##I; }
#define STB2(I) { int c = tid + 256 * I; int row = c >> 3, kc = (c & 7) * 8; *(uint4*)(Bs + row * 72 + kc) = pb_##I; }
#define GLOAD2(K0) { const int tl = otid(); LDA2(0, K0) LDA2(1, K0) LDA2(2, K0) LDA2(3, K0) LDB2(0, K0) LDB2(1, K0) LDB2(2, K0) LDB2(3, K0) LDB2(4, K0) LDB2(5, K0) LDB2(6, K0) LDB2(7, K0) }
#define SSTORE2() { STA2(0) STA2(1) STA2(2) STA2(3) STB2(0) STB2(1) STB2(2) STB2(3) STB2(4) STB2(5) STB2(6) STB2(7) }
  const int nk = K >> 6;
  GLOAD2(0);
  const bf16* a_ = As + (wm * 64 + r) * 72 + h * 8;
  const bf16* b_ = Bs + (wn * 128 + r) * 72 + h * 8;
  for (int kt = 0; kt < nk; ++kt) {
    __syncthreads();
    SSTORE2();
    __syncthreads();
    if (kt + 1 < nk) GLOAD2((kt + 1) * 64);
#pragma unroll
    for (int ks = 0; ks < 4; ++ks) {
      bf16x8 fa[2], fb[4];
#pragma unroll
      for (int mb = 0; mb < 2; ++mb) fa[mb] = *(const bf16x8*)(a_ + mb * 32 * 72 + ks * 16);
#pragma unroll
      for (int nb = 0; nb < 4; ++nb) fb[nb] = *(const bf16x8*)(b_ + nb * 32 * 72 + ks * 16);
#pragma unroll
      for (int mb = 0; mb < 2; ++mb)
#pragma unroll
        for (int nb = 0; nb < 4; ++nb) acc[mb][nb] = MFMA32(fa[mb], fb[nb], acc[mb][nb]);
    }
  }
#undef LDA2
#undef LDB2
#undef STA2
#undef STB2
#undef GLOAD2
#undef SSTORE2
  float* Cs = (float*)smem;
#pragma unroll
  for (int hf = 0; hf < 2; ++hf) {
    if (hf < nhalf) {
      __syncthreads();
      if (wn == hf) {
#pragma unroll
        for (int mb = 0; mb < 2; ++mb)
#pragma unroll
          for (int nb = 0; nb < 4; ++nb)
#pragma unroll
            for (int i = 0; i < 16; ++i) Cs[(wm * 64 + mb * 32 + crow(i, h)) * 132 + nb * 32 + r] = acc[mb][nb][i];
      }
      __syncthreads();
      epi(Cs);
      n0ref += 128;
    }
  }
}

DI void tile_map(int t, int ntn, int& tm, int& tn) {
  const int per = 8 * ntn;
  const int grp = t / per, rem = t - grp * per;
  tm = grp * 8 + (rem & 7);
  tn = rem >> 3;
}
template <class F>
DI void epi_rows(const float* Cs, F f) {
  const int tid = otid();
#pragma unroll
  for (int j = 0; j < 8; ++j) {
    int c = tid + 256 * j;
    int row = c >> 4, cc = (c & 15) * 8;
    float v[8];
    float4 a = *(const float4*)(Cs + row * 132 + cc);
    float4 b = *(const float4*)(Cs + row * 132 + cc + 4);
    v[0] = a.x; v[1] = a.y; v[2] = a.z; v[3] = a.w; v[4] = b.x; v[5] = b.y; v[6] = b.z; v[7] = b.w;
    f(row, cc, v);
  }
}
template <class F>
DI void epi_cols(const float* Cs, F f) {
  const int tid = otid();
#pragma unroll
  for (int j = 0; j < 8; ++j) {
    int c = tid + 256 * j;
    int col = c & 127, r8 = (c >> 7) * 8;
    float v[8];
#pragma unroll
    for (int e = 0; e < 8; ++e) v[e] = Cs[(r8 + e) * 132 + col];
    f(col, r8, v);
  }
}
template <class F>
DI void epi_rope(const float* Cs, int cb, int m0, const float* rc, const float* rs, float scale_unused, F f) {
  const int tid = otid();
#pragma unroll
  for (int j = 0; j < 2; ++j) {
    int c = tid + 256 * j;
    int row = c >> 2, cc = (c & 3) * 8;
    float x1[8], x2[8], o1[8], o2[8];
#pragma unroll
    for (int e = 0; e < 8; ++e) {
      x1[e] = Cs[row * 132 + cb + cc + e];
      x2[e] = Cs[row * 132 + cb + 32 + cc + e];
    }
    const float* pc = rc + (size_t)(m0 + row) * 32 + cc;
    const float* ps = rs + (size_t)(m0 + row) * 32 + cc;
#pragma unroll
    for (int e = 0; e < 8; ++e) {
      float cs = pc[e], sn = ps[e];
      o1[e] = x1[e] * cs - x2[e] * sn;
      o2[e] = x1[e] * sn + x2[e] * cs;
    }
    f(row, cc, o1);
    f(row, cc + 32, o2);
  }
}

template <int DK>
struct KVPre {
  uint4 k[DK / 32];
  uint4 v[4];
  float aux;
};
constexpr int AT_VS = 25600;
constexpr int AT_AUX = 43008;
constexpr int AT_X0 = 43264;
constexpr int AT_IMP = AT_X0 + 12800;
constexpr int AT_SEL = AT_IMP + 16896;

template <int DK, bool PV, class SF, class PH>
DI void attn_tile(const bf16x8 (&qf)[DK / 16], f32x16 (&o)[4], float& m, float& l, const char* smem, SF sf, PH ph) {
  const int lane = otid() & 63, r = lane & 31, h = lane >> 5;
  const bf16* Ks = (const bf16*)smem;
  const bf16* Vs = (const bf16*)(smem + AT_VS);
  const float* auxs = (const float*)(smem + AT_AUX);
  f32x16 s[2];
#pragma unroll
  for (int kb = 0; kb < 2; ++kb) {
#pragma unroll
    for (int i = 0; i < 16; ++i) s[kb][i] = 0.f;
#pragma unroll
    for (int ks = 0; ks < DK / 16; ++ks) {
      bf16x8 a = *(const bf16x8*)(Ks + (kb * 32 + r) * (DK + 8) + ks * 16 + h * 8);
      s[kb] = MFMA32(a, qf[ks], s[kb]);
    }
  }
  float mx = m;
#pragma unroll
  for (int kb = 0; kb < 2; ++kb)
#pragma unroll
    for (int i = 0; i < 16; ++i) {
      int kl = kb * 32 + crow(i, h);
      float v = sf(s[kb][i], kl, auxs[kl]);
      s[kb][i] = v;
      mx = fmaxf(mx, v);
    }
  mx = fmaxf(mx, __shfl_xor(mx, 32));
  float alpha = ex2(m - mx);
  m = mx;
  float psum = 0.f;
#pragma unroll
  for (int kb = 0; kb < 2; ++kb)
#pragma unroll
    for (int i = 0; i < 16; ++i) {
      float pv = ex2(s[kb][i] - mx);
      s[kb][i] = pv;
      psum += pv;
    }
  l = l * alpha + psum;
  ph(0, s[0]);
  ph(1, s[1]);
  if (PV) {
    if (__builtin_amdgcn_ballot_w64(alpha != 1.f) != 0ull) {
#pragma unroll
      for (int d = 0; d < 4; ++d)
#pragma unroll
        for (int i = 0; i < 16; ++i) o[d][i] *= alpha;
    }
#pragma unroll
    for (int st = 0; st < 4; ++st) {
      const int kb = st >> 1, s2 = st & 1;
      uint4 pu;
      pu.x = pack2(s[kb][8 * s2 + 0], s[kb][8 * s2 + 1]);
      pu.y = pack2(s[kb][8 * s2 + 2], s[kb][8 * s2 + 3]);
      pu.z = pack2(s[kb][8 * s2 + 4], s[kb][8 * s2 + 5]);
      pu.w = pack2(s[kb][8 * s2 + 6], s[kb][8 * s2 + 7]);
      bf16x8 pf = __builtin_bit_cast(bf16x8, pu);
#pragma unroll
      for (int d = 0; d < 4; ++d) {
        const bf16* vp = Vs + (d * 32 + r) * 68 + st * 16 + 4 * h;
        uint2 lo = *(const uint2*)vp;
        uint2 hi = *(const uint2*)(vp + 8);
        uint4 vu = make_uint4(lo.x, lo.y, hi.x, hi.y);
        bf16x8 vf = __builtin_bit_cast(bf16x8, vu);
        o[d] = MFMA32(vf, pf, o[d]);
      }
    }
  }
}

template <int DK, int FM>
DI void attn_tile_c(const bf16x8 (&qf)[DK / 16], f32x16 (&o)[4], float& m, float& l, const char* smem, float sc, float c) {
  const int lane = otid() & 63, r = lane & 31, h = lane >> 5;
  const bf16* Ks = (const bf16*)smem;
  const bf16* Vs = (const bf16*)(smem + AT_VS);
  const float* auxs = (const float*)(smem + AT_AUX);
  f32x16 s0, s1;
#pragma unroll
  for (int i = 0; i < 16; ++i) { s0[i] = 0.f; s1[i] = 0.f; }
#pragma unroll
  for (int ks = 0; ks < DK / 16; ++ks) {
    bf16x8 a = *(const bf16x8*)(Ks + r * (DK + 8) + ks * 16 + h * 8);
    s0 = MFMA32(a, qf[ks], s0);
  }
#pragma unroll
  for (int ks = 0; ks < DK / 16; ++ks) {
    bf16x8 a = *(const bf16x8*)(Ks + (32 + r) * (DK + 8) + ks * 16 + h * 8);
    s1 = MFMA32(a, qf[ks], s1);
  }
  float mx;
  if (FM == 2) {
    mx = m;
#pragma unroll
    for (int i = 0; i < 16; ++i) {
      float v = __builtin_fmaf(s0[i], sc, -auxs[crow(i, h)]);
      s0[i] = v;
      mx = fmaxf(mx, v);
    }
  } else {
    float rm = s0[0];
#pragma unroll
    for (int i = 1; i < 16; ++i) rm = fmaxf(rm, s0[i]);
    mx = fmaxf(m, __builtin_fmaf(rm, sc, c));
  }
  mx = fmaxf(mx, __shfl_xor(mx, 32));
  const float alpha = ex2(m - mx);
  m = mx;
  const float off = c - mx;
#pragma unroll
  for (int d = 0; d < 4; ++d)
#pragma unroll
    for (int i = 0; i < 16; ++i) o[d][i] *= alpha;
  l *= alpha;
  float psum = 0.f;
#pragma unroll
  for (int i = 0; i < 16; ++i) {
    float pv = (FM == 2) ? ex2(s0[i] - mx) : ex2(__builtin_fmaf(s0[i], sc, off));
    s0[i] = pv;
    psum += pv;
  }
#pragma unroll
  for (int s2 = 0; s2 < 2; ++s2) {
    uint4 pu;
    pu.x = pack2(s0[8 * s2 + 0], s0[8 * s2 + 1]);
    pu.y = pack2(s0[8 * s2 + 2], s0[8 * s2 + 3]);
    pu.z = pack2(s0[8 * s2 + 4], s0[8 * s2 + 5]);
    pu.w = pack2(s0[8 * s2 + 6], s0[8 * s2 + 7]);
    bf16x8 pf = __builtin_bit_cast(bf16x8, pu);
#pragma unroll
    for (int d = 0; d < 4; ++d) {
      const bf16* vp = Vs + (d * 32 + r) * 68 + s2 * 16 + 4 * h;
      uint2 lo = *(const uint2*)vp;
      uint2 hi = *(const uint2*)(vp + 8);
      uint4 vu = make_uint4(lo.x, lo.y, hi.x, hi.y);
      o[d] = MFMA32(__builtin_bit_cast(bf16x8, vu), pf, o[d]);
    }
  }
#pragma unroll
  for (int i = 0; i < 16; ++i) {
    float pv;
    if (FM == 2) pv = ex2(__builtin_fmaf(s1[i], sc, -auxs[32 + crow(i, h)]) - mx);
    else pv = ex2(__builtin_fmaf(s1[i], sc, off));
    s1[i] = pv;
    psum += pv;
  }
  l += psum;
#pragma unroll
  for (int s2 = 0; s2 < 2; ++s2) {
    uint4 pu;
    pu.x = pack2(s1[8 * s2 + 0], s1[8 * s2 + 1]);
    pu.y = pack2(s1[8 * s2 + 2], s1[8 * s2 + 3]);
    pu.z = pack2(s1[8 * s2 + 4], s1[8 * s2 + 5]);
    pu.w = pack2(s1[8 * s2 + 6], s1[8 * s2 + 7]);
    bf16x8 pf = __builtin_bit_cast(bf16x8, pu);
#pragma unroll
    for (int d = 0; d < 4; ++d) {
      const bf16* vp = Vs + (d * 32 + r) * 68 + (2 + s2) * 16 + 4 * h;
      uint2 lo = *(const uint2*)vp;
      uint2 hi = *(const uint2*)(vp + 8);
      uint4 vu = make_uint4(lo.x, lo.y, hi.x, hi.y);
      o[d] = MFMA32(__builtin_bit_cast(bf16x8, vu), pf, o[d]);
    }
  }
}

struct NoHook { DI void operator()(int, const f32x16&) const {} };

template <int DK, bool PV, bool PF, class Ctx>
DI void attn_run(const bf16x8 (&qf)[DK / 16], f32x16 (&o)[4], float& m, float& l, const bf16* K1, int ldk1,
                 const bf16* K2, int ldk2, const bf16* Vt, int ldv, int first, Ctx& ctx, char* smem) {
  const int tid = otid();
  int tcur = first;
  if (tcur < 0) return;
  constexpr int CPR = DK / 8;
  constexpr int NKC = DK / 32;
  uint4 rk0, rk1, rk2, rk3, rk4 = make_uint4(0, 0, 0, 0), rk5 = make_uint4(0, 0, 0, 0), rv[4];
  float raux;
  bf16* Ks = (bf16*)smem;
  bf16* Vs = (bf16*)(smem + AT_VS);
  auto ldk = [&](int i, int key0) -> uint4 {
    int c = otid() + 256 * i;
    int row = c / CPR, cc = c % CPR;
    const bf16* src;
    if (DK == 128 || cc < 16) src = K1 + (size_t)(key0 + row) * ldk1 + cc * 8;
    else src = K2 + (size_t)(key0 + row) * ldk2 + (cc - 16) * 8;
    return *(const uint4*)src;
  };
  auto stk = [&](int i, const uint4& v) {
    int c = tid + 256 * i;
    int row = c / CPR, cc = c % CPR;
    *(uint4*)(Ks + row * (DK + 8) + cc * 8) = v;
  };
  auto gload = [&](int key0) {
    rk0 = ldk(0, key0); rk1 = ldk(1, key0); rk2 = ldk(2, key0); rk3 = ldk(3, key0);
    if (NKC > 4) { rk4 = ldk(4, key0); rk5 = ldk(5, key0); }
    const int tl = otid();
#pragma unroll
    for (int i = 0; i < 4; ++i) {
      int c = tl + 256 * i;
      int d = c >> 3, cc = c & 7;
      rv[i] = *(const uint4*)(Vt + (size_t)d * ldv + key0 + cc * 8);
    }
    raux = (tid < 64) ? ctx.aux(key0 + tid) : 0.f;
  };
  auto sstore = [&]() {
    stk(0, rk0); stk(1, rk1); stk(2, rk2); stk(3, rk3);
    if (NKC > 4) { stk(4, rk4); stk(5, rk5); }
#pragma unroll
    for (int i = 0; i < 4; ++i) {
      int c = tid + 256 * i;
      int d = c >> 3, cc = c & 7;
      uint2* dst = (uint2*)(Vs + d * 68 + cc * 8);
      dst[0] = make_uint2(rv[i].x, rv[i].y);
      dst[1] = make_uint2(rv[i].z, rv[i].w);
    }
    if (tid < 64) ((float*)(smem + AT_AUX))[tid] = raux;
  };
  if (PF) gload(tcur * 64);
  while (tcur >= 0) {
    __syncthreads();
    if (!PF) gload(tcur * 64);
    sstore();
    __syncthreads();
    int tnext = ctx.next(tcur);
    if (PF && tnext >= 0) gload(tnext * 64);
    if (!ctx.skip(tcur)) {
      const int tc = tcur;
      if (Ctx::FMODE != 0 && (Ctx::ALWAYS_FAST || ctx.fast(tc))) {
        attn_tile_c<DK, (Ctx::FMODE == 2 ? 2 : 1)>(qf, o, m, l, smem, ctx.sc, ctx.fconst(tc));
      } else if (!Ctx::ALWAYS_FAST) {
        attn_tile<DK, PV>(qf, o, m, l, smem,
                          [&](float s, int kl, float ax) { return ctx.score(s, tc * 64 + kl, ax, tc); },
                          [&](int kb, const f32x16& pt) { ctx.hook(kb, pt, tc); });
      }
    }
    tcur = tnext;
  }
}

template <int DK>
DI void load_q(bf16x8 (&qf)[DK / 16], const bf16* qrow, int h) {
#pragma unroll
  for (int ks = 0; ks < DK / 16; ++ks) qf[ks] = *(const bf16x8*)(qrow + ks * 16 + h * 8);
}
DI void zero_o(f32x16 (&o)[4]) {
#pragma unroll
  for (int d = 0; d < 4; ++d)
#pragma unroll
    for (int i = 0; i < 16; ++i) o[d][i] = 0.f;
}

struct CtxCausal {
  int tq, q0w, last; float sc;
  DI int next(int t) const { return t + 1 <= last ? t + 1 : -1; }
  DI float aux(int) const { return 0.f; }
  DI bool skip(int t) const { return t * 64 > q0w + 31; }
  DI float score(float s, int key, float, int) const { return key <= tq ? s * sc : NEG; }
  static constexpr int FMODE = 1;
  static constexpr bool ALWAYS_FAST = false;
  DI bool fast(int t) const { return t * 64 + 63 <= q0w; }
  DI float fconst(int) const { return 0.f; }
  DI void hook(int, const f32x16&, int) const {}
};
struct CtxFox {
  int tq, q0w, last; float sc; const float* cuml; const float* cpre;
  DI int next(int t) const { return t + 1 <= last ? t + 1 : -1; }
  DI float aux(int key) const { return (cuml[key] + cpre[key >> 7]) * LOG2E; }
  DI bool skip(int t) const { return t * 64 > q0w + 31; }
  DI float score(float s, int key, float ax, int) const { return key <= tq ? s * sc - ax : NEG; }
  static constexpr int FMODE = 2;
  static constexpr bool ALWAYS_FAST = false;
  DI bool fast(int t) const { return t * 64 + 63 <= q0w; }
  DI float fconst(int) const { return 0.f; }
  DI void hook(int, const f32x16&, int) const {}
};
struct CtxMem {
  float sc;
  DI int next(int t) const { return t + 1 < 4 ? t + 1 : -1; }
  DI float aux(int) const { return 0.f; }
  DI bool skip(int) const { return false; }
  DI float score(float s, int, float, int) const { return s * sc; }
  static constexpr int FMODE = 1;
  static constexpr bool ALWAYS_FAST = true;
  DI bool fast(int) const { return true; }
  DI float fconst(int) const { return 0.f; }
  DI void hook(int, const f32x16&, int) const {}
};

DI void store_out_A(const f32x16 (&o)[4], float inv_l, const bf16* grow, bf16* orow, int h) {
#pragma unroll
  for (int d = 0; d < 4; ++d)
#pragma unroll
    for (int i4 = 0; i4 < 4; ++i4) {
      int dv0 = d * 32 + 8 * i4 + 4 * h;
      uint2 gu = *(const uint2*)(grow + dv0);
      float g0 = bflo(gu.x), g1 = bfhi(gu.x), g2 = bflo(gu.y), g3 = bfhi(gu.y);
      uint2 ou;
      ou.x = pack2(o[d][4 * i4 + 0] * inv_l * silu(g0), o[d][4 * i4 + 1] * inv_l * silu(g1));
      ou.y = pack2(o[d][4 * i4 + 2] * inv_l * silu(g2), o[d][4 * i4 + 3] * inv_l * silu(g3));
      *(uint2*)(orow + dv0) = ou;
    }
}

        struct CtxCmp {
          int tq, posq, last; float sc; const float* lutr; const int* pos; float invl; float* imp; int ql; bool p2;
          DI int next(int t) const { return t + 1 <= last ? t + 1 : -1; }
          DI float aux(int key) const { int n = key < 511 ? key : 510; return __int_as_float(pos[16 * n + 31]); }
          DI bool skip(int) const { return false; }
          DI float score(float s, int key, float ax, int) const {
            bool valid = (16 * key + 31 <= tq) && key < 511;
            int d = posq - __float_as_int(ax);
            d = d < 0 ? 0 : (d > 799 ? 799 : d);
            return valid ? s * sc + lutr[d] : NEG;
          }
          static constexpr int FMODE = 0;
          static constexpr bool ALWAYS_FAST = false;
          DI bool fast(int) const { return false; }
          DI float fconst(int) const { return 0.f; }
          DI void hook(int kb, const f32x16& pt, int tc) const {
            if (!p2) return;
            const int lane = otid() & 63, h = lane >> 5, r = lane & 31;
#pragma unroll
            for (int gq = 0; gq < 4; ++gq) {
              float p3 = 0.5f * pt[4 * gq + 3];
              float vm = (pt[4 * gq] + pt[4 * gq + 1] + pt[4 * gq + 2] + p3) * invl;
              float vs = p3 * invl;
              vm += __shfl_xor(vm, 8); vm += __shfl_xor(vm, 16);
              vs += __shfl_xor(vs, 8); vs += __shfl_xor(vs, 16);
              int j = tc * 16 + kb * 8 + 2 * gq + h;
              if (r < 8) { atomicAdd(&imp[ql * 132 + j], vm); atomicAdd(&imp[ql * 132 + j + 1], vs); }
            }
          }
        };
struct CtxSlc {
  int tq, posq; float sc; const float* lutr; const int* pos; unsigned long long ulo, uhi, mlo, mhi;
  const int* posmax; int pqmin, q0;
  DI bool farj(int j) const { return (j * 64 + 63 < q0) && (pqmin - posmax[j] >= 799); }
  DI bool inu(int j) const {
    unsigned long long a = (ulo >> (j & 63)) & (j < 64 ? 1ull : 0ull);
    unsigned long long b = (uhi >> (j & 63)) & (j >= 64 ? 1ull : 0ull);
    return (a | b) != 0ull;
  }
  DI bool mine(int j) const {
    unsigned long long a = (mlo >> (j & 63)) & (j < 64 ? 1ull : 0ull);
    unsigned long long b = (mhi >> (j & 63)) & (j >= 64 ? 1ull : 0ull);
    return (a | b) != 0ull;
  }
  DI int next(int t) const { for (int j = t + 1; j < 128; ++j) if (inu(j) && !farj(j)) return j; return -1; }
  DI float aux(int key) const { return __int_as_float(pos[key]); }
  DI bool skip(int t) const { return __builtin_amdgcn_ballot_w64(mine(t)) == 0ull; }
  DI float score(float s, int key, float ax, int t) const {
    bool valid = mine(t) && key <= tq;
    int d = posq - __float_as_int(ax);
    d = d < 0 ? 0 : (d > 799 ? 799 : d);
    return valid ? s * sc + lutr[d] : NEG;
  }
  static constexpr int FMODE = 0;
  static constexpr bool ALWAYS_FAST = false;
  DI bool fast(int) const { return false; }
  DI float fconst(int) const { return 0.f; }
  DI void hook(int, const f32x16&, int) const {}
};
struct CtxSlcFar {
  float sc, bfar; unsigned long long ulo, uhi, mlo, mhi; const int* posmax; int pqmin, q0;
  DI bool farj(int j) const { return (j * 64 + 63 < q0) && (pqmin - posmax[j] >= 799); }
  DI bool inu(int j) const {
    unsigned long long a = (ulo >> (j & 63)) & (j < 64 ? 1ull : 0ull);
    unsigned long long b = (uhi >> (j & 63)) & (j >= 64 ? 1ull : 0ull);
    return (a | b) != 0ull;
  }
  DI bool mine(int j) const {
    unsigned long long a = (mlo >> (j & 63)) & (j < 64 ? 1ull : 0ull);
    unsigned long long b = (mhi >> (j & 63)) & (j >= 64 ? 1ull : 0ull);
    return (a | b) != 0ull;
  }
  DI int next(int t) const { for (int j = t + 1; j < 128; ++j) if (inu(j) && farj(j)) return j; return -1; }
  DI float aux(int) const { return 0.f; }
  DI bool skip(int t) const { return __builtin_amdgcn_ballot_w64(mine(t)) == 0ull; }
  DI float score(float s, int, float, int t) const { return mine(t) ? s * sc + bfar : NEG; }
  static constexpr int FMODE = 1;
  static constexpr bool ALWAYS_FAST = true;
  DI bool fast(int) const { return true; }
  DI float fconst(int t) const { return mine(t) ? bfar : NEG; }
  DI void hook(int, const f32x16&, int) const {}
};
struct CtxWin {
  int tq, posq, last; float sc; const float* lutr; const int* pos;
  DI int next(int t) const { return t + 1 <= last ? t + 1 : -1; }
  DI float aux(int key) const { return __int_as_float(pos[key]); }
  DI bool skip(int) const { return false; }
  DI float score(float s, int key, float ax, int) const {
    bool valid = key <= tq && (tq - key) < 512;
    int d = posq - __float_as_int(ax);
    d = d < 0 ? 0 : (d > 799 ? 799 : d);
    return valid ? s * sc + lutr[d] : NEG;
  }
  static constexpr int FMODE = 0;
  static constexpr bool ALWAYS_FAST = false;
  DI bool fast(int) const { return false; }
  DI float fconst(int) const { return 0.f; }
  DI void hook(int, const f32x16&, int) const {}
};

DI int cvt_next_count(const Params& p, int nl) {
      const bool ne = (nl & 1) == 0;
      const int nli = nl >> 1;
      return cvt_set_count(p, ne ? SET_IN_EVEN : SET_IN_ODD, nli) + cvt_set_count(p, SET_MEM, nl) +
             cvt_set_count(p, ne ? SET_MISC_EVEN : SET_MISC_ODD, nli) + (ne ? 16 : 32);
}
DI void cvt_next(const Params& p, char* smem, int nl, int t) {
  char* ws = p.ws;
      const bool ne = (nl & 1) == 0;
      const int nli = nl >> 1;
      const int s0 = ne ? SET_IN_EVEN : SET_IN_ODD, s2 = ne ? SET_MISC_EVEN : SET_MISC_ODD;
      const int c0 = cvt_set_count(p, s0, nli), c1 = cvt_set_count(p, SET_MEM, nl), c2 = cvt_set_count(p, s2, nli);
      if (t < c0) cvt_set_task(p, s0, nli, t, smem);
      else if (t < c0 + c1) cvt_set_task(p, SET_MEM, nl, t - c0, smem);
      else if (t < c0 + c1 + c2) cvt_set_task(p, s2, nli, t - c0 - c1, smem);
      else {
            const int tid = otid();
            int e = t - c0 - c1 - c2;
            if (ne) {
              float* S5P = (float*)(ws + WS_S5P);
              int gp = e * 256 + tid;
              int g = gp >> 6;
              float dt = expf(p.log_dt[nli * 64 + g]);
              float lr = p.lam_re[nli * 4096 + gp], lim = p.lam_im[nli * 4096 + gp];
              float mag = expf(lr * dt);
              float abr = mag * cosf(lim * dt), abi = mag * sinf(lim * dt);
              float den = lr * lr + lim * lim;
              float nr = abr - 1.f;
              float fre = (nr * lr + abi * lim) / den;
              float fim = (abi * lr - nr * lim) / den;
              S5P[gp] = abr;
              S5P[4096 + gp] = abi;
              float ar = abr, ai = abi;
#pragma unroll
              for (int q = 0; q < 7; ++q) { float nr2 = ar * ar - ai * ai; ai = 2.f * ar * ai; ar = nr2; }
              S5P[8192 + gp] = ar;
              S5P[12288 + gp] = ai;
              const float* br = p.b_re + (size_t)nli * 65536 + gp * 16;
              const float* bi = p.b_im + (size_t)nli * 65536 + gp * 16;
#pragma unroll
              for (int c = 0; c < 16; ++c) {
                S5P[16384 + gp * 16 + c] = fre * br[c] - fim * bi[c];
                S5P[16384 + 65536 + gp * 16 + c] = fre * bi[c] + fim * br[c];
              }
            } else {
              int which = e >> 4, part = e & 15;
              const float* pe = p.cmp_pe + (size_t)(nli * 2 + which) * 4096 + part * 256;
              const float* w1 = p.cmp_w1 + ((size_t)(nli * 2 + which) * 4096 + part * 256) * 256 + tid;
              float acc = 0.f;
#pragma unroll 8
              for (int k = 0; k < 256; ++k) acc += pe[k] * w1[(size_t)k * 256];
              ((float*)(ws + WS_CMPB))[(which * 16 + part) * 256 + tid] = acc;
            }
      }
}

#define XB_TMO      128
#define XB_XCNT(j)  (256  + 64 * (j))
#define XB_XSUB(j)  (1280 + 64 * (j))
#define XB_XGEN(j)  (2304 + 64 * (j))
#define XB_TOP      3328
#define XB_TOPGEN   3392
#define XCD_BAR_WORDS 3456
#define XB_SPIN_CAP (1u << 18)
#define LAS __attribute__((address_space(3)))

__device__ __forceinline__ unsigned xb_ld(unsigned* p)              { return __hip_atomic_load(p, __ATOMIC_RELAXED, __HIP_MEMORY_SCOPE_AGENT); }
__device__ __forceinline__ unsigned xb_add(unsigned* p, unsigned v) { return __hip_atomic_fetch_add(p, v, __ATOMIC_RELAXED, __HIP_MEMORY_SCOPE_AGENT); }
__device__ __forceinline__ unsigned xb_xcc_id() { return (unsigned)__builtin_amdgcn_s_getreg((3 << 11) | 20) & 0xFu; }
#define XB_SPIN(cond, bar) do { unsigned _sp = 0; while (cond) { __builtin_amdgcn_s_sleep(1); \
    if ((++_sp & 255u) == 0u) { if (xb_ld(&(bar)[XB_TMO])) break; if (_sp > XB_SPIN_CAP) { atomicAdd(&(bar)[XB_TMO], 1u); break; } } } } while (0)

struct XcdBarrier {
    unsigned* bar; unsigned x;
    volatile LAS unsigned* st;
};

__device__ __forceinline__ XcdBarrier xcd_barrier_post(unsigned* bar, volatile LAS unsigned* st) {
    XcdBarrier b; b.bar = bar; b.x = xb_xcc_id(); b.st = st;
    if (threadIdx.x == 0) (void)xb_add(&bar[XB_XCNT(b.x)], 1u);
    return b;
}
__device__ __forceinline__ void xcd_barrier_complete(unsigned* bar, unsigned x, unsigned& nloc, unsigned& nx) {
    const unsigned G = gridDim.x * gridDim.y * gridDim.z;
    unsigned sum, cnt, mine, sp = 0u;
    for (;;) {
        sum = 0u; cnt = 0u; mine = 0u;
#pragma unroll
        for (unsigned j = 0; j < 16; ++j) { const unsigned c = xb_ld(&bar[XB_XCNT(j)]); sum += c; cnt += (c > 0u) ? 1u : 0u; mine = (j == x) ? c : mine; }
        if (sum == G) break;
        __builtin_amdgcn_s_sleep(1);
        if ((++sp & 255u) == 0u) { if (xb_ld(&bar[XB_TMO])) break; if (sp > XB_SPIN_CAP) { atomicAdd(&bar[XB_TMO], 1u); break; } }
    }
    nloc = mine > 0u ? mine : 1u; nx = cnt > 0u ? cnt : 1u;
}

__device__ __forceinline__ void xcd_barrier(const XcdBarrier& b) {
    asm volatile("s_waitcnt vmcnt(0)" ::: "memory");
    __syncthreads();
    if (threadIdx.x == 0) {
        unsigned* bar = b.bar;
        __builtin_amdgcn_s_waitcnt(0);
        unsigned nloc = b.st[0], nx = b.st[1];
        if (nloc == 0u) { xcd_barrier_complete(bar, b.x, nloc, nx); b.st[0] = nloc; b.st[1] = nx; }
        const unsigned old = xb_add(&bar[XB_XSUB(b.x)], 1u);
        const unsigned gen = old / nloc;
        if (old + 1u == (gen + 1u) * nloc) {
            __builtin_amdgcn_fence(__ATOMIC_RELEASE, "agent");
            asm volatile("s_waitcnt vmcnt(0)" ::: "memory");
            const unsigned og = xb_add(&bar[XB_TOP], 1u);
            const unsigned tg = og / nx;
            if (og + 1u == (tg + 1u) * nx) xb_add(&bar[XB_TOPGEN], 1u);
            else XB_SPIN(xb_ld(&bar[XB_TOPGEN]) == tg, bar);
            __builtin_amdgcn_fence(__ATOMIC_ACQUIRE, "agent");
            xb_add(&bar[XB_XGEN(b.x)], 1u);
            asm volatile("s_waitcnt vmcnt(0)" ::: "memory");
        } else {
            XB_SPIN(xb_ld(&bar[XB_XGEN(b.x)]) == gen, bar);
            __builtin_amdgcn_fence(__ATOMIC_ACQUIRE, "agent");
            asm volatile("s_waitcnt vmcnt(0)" ::: "memory");
        }
    }
    __syncthreads();
}


__global__ void __launch_bounds__(256, LB2) mega(Params p, int ph_lo, int ph_hi) {
  __shared__ __attribute__((aligned(16))) char smem[SM_TOTAL];
  __shared__ int s_task;
  __shared__ uint4 xb_words;
  if (threadIdx.x == 0) xb_words = make_uint4(0u, 0u, 0u, 0u);
  __syncthreads();
  (void)xcd_barrier_post((unsigned*)(p.ws + WS_BAR), (volatile LAS unsigned*)&xb_words);
  const int bid = blockIdx.x, nb = gridDim.x;

  for (int ph = ph_lo; ph <= ph_hi; ++ph) {
    if (ph > ph_lo) {
      if (ph == ph_lo + 1) cg::this_grid().sync();
      else {
        XcdBarrier xb2;
        xb2.bar = (unsigned*)(((const Params*)__builtin_amdgcn_kernarg_segment_ptr())->ws + WS_BAR);
        xb2.x = xb_xcc_id();
        xb2.st = (volatile LAS unsigned*)&xb_words;
        xcd_barrier(xb2);
      }
    }
    const int nrep = (REP_PH >= 0 && ph == REP_PH) ? 2 : 1;
    for (int rep = 0; rep < nrep; ++rep) {
    if (rep) cg::this_grid().sync();
    const int tid = otid(), lane = tid & 63, w = tid >> 6, r = lane & 31, h = lane >> 5;
    const int vb = (bid & 7) * (nb >> 3) + (bid >> 3);
    int zoff_;
    asm volatile("s_mov_b32 %0, 0" : "=s"(zoff_));
    const Params& p = *(const Params*)((const char*)__builtin_amdgcn_kernarg_segment_ptr() + zoff_);
    char* ws = p.ws;
    char* const ws_ph = ws;
    bf16* XN = (bf16*)(ws + WS_XN);
    bf16* P = (bf16*)(ws + WS_P);
    bf16* MIXED = (bf16*)(ws + WS_MIXED);
    float* ROPEC = (float*)(ws + WS_ROPEC);
    float* ROPES = (float*)(ws + WS_ROPES);
    float* hbuf = p.out;
    int* CTR = (int*)(ws + WS_CTR);
    auto fetch_task = [&](int* ctr) {
      __syncthreads();
      if (tid == 0) s_task = atomicAdd(ctr, 1);
      __syncthreads();
      return s_task;
    };
    const int layer = ph == 0 ? 0 : (ph - 1) / 6;
    const int sub = ph == 0 ? -1 : (ph - 1) % 6;
    const bool even = (layer & 1) == 0;
    const int li = layer >> 1;
    const int NP = even ? NPE : NPO;

    if ((PHM & 1) && (ph == 0 || sub == 5)) {
      if (ph == 0) {
        if (bid == 0 && tid < 64) CTR[tid] = 0;
        if (bid == 1 % nb && tid < 128) {
          int mx = p.pos[tid * 64];
          for (int q = 1; q < 64; ++q) mx = max(mx, p.pos[tid * 64 + q]);
          ((int*)(ws + WS_POSMAX))[tid] = mx;
        }
        for (int i = bid * 256 + tid; i < L * 32; i += nb * 256) {
          int t = i >> 5, f = i & 31;
          float inv = powf(10000.f, -(float)f / 32.f);
          float ang = (float)p.pos[t] * inv;
          ROPEC[i] = cosf(ang);
          ROPES[i] = sinf(ang);
        }
        for (int row = bid * 4 + w; row < 256; row += nb * 4)
          norm_row_bf16(p.mem + (size_t)row * DM, p.mem_norm_g, (bf16*)(ws + WS_MEMN) + (size_t)row * DM, lane);
      }
      const int nl = ph == 0 ? 0 : layer + 1;
      if (nl < 4) {
        const float* src = ph == 0 ? p.x : hbuf;
        for (int row = bid * 4 + w; row < L; row += nb * 4)
          norm_row_bf16(src + (size_t)row * DM, p.norm_g + nl * DM, XN + (size_t)row * LDX, lane);
      } else {
        for (int row = bid * 4 + w; row < L; row += nb * 4) norm_row_f32(hbuf + (size_t)row * DM, p.final_norm_g, lane);
      }
    }
    if ((PHM & 4) && sub == 0) {
      const int ntn = (NP / 128 + 1) / 2;
      const int n_in = 64 * ntn;
      const bf16* Win = (const bf16*)(ws + WS_WIN);
      for (int t = vb; t < n_in + 16; t += nb) {
        if (t < n_in) {
          int tm, tn;
          tile_map(t, ntn, tm, tn);
          const int m0 = tm * 128;
          int n0 = tn * 256;
          const int nhalf = (n0 + 128 < NP) ? 2 : 1;
          ALin af{XN + (size_t)m0 * LDX, LDX};
          if (even) {
            gemm_tile2(af, Win + (size_t)n0 * LDX, LDX, DM, smem, n0, nhalf, [&](const float* Cs) {
              if (n0 >= 4096 && n0 < 5120) {
                bf16* VT = (bf16*)(ws + WS_VTFOX);
                epi_cols(Cs, [&](int col, int r8, const float* v) {
                  *(uint4*)(VT + (size_t)(n0 - 4096 + col) * L + m0 + r8) = pack8(v);
                });
              } else if (n0 == 7168) {
                float* FL = (float*)(ws + WS_FLOG);
                for (int i = tid; i < 128 * 8; i += 256) {
                  int row = i >> 3, c = i & 7;
                  FL[(size_t)(m0 + row) * 8 + c] = Cs[row * 132 + c];
                }
              } else {
                epi_rows(Cs, [&](int row, int cc, const float* v) {
                  *(uint4*)(P + (size_t)(m0 + row) * NPE + n0 + cc) = pack8(v);
                });
              }
            });
          } else {
            gemm_tile2(af, Win + (size_t)n0 * LDX, LDX, DM, smem, n0, nhalf, [&](const float* Cs) {
              if (n0 == 3840 || n0 == 3968 || n0 == 4352 || n0 == 4480) {
                bf16* VT = (n0 < 4096) ? (bf16*)(ws + WS_VTSLC) + (size_t)(n0 - 3840) * L
                                       : (bf16*)(ws + WS_VTWIN) + (size_t)(n0 - 4352) * L;
                epi_cols(Cs, [&](int col, int r8, const float* v) {
                  *(uint4*)(VT + (size_t)col * L + m0 + r8) = pack8(v);
                });
              } else if (n0 == 6656) {
                epi_rope(Cs, 0, m0, ROPEC, ROPES, 1.f, [&](int row, int cl, const float* v) {
                  *(uint4*)(P + (size_t)(m0 + row) * NPO + 6656 + cl) = pack8(v);
                });
                float* GT = (float*)(ws + WS_FLOG);
                for (int i = tid; i < 128 * 24; i += 256) {
                  int row = i / 24, c = i % 24;
                  GT[(size_t)(m0 + row) * 24 + c] = Cs[row * 132 + 64 + c];
                }
              } else {
                epi_rows(Cs, [&](int row, int cc, const float* v) {
                  *(uint4*)(P + (size_t)(m0 + row) * NPO + n0 + cc) = pack8(v);
                });
              }
            });
          }
        } else {
          const int t2 = t - n_in;
          const int m0 = (t2 >> 3) * 128, n0 = (t2 & 7) * 128;
          ALin af{(const bf16*)(ws + WS_MEMN) + (size_t)m0 * DM, DM};
          gemm_tile(af, (const bf16*)(ws + WS_WMEM) + (size_t)n0 * DM, DM, DM, smem, [&](const float* Cs) {
            if (n0 < 512) {
              bf16* MK = (bf16*)(ws + WS_MEMK);
              epi_rows(Cs, [&](int row, int cc, const float* v) {
                *(uint4*)(MK + (size_t)(m0 + row) * 512 + n0 + cc) = pack8(v);
              });
            } else {
              bf16* MV = (bf16*)(ws + WS_MEMVT);
              epi_cols(Cs, [&](int col, int r8, const float* v) {
                *(uint4*)(MV + (size_t)(n0 - 512 + col) * 256 + m0 + r8) = pack8(v);
              });
            }
          });
        }
      }
    }

    if ((PHM & 4) && sub == 0) {
      const int cw = cvt_set_count(p, SET_OUT, layer), cw4 = (cw + 3) >> 2;
      for (;;) {
        const int t = fetch_task(CTR + 32 + ph);
        if (t >= cw4) break;
        for (int q = 0; q < 4; ++q) {
          const int ci = t * 4 + q;
          if (ci < cw) cvt_set_task(p, SET_OUT, layer, ci, smem);
        }
      }
    }
    auto mem_attn_task = [&](int t) {
      const int tid = otid(), lane = tid & 63, w = tid >> 6, r = lane & 31, h = lane >> 5;
      (void)tid;
      const int qt = t >> 2, head = t & 3;
      const int tq = qt * 128 + w * 32 + r;
      const int qcol = even ? 6144 : 5632, gcol = even ? 6656 : 6144;
      bf16x8 qf[8];
      load_q<128>(qf, P + (size_t)tq * NP + qcol + head * 128, h);
      f32x16 o[4];
      zero_o(o);
      float m = NEG, l = 0.f;
      CtxMem ctx{0.08838834764831845f * LOG2E};
      attn_run<128, true, true>(qf, o, m, l, (const bf16*)(ws + WS_MEMK) + head * 128, 512, nullptr, 0,
                          (const bf16*)(ws + WS_MEMVT) + (size_t)head * 128 * 256, 256, 0, ctx, smem);
      float lt = l + __shfl_xor(l, 32);
      store_out_A(o, 1.f / lt, P + (size_t)tq * NP + gcol + head * 128, MIXED + (size_t)tq * MIXW + 2048 + head * 128, h);
    };

    if ((PHM & 8) && sub == 1 && even) {
      const int cw = 0;
      const int n_s5 = 1024, n_cum = 64, n_mem = 256;
      for (int t = bid; t < n_mem + n_s5 + n_cum + cw; t += nb) {
        if (t < n_mem) {
          mem_attn_task(t);
        } else if (t < n_mem + n_s5) {
          const int t2 = t - n_mem;
          const int ch = t2 >> 4, gq = t2 & 15;
          float* us = (float*)smem;
          __syncthreads();
          for (int i = tid; i < 128 * 8; i += 256) {
            int tt = i >> 3, c8 = (i & 7) * 8;
            uint4 u = *(const uint4*)(P + (size_t)(ch * 128 + tt) * NPE + gq * 64 + c8);
            float* d = us + tt * 64 + c8;
            d[0] = bflo(u.x); d[1] = bfhi(u.x); d[2] = bflo(u.y); d[3] = bfhi(u.y);
            d[4] = bflo(u.z); d[5] = bfhi(u.z); d[6] = bflo(u.w); d[7] = bfhi(u.w);
          }
          __syncthreads();
          const float* S5P = (const float*)(ws + WS_S5P);
          const int gp = (gq * 4 + w) * 64 + lane;
          const float ar = S5P[gp], ai = S5P[4096 + gp];
          float bbr[16], bbi[16];
#pragma unroll
          for (int c = 0; c < 16; ++c) { bbr[c] = S5P[16384 + gp * 16 + c]; bbi[c] = S5P[16384 + 65536 + gp * 16 + c]; }
          float xr = 0.f, xi = 0.f;
          for (int tt = 0; tt < 128; ++tt) {
            const float* up = us + tt * 64 + w * 16;
            float bur = 0.f, bui = 0.f;
#pragma unroll
            for (int c = 0; c < 16; ++c) { float uv = up[c]; bur += bbr[c] * uv; bui += bbi[c] * uv; }
            float nxr = ar * xr - ai * xi + bur;
            float nxi = ar * xi + ai * xr + bui;
            xr = nxr; xi = nxi;
          }
          float2* E = (float2*)(ws + WS_S5E);
          E[(size_t)ch * 4096 + gp] = make_float2(xr, xi);
        } else if (t < n_mem + n_s5 + n_cum) {
          const int ch = t - n_mem - n_s5;
          const float* FL = (const float*)(ws + WS_FLOG);
          float* CUML = (float*)(ws + WS_CUML);
          float* CT = (float*)(ws + WS_CT);
#pragma unroll
          for (int hh = 0; hh < 2; ++hh) {
            const int head = w * 2 + hh;
            const float bf = p.fox_b_f[li * 8 + head];
            const int t0 = ch * 128 + lane * 2;
            float x0 = FL[(size_t)t0 * 8 + head] + bf, x1 = FL[(size_t)(t0 + 1) * 8 + head] + bf;
            float v0 = x0 >= 0.f ? -log1pf(expf(-x0)) : x0 - log1pf(expf(x0));
            float v1 = x1 >= 0.f ? -log1pf(expf(-x1)) : x1 - log1pf(expf(x1));
            float s = v0 + v1;
            float inc = s;
#pragma unroll
            for (int o = 1; o < 64; o <<= 1) {
              float n = __shfl_up(inc, o);
              if (lane >= o) inc += n;
            }
            float excl = inc - s;
            CUML[(size_t)head * L + t0] = excl + v0;
            CUML[(size_t)head * L + t0 + 1] = excl + v0 + v1;
            if (lane == 63) CT[head * 64 + ch] = inc;
          }
        } else {
          cvt_set_task(p, SET_OUT, layer, t - n_mem - n_s5 - n_cum, smem);
        }
      }
    }
    if ((PHM & 16) && sub == 2 && even) {
      const int n_fox = 512, n_s5 = 1024;
      for (;;) {
        const int t = fetch_task(CTR + ph);
        if (t >= n_fox + n_s5) break;
        const int tid = otid(), lane = tid & 63, w = tid >> 6, r = lane & 31, h = lane >> 5;
        int zt_;
        asm volatile("s_mov_b32 %0, 0" : "=s"(zt_));
        char* const ws = ws_ph + zt_;
        if (t < n_fox) {
          const int qt = 63 - (t >> 3), head = t & 7;
          const int q0w = qt * 128 + w * 32, tq = q0w + r;
          float* cpre = (float*)(smem + AT_X0);
          __syncthreads();
          if (tid < 64) {
            const float v0 = ((const float*)(ws + WS_CT))[head * 64 + tid];
            float inc = v0;
#pragma unroll
            for (int of = 1; of < 64; of <<= 1) {
              float n = __shfl_up(inc, of);
              if (tid >= of) inc += n;
            }
            cpre[tid] = inc - v0;
          }
          __syncthreads();
          const float* cuml = (const float*)(ws + WS_CUML) + (size_t)head * L;
          bf16x8 qf[8];
          load_q<128>(qf, P + (size_t)tq * NPE + 2048 + head * 128, h);
          f32x16 o[4];
          zero_o(o);
          float m = NEG, l = 0.f;
          CtxFox ctx{tq, q0w, 2 * qt + 1, 0.08838834764831845f * LOG2E, cuml, cpre};
          attn_run<128, true, true>(qf, o, m, l, P + 3072 + head * 128, NPE, nullptr, 0,
                              (const bf16*)(ws + WS_VTFOX) + (size_t)head * 128 * L, L, 0, ctx, smem);
          float lt = l + __shfl_xor(l, 32);
          store_out_A(o, 1.f / lt, P + (size_t)tq * NPE + 5120 + head * 128, MIXED + (size_t)tq * MIXW + 1024 + head * 128, h);
        } else {
          const int t2 = t - n_fox;
          const int ch = t2 >> 4, gq = t2 & 15;
          float* us = (float*)smem;
          float* xs = (float*)(smem + 32768) + w * 16 * 132;
          __syncthreads();
          for (int i = tid; i < 128 * 8; i += 256) {
            int tt = i >> 3, c8 = (i & 7) * 8;
            uint4 u = *(const uint4*)(P + (size_t)(ch * 128 + tt) * NPE + gq * 64 + c8);
            float* d = us + tt * 64 + c8;
            d[0] = bflo(u.x); d[1] = bfhi(u.x); d[2] = bflo(u.y); d[3] = bfhi(u.y);
            d[4] = bflo(u.z); d[5] = bfhi(u.z); d[6] = bflo(u.w); d[7] = bfhi(u.w);
          }
          __syncthreads();
          const float* S5P = (const float*)(ws + WS_S5P);
          const int g = gq * 4 + w;
          const int gp = g * 64 + lane;
          const float ar = S5P[gp], ai = S5P[4096 + gp];
          const float atr = S5P[8192 + gp], ati = S5P[12288 + gp];
          float xr = 0.f, xi = 0.f;
          {
            const float2* E = (const float2*)(ws + WS_S5E) + gp;
#define CSTEP(e) { float nxr = atr * xr - ati * xi + e.x; float nxi = atr * xi + ati * xr + e.y; xr = nxr; xi = nxi; }
            int c = 0;
            for (; c + 8 <= ch; c += 8) {
              float2 e0 = E[(size_t)(c + 0) * 4096], e1 = E[(size_t)(c + 1) * 4096], e2 = E[(size_t)(c + 2) * 4096],
                     e3 = E[(size_t)(c + 3) * 4096], e4 = E[(size_t)(c + 4) * 4096], e5 = E[(size_t)(c + 5) * 4096],
                     e6 = E[(size_t)(c + 6) * 4096], e7 = E[(size_t)(c + 7) * 4096];
              CSTEP(e0) CSTEP(e1) CSTEP(e2) CSTEP(e3) CSTEP(e4) CSTEP(e5) CSTEP(e6) CSTEP(e7)
            }
            for (; c < ch; ++c) {
              float2 e = E[(size_t)c * 4096];
              CSTEP(e)
            }
#undef CSTEP
          }
          float bbr[16], bbi[16];
#pragma unroll
          for (int c = 0; c < 16; ++c) { bbr[c] = S5P[16384 + gp * 16 + c]; bbi[c] = S5P[16384 + 65536 + gp * 16 + c]; }
          const int chn = lane & 15, kq = lane >> 4;
          float cb[32];
          {
            const float* cre = p.c_re + ((size_t)li * 64 + g) * 1024 + chn * 64;
            const float* cim = p.c_im + ((size_t)li * 64 + g) * 1024 + chn * 64;
#pragma unroll
            for (int ks = 0; ks < 16; ++ks) { cb[ks] = cre[4 * ks + kq]; cb[16 + ks] = -cim[4 * ks + kq]; }
          }
          const float dsk = p.s5_d[li * 1024 + g * 16 + chn];
          bf16* Z = (bf16*)(ws + WS_Z);
          for (int sc = 0; sc < 8; ++sc) {
#pragma unroll 4
            for (int tt = 0; tt < 16; ++tt) {
              const float* up = us + (sc * 16 + tt) * 64 + w * 16;
              float bur = 0.f, bui = 0.f;
#pragma unroll
              for (int c = 0; c < 16; ++c) { float uv = up[c]; bur += bbr[c] * uv; bui += bbi[c] * uv; }
              float nxr = ar * xr - ai * xi + bur;
              float nxi = ar * xi + ai * xr + bui;
              xr = nxr; xi = nxi;
              xs[tt * 132 + lane] = xr;
              xs[tt * 132 + 64 + lane] = xi;
            }
            __syncthreads();
            f32x4 y = {0.f, 0.f, 0.f, 0.f};
#pragma unroll
            for (int ks = 0; ks < 32; ++ks) {
              float a = xs[chn * 132 + 4 * ks + kq];
              y = __builtin_amdgcn_mfma_f32_16x16x4f32(a, cb[ks], y, 0, 0, 0);
            }
#pragma unroll
            for (int i = 0; i < 4; ++i) {
              int tt = 4 * kq + i;
              float uv = us[(sc * 16 + tt) * 64 + w * 16 + chn];
              float yy = y[i] + dsk * uv;
              Z[(size_t)(ch * 128 + sc * 16 + tt) * LDZ + g * 16 + chn] = f2bf(gelu_t(yy));
            }
            __syncthreads();
          }
        }
      }
    }
    if ((PHM & 32) && sub == 3 && even) {
      const bf16* Z = (const bf16*)(ws + WS_Z);
      for (int t = vb; t < 64 * 8; t += nb) {
        int tm, tn;
        tile_map(t, 8, tm, tn);
        const int m0 = tm * 128, n0 = tn * 128;
        ALin af{Z + (size_t)m0 * LDZ, LDZ};
        gemm_tile(af, (const bf16*)(ws + WS_WMISC + WM_GLU) + (size_t)n0 * LDZ, LDZ, 1024, smem, [&](const float* Cs) {
          epi_rows(Cs, [&](int row, int cc, const float* v) {
            uint4 zu = *(const uint4*)(Z + (size_t)(m0 + row) * LDZ + n0 + cc);
            uint4 gu = *(const uint4*)(P + (size_t)(m0 + row) * NPE + 1024 + n0 + cc);
            float zz[8] = {bflo(zu.x), bfhi(zu.x), bflo(zu.y), bfhi(zu.y), bflo(zu.z), bfhi(zu.z), bflo(zu.w), bfhi(zu.w)};
            float gg[8] = {bflo(gu.x), bfhi(gu.x), bflo(gu.y), bfhi(gu.y), bflo(gu.z), bfhi(gu.z), bflo(gu.w), bfhi(gu.w)};
            float o[8];
#pragma unroll
            for (int e = 0; e < 8; ++e) o[e] = zz[e] * sigm(v[e]) * silu(gg[e]);
            *(uint4*)(MIXED + (size_t)(m0 + row) * MIXW + n0 + cc) = pack8(o);
          });
        });
      }
    }
    if ((PHM & 64) && sub == 1 && !even) {
      const int cw = 0;
      const int n_c1 = 32, n_q = 64 * 12, n_kv = 64 * 16, n_mem = 256;
      float* rsx = (float*)(smem + SM_EXTRA);
      const bool split = (nb % 8 == 0) && nb >= 64;
      int t0, tstride;
      if (!split) { t0 = bid; tstride = nb; }
      else if (bid < n_c1) { t0 = bid; tstride = 1 << 28; }
      else { t0 = n_c1 + (bid & 7) * ((nb - n_c1) >> 3) + ((bid >> 3) - (n_c1 >> 3)); tstride = nb - n_c1; }
      for (int t = t0; t < n_c1 + n_q + n_kv + n_mem + cw; t += tstride) {
        if (t < n_c1) {
          const int which = t >> 4, tm = (t >> 1) & 7, tn = t & 1;
          const int m0 = tm * 128, n0 = tn * 128;
          __syncthreads();
          if (tid < 128) {
            const float* CB = (const float*)(ws + WS_CMPB) + which * 16 * 256 + n0 + tid;
            float b = 0.f;
            for (int q = 0; q < 16; ++q) b += CB[q * 256];
            rsx[tid] = b;
          }
          ACmp af{P + (which ? 3328 : 3072), m0};
          bf16* HID = (bf16*)(ws + WS_HID) + (size_t)which * 1024 * 256;
          gemm_tile(af, (const bf16*)(ws + WS_WMISC + WM_W1) + (size_t)which * 256 * 4096 + (size_t)n0 * 4096, 4096, 4096,
                    smem, [&](const float* Cs) {
                      epi_rows(Cs, [&](int row, int cc, const float* v) {
                        float o[8];
#pragma unroll
                        for (int e = 0; e < 8; ++e) o[e] = gelu_t(v[e] + rsx[cc + e]);
                        *(uint4*)(HID + (size_t)(m0 + row) * 256 + n0 + cc) = pack8(o);
                      });
                    });
        } else if (t < n_c1 + n_q + n_kv) {
          const int t2 = t - n_c1;
          const bool isq = t2 < n_q;
          const int t3 = isq ? t2 : t2 - n_q;
          const int ntn = isq ? 12 : 16;
          int tm, tn;
          tile_map(t3, ntn, tm, tn);
          const int m0 = tm * 128, n0 = tn * 128;
          const bf16* Ab = P + (size_t)m0 * NPO + (isq ? 0 : 512);
          __syncthreads();
          for (int r8 = 0; r8 < 4; ++r8) {
            float ssq[8];
#pragma unroll
            for (int q = 0; q < 8; ++q) {
              int row = w * 32 + r8 * 8 + q;
              uint4 u = *(const uint4*)(Ab + (size_t)row * NPO + lane * 8);
              float a0 = bflo(u.x), a1 = bfhi(u.x), a2 = bflo(u.y), a3 = bfhi(u.y), a4 = bflo(u.z), a5 = bfhi(u.z),
                    a6 = bflo(u.w), a7 = bfhi(u.w);
              ssq[q] = a0 * a0 + a1 * a1 + a2 * a2 + a3 * a3 + a4 * a4 + a5 * a5 + a6 * a6 + a7 * a7;
            }
#pragma unroll
            for (int q = 0; q < 8; ++q) {
              float ss = wave_sum(ssq[q]);
              if (lane == 0) rsx[w * 32 + r8 * 8 + q] = rsqrtf(ss * (1.f / 512.f) + EPS);
            }
          }
          ALin af{Ab, NPO};
          if (isq) {
            bf16* QM = (bf16*)(ws + WS_QMLA);
            gemm_tile(af, (const bf16*)(ws + WS_WMISC + WM_UQ) + (size_t)n0 * 512, 512, 512, smem, [&](const float* Cs) {
              const int md = n0 % 192;
              const int ropehalf = md == 128 ? 0 : (md == 64 ? 1 : -1);
              epi_rows(Cs, [&](int row, int cc, const float* v) {
                if ((cc >> 6) == ropehalf) return;
                float o[8];
                float sc = rsx[row];
#pragma unroll
                for (int e = 0; e < 8; ++e) o[e] = v[e] * sc;
                *(uint4*)(QM + (size_t)(m0 + row) * 1536 + n0 + cc) = pack8(o);
              });
              if (ropehalf >= 0) {
                epi_rope(Cs, ropehalf * 64, m0, ROPEC, ROPES, 1.f, [&](int row, int cl, const float* v) {
                  float o[8];
                  float sc = rsx[row];
#pragma unroll
                  for (int e = 0; e < 8; ++e) o[e] = v[e] * sc;
                  *(uint4*)(QM + (size_t)(m0 + row) * 1536 + n0 + ropehalf * 64 + cl) = pack8(o);
                });
              }
            });
          } else {
            gemm_tile(af, (const bf16*)(ws + WS_WMISC + WM_UKV) + (size_t)n0 * 512, 512, 512, smem, [&](const float* Cs) {
              const int head = n0 >> 8, part = (n0 >> 7) & 1;
              if (part == 0) {
                bf16* KM = (bf16*)(ws + WS_KMLA);
                epi_rows(Cs, [&](int row, int cc, const float* v) {
                  float o[8];
                  float sc = rsx[row];
#pragma unroll
                  for (int e = 0; e < 8; ++e) o[e] = v[e] * sc;
                  *(uint4*)(KM + (size_t)(m0 + row) * 1024 + head * 128 + cc) = pack8(o);
                });
              } else {
                bf16* VT = (bf16*)(ws + WS_VTMLA);
                epi_cols(Cs, [&](int col, int r8, const float* v) {
                  float o[8];
#pragma unroll
                  for (int e = 0; e < 8; ++e) o[e] = v[e] * rsx[r8 + e];
                  *(uint4*)(VT + (size_t)(head * 128 + col) * L + m0 + r8) = pack8(o);
                });
              }
            });
          }
        } else if (t < n_c1 + n_q + n_kv + n_mem) {
          mem_attn_task(t - n_c1 - n_q - n_kv);
        } else {
          cvt_set_task(p, SET_OUT, layer, t - n_c1 - n_q - n_kv - n_mem, smem);
        }
      }
    }
    if ((PHM & 128) && sub == 2 && !even) {
      const int n_c2 = 16, n_mem2 = 0;
      for (int t = bid; t < n_c2 + n_mem2; t += nb) {
        if (t >= n_c2) {
          mem_attn_task(t - n_c2);
        } else {
          const int t2 = t;
          const int which = t2 >> 3, m0 = (t2 & 7) * 128;
          ALin af{(const bf16*)(ws + WS_HID) + (size_t)which * 1024 * 256 + (size_t)m0 * 256, 256};
          gemm_tile(af, (const bf16*)(ws + WS_WMISC + WM_W2) + (size_t)which * 128 * 256, 256, 256, smem, [&](const float* Cs) {
            if (which == 0) {
              bf16* KC = (bf16*)(ws + WS_KC);
              epi_rows(Cs, [&](int row, int cc, const float* v) {
                int gr = m0 + row;
                int n = gr >> 1, g = gr & 1;
                *(uint4*)(KC + ((size_t)g * 512 + n) * 128 + cc) = pack8(v);
              });
            } else {
              bf16* VC = (bf16*)(ws + WS_VCT);
              for (int i = tid; i < 128 * 128; i += 256) {
                int row = i & 127, col = i >> 7;
                int gr = m0 + row;
                int n = gr >> 1, g = gr & 1;
                VC[((size_t)g * 128 + col) * 512 + n] = f2bf(Cs[row * 132 + col]);
              }
            }
          });
        }
      }
    }
    if ((PHM & 256) && sub == 3 && !even) {
      const int* pos = p.pos;
      float* lut = (float*)(smem + AT_X0);
      float* imp = (float*)(smem + AT_IMP);
      unsigned* sel = (unsigned*)(smem + AT_SEL);
      const float* GT = (const float*)(ws + WS_FLOG);
      float* NSAO = (float*)(ws + WS_NSAO);
      for (;;) {
        const int tt_ = fetch_task(CTR + ph);
        if (tt_ >= 1024) break;
        const int t = tt_ >> 1;
        const int tid = otid(), lane = tid & 63, w = tid >> 6, r = lane & 31, h = lane >> 5;
        int zt_;
        asm volatile("s_mov_b32 %0, 0" : "=s"(zt_));
        char* const ws = ws_ph + zt_;
        if ((tt_ & 1) == 0) {
          const int qt = 63 - (t >> 3), head = t & 7;
          const int q0w = qt * 128 + w * 32, tq = q0w + r;
          bf16x8 qf[12];
          load_q<192>(qf, (const bf16*)(ws + WS_QMLA) + (size_t)tq * 1536 + head * 192, h);
          f32x16 o[4];
          zero_o(o);
          float m = NEG, l = 0.f;
          CtxCausal ctx{tq, q0w, 2 * qt + 1, 0.07216878364870322f * LOG2E};
          attn_run<192, true, true>(qf, o, m, l, (const bf16*)(ws + WS_KMLA) + head * 128, 1024, P + 6656, NPO,
                              (const bf16*)(ws + WS_VTMLA) + (size_t)head * 128 * L, L, 0, ctx, smem);
          float lt = l + __shfl_xor(l, 32);
          store_out_A(o, 1.f / lt, P + (size_t)tq * NPO + 1024 + head * 128, MIXED + (size_t)tq * MIXW + head * 128, h);
          continue;
        }
        const int qt = 255 - (t >> 1), g = t & 1;
        const int q0 = qt * 32;
        const int hr = r >> 3, qi = r & 7;
        const int ql = w * 8 + qi;
        const int tq = q0 + ql;
        const int head = g * 4 + hr;
        const int posq = pos[tq];
        __syncthreads();
        for (int i = tid; i < 4 * 800; i += 256) {
          int rr = i / 800, n = i % 800;
          int b;
          if (n < 16) b = n;
          else {
            float lr = logf((float)n / 16.f) / 4.1588830833596715f;
            b = 16 + (int)(lr * 16.f);
            if (b > 31) b = 31;
          }
          lut[i] = p.t5[b * 8 + g * 4 + rr] * LOG2E;
        }
        for (int i = tid; i < 32 * 132; i += 256) imp[i] = 0.f;
        __syncthreads();
        const float* lutr = lut + hr * 800;
        bf16x8 qf[8];
        load_q<128>(qf, P + (size_t)tq * NPO + 2048 + head * 128, h);
        const float sc = 0.08838834764831845f * LOG2E;
        f32x16 o[4];
        float* orow = NSAO + (size_t)tq * 1024 + head * 128;

        const int ncv = min(q0 / 16 + 1, 511);
        const int last_c = (ncv - 1) >> 6;
        float m = NEG, l = 0.f;
        CtxCmp cc{tq, posq, last_c, sc, lutr, pos, 0.f, imp, ql, false};
        zero_o(o);
        const bf16* KCg = (const bf16*)(ws + WS_KC) + (size_t)g * 512 * 128;
        const bf16* VCg = (const bf16*)(ws + WS_VCT) + (size_t)g * 128 * 512;
        attn_run<128, false, false>(qf, o, m, l, KCg, 128, nullptr, 0, VCg, 512, 0, cc, smem);
        float lt = l + __shfl_xor(l, 32);
        const bool has_c = m > -1e29f;
        float m2 = has_c ? m : 0.f;
        float invl = has_c ? 1.f / lt : 0.f;
        cc.invl = invl; cc.p2 = true;
        float l2 = 0.f;
        attn_run<128, true, false>(qf, o, m2, l2, KCg, 128, nullptr, 0, VCg, 512, 0, cc, smem);
        {
          float gs = sigm(GT[(size_t)tq * 24 + head * 3 + 0]) * invl;
#pragma unroll
          for (int d = 0; d < 4; ++d)
#pragma unroll
            for (int i4 = 0; i4 < 4; ++i4) {
              int dv0 = d * 32 + 8 * i4 + 4 * h;
              float4 v = make_float4(o[d][4 * i4] * gs, o[d][4 * i4 + 1] * gs, o[d][4 * i4 + 2] * gs, o[d][4 * i4 + 3] * gs);
              *(float4*)(orow + dv0) = v;
            }
        }
        __syncthreads();
        for (int q8 = 0; q8 < 8; ++q8) {
          const int qq = w * 8 + q8;
          const int tt = q0 + qq;
          const int cur = tt >> 6;
          const float* ip = imp + qq * 132;
          const int j0 = lane, j1 = lane + 64;
          const bool v0 = j0 <= cur, v1 = j1 <= cur;
          const bool f0 = (j0 == 0) || (j0 == cur) || (j0 == cur - 1);
          const bool f1 = (j1 == cur) || (j1 == cur - 1);
          const int nforced = cur == 0 ? 1 : (cur == 1 ? 2 : 3);
          const int nfree = 16 - nforced;
          const bool c0 = v0 && !f0, c1 = v1 && !f1;
          const unsigned u0 = __float_as_uint(ip[j0]), u1 = __float_as_uint(ip[j1]);
          const int ncand = __popcll(__ballot(c0)) + __popcll(__ballot(c1));
          bool s0, s1;
          if (ncand <= nfree) {
            s0 = v0; s1 = v1;
          } else {
            unsigned T = 0u;
            for (int bit = 30; bit >= 0; --bit) {
              const unsigned cth = T | (1u << bit);
              const int cnt = __popcll(__ballot(c0 && u0 >= cth)) + __popcll(__ballot(c1 && u1 >= cth));
              if (cnt >= nfree) T = cth;
            }
            const bool g0 = c0 && u0 > T, g1 = c1 && u1 > T;
            const bool e0 = c0 && u0 == T, e1 = c1 && u1 == T;
            const unsigned long long me0 = __ballot(e0), me1 = __ballot(e1);
            const int need0 = nfree - (__popcll(__ballot(g0)) + __popcll(__ballot(g1)));
            const int need1 = need0 - __popcll(me0);
            const int rk0 = __builtin_amdgcn_mbcnt_hi((unsigned)(me0 >> 32), __builtin_amdgcn_mbcnt_lo((unsigned)me0, 0u));
            const int rk1 = __builtin_amdgcn_mbcnt_hi((unsigned)(me1 >> 32), __builtin_amdgcn_mbcnt_lo((unsigned)me1, 0u));
            s0 = (v0 && f0) || g0 || (e0 && rk0 < need0);
            s1 = (v1 && f1) || g1 || (e1 && rk1 < need1);
          }
          unsigned long long b0 = __ballot(s0), b1 = __ballot(s1);
          if (lane == 0) {
            sel[qq * 4 + 0] = (unsigned)b0; sel[qq * 4 + 1] = (unsigned)(b0 >> 32);
            sel[qq * 4 + 2] = (unsigned)b1; sel[qq * 4 + 3] = (unsigned)(b1 >> 32);
          }
        }
        __syncthreads();
        unsigned un0, un1, un2, un3;
        {
          un0 = sel[r * 4 + 0]; un1 = sel[r * 4 + 1]; un2 = sel[r * 4 + 2]; un3 = sel[r * 4 + 3];
#pragma unroll
          for (int of = 1; of < 32; of <<= 1) {
            un0 |= __shfl_xor(un0, of); un1 |= __shfl_xor(un1, of); un2 |= __shfl_xor(un2, of); un3 |= __shfl_xor(un3, of);
          }
          un0 = __builtin_amdgcn_readfirstlane(un0); un1 = __builtin_amdgcn_readfirstlane(un1);
          un2 = __builtin_amdgcn_readfirstlane(un2); un3 = __builtin_amdgcn_readfirstlane(un3);
        }
        {
          const unsigned long long ulo = (unsigned long long)un0 | ((unsigned long long)un1 << 32);
          const unsigned long long uhi = (unsigned long long)un2 | ((unsigned long long)un3 << 32);
          const unsigned long long mlo = (unsigned long long)sel[ql * 4] | ((unsigned long long)sel[ql * 4 + 1] << 32);
          const unsigned long long mhi = (unsigned long long)sel[ql * 4 + 2] | ((unsigned long long)sel[ql * 4 + 3] << 32);
          int pqmin = pos[q0];
          for (int q = 1; q < 32; ++q) pqmin = min(pqmin, pos[q0 + q]);
          const int* posmax = (const int*)(ws + WS_POSMAX);
          zero_o(o);
          m = NEG; l = 0.f;
          {
            CtxSlc cs{tq, posq, sc, lutr, pos, ulo, uhi, mlo, mhi, posmax, pqmin, q0};
            attn_run<128, true, false>(qf, o, m, l, P + 3584 + g * 128, NPO, nullptr, 0,
                                       (const bf16*)(ws + WS_VTSLC) + (size_t)g * 128 * L, L, cs.next(-1), cs, smem);
          }
          {
            CtxSlcFar cf{sc, lutr[799], ulo, uhi, mlo, mhi, posmax, pqmin, q0};
            attn_run<128, true, false>(qf, o, m, l, P + 3584 + g * 128, NPO, nullptr, 0,
                                       (const bf16*)(ws + WS_VTSLC) + (size_t)g * 128 * L, L, cf.next(-1), cf, smem);
          }
          lt = l + __shfl_xor(l, 32);
          float gs = sigm(GT[(size_t)tq * 24 + head * 3 + 1]) / lt;
#pragma unroll
          for (int d = 0; d < 4; ++d)
#pragma unroll
            for (int i4 = 0; i4 < 4; ++i4) {
              int dv0 = d * 32 + 8 * i4 + 4 * h;
              float4 v = *(float4*)(orow + dv0);
              v.x += o[d][4 * i4] * gs; v.y += o[d][4 * i4 + 1] * gs; v.z += o[d][4 * i4 + 2] * gs; v.w += o[d][4 * i4 + 3] * gs;
              *(float4*)(orow + dv0) = v;
            }
        }
        {
          const int kfirst = q0 - 511 > 0 ? (q0 - 511) >> 6 : 0;
          CtxWin cwn{tq, posq, (q0 + 31) >> 6, sc, lutr, pos};
          zero_o(o);
          m = NEG; l = 0.f;
          attn_run<128, true, false>(qf, o, m, l, P + 4096 + g * 128, NPO, nullptr, 0,
                              (const bf16*)(ws + WS_VTWIN) + (size_t)g * 128 * L, L, kfirst, cwn, smem);
          lt = l + __shfl_xor(l, 32);
          float gs = sigm(GT[(size_t)tq * 24 + head * 3 + 2]) / lt;
          const bf16* grow = P + (size_t)tq * NPO + 4608 + head * 128;
          bf16* mrow = MIXED + (size_t)tq * MIXW + 1024 + head * 128;
#pragma unroll
          for (int d = 0; d < 4; ++d)
#pragma unroll
            for (int i4 = 0; i4 < 4; ++i4) {
              int dv0 = d * 32 + 8 * i4 + 4 * h;
              float4 v = *(float4*)(orow + dv0);
              v.x += o[d][4 * i4] * gs; v.y += o[d][4 * i4 + 1] * gs; v.z += o[d][4 * i4 + 2] * gs; v.w += o[d][4 * i4 + 3] * gs;
              uint2 gu = *(const uint2*)(grow + dv0);
              uint2 ou;
              ou.x = pack2(v.x * silu(bflo(gu.x)), v.y * silu(bfhi(gu.x)));
              ou.y = pack2(v.z * silu(bflo(gu.y)), v.w * silu(bfhi(gu.y)));
              *(uint2*)(mrow + dv0) = ou;
            }
        }
      }
    }
    if ((PHM & 2) && (ph == 0 || (sub == 2 && even) || (sub == 3 && !even))) {
      const int nl = ph == 0 ? 0 : layer + 1;
      if (nl < 4) {
        const int n_cv = cvt_next_count(p, nl), n_cv4 = (n_cv + 3) >> 2;
        const bool dyn = ph != 0;
        int t = dyn ? fetch_task(CTR + 32 + ph) : bid;
        while (t < n_cv4) {
          for (int q = 0; q < 4; ++q) {
            const int ci = t * 4 + q;
            if (ci < n_cv) cvt_next(p, smem, nl, ci);
          }
          t = dyn ? fetch_task(CTR + 32 + ph) : t + nb;
        }
      }
    }
    if ((PHM & 512) && sub == 4) {
      const float* hin = layer == 0 ? p.x : hbuf;
      for (int t = vb; t < 64 * 8; t += nb) {
        int tm, tn;
        tile_map(t, 8, tm, tn);
        const int m0 = tm * 128;
        int n0 = tn * 256;
        ALin af{MIXED + (size_t)m0 * MIXW, MIXW};
        gemm_tile2(af, (const bf16*)(ws + WS_WOUT) + (size_t)n0 * MIXW, MIXW, MIXW, smem, n0, 2, [&](const float* Cs) {
          const int tid2 = otid();
#pragma unroll
          for (int j = 0; j < 16; ++j) {
            int c = tid2 + 256 * j;
            int row = c >> 5, cc = (c & 31) * 4;
            float4 a = *(const float4*)(Cs + row * 132 + cc);
            float4 hv = *(const float4*)(hin + (size_t)(m0 + row) * DM + n0 + cc);
            hv.x += a.x; hv.y += a.y; hv.z += a.z; hv.w += a.w;
            *(float4*)(hbuf + (size_t)(m0 + row) * DM + n0 + cc) = hv;
          }
        });
      }
    }
    }
  }
}

extern "C" void kernel_launch(void* const* d_in, const int* in_sizes, int n_in, void* d_out, int out_size, void* d_ws,
                              size_t ws_size, hipStream_t stream) {
  Params p{};
  p.x = (const float*)d_in[0]; p.mem = (const float*)d_in[1]; p.pos = (const int*)d_in[2];
  p.norm_g = (const float*)d_in[3]; p.mem_norm_g = (const float*)d_in[4]; p.final_norm_g = (const float*)d_in[5];
  p.t5 = (const float*)d_in[6]; p.w_out = (const float*)d_in[7]; p.mem_w_kv = (const float*)d_in[8];
  p.even_w_in = (const float*)d_in[9]; p.lam_re = (const float*)d_in[10]; p.lam_im = (const float*)d_in[11];
  p.log_dt = (const float*)d_in[12]; p.b_re = (const float*)d_in[13]; p.b_im = (const float*)d_in[14];
  p.c_re = (const float*)d_in[15]; p.c_im = (const float*)d_in[16]; p.s5_d = (const float*)d_in[17];
  p.w_glu = (const float*)d_in[18]; p.fox_b_f = (const float*)d_in[19]; p.odd_w_in = (const float*)d_in[20];
  p.g_cq = (const float*)d_in[21]; p.g_ckv = (const float*)d_in[22]; p.w_uq = (const float*)d_in[23];
  p.w_ukv = (const float*)d_in[24]; p.cmp_pe = (const float*)d_in[25]; p.cmp_w1 = (const float*)d_in[26];
  p.cmp_w2 = (const float*)d_in[27];
  p.out = (float*)d_out; p.ws = (char*)d_ws;
  if (ws_size < WS_END) fprintf(stderr, "workspace too small: %zu < %zu\n", ws_size, (size_t)WS_END);
  static int grid_blocks = 0;
  if (!grid_blocks) {
    int dev = 0, cus = 0, per_cu = 0;
    hipGetDevice(&dev);
    hipDeviceGetAttribute(&cus, hipDeviceAttributeMultiprocessorCount, dev);
    hipOccupancyMaxActiveBlocksPerMultiprocessor(&per_cu, mega, 256, 0);
    if (per_cu > 2) per_cu = 2;
    if (per_cu < 1) per_cu = 1;
    grid_blocks = cus * per_cu;
  }
  (void)hipMemsetAsync((char*)d_ws + WS_BAR, 0, XCD_BAR_WORDS * sizeof(unsigned), stream);
#if MULTI_LAUNCH
  for (int ph = 0; ph <= 24; ++ph) {
    int lo = ph, hi = ph;
    void* args[] = {&p, &lo, &hi};
    hipLaunchCooperativeKernel((void*)mega, dim3(grid_blocks), dim3(256), args, 0, stream);
  }
#else
  int lo = 0, hi = 24;
  void* args[] = {&p, &lo, &hi};
  hipError_t e = hipLaunchCooperativeKernel((void*)mega, dim3(grid_blocks), dim3(256), args, 0, stream);
  if (e != hipSuccess) fprintf(stderr, "cooperative launch failed: %s (grid %d)\n", hipGetErrorString(e), grid_blocks);
#endif
}
```

```cpp
#include <hip/hip_runtime.h>
#include <hip/hip_cooperative_groups.h>
#include <cstdio>
#include <cstdint>
namespace cg = cooperative_groups;

typedef unsigned short bf16;
typedef short bf16x8 __attribute__((ext_vector_type(8)));
typedef float f32x16 __attribute__((ext_vector_type(16)));
typedef float f32x4 __attribute__((ext_vector_type(4)));
typedef __bf16 bf2v __attribute__((ext_vector_type(2)));
typedef float f2v __attribute__((ext_vector_type(2)));

#define DI __device__ __forceinline__
#define MFMA32(a, b, c) __builtin_amdgcn_mfma_f32_32x32x16_bf16((a), (b), (c), 0, 0, 0)

#ifndef LB2
#define LB2 2
#endif
#ifndef REP_PH
#define REP_PH -1
#endif
#ifndef PHM
#define PHM 1023
#endif
#ifndef MULTI_LAUNCH
#define MULTI_LAUNCH 0
#endif

constexpr int L = 8192;
constexpr int DM = 2048;
constexpr int NPE = 7296;
constexpr int NPO = 6784;
constexpr int EVEN_IN = 7176;
constexpr int ODD_IN = 6744;
constexpr int MIXW = 2560;
constexpr int LDX = 2112;
constexpr int LDZ = 1088;
constexpr float LOG2E = 1.4426950408889634f;
constexpr float NEG = -1e30f;
constexpr float EPS = 1e-6f;

constexpr size_t MB = 1024 * 1024;
constexpr size_t WS_WIN = 0;
constexpr size_t WS_WOUT = WS_WIN + 32 * MB;
constexpr size_t WS_WMEM = WS_WOUT + 10 * MB;
constexpr size_t WS_WMISC = WS_WMEM + 4 * MB;
constexpr size_t WS_XN = WS_WMISC + 11 * MB;
constexpr size_t WS_MEMN = WS_XN + 36 * MB;
constexpr size_t WS_P = WS_MEMN + 1 * MB;
constexpr size_t WS_MIXED = WS_P + 114 * MB;
constexpr size_t WS_MEMK = WS_MIXED + 40 * MB;
constexpr size_t WS_MEMVT = WS_MEMK + 256 * 1024;
constexpr size_t WS_ROPEC = WS_MEMVT + 256 * 1024;
constexpr size_t WS_ROPES = WS_ROPEC + 1 * MB;
constexpr size_t WS_FLOG = WS_ROPES + 1 * MB;
constexpr size_t WS_CUML = WS_FLOG + 1 * MB;
constexpr size_t WS_CT = WS_CUML + 256 * 1024;
constexpr size_t WS_S5P = WS_CT + 4096;
constexpr size_t WS_S5E = WS_S5P + 1 * MB;
constexpr size_t WS_CMPB = WS_S5E + 2 * MB;
constexpr size_t WS_CTR = WS_CMPB + 64 * 1024;
constexpr size_t WS_BAR = WS_CTR + 4096;
constexpr size_t WS_POSMAX = WS_BAR + 16384;
constexpr size_t WS_VAR = WS_POSMAX + 4096;
constexpr size_t WS_Z = WS_VAR;
constexpr size_t WS_VTFOX = WS_Z + 18 * MB;
constexpr size_t WS_QMLA = WS_VAR;
constexpr size_t WS_KMLA = WS_QMLA + 24 * MB;
constexpr size_t WS_VTMLA = WS_KMLA + 16 * MB;
constexpr size_t WS_VTSLC = WS_VTMLA + 16 * MB;
constexpr size_t WS_VTWIN = WS_VTSLC + 4 * MB;
constexpr size_t WS_HID = WS_VTWIN + 4 * MB;
constexpr size_t WS_KC = WS_HID + 1 * MB;
constexpr size_t WS_VCT = WS_KC + 256 * 1024;
constexpr size_t WS_NSAO = WS_VCT + 256 * 1024;
constexpr size_t WS_END = WS_NSAO + 32 * MB;
constexpr size_t WM_GLU = 0;
constexpr size_t WM_UQ = 5 * MB / 2;
constexpr size_t WM_UKV = WM_UQ + 1536 * 512 * 2;
constexpr size_t WM_W1 = WM_UKV + 2048 * 512 * 2;
constexpr size_t WM_W2 = WM_W1 + 2 * 256 * 4096 * 2;

constexpr int SM_EXTRA = 73728;
constexpr int SM_TOTAL = 73728 + 1024;

struct Params {
  const float *x, *mem;
  const int* pos;
  const float *norm_g, *mem_norm_g, *final_norm_g, *t5, *w_out, *mem_w_kv, *even_w_in, *lam_re, *lam_im, *log_dt,
      *b_re, *b_im, *c_re, *c_im, *s5_d, *w_glu, *fox_b_f, *odd_w_in, *g_cq, *g_ckv, *w_uq, *w_ukv, *cmp_pe,
      *cmp_w1, *cmp_w2;
  float* out;
  char* ws;
};

DI unsigned pack2(float a, float b) {
  f2v v = {a, b};
  bf2v r = __builtin_convertvector(v, bf2v);
  return __builtin_bit_cast(unsigned, r);
}
DI float bflo(unsigned u) { return __uint_as_float(u << 16); }
DI float bfhi(unsigned u) { return __uint_as_float(u & 0xffff0000u); }
DI float bf2f(bf16 v) { return __uint_as_float(((unsigned)v) << 16); }
DI bf16 f2bf(float f) { return (bf16)(pack2(f, 0.f) & 0xffffu); }
DI int otid() { int z; asm volatile("s_mov_b32 %0, 0" : "=s"(z)); return (int)threadIdx.x + z; }
DI int crow(int i, int h) { return (i & 3) + 8 * (i >> 2) + 4 * h; }
DI float sigm(float x) { return 1.f / (1.f + __expf(-x)); }
DI float silu(float x) { return x * sigm(x); }
DI float gelu_t(float x) {
  float u = 0.7978845608028654f * (x + 0.044715f * x * x * x);
  float e = __expf(2.f * u);
  float t = 1.f - 2.f / (e + 1.f);
  return 0.5f * x * (1.f + t);
}
DI float ex2(float x) { return __builtin_amdgcn_exp2f(x); }
DI float wave_sum(float v) {
#pragma unroll
  for (int o = 32; o > 0; o >>= 1) v += __shfl_xor(v, o);
  return v;
}
DI uint4 pack8(const float* v) {
  uint4 u;
  u.x = pack2(v[0], v[1]); u.y = pack2(v[2], v[3]); u.z = pack2(v[4], v[5]); u.w = pack2(v[6], v[7]);
  return u;
}

struct CvtSeg {
  const float* src; int lds; int sc0; bf16* dst; int dr0; int ncols; int npad; int K; const float* kscale; int ldd;
};
DI int cvt_count(const CvtSeg& s) { return (s.K >> 6) * (s.npad >> 6); }
DI void cvt_tile(const CvtSeg& s, int tile, char* smem) {
  float* T = (float*)smem;
  const int tid = otid();
  const int nkt = s.K >> 6;
  const int kt = tile % nkt, nt = tile / nkt;
  const int k0 = kt * 64, n0 = nt * 64;
  __syncthreads();
#pragma unroll
  for (int i = 0; i < 4; ++i) {
    const int k = i * 16 + (tid >> 4), n4 = (tid & 15) * 4;
    float4 v = make_float4(0.f, 0.f, 0.f, 0.f);
    if (n0 + n4 < s.ncols) {
      v = *(const float4*)(s.src + (size_t)(k0 + k) * s.lds + s.sc0 + n0 + n4);
      if (s.kscale) { float sc = s.kscale[k0 + k]; v.x *= sc; v.y *= sc; v.z *= sc; v.w *= sc; }
    }
    float* d = T + k * 65 + n4;
    d[0] = v.x; d[1] = v.y; d[2] = v.z; d[3] = v.w;
  }
  __syncthreads();
#pragma unroll
  for (int j = 0; j < 2; ++j) {
    int c = tid + 256 * j;
    int n = c >> 3, kc = (c & 7) * 8;
    float v[8];
#pragma unroll
    for (int e = 0; e < 8; ++e) v[e] = T[(kc + e) * 65 + n];
    *(uint4*)(s.dst + (size_t)(s.dr0 + n0 + n) * s.ldd + k0 + kc) = pack8(v);
  }
}

enum { SET_IN_EVEN = 0, SET_IN_ODD, SET_OUT, SET_MEM, SET_MISC_EVEN, SET_MISC_ODD };
DI int cvt_nseg(int set) {
  switch (set) {
    case SET_IN_EVEN: return 3;
    case SET_IN_ODD: return 5;
    case SET_OUT: return 1;
    case SET_MEM: return 1;
    case SET_MISC_EVEN: return 1;
    default: return 6;
  }
}
DI CvtSeg cvt_get(const Params& p, int set, int li, int s) {
  CvtSeg r;
  r.kscale = nullptr;
  char* ws = p.ws;
  if (set == SET_IN_EVEN) {
    r.src = p.even_w_in + (size_t)li * DM * EVEN_IN; r.lds = EVEN_IN; r.K = DM; r.dst = (bf16*)(ws + WS_WIN);
    if (s == 0) { r.sc0 = 0; r.dr0 = 0; r.ncols = 5120; r.npad = 5120; }
    else if (s == 1) { r.sc0 = 5128; r.dr0 = 5120; r.ncols = 2048; r.npad = 2048; }
    else { r.sc0 = 5120; r.dr0 = 7168; r.ncols = 8; r.npad = 128; }
  } else if (set == SET_IN_ODD) {
    r.src = p.odd_w_in + (size_t)li * DM * ODD_IN; r.lds = ODD_IN; r.K = DM; r.dst = (bf16*)(ws + WS_WIN);
    if (s == 0) { r.sc0 = 0; r.dr0 = 0; r.ncols = 1024; r.npad = 1024; }
    else if (s == 1) { r.sc0 = 1088; r.dr0 = 1024; r.ncols = 3584; r.npad = 3584; }
    else if (s == 2) { r.sc0 = 4696; r.dr0 = 4608; r.ncols = 2048; r.npad = 2048; }
    else if (s == 3) { r.sc0 = 1024; r.dr0 = 6656; r.ncols = 64; r.npad = 64; }
    else { r.sc0 = 4672; r.dr0 = 6720; r.ncols = 24; r.npad = 64; }
  } else if (set == SET_OUT) {
    r.src = p.w_out + (size_t)li * MIXW * DM; r.lds = DM; r.K = MIXW; r.dst = (bf16*)(ws + WS_WOUT);
    r.sc0 = 0; r.dr0 = 0; r.ncols = DM; r.npad = DM;
  } else if (set == SET_MEM) {
    r.src = p.mem_w_kv + (size_t)li * DM * 1024; r.lds = 1024; r.K = DM; r.dst = (bf16*)(ws + WS_WMEM);
    r.sc0 = 0; r.dr0 = 0; r.ncols = 1024; r.npad = 1024;
  } else if (set == SET_MISC_EVEN) {
    r.src = p.w_glu + (size_t)li * 1024 * 1024; r.lds = 1024; r.K = 1024; r.dst = (bf16*)(ws + WS_WMISC + WM_GLU);
    r.sc0 = 0; r.dr0 = 0; r.ncols = 1024; r.npad = 1024;
  } else {
    r.sc0 = 0; r.dr0 = 0;
    if (s == 0) {
      r.src = p.w_uq + (size_t)li * 512 * 1536; r.lds = 1536; r.K = 512; r.dst = (bf16*)(ws + WS_WMISC + WM_UQ);
      r.ncols = 1536; r.npad = 1536; r.kscale = p.g_cq + li * 512;
    } else if (s == 1) {
      r.src = p.w_ukv + (size_t)li * 512 * 2048; r.lds = 2048; r.K = 512; r.dst = (bf16*)(ws + WS_WMISC + WM_UKV);
      r.ncols = 2048; r.npad = 2048; r.kscale = p.g_ckv + li * 512;
    } else if (s < 4) {
      int which = s - 2;
      r.src = p.cmp_w1 + (size_t)(li * 2 + which) * 4096 * 256; r.lds = 256; r.K = 4096;
      r.dst = (bf16*)(ws + WS_WMISC + WM_W1) + (size_t)which * 256 * 4096; r.ncols = 256; r.npad = 256;
    } else {
      int which = s - 4;
      r.src = p.cmp_w2 + (size_t)(li * 2 + which) * 256 * 128; r.lds = 128; r.K = 256;
      r.dst = (bf16*)(ws + WS_WMISC + WM_W2) + (size_t)which * 128 * 256; r.ncols = 128; r.npad = 128;
    }
  }
  r.ldd = (set == SET_IN_EVEN || set == SET_IN_ODD) ? LDX : (set == SET_MISC_EVEN ? LDZ : r.K);
  return r;
}
DI int cvt_set_count(const Params& p, int set, int li) {
  int n = 0;
  for (int s = 0; s < cvt_nseg(set); ++s) n += cvt_count(cvt_get(p, set, li, s));
  return n;
}
DI void cvt_set_task(const Params& p, int set, int li, int t, char* smem) {
  const int ns = cvt_nseg(set);
  for (int s = 0; s < ns; ++s) {
    CvtSeg sg = cvt_get(p, set, li, s);
    int c = cvt_count(sg);
    if (t < c) { cvt_tile(sg, t, smem); return; }
    t -= c;
  }
}

DI void norm_row_bf16(const float* __restrict__ src, const float* __restrict__ g, bf16* __restrict__ dst, int lane) {
  float4 v[8];
  float ss = 0.f;
#pragma unroll
  for (int i = 0; i < 8; ++i) {
    v[i] = *(const float4*)(src + (i * 64 + lane) * 4);
    ss += v[i].x * v[i].x + v[i].y * v[i].y + v[i].z * v[i].z + v[i].w * v[i].w;
  }
  ss = wave_sum(ss);
  float r = rsqrtf(ss * (1.f / DM) + EPS);
#pragma unroll
  for (int i = 0; i < 8; ++i) {
    float4 gg = *(const float4*)(g + (i * 64 + lane) * 4);
    uint2 u;
    u.x = pack2(v[i].x * r * gg.x, v[i].y * r * gg.y);
    u.y = pack2(v[i].z * r * gg.z, v[i].w * r * gg.w);
    *(uint2*)(dst + (i * 64 + lane) * 4) = u;
  }
}
DI void norm_row_f32(float* __restrict__ io, const float* __restrict__ g, int lane) {
  float4 v[8];
  float ss = 0.f;
#pragma unroll
  for (int i = 0; i < 8; ++i) {
    v[i] = *(const float4*)(io + (i * 64 + lane) * 4);
    ss += v[i].x * v[i].x + v[i].y * v[i].y + v[i].z * v[i].z + v[i].w * v[i].w;
  }
  ss = wave_sum(ss);
  float r = rsqrtf(ss * (1.f / DM) + EPS);
#pragma unroll
  for (int i = 0; i < 8; ++i) {
    float4 gg = *(const float4*)(g + (i * 64 + lane) * 4);
    float4 o;
    o.x = v[i].x * r * gg.x; o.y = v[i].y * r * gg.y; o.z = v[i].z * r * gg.z; o.w = v[i].w * r * gg.w;
    *(float4*)(io + (i * 64 + lane) * 4) = o;
  }
}

struct ALin {
  const bf16* p; int ld;
  DI const bf16* operator()(int row, int k) const { return p + (size_t)row * ld + k; }
};
struct ACmp {
  const bf16* p; int m0;
  DI const bf16* operator()(int row, int k) const {
    int gr = m0 + row;
    if (gr > 1021) gr = 1021;
    int n = gr >> 1, g = gr & 1;
    return p + (size_t)(16 * n + (k >> 7)) * NPO + g * 128 + (k & 127);
  }
};

template <class AF, class Epi>
DI void gemm_tile(AF af, const bf16* __restrict__ Bt, int ldb, int K, char* smem, Epi epi) {
  const int tid = otid(), lane = tid & 63, w = tid >> 6, r = lane & 31, h = lane >> 5;
  const int wm = w >> 1, wn = w & 1;
  bf16* As = (bf16*)smem;
  bf16* Bs = As + 2 * 128 * 72;
  f32x16 acc[2][2];
#pragma unroll
  for (int a = 0; a < 2; ++a)
#pragma unroll
    for (int b = 0; b < 2; ++b)
#pragma unroll
      for (int i = 0; i < 16; ++i) acc[a][b][i] = 0.f;
  uint4 ra0_0, ra0_1, ra0_2, ra0_3, rb0_0, rb0_1, rb0_2, rb0_3, ra1_0, ra1_1, ra1_2, ra1_3, rb1_0, rb1_1, rb1_2, rb1_3;
#define LD1(S, I, K0)                                                                  \
  {                                                                                    \
    int c = tl + 256 * I;                                                              \
    int row = c >> 3, kc = (c & 7) * 8;                                                \
    ra##S##_##I = *(const uint4*)af(row, (K0) + kc);                                   \
    rb##S##_##I = *(const uint4*)(Bt + (size_t)row * ldb + (K0) + kc);                 \
  }
#define ST1(S, I, BUF)                                                                 \
  {                                                                                    \
    int c = tid + 256 * I;                                                             \
    int row = c >> 3, kc = (c & 7) * 8;                                                \
    *(uint4*)(As + (BUF) * 9216 + row * 72 + kc) = ra##S##_##I;                        \
    *(uint4*)(Bs + (BUF) * 9216 + row * 72 + kc) = rb##S##_##I;                        \
  }
#define GLOAD(S, K0) { const int tl = otid(); LD1(S, 0, K0) LD1(S, 1, K0) LD1(S, 2, K0) LD1(S, 3, K0) }
#define SSTORE(S, BUF) { ST1(S, 0, BUF) ST1(S, 1, BUF) ST1(S, 2, BUF) ST1(S, 3, BUF) }
  auto compute = [&](int buf) {
    const bf16* a_ = As + buf * 9216 + (wm * 64 + r) * 72 + h * 8;
    const bf16* b_ = Bs + buf * 9216 + (wn * 64 + r) * 72 + h * 8;
    bf16x8 fa0, fa1, fb0, fb1, ga0, ga1, gb0, gb1, ha0, ha1, hb0, hb1, ia0, ia1, ib0, ib1;
    fa0 = *(const bf16x8*)(a_ + 0);            fa1 = *(const bf16x8*)(a_ + 32 * 72);
    fb0 = *(const bf16x8*)(b_ + 0);            fb1 = *(const bf16x8*)(b_ + 32 * 72);
    ga0 = *(const bf16x8*)(a_ + 16);           ga1 = *(const bf16x8*)(a_ + 32 * 72 + 16);
    gb0 = *(const bf16x8*)(b_ + 16);           gb1 = *(const bf16x8*)(b_ + 32 * 72 + 16);
    ha0 = *(const bf16x8*)(a_ + 32);           ha1 = *(const bf16x8*)(a_ + 32 * 72 + 32);
    hb0 = *(const bf16x8*)(b_ + 32);           hb1 = *(const bf16x8*)(b_ + 32 * 72 + 32);
    ia0 = *(const bf16x8*)(a_ + 48);           ia1 = *(const bf16x8*)(a_ + 32 * 72 + 48);
    ib0 = *(const bf16x8*)(b_ + 48);           ib1 = *(const bf16x8*)(b_ + 32 * 72 + 48);
    __builtin_amdgcn_sched_barrier(0);
    acc[0][0] = MFMA32(fa0, fb0, acc[0][0]); acc[0][1] = MFMA32(fa0, fb1, acc[0][1]);
    acc[1][0] = MFMA32(fa1, fb0, acc[1][0]); acc[1][1] = MFMA32(fa1, fb1, acc[1][1]);
    acc[0][0] = MFMA32(ga0, gb0, acc[0][0]); acc[0][1] = MFMA32(ga0, gb1, acc[0][1]);
    acc[1][0] = MFMA32(ga1, gb0, acc[1][0]); acc[1][1] = MFMA32(ga1, gb1, acc[1][1]);
    acc[0][0] = MFMA32(ha0, hb0, acc[0][0]); acc[0][1] = MFMA32(ha0, hb1, acc[0][1]);
    acc[1][0] = MFMA32(ha1, hb0, acc[1][0]); acc[1][1] = MFMA32(ha1, hb1, acc[1][1]);
    acc[0][0] = MFMA32(ia0, ib0, acc[0][0]); acc[0][1] = MFMA32(ia0, ib1, acc[0][1]);
    acc[1][0] = MFMA32(ia1, ib0, acc[1][0]); acc[1][1] = MFMA32(ia1, ib1, acc[1][1]);
    __builtin_amdgcn_sched_barrier(0);
  };
  __syncthreads();
  const int nk = K >> 6;
  GLOAD(0, 0);
  SSTORE(0, 0);
  GLOAD(0, 64);
  __syncthreads();
  for (int kt = 0; kt < nk; kt += 2) {
    if (kt + 2 < nk) GLOAD(1, (kt + 2) * 64);
    compute(0);
    SSTORE(0, 1);
    __syncthreads();
    if (kt + 3 < nk) GLOAD(0, (kt + 3) * 64);
    compute(1);
    if (kt + 2 < nk) SSTORE(1, 0);
    __syncthreads();
  }
#undef GLOAD
#undef SSTORE
#undef LD1
#undef ST1
  float* Cs = (float*)smem;
#pragma unroll
  for (int mb = 0; mb < 2; ++mb)
#pragma unroll
    for (int nb = 0; nb < 2; ++nb)
#pragma unroll
      for (int i = 0; i < 16; ++i)
        Cs[(wm * 64 + mb * 32 + crow(i, h)) * 132 + wn * 64 + nb * 32 + r] = acc[mb][nb][i];
  __syncthreads();
  epi(Cs);
}


template <class AF, class Epi>
DI void gemm_tile2(AF af, const bf16* __restrict__ Bt, int ldb, int K, char* smem, int& n0ref, int nhalf, Epi epi) {
  const int tid = otid(), lane = tid & 63, w = tid >> 6, r = lane & 31, h = lane >> 5;
  const int wm = w >> 1, wn = w & 1;
  bf16* As = (bf16*)smem;
  bf16* Bs = As + 128 * 72;
  f32x16 acc[2][4];
#pragma unroll
  for (int a = 0; a < 2; ++a)
#pragma unroll
    for (int b = 0; b < 4; ++b)
#pragma unroll
      for (int i = 0; i < 16; ++i) acc[a][b][i] = 0.f;
  uint4 pa_0, pa_1, pa_2, pa_3, pb_0, pb_1, pb_2, pb_3, pb_4, pb_5, pb_6, pb_7;
#define LDA2(I, K0) { int c = tl + 256 * I; int row = c >> 3, kc = (c & 7) * 8; pa_##I = *(const uint4*)af(row, (K0) + kc); }
#define LDB2(I, K0) { int c = tl + 256 * I; int row = c >> 3, kc = (c & 7) * 8; pb_##I = *(const uint4*)(Bt + (size_t)row * ldb + (K0) + kc); }
#define STA2(I) { int c = tid + 256 * I; int row = c >> 3, kc = (c & 7) * 8; *(uint4*)(As + row * 72 + kc) = pa_##I; }
#define STB2(I) { int c = tid + 256 * I; int row = c >> 3, kc = (c & 7) * 8; *(uint4*)(Bs + row * 72 + kc) = pb_##I; }
#define GLOAD2(K0) { const int tl = otid(); LDA2(0, K0) LDA2(1, K0) LDA2(2, K0) LDA2(3, K0) LDB2(0, K0) LDB2(1, K0) LDB2(2, K0) LDB2(3, K0) LDB2(4, K0) LDB2(5, K0) LDB2(6, K0) LDB2(7, K0) }
#define SSTORE2() { STA2(0) STA2(1) STA2(2) STA2(3) STB2(0) STB2(1) STB2(2) STB2(3) STB2(4) STB2(5) STB2(6) STB2(7) }
  const int nk = K >> 6;
  GLOAD2(0);
  const bf16* a_ = As + (wm * 64 + r) * 72 + h * 8;
  const bf16* b_ = Bs + (wn * 128 + r) * 72 + h * 8;
  for (int kt = 0; kt < nk; ++kt) {
    __syncthreads();
    SSTORE2();
    __syncthreads();
    if (kt + 1 < nk) GLOAD2((kt + 1) * 64);
#pragma unroll
    for (int ks = 0; ks < 4; ++ks) {
      bf16x8 fa[2], fb[4];
#pragma unroll
      for (int mb = 0; mb < 2; ++mb) fa[mb] = *(const bf16x8*)(a_ + mb * 32 * 72 + ks * 16);
#pragma unroll
      for (int nb = 0; nb < 4; ++nb) fb[nb] = *(const bf16x8*)(b_ + nb * 32 * 72 + ks * 16);
#pragma unroll
      for (int mb = 0; mb < 2; ++mb)
#pragma unroll
        for (int nb = 0; nb < 4; ++nb) acc[mb][nb] = MFMA32(fa[mb], fb[nb], acc[mb][nb]);
    }
  }
#undef LDA2
#undef LDB2
#undef STA2
#undef STB2
#undef GLOAD2
#undef SSTORE2
  float* Cs = (float*)smem;
#pragma unroll
  for (int hf = 0; hf < 2; ++hf) {
    if (hf < nhalf) {
      __syncthreads();
      if (wn == hf) {
#pragma unroll
        for (int mb = 0; mb < 2; ++mb)
#pragma unroll
          for (int nb = 0; nb < 4; ++nb)
#pragma unroll
            for (int i = 0; i < 16; ++i) Cs[(wm * 64 + mb * 32 + crow(i, h)) * 132 + nb * 32 + r] = acc[mb][nb][i];
      }
      __syncthreads();
      epi(Cs);
      n0ref += 128;
    }
  }
}

DI void tile_map(int t, int ntn, int& tm, int& tn) {
  const int per = 8 * ntn;
  const int grp = t / per, rem = t - grp * per;
  tm = grp * 8 + (rem & 7);
  tn = rem >> 3;
}
template <class F>
DI void epi_rows(const float* Cs, F f) {
  const int tid = otid();
#pragma unroll
  for (int j = 0; j < 8; ++j) {
    int c = tid + 256 * j;
    int row = c >> 4, cc = (c & 15) * 8;
    float v[8];
    float4 a = *(const float4*)(Cs + row * 132 + cc);
    float4 b = *(const float4*)(Cs + row * 132 + cc + 4);
    v[0] = a.x; v[1] = a.y; v[2] = a.z; v[3] = a.w; v[4] = b.x; v[5] = b.y; v[6] = b.z; v[7] = b.w;
    f(row, cc, v);
  }
}
template <class F>
DI void epi_cols(const float* Cs, F f) {
  const int tid = otid();
#pragma unroll
  for (int j = 0; j < 8; ++j) {
    int c = tid + 256 * j;
    int col = c & 127, r8 = (c >> 7) * 8;
    float v[8];
#pragma unroll
    for (int e = 0; e < 8; ++e) v[e] = Cs[(r8 + e) * 132 + col];
    f(col, r8, v);
  }
}
template <class F>
DI void epi_rope(const float* Cs, int cb, int m0, const float* rc, const float* rs, float scale_unused, F f) {
  const int tid = otid();
#pragma unroll
  for (int j = 0; j < 2; ++j) {
    int c = tid + 256 * j;
    int row = c >> 2, cc = (c & 3) * 8;
    float x1[8], x2[8], o1[8], o2[8];
#pragma unroll
    for (int e = 0; e < 8; ++e) {
      x1[e] = Cs[row * 132 + cb + cc + e];
      x2[e] = Cs[row * 132 + cb + 32 + cc + e];
    }
    const float* pc = rc + (size_t)(m0 + row) * 32 + cc;
    const float* ps = rs + (size_t)(m0 + row) * 32 + cc;
#pragma unroll
    for (int e = 0; e < 8; ++e) {
      float cs = pc[e], sn = ps[e];
      o1[e] = x1[e] * cs - x2[e] * sn;
      o2[e] = x1[e] * sn + x2[e] * cs;
    }
    f(row, cc, o1);
    f(row, cc + 32, o2);
  }
}

template <int DK>
struct KVPre {
  uint4 k[DK / 32];
  uint4 v[4];
  float aux;
};
constexpr int AT_VS = 25600;
constexpr int AT_AUX = 43008;
constexpr int AT_X0 = 43264;
constexpr int AT_IMP = AT_X0 + 12800;
constexpr int AT_SEL = AT_IMP + 16896;

template <int DK, bool PV, class SF, class PH>
DI void attn_tile(const bf16x8 (&qf)[DK / 16], f32x16 (&o)[4], float& m, float& l, const char* smem, SF sf, PH ph) {
  const int lane = otid() & 63, r = lane & 31, h = lane >> 5;
  const bf16* Ks = (const bf16*)smem;
  const bf16* Vs = (const bf16*)(smem + AT_VS);
  const float* auxs = (const float*)(smem + AT_AUX);
  f32x16 s[2];
#pragma unroll
  for (int kb = 0; kb < 2; ++kb) {
#pragma unroll
    for (int i = 0; i < 16; ++i) s[kb][i] = 0.f;
#pragma unroll
    for (int ks = 0; ks < DK / 16; ++ks) {
      bf16x8 a = *(const bf16x8*)(Ks + (kb * 32 + r) * (DK + 8) + ks * 16 + h * 8);
      s[kb] = MFMA32(a, qf[ks], s[kb]);
    }
  }
  float mx = m;
#pragma unroll
  for (int kb = 0; kb < 2; ++kb)
#pragma unroll
    for (int i = 0; i < 16; ++i) {
      int kl = kb * 32 + crow(i, h);
      float v = sf(s[kb][i], kl, auxs[kl]);
      s[kb][i] = v;
      mx = fmaxf(mx, v);
    }
  mx = fmaxf(mx, __shfl_xor(mx, 32));
  float alpha = ex2(m - mx);
  m = mx;
  float psum = 0.f;
#pragma unroll
  for (int kb = 0; kb < 2; ++kb)
#pragma unroll
    for (int i = 0; i < 16; ++i) {
      float pv = ex2(s[kb][i] - mx);
      s[kb][i] = pv;
      psum += pv;
    }
  l = l * alpha + psum;
  ph(0, s[0]);
  ph(1, s[1]);
  if (PV) {
    if (__builtin_amdgcn_ballot_w64(alpha != 1.f) != 0ull) {
#pragma unroll
      for (int d = 0; d < 4; ++d)
#pragma unroll
        for (int i = 0; i < 16; ++i) o[d][i] *= alpha;
    }
#pragma unroll
    for (int st = 0; st < 4; ++st) {
      const int kb = st >> 1, s2 = st & 1;
      uint4 pu;
      pu.x = pack2(s[kb][8 * s2 + 0], s[kb][8 * s2 + 1]);
      pu.y = pack2(s[kb][8 * s2 + 2], s[kb][8 * s2 + 3]);
      pu.z = pack2(s[kb][8 * s2 + 4], s[kb][8 * s2 + 5]);
      pu.w = pack2(s[kb][8 * s2 + 6], s[kb][8 * s2 + 7]);
      bf16x8 pf = __builtin_bit_cast(bf16x8, pu);
#pragma unroll
      for (int d = 0; d < 4; ++d) {
        const bf16* vp = Vs + (d * 32 + r) * 68 + st * 16 + 4 * h;
        uint2 lo = *(const uint2*)vp;
        uint2 hi = *(const uint2*)(vp + 8);
        uint4 vu = make_uint4(lo.x, lo.y, hi.x, hi.y);
        bf16x8 vf = __builtin_bit_cast(bf16x8, vu);
        o[d] = MFMA32(vf, pf, o[d]);
      }
    }
  }
}

template <int DK, int FM>
DI void attn_tile_c(const bf16x8 (&qf)[DK / 16], f32x16 (&o)[4], float& m, float& l, const char* smem, float sc, float c) {
  const int lane = otid() & 63, r = lane & 31, h = lane >> 5;
  const bf16* Ks = (const bf16*)smem;
  const bf16* Vs = (const bf16*)(smem + AT_VS);
  const float* auxs = (const float*)(smem + AT_AUX);
  f32x16 s0, s1;
#pragma unroll
  for (int i = 0; i < 16; ++i) { s0[i] = 0.f; s1[i] = 0.f; }
#pragma unroll
  for (int ks = 0; ks < DK / 16; ++ks) {
    bf16x8 a = *(const bf16x8*)(Ks + r * (DK + 8) + ks * 16 + h * 8);
    s0 = MFMA32(a, qf[ks], s0);
  }
#pragma unroll
  for (int ks = 0; ks < DK / 16; ++ks) {
    bf16x8 a = *(const bf16x8*)(Ks + (32 + r) * (DK + 8) + ks * 16 + h * 8);
    s1 = MFMA32(a, qf[ks], s1);
  }
  float mx;
  if (FM == 2) {
    mx = m;
#pragma unroll
    for (int i = 0; i < 16; ++i) {
      float v = __builtin_fmaf(s0[i], sc, -auxs[crow(i, h)]);
      s0[i] = v;
      mx = fmaxf(mx, v);
    }
  } else {
    float rm = s0[0];
#pragma unroll
    for (int i = 1; i < 16; ++i) rm = fmaxf(rm, s0[i]);
    mx = fmaxf(m, __builtin_fmaf(rm, sc, c));
  }
  mx = fmaxf(mx, __shfl_xor(mx, 32));
  const float alpha = ex2(m - mx);
  m = mx;
  const float off = c - mx;
#pragma unroll
  for (int d = 0; d < 4; ++d)
#pragma unroll
    for (int i = 0; i < 16; ++i) o[d][i] *= alpha;
  l *= alpha;
  float psum = 0.f;
#pragma unroll
  for (int i = 0; i < 16; ++i) {
    float pv = (FM == 2) ? ex2(s0[i] - mx) : ex2(__builtin_fmaf(s0[i], sc, off));
    s0[i] = pv;
    psum += pv;
  }
#pragma unroll
  for (int s2 = 0; s2 < 2; ++s2) {
    uint4 pu;
    pu.x = pack2(s0[8 * s2 + 0], s0[8 * s2 + 1]);
    pu.y = pack2(s0[8 * s2 + 2], s0[8 * s2 + 3]);
    pu.z = pack2(s0[8 * s2 + 4], s0[8 * s2 + 5]);
    pu.w = pack2(s0[8 * s2 + 6], s0[8 * s2 + 7]);
    bf16x8 pf = __builtin_bit_cast(bf16x8, pu);
#pragma unroll
    for (int d = 0; d < 4; ++d) {
      const bf16* vp = Vs + (d * 32 + r) * 68 + s2 * 16 + 4 * h;
      uint2 lo = *(const uint2*)vp;
      uint2 hi = *(const uint2*)(vp + 8);
      uint4 vu = make_uint4(lo.x, lo.y, hi.x, hi.y);
      o[d] = MFMA32(__builtin_bit_cast(bf16x8, vu), pf, o[d]);
    }
  }
#pragma unroll
  for (int i = 0; i < 16; ++i) {
    float pv;
    if (FM == 2) pv = ex2(__builtin_fmaf(s1[i], sc, -auxs[32 + crow(i, h)]) - mx);
    else pv = ex2(__builtin_fmaf(s1[i], sc, off));
    s1[i] = pv;
    psum += pv;
  }
  l += psum;
#pragma unroll
  for (int s2 = 0; s2 < 2; ++s2) {
    uint4 pu;
    pu.x = pack2(s1[8 * s2 + 0], s1[8 * s2 + 1]);
    pu.y = pack2(s1[8 * s2 + 2], s1[8 * s2 + 3]);
    pu.z = pack2(s1[8 * s2 + 4], s1[8 * s2 + 5]);
    pu.w = pack2(s1[8 * s2 + 6], s1[8 * s2 + 7]);
    bf16x8 pf = __builtin_bit_cast(bf16x8, pu);
#pragma unroll
    for (int d = 0; d < 4; ++d) {
      const bf16* vp = Vs + (d * 32 + r) * 68 + (2 + s2) * 16 + 4 * h;
      uint2 lo = *(const uint2*)vp;
      uint2 hi = *(const uint2*)(vp + 8);
      uint4 vu = make_uint4(lo.x, lo.y, hi.x, hi.y);
      o[d] = MFMA32(__builtin_bit_cast(bf16x8, vu), pf, o[d]);
    }
  }
}

struct NoHook { DI void operator()(int, const f32x16&) const {} };

template <int DK, bool PV, bool PF, class Ctx>
DI void attn_run(const bf16x8 (&qf)[DK / 16], f32x16 (&o)[4], float& m, float& l, const bf16* K1, int ldk1,
                 const bf16* K2, int ldk2, const bf16* Vt, int ldv, int first, Ctx& ctx, char* smem) {
  const int tid = otid();
  int tcur = first;
  if (tcur < 0) return;
  constexpr int CPR = DK / 8;
  constexpr int NKC = DK / 32;
  uint4 rk0, rk1, rk2, rk3, rk4 = make_uint4(0, 0, 0, 0), rk5 = make_uint4(0, 0, 0, 0), rv[4];
  float raux;
  bf16* Ks = (bf16*)smem;
  bf16* Vs = (bf16*)(smem + AT_VS);
  auto ldk = [&](int i, int key0) -> uint4 {
    int c = otid() + 256 * i;
    int row = c / CPR, cc = c % CPR;
    const bf16* src;
    if (DK == 128 || cc < 16) src = K1 + (size_t)(key0 + row) * ldk1 + cc * 8;
    else src = K2 + (size_t)(key0 + row) * ldk2 + (cc - 16) * 8;
    return *(const uint4*)src;
  };
  auto stk = [&](int i, const uint4& v) {
    int c = tid + 256 * i;
    int row = c / CPR, cc = c % CPR;
    *(uint4*)(Ks + row * (DK + 8) + cc * 8) = v;
  };
  auto gload = [&](int key0) {
    rk0 = ldk(0, key0); rk1 = ldk(1, key0); rk2 = ldk(2, key0); rk3 = ldk(3, key0);
    if (NKC > 4) { rk4 = ldk(4, key0); rk5 = ldk(5, key0); }
    const int tl = otid();
#pragma unroll
    for (int i = 0; i < 4; ++i) {
      int c = tl + 256 * i;
      int d = c >> 3, cc = c & 7;
      rv[i] = *(const uint4*)(Vt + (size_t)d * ldv + key0 + cc * 8);
    }
    raux = (tid < 64) ? ctx.aux(key0 + tid) : 0.f;
  };
  auto sstore = [&]() {
    stk(0, rk0); stk(1, rk1); stk(2, rk2); stk(3, rk3);
    if (NKC > 4) { stk(4, rk4); stk(5, rk5); }
#pragma unroll
    for (int i = 0; i < 4; ++i) {
      int c = tid + 256 * i;
      int d = c >> 3, cc = c & 7;
      uint2* dst = (uint2*)(Vs + d * 68 + cc * 8);
      dst[0] = make_uint2(rv[i].x, rv[i].y);
      dst[1] = make_uint2(rv[i].z, rv[i].w);
    }
    if (tid < 64) ((float*)(smem + AT_AUX))[tid] = raux;
  };
  if (PF) gload(tcur * 64);
  while (tcur >= 0) {
    __syncthreads();
    if (!PF) gload(tcur * 64);
    sstore();
    __syncthreads();
    int tnext = ctx.next(tcur);
    if (PF && tnext >= 0) gload(tnext * 64);
    if (!ctx.skip(tcur)) {
      const int tc = tcur;
      if (Ctx::FMODE != 0 && (Ctx::ALWAYS_FAST || ctx.fast(tc))) {
        attn_tile_c<DK, (Ctx::FMODE == 2 ? 2 : 1)>(qf, o, m, l, smem, ctx.sc, ctx.fconst(tc));
      } else if (!Ctx::ALWAYS_FAST) {
        attn_tile<DK, PV>(qf, o, m, l, smem,
                          [&](float s, int kl, float ax) { return ctx.score(s, tc * 64 + kl, ax, tc); },
                          [&](int kb, const f32x16& pt) { ctx.hook(kb, pt, tc); });
      }
    }
    tcur = tnext;
  }
}

template <int DK>
DI void load_q(bf16x8 (&qf)[DK / 16], const bf16* qrow, int h) {
#pragma unroll
  for (int ks = 0; ks < DK / 16; ++ks) qf[ks] = *(const bf16x8*)(qrow + ks * 16 + h * 8);
}
DI void zero_o(f32x16 (&o)[4]) {
#pragma unroll
  for (int d = 0; d < 4; ++d)
#pragma unroll
    for (int i = 0; i < 16; ++i) o[d][i] = 0.f;
}

struct CtxCausal {
  int tq, q0w, last; float sc;
  DI int next(int t) const { return t + 1 <= last ? t + 1 : -1; }
  DI float aux(int) const { return 0.f; }
  DI bool skip(int t) const { return t * 64 > q0w + 31; }
  DI float score(float s, int key, float, int) const { return key <= tq ? s * sc : NEG; }
  static constexpr int FMODE = 1;
  static constexpr bool ALWAYS_FAST = false;
  DI bool fast(int t) const { return t * 64 + 63 <= q0w; }
  DI float fconst(int) const { return 0.f; }
  DI void hook(int, const f32x16&, int) const {}
};
struct CtxFox {
  int tq, q0w, last; float sc; const float* cuml; const float* cpre;
  DI int next(int t) const { return t + 1 <= last ? t + 1 : -1; }
  DI float aux(int key) const { return (cuml[key] + cpre[key >> 7]) * LOG2E; }
  DI bool skip(int t) const { return t * 64 > q0w + 31; }
  DI float score(float s, int key, float ax, int) const { return key <= tq ? s * sc - ax : NEG; }
  static constexpr int FMODE = 2;
  static constexpr bool ALWAYS_FAST = false;
  DI bool fast(int t) const { return t * 64 + 63 <= q0w; }
  DI float fconst(int) const { return 0.f; }
  DI void hook(int, const f32x16&, int) const {}
};
struct CtxMem {
  float sc;
  DI int next(int t) const { return t + 1 < 4 ? t + 1 : -1; }
  DI float aux(int) const { return 0.f; }
  DI bool skip(int) const { return false; }
  DI float score(float s, int, float, int) const { return s * sc; }
  static constexpr int FMODE = 1;
  static constexpr bool ALWAYS_FAST = true;
  DI bool fast(int) const { return true; }
  DI float fconst(int) const { return 0.f; }
  DI void hook(int, const f32x16&, int) const {}
};

DI void store_out_A(const f32x16 (&o)[4], float inv_l, const bf16* grow, bf16* orow, int h) {
#pragma unroll
  for (int d = 0; d < 4; ++d)
#pragma unroll
    for (int i4 = 0; i4 < 4; ++i4) {
      int dv0 = d * 32 + 8 * i4 + 4 * h;
      uint2 gu = *(const uint2*)(grow + dv0);
      float g0 = bflo(gu.x), g1 = bfhi(gu.x), g2 = bflo(gu.y), g3 = bfhi(gu.y);
      uint2 ou;
      ou.x = pack2(o[d][4 * i4 + 0] * inv_l * silu(g0), o[d][4 * i4 + 1] * inv_l * silu(g1));
      ou.y = pack2(o[d][4 * i4 + 2] * inv_l * silu(g2), o[d][4 * i4 + 3] * inv_l * silu(g3));
      *(uint2*)(orow + dv0) = ou;
    }
}

        struct CtxCmp {
          int tq, posq, last; float sc; const float* lutr; const int* pos; float invl; float* imp; int ql; bool p2;
          DI int next(int t) const { return t + 1 <= last ? t + 1 : -1; }
          DI float aux(int key) const { int n = key < 511 ? key : 510; return __int_as_float(pos[16 * n + 31]); }
          DI bool skip(int) const { return false; }
          DI float score(float s, int key, float ax, int) const {
            bool valid = (16 * key + 31 <= tq) && key < 511;
            int d = posq - __float_as_int(ax);
            d = d < 0 ? 0 : (d > 799 ? 799 : d);
            return valid ? s * sc + lutr[d] : NEG;
          }
          static constexpr int FMODE = 0;
          static constexpr bool ALWAYS_FAST = false;
          DI bool fast(int) const { return false; }
          DI float fconst(int) const { return 0.f; }
          DI void hook(int kb, const f32x16& pt, int tc) const {
            if (!p2) return;
            const int lane = otid() & 63, h = lane >> 5, r = lane & 31;
#pragma unroll
            for (int gq = 0; gq < 4; ++gq) {
              float p3 = 0.5f * pt[4 * gq + 3];
              float vm = (pt[4 * gq] + pt[4 * gq + 1] + pt[4 * gq + 2] + p3) * invl;
              float vs = p3 * invl;
              vm += __shfl_xor(vm, 8); vm += __shfl_xor(vm, 16);
              vs += __shfl_xor(vs, 8); vs += __shfl_xor(vs, 16);
              int j = tc * 16 + kb * 8 + 2 * gq + h;
              if (r < 8) { atomicAdd(&imp[ql * 132 + j], vm); atomicAdd(&imp[ql * 132 + j + 1], vs); }
            }
          }
        };
struct CtxSlc {
  int tq, posq; float sc; const float* lutr; const int* pos; unsigned long long ulo, uhi, mlo, mhi;
  const int* posmax; int pqmin, q0;
  DI bool farj(int j) const { return (j * 64 + 63 < q0) && (pqmin - posmax[j] >= 799); }
  DI bool inu(int j) const {
    unsigned long long a = (ulo >> (j & 63)) & (j < 64 ? 1ull : 0ull);
    unsigned long long b = (uhi >> (j & 63)) & (j >= 64 ? 1ull : 0ull);
    return (a | b) != 0ull;
  }
  DI bool mine(int j) const {
    unsigned long long a = (mlo >> (j & 63)) & (j < 64 ? 1ull : 0ull);
    unsigned long long b = (mhi >> (j & 63)) & (j >= 64 ? 1ull : 0ull);
    return (a | b) != 0ull;
  }
  DI int next(int t) const { for (int j = t + 1; j < 128; ++j) if (inu(j) && !farj(j)) return j; return -1; }
  DI float aux(int key) const { return __int_as_float(pos[key]); }
  DI bool skip(int t) const { return __builtin_amdgcn_ballot_w64(mine(t)) == 0ull; }
  DI float score(float s, int key, float ax, int t) const {
    bool valid = mine(t) && key <= tq;
    int d = posq - __float_as_int(ax);
    d = d < 0 ? 0 : (d > 799 ? 799 : d);
    return valid ? s * sc + lutr[d] : NEG;
  }
  static constexpr int FMODE = 0;
  static constexpr bool ALWAYS_FAST = false;
  DI bool fast(int) const { return false; }
  DI float fconst(int) const { return 0.f; }
  DI void hook(int, const f32x16&, int) const {}
};
struct CtxSlcFar {
  float sc, bfar; unsigned long long ulo, uhi, mlo, mhi; const int* posmax; int pqmin, q0;
  DI bool farj(int j) const { return (j * 64 + 63 < q0) && (pqmin - posmax[j] >= 799); }
  DI bool inu(int j) const {
    unsigned long long a = (ulo >> (j & 63)) & (j < 64 ? 1ull : 0ull);
    unsigned long long b = (uhi >> (j & 63)) & (j >= 64 ? 1ull : 0ull);
    return (a | b) != 0ull;
  }
  DI bool mine(int j) const {
    unsigned long long a = (mlo >> (j & 63)) & (j < 64 ? 1ull : 0ull);
    unsigned long long b = (mhi >> (j & 63)) & (j >= 64 ? 1ull : 0ull);
    return (a | b) != 0ull;
  }
  DI int next(int t) const { for (int j = t + 1; j < 128; ++j) if (inu(j) && farj(j)) return j; return -1; }
  DI float aux(int) const { return 0.f; }
  DI bool skip(int t) const { return __builtin_amdgcn_ballot_w64(mine(t)) == 0ull; }
  DI float score(float s, int, float, int t) const { return mine(t) ? s * sc + bfar : NEG; }
  static constexpr int FMODE = 1;
  static constexpr bool ALWAYS_FAST = true;
  DI bool fast(int) const { return true; }
  DI float fconst(int t) const { return mine(t) ? bfar : NEG; }
  DI void hook(int, const f32x16&, int) const {}
};
struct CtxWin {
  int tq, posq, last; float sc; const float* lutr; const int* pos;
  DI int next(int t) const { return t + 1 <= last ? t + 1 : -1; }
  DI float aux(int key) const { return __int_as_float(pos[key]); }
  DI bool skip(int) const { return false; }
  DI float score(float s, int key, float ax, int) const {
    bool valid = key <= tq && (tq - key) < 512;
    int d = posq - __float_as_int(ax);
    d = d < 0 ? 0 : (d > 799 ? 799 : d);
    return valid ? s * sc + lutr[d] : NEG;
  }
  static constexpr int FMODE = 0;
  static constexpr bool ALWAYS_FAST = false;
  DI bool fast(int) const { return false; }
  DI float fconst(int) const { return 0.f; }
  DI void hook(int, const f32x16&, int) const {}
};

DI int cvt_next_count(const Params& p, int nl) {
      const bool ne = (nl & 1) == 0;
      const int nli = nl >> 1;
      return cvt_set_count(p, ne ? SET_IN_EVEN : SET_IN_ODD, nli) + cvt_set_count(p, SET_MEM, nl) +
             cvt_set_count(p, ne ? SET_MISC_EVEN : SET_MISC_ODD, nli) + (ne ? 16 : 32);
}
DI void cvt_next(const Params& p, char* smem, int nl, int t) {
  char* ws = p.ws;
      const bool ne = (nl & 1) == 0;
      const int nli = nl >> 1;
      const int s0 = ne ? SET_IN_EVEN : SET_IN_ODD, s2 = ne ? SET_MISC_EVEN : SET_MISC_ODD;
      const int c0 = cvt_set_count(p, s0, nli), c1 = cvt_set_count(p, SET_MEM, nl), c2 = cvt_set_count(p, s2, nli);
      if (t < c0) cvt_set_task(p, s0, nli, t, smem);
      else if (t < c0 + c1) cvt_set_task(p, SET_MEM, nl, t - c0, smem);
      else if (t < c0 + c1 + c2) cvt_set_task(p, s2, nli, t - c0 - c1, smem);
      else {
            const int tid = otid();
            int e = t - c0 - c1 - c2;
            if (ne) {
              float* S5P = (float*)(ws + WS_S5P);
              int gp = e * 256 + tid;
              int g = gp >> 6;
              float dt = expf(p.log_dt[nli * 64 + g]);
              float lr = p.lam_re[nli * 4096 + gp], lim = p.lam_im[nli * 4096 + gp];
              float mag = expf(lr * dt);
              float abr = mag * cosf(lim * dt), abi = mag * sinf(lim * dt);
              float den = lr * lr + lim * lim;
              float nr = abr - 1.f;
              float fre = (nr * lr + abi * lim) / den;
              float fim = (abi * lr - nr * lim) / den;
              S5P[gp] = abr;
              S5P[4096 + gp] = abi;
              float ar = abr, ai = abi;
#pragma unroll
              for (int q = 0; q < 7; ++q) { float nr2 = ar * ar - ai * ai; ai = 2.f * ar * ai; ar = nr2; }
              S5P[8192 + gp] = ar;
              S5P[12288 + gp] = ai;
              const float* br = p.b_re + (size_t)nli * 65536 + gp * 16;
              const float* bi = p.b_im + (size_t)nli * 65536 + gp * 16;
#pragma unroll
              for (int c = 0; c < 16; ++c) {
                S5P[16384 + gp * 16 + c] = fre * br[c] - fim * bi[c];
                S5P[16384 + 65536 + gp * 16 + c] = fre * bi[c] + fim * br[c];
              }
            } else {
              int which = e >> 4, part = e & 15;
              const float* pe = p.cmp_pe + (size_t)(nli * 2 + which) * 4096 + part * 256;
              const float* w1 = p.cmp_w1 + ((size_t)(nli * 2 + which) * 4096 + part * 256) * 256 + tid;
              float acc = 0.f;
#pragma unroll 8
              for (int k = 0; k < 256; ++k) acc += pe[k] * w1[(size_t)k * 256];
              ((float*)(ws + WS_CMPB))[(which * 16 + part) * 256 + tid] = acc;
            }
      }
}

#define XB_TMO      128
#define XB_XCNT(j)  (256  + 64 * (j))
#define XB_XSUB(j)  (1280 + 64 * (j))
#define XB_XGEN(j)  (2304 + 64 * (j))
#define XB_TOP      3328
#define XB_TOPGEN   3392
#define XCD_BAR_WORDS 3456
#define XB_SPIN_CAP (1u << 18)
#define LAS __attribute__((address_space(3)))

__device__ __forceinline__ unsigned xb_ld(unsigned* p)              { return __hip_atomic_load(p, __ATOMIC_RELAXED, __HIP_MEMORY_SCOPE_AGENT); }
__device__ __forceinline__ unsigned xb_add(unsigned* p, unsigned v) { return __hip_atomic_fetch_add(p, v, __ATOMIC_RELAXED, __HIP_MEMORY_SCOPE_AGENT); }
__device__ __forceinline__ unsigned xb_xcc_id() { return (unsigned)__builtin_amdgcn_s_getreg((3 << 11) | 20) & 0xFu; }
#define XB_SPIN(cond, bar) do { unsigned _sp = 0; while (cond) { __builtin_amdgcn_s_sleep(1); \
    if ((++_sp & 255u) == 0u) { if (xb_ld(&(bar)[XB_TMO])) break; if (_sp > XB_SPIN_CAP) { atomicAdd(&(bar)[XB_TMO], 1u); break; } } } } while (0)

struct XcdBarrier {
    unsigned* bar; unsigned x;
    volatile LAS unsigned* st;
};

__device__ __forceinline__ XcdBarrier xcd_barrier_post(unsigned* bar, volatile LAS unsigned* st) {
    XcdBarrier b; b.bar = bar; b.x = xb_xcc_id(); b.st = st;
    if (threadIdx.x == 0) (void)xb_add(&bar[XB_XCNT(b.x)], 1u);
    return b;
}
__device__ __forceinline__ void xcd_barrier_complete(unsigned* bar, unsigned x, unsigned& nloc, unsigned& nx) {
    const unsigned G = gridDim.x * gridDim.y * gridDim.z;
    unsigned sum, cnt, mine, sp = 0u;
    for (;;) {
        sum = 0u; cnt = 0u; mine = 0u;
#pragma unroll
        for (unsigned j = 0; j < 16; ++j) { const unsigned c = xb_ld(&bar[XB_XCNT(j)]); sum += c; cnt += (c > 0u) ? 1u : 0u; mine = (j == x) ? c : mine; }
        if (sum == G) break;
        __builtin_amdgcn_s_sleep(1);
        if ((++sp & 255u) == 0u) { if (xb_ld(&bar[XB_TMO])) break; if (sp > XB_SPIN_CAP) { atomicAdd(&bar[XB_TMO], 1u); break; } }
    }
    nloc = mine > 0u ? mine : 1u; nx = cnt > 0u ? cnt : 1u;
}

__device__ __forceinline__ void xcd_barrier(const XcdBarrier& b) {
    asm volatile("s_waitcnt vmcnt(0)" ::: "memory");
    __syncthreads();
    if (threadIdx.x == 0) {
        unsigned* bar = b.bar;
        __builtin_amdgcn_s_waitcnt(0);
        unsigned nloc = b.st[0], nx = b.st[1];
        if (nloc == 0u) { xcd_barrier_complete(bar, b.x, nloc, nx); b.st[0] = nloc; b.st[1] = nx; }
        const unsigned old = xb_add(&bar[XB_XSUB(b.x)], 1u);
        const unsigned gen = old / nloc;
        if (old + 1u == (gen + 1u) * nloc) {
            __builtin_amdgcn_fence(__ATOMIC_RELEASE, "agent");
            asm volatile("s_waitcnt vmcnt(0)" ::: "memory");
            const unsigned og = xb_add(&bar[XB_TOP], 1u);
            const unsigned tg = og / nx;
            if (og + 1u == (tg + 1u) * nx) xb_add(&bar[XB_TOPGEN], 1u);
            else XB_SPIN(xb_ld(&bar[XB_TOPGEN]) == tg, bar);
            __builtin_amdgcn_fence(__ATOMIC_ACQUIRE, "agent");
            xb_add(&bar[XB_XGEN(b.x)], 1u);
            asm volatile("s_waitcnt vmcnt(0)" ::: "memory");
        } else {
            XB_SPIN(xb_ld(&bar[XB_XGEN(b.x)]) == gen, bar);
            __builtin_amdgcn_fence(__ATOMIC_ACQUIRE, "agent");
            asm volatile("s_waitcnt vmcnt(0)" ::: "memory");
        }
    }
    __syncthreads();
}


__global__ void __launch_bounds__(256, LB2) mega(Params p, int ph_lo, int ph_hi) {
  __shared__ __attribute__((aligned(16))) char smem[SM_TOTAL];
  __shared__ int s_task;
  __shared__ uint4 xb_words;
  if (threadIdx.x == 0) xb_words = make_uint4(0u, 0u, 0u, 0u);
  __syncthreads();
  (void)xcd_barrier_post((unsigned*)(p.ws + WS_BAR), (volatile LAS unsigned*)&xb_words);
  const int bid = blockIdx.x, nb = gridDim.x;

  for (int ph = ph_lo; ph <= ph_hi; ++ph) {
    if (ph > ph_lo) {
      if (ph == ph_lo + 1) cg::this_grid().sync();
      else {
        XcdBarrier xb2;
        xb2.bar = (unsigned*)(((const Params*)__builtin_amdgcn_kernarg_segment_ptr())->ws + WS_BAR);
        xb2.x = xb_xcc_id();
        xb2.st = (volatile LAS unsigned*)&xb_words;
        xcd_barrier(xb2);
      }
    }
    const int nrep = (REP_PH >= 0 && ph == REP_PH) ? 2 : 1;
    for (int rep = 0; rep < nrep; ++rep) {
    if (rep) cg::this_grid().sync();
    const int tid = otid(), lane = tid & 63, w = tid >> 6, r = lane & 31, h = lane >> 5;
    const int vb = (bid & 7) * (nb >> 3) + (bid >> 3);
    int zoff_;
    asm volatile("s_mov_b32 %0, 0" : "=s"(zoff_));
    const Params& p = *(const Params*)((const char*)__builtin_amdgcn_kernarg_segment_ptr() + zoff_);
    char* ws = p.ws;
    char* const ws_ph = ws;
    bf16* XN = (bf16*)(ws + WS_XN);
    bf16* P = (bf16*)(ws + WS_P);
    bf16* MIXED = (bf16*)(ws + WS_MIXED);
    float* ROPEC = (float*)(ws + WS_ROPEC);
    float* ROPES = (float*)(ws + WS_ROPES);
    float* hbuf = p.out;
    int* CTR = (int*)(ws + WS_CTR);
    auto fetch_task = [&](int* ctr) {
      __syncthreads();
      if (tid == 0) s_task = atomicAdd(ctr, 1);
      __syncthreads();
      return s_task;
    };
    const int layer = ph == 0 ? 0 : (ph - 1) / 6;
    const int sub = ph == 0 ? -1 : (ph - 1) % 6;
    const bool even = (layer & 1) == 0;
    const int li = layer >> 1;
    const int NP = even ? NPE : NPO;

    if ((PHM & 1) && (ph == 0 || sub == 5)) {
      if (ph == 0) {
        if (bid == 0 && tid < 64) CTR[tid] = 0;
        if (bid == 1 % nb && tid < 128) {
          int mx = p.pos[tid * 64];
          for (int q = 1; q < 64; ++q) mx = max(mx, p.pos[tid * 64 + q]);
          ((int*)(ws + WS_POSMAX))[tid] = mx;
        }
        for (int i = bid * 256 + tid; i < L * 32; i += nb * 256) {
          int t = i >> 5, f = i & 31;
          float inv = powf(10000.f, -(float)f / 32.f);
          float ang = (float)p.pos[t] * inv;
          ROPEC[i] = cosf(ang);
          ROPES[i] = sinf(ang);
        }
        for (int row = bid * 4 + w; row < 256; row += nb * 4)
          norm_row_bf16(p.mem + (size_t)row * DM, p.mem_norm_g, (bf16*)(ws + WS_MEMN) + (size_t)row * DM, lane);
      }
      const int nl = ph == 0 ? 0 : layer + 1;
      if (nl < 4) {
        const float* src = ph == 0 ? p.x : hbuf;
        for (int row = bid * 4 + w; row < L; row += nb * 4)
          norm_row_bf16(src + (size_t)row * DM, p.norm_g + nl * DM, XN + (size_t)row * LDX, lane);
      } else {
        for (int row = bid * 4 + w; row < L; row += nb * 4) norm_row_f32(hbuf + (size_t)row * DM, p.final_norm_g, lane);
      }
    }
    if ((PHM & 4) && sub == 0) {
      const int ntn = (NP / 128 + 1) / 2;
      const int n_in = 64 * ntn;
      const bf16* Win = (const bf16*)(ws + WS_WIN);
      const bool own = (nb & 7) == 0;
      const int per_g = 8 * ntn, nloc = nb >> 3;
      const int u_end = own ? per_g + 2 : n_in + 16;
      for (int u = own ? (bid >> 3) : vb; u < u_end; u += own ? nloc : nb) {
        const int t = own ? (u < per_g ? (bid & 7) * per_g + u : n_in + (bid & 7) * 2 + (u - per_g)) : u;
        if (t < n_in) {
          int tm, tn;
          tile_map(t, ntn, tm, tn);
          const int m0 = tm * 128;
          int n0 = tn * 256;
          const int nhalf = (n0 + 128 < NP) ? 2 : 1;
          ALin af{XN + (size_t)m0 * LDX, LDX};
          if (even) {
            gemm_tile2(af, Win + (size_t)n0 * LDX, LDX, DM, smem, n0, nhalf, [&](const float* Cs) {
              if (n0 >= 4096 && n0 < 5120) {
                bf16* VT = (bf16*)(ws + WS_VTFOX);
                epi_cols(Cs, [&](int col, int r8, const float* v) {
                  *(uint4*)(VT + (size_t)(n0 - 4096 + col) * L + m0 + r8) = pack8(v);
                });
              } else if (n0 == 7168) {
                float* FL = (float*)(ws + WS_FLOG);
                for (int i = tid; i < 128 * 8; i += 256) {
                  int row = i >> 3, c = i & 7;
                  FL[(size_t)(m0 + row) * 8 + c] = Cs[row * 132 + c];
                }
              } else {
                epi_rows(Cs, [&](int row, int cc, const float* v) {
                  *(uint4*)(P + (size_t)(m0 + row) * NPE + n0 + cc) = pack8(v);
                });
              }
            });
          } else {
            gemm_tile2(af, Win + (size_t)n0 * LDX, LDX, DM, smem, n0, nhalf, [&](const float* Cs) {
              if (n0 == 3840 || n0 == 3968 || n0 == 4352 || n0 == 4480) {
                bf16* VT = (n0 < 4096) ? (bf16*)(ws + WS_VTSLC) + (size_t)(n0 - 3840) * L
                                       : (bf16*)(ws + WS_VTWIN) + (size_t)(n0 - 4352) * L;
                epi_cols(Cs, [&](int col, int r8, const float* v) {
                  *(uint4*)(VT + (size_t)col * L + m0 + r8) = pack8(v);
                });
              } else if (n0 == 6656) {
                epi_rope(Cs, 0, m0, ROPEC, ROPES, 1.f, [&](int row, int cl, const float* v) {
                  *(uint4*)(P + (size_t)(m0 + row) * NPO + 6656 + cl) = pack8(v);
                });
                float* GT = (float*)(ws + WS_FLOG);
                for (int i = tid; i < 128 * 24; i += 256) {
                  int row = i / 24, c = i % 24;
                  GT[(size_t)(m0 + row) * 24 + c] = Cs[row * 132 + 64 + c];
                }
              } else {
                epi_rows(Cs, [&](int row, int cc, const float* v) {
                  *(uint4*)(P + (size_t)(m0 + row) * NPO + n0 + cc) = pack8(v);
                });
              }
            });
          }
        } else {
          const int t2 = t - n_in;
          const int m0 = (t2 >> 3) * 128, n0 = (t2 & 7) * 128;
          ALin af{(const bf16*)(ws + WS_MEMN) + (size_t)m0 * DM, DM};
          gemm_tile(af, (const bf16*)(ws + WS_WMEM) + (size_t)n0 * DM, DM, DM, smem, [&](const float* Cs) {
            if (n0 < 512) {
              bf16* MK = (bf16*)(ws + WS_MEMK);
              epi_rows(Cs, [&](int row, int cc, const float* v) {
                *(uint4*)(MK + (size_t)(m0 + row) * 512 + n0 + cc) = pack8(v);
              });
            } else {
              bf16* MV = (bf16*)(ws + WS_MEMVT);
              epi_cols(Cs, [&](int col, int r8, const float* v) {
                *(uint4*)(MV + (size_t)(n0 - 512 + col) * 256 + m0 + r8) = pack8(v);
              });
            }
          });
        }
      }
    }

    if ((PHM & 4) && sub == 0) {
      const int cw = cvt_set_count(p, SET_OUT, layer), cw4 = (cw + 3) >> 2;
      for (;;) {
        const int t = fetch_task(CTR + 32 + ph);
        if (t >= cw4) break;
        for (int q = 0; q < 4; ++q) {
          const int ci = t * 4 + q;
          if (ci < cw) cvt_set_task(p, SET_OUT, layer, ci, smem);
        }
      }
    }
    auto mem_attn_task = [&](int t) {
      const int tid = otid(), lane = tid & 63, w = tid >> 6, r = lane & 31, h = lane >> 5;
      (void)tid;
      const int qt = t >> 2, head = t & 3;
      const int tq = qt * 128 + w * 32 + r;
      const int qcol = even ? 6144 : 5632, gcol = even ? 6656 : 6144;
      bf16x8 qf[8];
      load_q<128>(qf, P + (size_t)tq * NP + qcol + head * 128, h);
      f32x16 o[4];
      zero_o(o);
      float m = NEG, l = 0.f;
      CtxMem ctx{0.08838834764831845f * LOG2E};
      attn_run<128, true, true>(qf, o, m, l, (const bf16*)(ws + WS_MEMK) + head * 128, 512, nullptr, 0,
                          (const bf16*)(ws + WS_MEMVT) + (size_t)head * 128 * 256, 256, 0, ctx, smem);
      float lt = l + __shfl_xor(l, 32);
      store_out_A(o, 1.f / lt, P + (size_t)tq * NP + gcol + head * 128, MIXED + (size_t)tq * MIXW + 2048 + head * 128, h);
    };

    if ((PHM & 8) && sub == 1 && even) {
      const int cw = 0;
      const int n_s5 = 1024, n_cum = 64, n_mem = 256;
      for (int t = bid; t < n_mem + n_s5 + n_cum + cw; t += nb) {
        if (t < n_mem) {
          mem_attn_task(t);
        } else if (t < n_mem + n_s5) {
          const int t2 = t - n_mem;
          const int ch = t2 >> 4, gq = t2 & 15;
          float* us = (float*)smem;
          __syncthreads();
          for (int i = tid; i < 128 * 8; i += 256) {
            int tt = i >> 3, c8 = (i & 7) * 8;
            uint4 u = *(const uint4*)(P + (size_t)(ch * 128 + tt) * NPE + gq * 64 + c8);
            float* d = us + tt * 64 + c8;
            d[0] = bflo(u.x); d[1] = bfhi(u.x); d[2] = bflo(u.y); d[3] = bfhi(u.y);
            d[4] = bflo(u.z); d[5] = bfhi(u.z); d[6] = bflo(u.w); d[7] = bfhi(u.w);
          }
          __syncthreads();
          const float* S5P = (const float*)(ws + WS_S5P);
          const int gp = (gq * 4 + w) * 64 + lane;
          const float ar = S5P[gp], ai = S5P[4096 + gp];
          float bbr[16], bbi[16];
#pragma unroll
          for (int c = 0; c < 16; ++c) { bbr[c] = S5P[16384 + gp * 16 + c]; bbi[c] = S5P[16384 + 65536 + gp * 16 + c]; }
          float xr = 0.f, xi = 0.f;
          for (int tt = 0; tt < 128; ++tt) {
            const float* up = us + tt * 64 + w * 16;
            float bur = 0.f, bui = 0.f;
#pragma unroll
            for (int c = 0; c < 16; ++c) { float uv = up[c]; bur += bbr[c] * uv; bui += bbi[c] * uv; }
            float nxr = ar * xr - ai * xi + bur;
            float nxi = ar * xi + ai * xr + bui;
            xr = nxr; xi = nxi;
          }
          float2* E = (float2*)(ws + WS_S5E);
          E[(size_t)ch * 4096 + gp] = make_float2(xr, xi);
        } else if (t < n_mem + n_s5 + n_cum) {
          const int ch = t - n_mem - n_s5;
          const float* FL = (const float*)(ws + WS_FLOG);
          float* CUML = (float*)(ws + WS_CUML);
          float* CT = (float*)(ws + WS_CT);
#pragma unroll
          for (int hh = 0; hh < 2; ++hh) {
            const int head = w * 2 + hh;
            const float bf = p.fox_b_f[li * 8 + head];
            const int t0 = ch * 128 + lane * 2;
            float x0 = FL[(size_t)t0 * 8 + head] + bf, x1 = FL[(size_t)(t0 + 1) * 8 + head] + bf;
            float v0 = x0 >= 0.f ? -log1pf(expf(-x0)) : x0 - log1pf(expf(x0));
            float v1 = x1 >= 0.f ? -log1pf(expf(-x1)) : x1 - log1pf(expf(x1));
            float s = v0 + v1;
            float inc = s;
#pragma unroll
            for (int o = 1; o < 64; o <<= 1) {
              float n = __shfl_up(inc, o);
              if (lane >= o) inc += n;
            }
            float excl = inc - s;
            CUML[(size_t)head * L + t0] = excl + v0;
            CUML[(size_t)head * L + t0 + 1] = excl + v0 + v1;
            if (lane == 63) CT[head * 64 + ch] = inc;
          }
        } else {
          cvt_set_task(p, SET_OUT, layer, t - n_mem - n_s5 - n_cum, smem);
        }
      }
    }
    if ((PHM & 16) && sub == 2 && even) {
      const int n_fox = 512, n_s5 = 1024;
      for (;;) {
        const int t = fetch_task(CTR + ph);
        if (t >= n_fox + n_s5) break;
        const int tid = otid(), lane = tid & 63, w = tid >> 6, r = lane & 31, h = lane >> 5;
        int zt_;
        asm volatile("s_mov_b32 %0, 0" : "=s"(zt_));
        char* const ws = ws_ph + zt_;
        if (t < n_fox) {
          const int qt = 63 - (t >> 3), head = t & 7;
          const int q0w = qt * 128 + w * 32, tq = q0w + r;
          float* cpre = (float*)(smem + AT_X0);
          __syncthreads();
          if (tid < 64) {
            const float v0 = ((const float*)(ws + WS_CT))[head * 64 + tid];
            float inc = v0;
#pragma unroll
            for (int of = 1; of < 64; of <<= 1) {
              float n = __shfl_up(inc, of);
              if (tid >= of) inc += n;
            }
            cpre[tid] = inc - v0;
          }
          __syncthreads();
          const float* cuml = (const float*)(ws + WS_CUML) + (size_t)head * L;
          bf16x8 qf[8];
          load_q<128>(qf, P + (size_t)tq * NPE + 2048 + head * 128, h);
          f32x16 o[4];
          zero_o(o);
          float m = NEG, l = 0.f;
          CtxFox ctx{tq, q0w, 2 * qt + 1, 0.08838834764831845f * LOG2E, cuml, cpre};
          attn_run<128, true, true>(qf, o, m, l, P + 3072 + head * 128, NPE, nullptr, 0,
                              (const bf16*)(ws + WS_VTFOX) + (size_t)head * 128 * L, L, 0, ctx, smem);
          float lt = l + __shfl_xor(l, 32);
          store_out_A(o, 1.f / lt, P + (size_t)tq * NPE + 5120 + head * 128, MIXED + (size_t)tq * MIXW + 1024 + head * 128, h);
        } else {
          const int t2 = t - n_fox;
          const int ch = t2 >> 4, gq = t2 & 15;
          float* us = (float*)smem;
          float* xs = (float*)(smem + 32768) + w * 16 * 132;
          __syncthreads();
          for (int i = tid; i < 128 * 8; i += 256) {
            int tt = i >> 3, c8 = (i & 7) * 8;
            uint4 u = *(const uint4*)(P + (size_t)(ch * 128 + tt) * NPE + gq * 64 + c8);
            float* d = us + tt * 64 + c8;
            d[0] = bflo(u.x); d[1] = bfhi(u.x); d[2] = bflo(u.y); d[3] = bfhi(u.y);
            d[4] = bflo(u.z); d[5] = bfhi(u.z); d[6] = bflo(u.w); d[7] = bfhi(u.w);
          }
          __syncthreads();
          const float* S5P = (const float*)(ws + WS_S5P);
          const int g = gq * 4 + w;
          const int gp = g * 64 + lane;
          const float ar = S5P[gp], ai = S5P[4096 + gp];
          const float atr = S5P[8192 + gp], ati = S5P[12288 + gp];
          float xr = 0.f, xi = 0.f;
          {
            const float2* E = (const float2*)(ws + WS_S5E) + gp;
#define CSTEP(e) { float nxr = atr * xr - ati * xi + e.x; float nxi = atr * xi + ati * xr + e.y; xr = nxr; xi = nxi; }
            int c = 0;
            for (; c + 8 <= ch; c += 8) {
              float2 e0 = E[(size_t)(c + 0) * 4096], e1 = E[(size_t)(c + 1) * 4096], e2 = E[(size_t)(c + 2) * 4096],
                     e3 = E[(size_t)(c + 3) * 4096], e4 = E[(size_t)(c + 4) * 4096], e5 = E[(size_t)(c + 5) * 4096],
                     e6 = E[(size_t)(c + 6) * 4096], e7 = E[(size_t)(c + 7) * 4096];
              CSTEP(e0) CSTEP(e1) CSTEP(e2) CSTEP(e3) CSTEP(e4) CSTEP(e5) CSTEP(e6) CSTEP(e7)
            }
            for (; c < ch; ++c) {
              float2 e = E[(size_t)c * 4096];
              CSTEP(e)
            }
#undef CSTEP
          }
          float bbr[16], bbi[16];
#pragma unroll
          for (int c = 0; c < 16; ++c) { bbr[c] = S5P[16384 + gp * 16 + c]; bbi[c] = S5P[16384 + 65536 + gp * 16 + c]; }
          const int chn = lane & 15, kq = lane >> 4;
          float cb[32];
          {
            const float* cre = p.c_re + ((size_t)li * 64 + g) * 1024 + chn * 64;
            const float* cim = p.c_im + ((size_t)li * 64 + g) * 1024 + chn * 64;
#pragma unroll
            for (int ks = 0; ks < 16; ++ks) { cb[ks] = cre[4 * ks + kq]; cb[16 + ks] = -cim[4 * ks + kq]; }
          }
          const float dsk = p.s5_d[li * 1024 + g * 16 + chn];
          bf16* Z = (bf16*)(ws + WS_Z);
          for (int sc = 0; sc < 8; ++sc) {
#pragma unroll 4
            for (int tt = 0; tt < 16; ++tt) {
              const float* up = us + (sc * 16 + tt) * 64 + w * 16;
              float bur = 0.f, bui = 0.f;
#pragma unroll
              for (int c = 0; c < 16; ++c) { float uv = up[c]; bur += bbr[c] * uv; bui += bbi[c] * uv; }
              float nxr = ar * xr - ai * xi + bur;
              float nxi = ar * xi + ai * xr + bui;
              xr = nxr; xi = nxi;
              xs[tt * 132 + lane] = xr;
              xs[tt * 132 + 64 + lane] = xi;
            }
            __syncthreads();
            f32x4 y = {0.f, 0.f, 0.f, 0.f};
#pragma unroll
            for (int ks = 0; ks < 32; ++ks) {
              float a = xs[chn * 132 + 4 * ks + kq];
              y = __builtin_amdgcn_mfma_f32_16x16x4f32(a, cb[ks], y, 0, 0, 0);
            }
#pragma unroll
            for (int i = 0; i < 4; ++i) {
              int tt = 4 * kq + i;
              float uv = us[(sc * 16 + tt) * 64 + w * 16 + chn];
              float yy = y[i] + dsk * uv;
              Z[(size_t)(ch * 128 + sc * 16 + tt) * LDZ + g * 16 + chn] = f2bf(gelu_t(yy));
            }
            __syncthreads();
          }
        }
      }
    }
    if ((PHM & 32) && sub == 3 && even) {
      const bf16* Z = (const bf16*)(ws + WS_Z);
      for (int t = vb; t < 64 * 8; t += nb) {
        int tm, tn;
        tile_map(t, 8, tm, tn);
        const int m0 = tm * 128, n0 = tn * 128;
        ALin af{Z + (size_t)m0 * LDZ, LDZ};
        gemm_tile(af, (const bf16*)(ws + WS_WMISC + WM_GLU) + (size_t)n0 * LDZ, LDZ, 1024, smem, [&](const float* Cs) {
          epi_rows(Cs, [&](int row, int cc, const float* v) {
            uint4 zu = *(const uint4*)(Z + (size_t)(m0 + row) * LDZ + n0 + cc);
            uint4 gu = *(const uint4*)(P + (size_t)(m0 + row) * NPE + 1024 + n0 + cc);
            float zz[8] = {bflo(zu.x), bfhi(zu.x), bflo(zu.y), bfhi(zu.y), bflo(zu.z), bfhi(zu.z), bflo(zu.w), bfhi(zu.w)};
            float gg[8] = {bflo(gu.x), bfhi(gu.x), bflo(gu.y), bfhi(gu.y), bflo(gu.z), bfhi(gu.z), bflo(gu.w), bfhi(gu.w)};
            float o[8];
#pragma unroll
            for (int e = 0; e < 8; ++e) o[e] = zz[e] * sigm(v[e]) * silu(gg[e]);
            *(uint4*)(MIXED + (size_t)(m0 + row) * MIXW + n0 + cc) = pack8(o);
          });
        });
      }
    }
    if ((PHM & 64) && sub == 1 && !even) {
      const int cw = 0;
      const int n_c1 = 32, n_q = 64 * 12, n_kv = 64 * 16, n_mem = 256;
      float* rsx = (float*)(smem + SM_EXTRA);
      const bool split = (nb % 8 == 0) && nb >= 64;
      int t0, tstride;
      if (!split) { t0 = bid; tstride = nb; }
      else if (bid < n_c1) { t0 = bid; tstride = 1 << 28; }
      else { t0 = n_c1 + (bid & 7) * ((nb - n_c1) >> 3) + ((bid >> 3) - (n_c1 >> 3)); tstride = nb - n_c1; }
      for (int t = t0; t < n_c1 + n_q + n_kv + n_mem + cw; t += tstride) {
        if (t < n_c1) {
          const int which = t >> 4, tm = (t >> 1) & 7, tn = t & 1;
          const int m0 = tm * 128, n0 = tn * 128;
          __syncthreads();
          if (tid < 128) {
            const float* CB = (const float*)(ws + WS_CMPB) + which * 16 * 256 + n0 + tid;
            float b = 0.f;
            for (int q = 0; q < 16; ++q) b += CB[q * 256];
            rsx[tid] = b;
          }
          ACmp af{P + (which ? 3328 : 3072), m0};
          bf16* HID = (bf16*)(ws + WS_HID) + (size_t)which * 1024 * 256;
          gemm_tile(af, (const bf16*)(ws + WS_WMISC + WM_W1) + (size_t)which * 256 * 4096 + (size_t)n0 * 4096, 4096, 4096,
                    smem, [&](const float* Cs) {
                      epi_rows(Cs, [&](int row, int cc, const float* v) {
                        float o[8];
#pragma unroll
                        for (int e = 0; e < 8; ++e) o[e] = gelu_t(v[e] + rsx[cc + e]);
                        *(uint4*)(HID + (size_t)(m0 + row) * 256 + n0 + cc) = pack8(o);
                      });
                    });
        } else if (t < n_c1 + n_q + n_kv) {
          const int t2 = t - n_c1;
          const bool isq = t2 < n_q;
          const int t3 = isq ? t2 : t2 - n_q;
          const int ntn = isq ? 12 : 16;
          int tm, tn;
          tile_map(t3, ntn, tm, tn);
          const int m0 = tm * 128, n0 = tn * 128;
          const bf16* Ab = P + (size_t)m0 * NPO + (isq ? 0 : 512);
          __syncthreads();
          for (int r8 = 0; r8 < 4; ++r8) {
            float ssq[8];
#pragma unroll
            for (int q = 0; q < 8; ++q) {
              int row = w * 32 + r8 * 8 + q;
              uint4 u = *(const uint4*)(Ab + (size_t)row * NPO + lane * 8);
              float a0 = bflo(u.x), a1 = bfhi(u.x), a2 = bflo(u.y), a3 = bfhi(u.y), a4 = bflo(u.z), a5 = bfhi(u.z),
                    a6 = bflo(u.w), a7 = bfhi(u.w);
              ssq[q] = a0 * a0 + a1 * a1 + a2 * a2 + a3 * a3 + a4 * a4 + a5 * a5 + a6 * a6 + a7 * a7;
            }
#pragma unroll
            for (int q = 0; q < 8; ++q) {
              float ss = wave_sum(ssq[q]);
              if (lane == 0) rsx[w * 32 + r8 * 8 + q] = rsqrtf(ss * (1.f / 512.f) + EPS);
            }
          }
          ALin af{Ab, NPO};
          if (isq) {
            bf16* QM = (bf16*)(ws + WS_QMLA);
            gemm_tile(af, (const bf16*)(ws + WS_WMISC + WM_UQ) + (size_t)n0 * 512, 512, 512, smem, [&](const float* Cs) {
              const int md = n0 % 192;
              const int ropehalf = md == 128 ? 0 : (md == 64 ? 1 : -1);
              epi_rows(Cs, [&](int row, int cc, const float* v) {
                if ((cc >> 6) == ropehalf) return;
                float o[8];
                float sc = rsx[row];
#pragma unroll
                for (int e = 0; e < 8; ++e) o[e] = v[e] * sc;
                *(uint4*)(QM + (size_t)(m0 + row) * 1536 + n0 + cc) = pack8(o);
              });
              if (ropehalf >= 0) {
                epi_rope(Cs, ropehalf * 64, m0, ROPEC, ROPES, 1.f, [&](int row, int cl, const float* v) {
                  float o[8];
                  float sc = rsx[row];
#pragma unroll
                  for (int e = 0; e < 8; ++e) o[e] = v[e] * sc;
                  *(uint4*)(QM + (size_t)(m0 + row) * 1536 + n0 + ropehalf * 64 + cl) = pack8(o);
                });
              }
            });
          } else {
            gemm_tile(af, (const bf16*)(ws + WS_WMISC + WM_UKV) + (size_t)n0 * 512, 512, 512, smem, [&](const float* Cs) {
              const int head = n0 >> 8, part = (n0 >> 7) & 1;
              if (part == 0) {
                bf16* KM = (bf16*)(ws + WS_KMLA);
                epi_rows(Cs, [&](int row, int cc, const float* v) {
                  float o[8];
                  float sc = rsx[row];
#pragma unroll
                  for (int e = 0; e < 8; ++e) o[e] = v[e] * sc;
                  *(uint4*)(KM + (size_t)(m0 + row) * 1024 + head * 128 + cc) = pack8(o);
                });
              } else {
                bf16* VT = (bf16*)(ws + WS_VTMLA);
                epi_cols(Cs, [&](int col, int r8, const float* v) {
                  float o[8];
#pragma unroll
                  for (int e = 0; e < 8; ++e) o[e] = v[e] * rsx[r8 + e];
                  *(uint4*)(VT + (size_t)(head * 128 + col) * L + m0 + r8) = pack8(o);
                });
              }
            });
          }
        } else if (t < n_c1 + n_q + n_kv + n_mem) {
          mem_attn_task(t - n_c1 - n_q - n_kv);
        } else {
          cvt_set_task(p, SET_OUT, layer, t - n_c1 - n_q - n_kv - n_mem, smem);
        }
      }
    }
    if ((PHM & 128) && sub == 2 && !even) {
      const int n_c2 = 16, n_mem2 = 0;
      for (int t = bid; t < n_c2 + n_mem2; t += nb) {
        if (t >= n_c2) {
          mem_attn_task(t - n_c2);
        } else {
          const int t2 = t;
          const int which = t2 >> 3, m0 = (t2 & 7) * 128;
          ALin af{(const bf16*)(ws + WS_HID) + (size_t)which * 1024 * 256 + (size_t)m0 * 256, 256};
          gemm_tile(af, (const bf16*)(ws + WS_WMISC + WM_W2) + (size_t)which * 128 * 256, 256, 256, smem, [&](const float* Cs) {
            if (which == 0) {
              bf16* KC = (bf16*)(ws + WS_KC);
              epi_rows(Cs, [&](int row, int cc, const float* v) {
                int gr = m0 + row;
                int n = gr >> 1, g = gr & 1;
                *(uint4*)(KC + ((size_t)g * 512 + n) * 128 + cc) = pack8(v);
              });
            } else {
              bf16* VC = (bf16*)(ws + WS_VCT);
              for (int i = tid; i < 128 * 128; i += 256) {
                int row = i & 127, col = i >> 7;
                int gr = m0 + row;
                int n = gr >> 1, g = gr & 1;
                VC[((size_t)g * 128 + col) * 512 + n] = f2bf(Cs[row * 132 + col]);
              }
            }
          });
        }
      }
    }
    if ((PHM & 256) && sub == 3 && !even) {
      const int* pos = p.pos;
      float* lut = (float*)(smem + AT_X0);
      float* imp = (float*)(smem + AT_IMP);
      unsigned* sel = (unsigned*)(smem + AT_SEL);
      const float* GT = (const float*)(ws + WS_FLOG);
      float* NSAO = (float*)(ws + WS_NSAO);
      for (;;) {
        const int tt_ = fetch_task(CTR + ph);
        if (tt_ >= 1024) break;
        const int t = tt_ >> 1;
        const int tid = otid(), lane = tid & 63, w = tid >> 6, r = lane & 31, h = lane >> 5;
        int zt_;
        asm volatile("s_mov_b32 %0, 0" : "=s"(zt_));
        char* const ws = ws_ph + zt_;
        if ((tt_ & 1) == 0) {
          const int qt = 63 - (t >> 3), head = t & 7;
          const int q0w = qt * 128 + w * 32, tq = q0w + r;
          bf16x8 qf[12];
          load_q<192>(qf, (const bf16*)(ws + WS_QMLA) + (size_t)tq * 1536 + head * 192, h);
          f32x16 o[4];
          zero_o(o);
          float m = NEG, l = 0.f;
          CtxCausal ctx{tq, q0w, 2 * qt + 1, 0.07216878364870322f * LOG2E};
          attn_run<192, true, true>(qf, o, m, l, (const bf16*)(ws + WS_KMLA) + head * 128, 1024, P + 6656, NPO,
                              (const bf16*)(ws + WS_VTMLA) + (size_t)head * 128 * L, L, 0, ctx, smem);
          float lt = l + __shfl_xor(l, 32);
          store_out_A(o, 1.f / lt, P + (size_t)tq * NPO + 1024 + head * 128, MIXED + (size_t)tq * MIXW + head * 128, h);
          continue;
        }
        const int qt = 255 - (t >> 1), g = t & 1;
        const int q0 = qt * 32;
        const int hr = r >> 3, qi = r & 7;
        const int ql = w * 8 + qi;
        const int tq = q0 + ql;
        const int head = g * 4 + hr;
        const int posq = pos[tq];
        __syncthreads();
        for (int i = tid; i < 4 * 800; i += 256) {
          int rr = i / 800, n = i % 800;
          int b;
          if (n < 16) b = n;
          else {
            float lr = logf((float)n / 16.f) / 4.1588830833596715f;
            b = 16 + (int)(lr * 16.f);
            if (b > 31) b = 31;
          }
          lut[i] = p.t5[b * 8 + g * 4 + rr] * LOG2E;
        }
        for (int i = tid; i < 32 * 132; i += 256) imp[i] = 0.f;
        __syncthreads();
        const float* lutr = lut + hr * 800;
        bf16x8 qf[8];
        load_q<128>(qf, P + (size_t)tq * NPO + 2048 + head * 128, h);
        const float sc = 0.08838834764831845f * LOG2E;
        f32x16 o[4];
        float* orow = NSAO + (size_t)tq * 1024 + head * 128;

        const int ncv = min(q0 / 16 + 1, 511);
        const int last_c = (ncv - 1) >> 6;
        float m = NEG, l = 0.f;
        CtxCmp cc{tq, posq, last_c, sc, lutr, pos, 0.f, imp, ql, false};
        zero_o(o);
        const bf16* KCg = (const bf16*)(ws + WS_KC) + (size_t)g * 512 * 128;
        const bf16* VCg = (const bf16*)(ws + WS_VCT) + (size_t)g * 128 * 512;
        attn_run<128, false, false>(qf, o, m, l, KCg, 128, nullptr, 0, VCg, 512, 0, cc, smem);
        float lt = l + __shfl_xor(l, 32);
        const bool has_c = m > -1e29f;
        float m2 = has_c ? m : 0.f;
        float invl = has_c ? 1.f / lt : 0.f;
        cc.invl = invl; cc.p2 = true;
        float l2 = 0.f;
        attn_run<128, true, false>(qf, o, m2, l2, KCg, 128, nullptr, 0, VCg, 512, 0, cc, smem);
        {
          float gs = sigm(GT[(size_t)tq * 24 + head * 3 + 0]) * invl;
#pragma unroll
          for (int d = 0; d < 4; ++d)
#pragma unroll
            for (int i4 = 0; i4 < 4; ++i4) {
              int dv0 = d * 32 + 8 * i4 + 4 * h;
              float4 v = make_float4(o[d][4 * i4] * gs, o[d][4 * i4 + 1] * gs, o[d][4 * i4 + 2] * gs, o[d][4 * i4 + 3] * gs);
              *(float4*)(orow + dv0) = v;
            }
        }
        __syncthreads();
        for (int q8 = 0; q8 < 8; ++q8) {
          const int qq = w * 8 + q8;
          const int tt = q0 + qq;
          const int cur = tt >> 6;
          const float* ip = imp + qq * 132;
          const int j0 = lane, j1 = lane + 64;
          const bool v0 = j0 <= cur, v1 = j1 <= cur;
          const bool f0 = (j0 == 0) || (j0 == cur) || (j0 == cur - 1);
          const bool f1 = (j1 == cur) || (j1 == cur - 1);
          const int nforced = cur == 0 ? 1 : (cur == 1 ? 2 : 3);
          const int nfree = 16 - nforced;
          const bool c0 = v0 && !f0, c1 = v1 && !f1;
          const unsigned u0 = __float_as_uint(ip[j0]), u1 = __float_as_uint(ip[j1]);
          const int ncand = __popcll(__ballot(c0)) + __popcll(__ballot(c1));
          bool s0, s1;
          if (ncand <= nfree) {
            s0 = v0; s1 = v1;
          } else {
            unsigned T = 0u;
            for (int bit = 30; bit >= 0; --bit) {
              const unsigned cth = T | (1u << bit);
              const int cnt = __popcll(__ballot(c0 && u0 >= cth)) + __popcll(__ballot(c1 && u1 >= cth));
              if (cnt >= nfree) T = cth;
            }
            const bool g0 = c0 && u0 > T, g1 = c1 && u1 > T;
            const bool e0 = c0 && u0 == T, e1 = c1 && u1 == T;
            const unsigned long long me0 = __ballot(e0), me1 = __ballot(e1);
            const int need0 = nfree - (__popcll(__ballot(g0)) + __popcll(__ballot(g1)));
            const int need1 = need0 - __popcll(me0);
            const int rk0 = __builtin_amdgcn_mbcnt_hi((unsigned)(me0 >> 32), __builtin_amdgcn_mbcnt_lo((unsigned)me0, 0u));
            const int rk1 = __builtin_amdgcn_mbcnt_hi((unsigned)(me1 >> 32), __builtin_amdgcn_mbcnt_lo((unsigned)me1, 0u));
            s0 = (v0 && f0) || g0 || (e0 && rk0 < need0);
            s1 = (v1 && f1) || g1 || (e1 && rk1 < need1);
          }
          unsigned long long b0 = __ballot(s0), b1 = __ballot(s1);
          if (lane == 0) {
            sel[qq * 4 + 0] = (unsigned)b0; sel[qq * 4 + 1] = (unsigned)(b0 >> 32);
            sel[qq * 4 + 2] = (unsigned)b1; sel[qq * 4 + 3] = (unsigned)(b1 >> 32);
          }
        }
        __syncthreads();
        unsigned un0, un1, un2, un3;
        {
          un0 = sel[r * 4 + 0]; un1 = sel[r * 4 + 1]; un2 = sel[r * 4 + 2]; un3 = sel[r * 4 + 3];
#pragma unroll
          for (int of = 1; of < 32; of <<= 1) {
            un0 |= __shfl_xor(un0, of); un1 |= __shfl_xor(un1, of); un2 |= __shfl_xor(un2, of); un3 |= __shfl_xor(un3, of);
          }
          un0 = __builtin_amdgcn_readfirstlane(un0); un1 = __builtin_amdgcn_readfirstlane(un1);
          un2 = __builtin_amdgcn_readfirstlane(un2); un3 = __builtin_amdgcn_readfirstlane(un3);
        }
        {
          const unsigned long long ulo = (unsigned long long)un0 | ((unsigned long long)un1 << 32);
          const unsigned long long uhi = (unsigned long long)un2 | ((unsigned long long)un3 << 32);
          const unsigned long long mlo = (unsigned long long)sel[ql * 4] | ((unsigned long long)sel[ql * 4 + 1] << 32);
          const unsigned long long mhi = (unsigned long long)sel[ql * 4 + 2] | ((unsigned long long)sel[ql * 4 + 3] << 32);
          int pqmin = pos[q0];
          for (int q = 1; q < 32; ++q) pqmin = min(pqmin, pos[q0 + q]);
          const int* posmax = (const int*)(ws + WS_POSMAX);
          zero_o(o);
          m = NEG; l = 0.f;
          {
            CtxSlc cs{tq, posq, sc, lutr, pos, ulo, uhi, mlo, mhi, posmax, pqmin, q0};
            attn_run<128, true, false>(qf, o, m, l, P + 3584 + g * 128, NPO, nullptr, 0,
                                       (const bf16*)(ws + WS_VTSLC) + (size_t)g * 128 * L, L, cs.next(-1), cs, smem);
          }
          {
            CtxSlcFar cf{sc, lutr[799], ulo, uhi, mlo, mhi, posmax, pqmin, q0};
            attn_run<128, true, false>(qf, o, m, l, P + 3584 + g * 128, NPO, nullptr, 0,
                                       (const bf16*)(ws + WS_VTSLC) + (size_t)g * 128 * L, L, cf.next(-1), cf, smem);
          }
          lt = l + __shfl_xor(l, 32);
          float gs = sigm(GT[(size_t)tq * 24 + head * 3 + 1]) / lt;
#pragma unroll
          for (int d = 0; d < 4; ++d)
#pragma unroll
            for (int i4 = 0; i4 < 4; ++i4) {
              int dv0 = d * 32 + 8 * i4 + 4 * h;
              float4 v = *(float4*)(orow + dv0);
              v.x += o[d][4 * i4] * gs; v.y += o[d][4 * i4 + 1] * gs; v.z += o[d][4 * i4 + 2] * gs; v.w += o[d][4 * i4 + 3] * gs;
              *(float4*)(orow + dv0) = v;
            }
        }
        {
          const int kfirst = q0 - 511 > 0 ? (q0 - 511) >> 6 : 0;
          CtxWin cwn{tq, posq, (q0 + 31) >> 6, sc, lutr, pos};
          zero_o(o);
          m = NEG; l = 0.f;
          attn_run<128, true, false>(qf, o, m, l, P + 4096 + g * 128, NPO, nullptr, 0,
                              (const bf16*)(ws + WS_VTWIN) + (size_t)g * 128 * L, L, kfirst, cwn, smem);
          lt = l + __shfl_xor(l, 32);
          float gs = sigm(GT[(size_t)tq * 24 + head * 3 + 2]) / lt;
          const bf16* grow = P + (size_t)tq * NPO + 4608 + head * 128;
          bf16* mrow = MIXED + (size_t)tq * MIXW + 1024 + head * 128;
#pragma unroll
          for (int d = 0; d < 4; ++d)
#pragma unroll
            for (int i4 = 0; i4 < 4; ++i4) {
              int dv0 = d * 32 + 8 * i4 + 4 * h;
              float4 v = *(float4*)(orow + dv0);
              v.x += o[d][4 * i4] * gs; v.y += o[d][4 * i4 + 1] * gs; v.z += o[d][4 * i4 + 2] * gs; v.w += o[d][4 * i4 + 3] * gs;
              uint2 gu = *(const uint2*)(grow + dv0);
              uint2 ou;
              ou.x = pack2(v.x * silu(bflo(gu.x)), v.y * silu(bfhi(gu.x)));
              ou.y = pack2(v.z * silu(bflo(gu.y)), v.w * silu(bfhi(gu.y)));
              *(uint2*)(mrow + dv0) = ou;
            }
        }
      }
    }
    if ((PHM & 2) && (ph == 0 || (sub == 2 && even) || (sub == 3 && !even))) {
      const int nl = ph == 0 ? 0 : layer + 1;
      if (nl < 4) {
        const int n_cv = cvt_next_count(p, nl), n_cv4 = (n_cv + 3) >> 2;
        const bool dyn = ph != 0;
        int t = dyn ? fetch_task(CTR + 32 + ph) : bid;
        while (t < n_cv4) {
          for (int q = 0; q < 4; ++q) {
            const int ci = t * 4 + q;
            if (ci < n_cv) cvt_next(p, smem, nl, ci);
          }
          t = dyn ? fetch_task(CTR + 32 + ph) : t + nb;
        }
      }
    }
    if ((PHM & 512) && sub == 4) {
      const float* hin = layer == 0 ? p.x : hbuf;
      for (int t = vb; t < 64 * 8; t += nb) {
        int tm, tn;
        tile_map(t, 8, tm, tn);
        const int m0 = tm * 128;
        int n0 = tn * 256;
        ALin af{MIXED + (size_t)m0 * MIXW, MIXW};
        gemm_tile2(af, (const bf16*)(ws + WS_WOUT) + (size_t)n0 * MIXW, MIXW, MIXW, smem, n0, 2, [&](const float* Cs) {
          const int tid2 = otid();
#pragma unroll
          for (int j = 0; j < 16; ++j) {
            int c = tid2 + 256 * j;
            int row = c >> 5, cc = (c & 31) * 4;
            float4 a = *(const float4*)(Cs + row * 132 + cc);
            float4 hv = *(const float4*)(hin + (size_t)(m0 + row) * DM + n0 + cc);
            hv.x += a.x; hv.y += a.y; hv.z += a.z; hv.w += a.w;
            *(float4*)(hbuf + (size_t)(m0 + row) * DM + n0 + cc) = hv;
          }
        });
      }
    }
    }
  }
}

extern "C" void kernel_launch(void* const* d_in, const int* in_sizes, int n_in, void* d_out, int out_size, void* d_ws,
                              size_t ws_size, hipStream_t stream) {
  Params p{};
  p.x = (const float*)d_in[0]; p.mem = (const float*)d_in[1]; p.pos = (const int*)d_in[2];
  p.norm_g = (const float*)d_in[3]; p.mem_norm_g = (const float*)d_in[4]; p.final_norm_g = (const float*)d_in[5];
  p.t5 = (const float*)d_in[6]; p.w_out = (const float*)d_in[7]; p.mem_w_kv = (const float*)d_in[8];
  p.even_w_in = (const float*)d_in[9]; p.lam_re = (const float*)d_in[10]; p.lam_im = (const float*)d_in[11];
  p.log_dt = (const float*)d_in[12]; p.b_re = (const float*)d_in[13]; p.b_im = (const float*)d_in[14];
  p.c_re = (const float*)d_in[15]; p.c_im = (const float*)d_in[16]; p.s5_d = (const float*)d_in[17];
  p.w_glu = (const float*)d_in[18]; p.fox_b_f = (const float*)d_in[19]; p.odd_w_in = (const float*)d_in[20];
  p.g_cq = (const float*)d_in[21]; p.g_ckv = (const float*)d_in[22]; p.w_uq = (const float*)d_in[23];
  p.w_ukv = (const float*)d_in[24]; p.cmp_pe = (const float*)d_in[25]; p.cmp_w1 = (const float*)d_in[26];
  p.cmp_w2 = (const float*)d_in[27];
  p.out = (float*)d_out; p.ws = (char*)d_ws;
  if (ws_size < WS_END) fprintf(stderr, "workspace too small: %zu < %zu\n", ws_size, (size_t)WS_END);
  static int grid_blocks = 0;
  if (!grid_blocks) {
    int dev = 0, cus = 0, per_cu = 0;
    hipGetDevice(&dev);
    hipDeviceGetAttribute(&cus, hipDeviceAttributeMultiprocessorCount, dev);
    hipOccupancyMaxActiveBlocksPerMultiprocessor(&per_cu, mega, 256, 0);
    if (per_cu > 2) per_cu = 2;
    if (per_cu < 1) per_cu = 1;
    grid_blocks = cus * per_cu;
  }
  (void)hipMemsetAsync((char*)d_ws + WS_BAR, 0, XCD_BAR_WORDS * sizeof(unsigned), stream);
#if MULTI_LAUNCH
  for (int ph = 0; ph <= 24; ++ph) {
    int lo = ph, hi = ph;
    void* args[] = {&p, &lo, &hi};
    hipLaunchCooperativeKernel((void*)mega, dim3(grid_blocks), dim3(256), args, 0, stream);
  }
#else
  int lo = 0, hi = 24;
  void* args[] = {&p, &lo, &hi};
  hipError_t e = hipLaunchCooperativeKernel((void*)mega, dim3(grid_blocks), dim3(256), args, 0, stream);
  if (e != hipSuccess) fprintf(stderr, "cooperative launch failed: %s (grid %d)\n", hipGetErrorString(e), grid_blocks);
#endif
}
```

```cpp
#include <hip/hip_runtime.h>
#include <hip/hip_cooperative_groups.h>
#include <cstdio>
#include <cstdint>
namespace cg = cooperative_groups;

typedef unsigned short bf16;
typedef short bf16x8 __attribute__((ext_vector_type(8)));
typedef float f32x16 __attribute__((ext_vector_type(16)));
typedef float f32x4 __attribute__((ext_vector_type(4)));
typedef __bf16 bf2v __attribute__((ext_vector_type(2)));
typedef float f2v __attribute__((ext_vector_type(2)));

#define DI __device__ __forceinline__
#define MFMA32(a, b, c) __builtin_amdgcn_mfma_f32_32x32x16_bf16((a), (b), (c), 0, 0, 0)

#ifndef LB2
#define LB2 2
#endif
#ifndef REP_PH
#define REP_PH -1
#endif
#ifndef PHM
#define PHM 1023
#endif
#ifndef MULTI_LAUNCH
#define MULTI_LAUNCH 0
#endif

constexpr int L = 8192;
constexpr int DM = 2048;
constexpr int NPE = 7296;
constexpr int NPO = 6784;
constexpr int EVEN_IN = 7176;
constexpr int ODD_IN = 6744;
constexpr int MIXW = 2560;
constexpr int LDX = 2112;
constexpr int LDZ = 1088;
constexpr float LOG2E = 1.4426950408889634f;
constexpr float NEG = -1e30f;
constexpr float EPS = 1e-6f;

constexpr size_t MB = 1024 * 1024;
constexpr size_t WS_WIN = 0;
constexpr size_t WS_WOUT = WS_WIN + 32 * MB;
constexpr size_t WS_WMEM = WS_WOUT + 10 * MB;
constexpr size_t WS_WMISC = WS_WMEM + 4 * MB;
constexpr size_t WS_XN = WS_WMISC + 11 * MB;
constexpr size_t WS_MEMN = WS_XN + 36 * MB;
constexpr size_t WS_P = WS_MEMN + 1 * MB;
constexpr size_t WS_MIXED = WS_P + 114 * MB;
constexpr size_t WS_MEMK = WS_MIXED + 40 * MB;
constexpr size_t WS_MEMVT = WS_MEMK + 256 * 1024;
constexpr size_t WS_ROPEC = WS_MEMVT + 256 * 1024;
constexpr size_t WS_ROPES = WS_ROPEC + 1 * MB;
constexpr size_t WS_FLOG = WS_ROPES + 1 * MB;
constexpr size_t WS_CUML = WS_FLOG + 1 * MB;
constexpr size_t WS_CT = WS_CUML + 256 * 1024;
constexpr size_t WS_S5P = WS_CT + 4096;
constexpr size_t WS_S5E = WS_S5P + 1 * MB;
constexpr size_t WS_CMPB = WS_S5E + 2 * MB;
constexpr size_t WS_CTR = WS_CMPB + 64 * 1024;
constexpr size_t WS_BAR = WS_CTR + 4096;
constexpr size_t WS_POSMAX = WS_BAR + 16384;
constexpr size_t WS_VAR = WS_POSMAX + 4096;
constexpr size_t WS_Z = WS_VAR;
constexpr size_t WS_VTFOX = WS_Z + 18 * MB;
constexpr size_t WS_QMLA = WS_VAR;
constexpr size_t WS_KMLA = WS_QMLA + 24 * MB;
constexpr size_t WS_VTMLA = WS_KMLA + 16 * MB;
constexpr size_t WS_VTSLC = WS_VTMLA + 16 * MB;
constexpr size_t WS_VTWIN = WS_VTSLC + 4 * MB;
constexpr size_t WS_HID = WS_VTWIN + 4 * MB;
constexpr size_t WS_KC = WS_HID + 1 * MB;
constexpr size_t WS_VCT = WS_KC + 256 * 1024;
constexpr size_t WS_NSAO = WS_VCT + 256 * 1024;
constexpr size_t WS_END = WS_NSAO + 32 * MB;
constexpr size_t WM_GLU = 0;
constexpr size_t WM_UQ = 5 * MB / 2;
constexpr size_t WM_UKV = WM_UQ + 1536 * 512 * 2;
constexpr size_t WM_W1 = WM_UKV + 2048 * 512 * 2;
constexpr size_t WM_W2 = WM_W1 + 2 * 256 * 4096 * 2;

constexpr int SM_EXTRA = 73728;
constexpr int SM_TOTAL = 73728 + 1024;

struct Params {
  const float *x, *mem;
  const int* pos;
  const float *norm_g, *mem_norm_g, *final_norm_g, *t5, *w_out, *mem_w_kv, *even_w_in, *lam_re, *lam_im, *log_dt,
      *b_re, *b_im, *c_re, *c_im, *s5_d, *w_glu, *fox_b_f, *odd_w_in, *g_cq, *g_ckv, *w_uq, *w_ukv, *cmp_pe,
      *cmp_w1, *cmp_w2;
  float* out;
  char* ws;
};

DI unsigned pack2(float a, float b) {
  f2v v = {a, b};
  bf2v r = __builtin_convertvector(v, bf2v);
  return __builtin_bit_cast(unsigned, r);
}
DI float bflo(unsigned u) { return __uint_as_float(u << 16); }
DI float bfhi(unsigned u) { return __uint_as_float(u & 0xffff0000u); }
DI float bf2f(bf16 v) { return __uint_as_float(((unsigned)v) << 16); }
DI bf16 f2bf(float f) { return (bf16)(pack2(f, 0.f) & 0xffffu); }
DI int otid() { int z; asm volatile("s_mov_b32 %0, 0" : "=s"(z)); return (int)threadIdx.x + z; }
DI int crow(int i, int h) { return (i & 3) + 8 * (i >> 2) + 4 * h; }
DI float sigm(float x) { return 1.f / (1.f + __expf(-x)); }
DI float silu(float x) { return x * sigm(x); }
DI float gelu_t(float x) {
  float u = 0.7978845608028654f * (x + 0.044715f * x * x * x);
  float e = __expf(2.f * u);
  float t = 1.f - 2.f / (e + 1.f);
  return 0.5f * x * (1.f + t);
}
DI float ex2(float x) { return __builtin_amdgcn_exp2f(x); }
DI float wave_sum(float v) {
#pragma unroll
  for (int o = 32; o > 0; o >>= 1) v += __shfl_xor(v, o);
  return v;
}
DI uint4 pack8(const float* v) {
  uint4 u;
  u.x = pack2(v[0], v[1]); u.y = pack2(v[2], v[3]); u.z = pack2(v[4], v[5]); u.w = pack2(v[6], v[7]);
  return u;
}

struct CvtSeg {
  const float* src; int lds; int sc0; bf16* dst; int dr0; int ncols; int npad; int K; const float* kscale; int ldd;
};
DI int cvt_count(const CvtSeg& s) { return (s.K >> 6) * (s.npad >> 6); }
DI void cvt_tile(const CvtSeg& s, int tile, char* smem) {
  float* T = (float*)smem;
  const int tid = otid();
  const int nkt = s.K >> 6;
  const int kt = tile % nkt, nt = tile / nkt;
  const int k0 = kt * 64, n0 = nt * 64;
  __syncthreads();
#pragma unroll
  for (int i = 0; i < 4; ++i) {
    const int k = i * 16 + (tid >> 4), n4 = (tid & 15) * 4;
    float4 v = make_float4(0.f, 0.f, 0.f, 0.f);
    if (n0 + n4 < s.ncols) {
      v = *(const float4*)(s.src + (size_t)(k0 + k) * s.lds + s.sc0 + n0 + n4);
      if (s.kscale) { float sc = s.kscale[k0 + k]; v.x *= sc; v.y *= sc; v.z *= sc; v.w *= sc; }
    }
    float* d = T + k * 65 + n4;
    d[0] = v.x; d[1] = v.y; d[2] = v.z; d[3] = v.w;
  }
  __syncthreads();
#pragma unroll
  for (int j = 0; j < 2; ++j) {
    int c = tid + 256 * j;
    int n = c >> 3, kc = (c & 7) * 8;
    float v[8];
#pragma unroll
    for (int e = 0; e < 8; ++e) v[e] = T[(kc + e) * 65 + n];
    *(uint4*)(s.dst + (size_t)(s.dr0 + n0 + n) * s.ldd + k0 + kc) = pack8(v);
  }
}

enum { SET_IN_EVEN = 0, SET_IN_ODD, SET_OUT, SET_MEM, SET_MISC_EVEN, SET_MISC_ODD };
DI int cvt_nseg(int set) {
  switch (set) {
    case SET_IN_EVEN: return 3;
    case SET_IN_ODD: return 5;
    case SET_OUT: return 1;
    case SET_MEM: return 1;
    case SET_MISC_EVEN: return 1;
    default: return 6;
  }
}
DI CvtSeg cvt_get(const Params& p, int set, int li, int s) {
  CvtSeg r;
  r.kscale = nullptr;
  char* ws = p.ws;
  if (set == SET_IN_EVEN) {
    r.src = p.even_w_in + (size_t)li * DM * EVEN_IN; r.lds = EVEN_IN; r.K = DM; r.dst = (bf16*)(ws + WS_WIN);
    if (s == 0) { r.sc0 = 0; r.dr0 = 0; r.ncols = 5120; r.npad = 5120; }
    else if (s == 1) { r.sc0 = 5128; r.dr0 = 5120; r.ncols = 2048; r.npad = 2048; }
    else { r.sc0 = 5120; r.dr0 = 7168; r.ncols = 8; r.npad = 128; }
  } else if (set == SET_IN_ODD) {
    r.src = p.odd_w_in + (size_t)li * DM * ODD_IN; r.lds = ODD_IN; r.K = DM; r.dst = (bf16*)(ws + WS_WIN);
    if (s == 0) { r.sc0 = 0; r.dr0 = 0; r.ncols = 1024; r.npad = 1024; }
    else if (s == 1) { r.sc0 = 1088; r.dr0 = 1024; r.ncols = 3584; r.npad = 3584; }
    else if (s == 2) { r.sc0 = 4696; r.dr0 = 4608; r.ncols = 2048; r.npad = 2048; }
    else if (s == 3) { r.sc0 = 1024; r.dr0 = 6656; r.ncols = 64; r.npad = 64; }
    else { r.sc0 = 4672; r.dr0 = 6720; r.ncols = 24; r.npad = 64; }
  } else if (set == SET_OUT) {
    r.src = p.w_out + (size_t)li * MIXW * DM; r.lds = DM; r.K = MIXW; r.dst = (bf16*)(ws + WS_WOUT);
    r.sc0 = 0; r.dr0 = 0; r.ncols = DM; r.npad = DM;
  } else if (set == SET_MEM) {
    r.src = p.mem_w_kv + (size_t)li * DM * 1024; r.lds = 1024; r.K = DM; r.dst = (bf16*)(ws + WS_WMEM);
    r.sc0 = 0; r.dr0 = 0; r.ncols = 1024; r.npad = 1024;
  } else if (set == SET_MISC_EVEN) {
    r.src = p.w_glu + (size_t)li * 1024 * 1024; r.lds = 1024; r.K = 1024; r.dst = (bf16*)(ws + WS_WMISC + WM_GLU);
    r.sc0 = 0; r.dr0 = 0; r.ncols = 1024; r.npad = 1024;
  } else {
    r.sc0 = 0; r.dr0 = 0;
    if (s == 0) {
      r.src = p.w_uq + (size_t)li * 512 * 1536; r.lds = 1536; r.K = 512; r.dst = (bf16*)(ws + WS_WMISC + WM_UQ);
      r.ncols = 1536; r.npad = 1536; r.kscale = p.g_cq + li * 512;
    } else if (s == 1) {
      r.src = p.w_ukv + (size_t)li * 512 * 2048; r.lds = 2048; r.K = 512; r.dst = (bf16*)(ws + WS_WMISC + WM_UKV);
      r.ncols = 2048; r.npad = 2048; r.kscale = p.g_ckv + li * 512;
    } else if (s < 4) {
      int which = s - 2;
      r.src = p.cmp_w1 + (size_t)(li * 2 + which) * 4096 * 256; r.lds = 256; r.K = 4096;
      r.dst = (bf16*)(ws + WS_WMISC + WM_W1) + (size_t)which * 256 * 4096; r.ncols = 256; r.npad = 256;
    } else {
      int which = s - 4;
      r.src = p.cmp_w2 + (size_t)(li * 2 + which) * 256 * 128; r.lds = 128; r.K = 256;
      r.dst = (bf16*)(ws + WS_WMISC + WM_W2) + (size_t)which * 128 * 256; r.ncols = 128; r.npad = 128;
    }
  }
  r.ldd = (set == SET_IN_EVEN || set == SET_IN_ODD) ? LDX : (set == SET_MISC_EVEN ? LDZ : r.K);
  return r;
}
DI int cvt_set_count(const Params& p, int set, int li) {
  int n = 0;
  for (int s = 0; s < cvt_nseg(set); ++s) n += cvt_count(cvt_get(p, set, li, s));
  return n;
}
DI void cvt_set_task(const Params& p, int set, int li, int t, char* smem) {
  const int ns = cvt_nseg(set);
  for (int s = 0; s < ns; ++s) {
    CvtSeg sg = cvt_get(p, set, li, s);
    int c = cvt_count(sg);
    if (t < c) { cvt_tile(sg, t, smem); return; }
    t -= c;
  }
}

DI void norm_row_bf16(const float* __restrict__ src, const float* __restrict__ g, bf16* __restrict__ dst, int lane) {
  float4 v[8];
  float ss = 0.f;
#pragma unroll
  for (int i = 0; i < 8; ++i) {
    v[i] = *(const float4*)(src + (i * 64 + lane) * 4);
    ss += v[i].x * v[i].x + v[i].y * v[i].y + v[i].z * v[i].z + v[i].w * v[i].w;
  }
  ss = wave_sum(ss);
  float r = rsqrtf(ss * (1.f / DM) + EPS);
#pragma unroll
  for (int i = 0; i < 8; ++i) {
    float4 gg = *(const float4*)(g + (i * 64 + lane) * 4);
    uint2 u;
    u.x = pack2(v[i].x * r * gg.x, v[i].y * r * gg.y);
    u.y = pack2(v[i].z * r * gg.z, v[i].w * r * gg.w);
    *(uint2*)(dst + (i * 64 + lane) * 4) = u;
  }
}
DI void norm_row_f32(float* __restrict__ io, const float* __restrict__ g, int lane) {
  float4 v[8];
  float ss = 0.f;
#pragma unroll
  for (int i = 0; i < 8; ++i) {
    v[i] = *(const float4*)(io + (i * 64 + lane) * 4);
    ss += v[i].x * v[i].x + v[i].y * v[i].y + v[i].z * v[i].z + v[i].w * v[i].w;
  }
  ss = wave_sum(ss);
  float r = rsqrtf(ss * (1.f / DM) + EPS);
#pragma unroll
  for (int i = 0; i < 8; ++i) {
    float4 gg = *(const float4*)(g + (i * 64 + lane) * 4);
    float4 o;
    o.x = v[i].x * r * gg.x; o.y = v[i].y * r * gg.y; o.z = v[i].z * r * gg.z; o.w = v[i].w * r * gg.w;
    *(float4*)(io + (i * 64 + lane) * 4) = o;
  }
}

struct ALin {
  const bf16* p; int ld;
  DI const bf16* operator()(int row, int k) const { return p + (size_t)row * ld + k; }
};
struct ACmp {
  const bf16* p; int m0;
  DI const bf16* operator()(int row, int k) const {
    int gr = m0 + row;
    if (gr > 1021) gr = 1021;
    int n = gr >> 1, g = gr & 1;
    return p + (size_t)(16 * n + (k >> 7)) * NPO + g * 128 + (k & 127);
  }
};

template <class AF, class Epi>
DI void gemm_tile(AF af, const bf16* __restrict__ Bt, int ldb, int K, char* smem, Epi epi) {
  const int tid = otid(), lane = tid & 63, w = tid >> 6, r = lane & 31, h = lane >> 5;
  const int wm = w >> 1, wn = w & 1;
  bf16* As = (bf16*)smem;
  bf16* Bs = As + 2 * 128 * 72;
  f32x16 acc[2][2];
#pragma unroll
  for (int a = 0; a < 2; ++a)
#pragma unroll
    for (int b = 0; b < 2; ++b)
#pragma unroll
      for (int i = 0; i < 16; ++i) acc[a][b][i] = 0.f;
  uint4 ra0_0, ra0_1, ra0_2, ra0_3, rb0_0, rb0_1, rb0_2, rb0_3, ra1_0, ra1_1, ra1_2, ra1_3, rb1_0, rb1_1, rb1_2, rb1_3;
#define LD1(S, I, K0)                                                                  \
  {                                                                                    \
    int c = tl + 256 * I;                                                              \
    int row = c >> 3, kc = (c & 7) * 8;                                                \
    ra##S##_##I = *(const uint4*)af(row, (K0) + kc);                                   \
    rb##S##_##I = *(const uint4*)(Bt + (size_t)row * ldb + (K0) + kc);                 \
  }
#define ST1(S, I, BUF)                                                                 \
  {                                                                                    \
    int c = tid + 256 * I;                                                             \
    int row = c >> 3, kc = (c & 7) * 8;                                                \
    *(uint4*)(As + (BUF) * 9216 + row * 72 + kc) = ra##S##_##I;                        \
    *(uint4*)(Bs + (BUF) * 9216 + row * 72 + kc) = rb##S##_##I;                        \
  }
#define GLOAD(S, K0) { const int tl = otid(); LD1(S, 0, K0) LD1(S, 1, K0) LD1(S, 2, K0) LD1(S, 3, K0) }
#define SSTORE(S, BUF) { ST1(S, 0, BUF) ST1(S, 1, BUF) ST1(S, 2, BUF) ST1(S, 3, BUF) }
  auto compute = [&](int buf) {
    const bf16* a_ = As + buf * 9216 + (wm * 64 + r) * 72 + h * 8;
    const bf16* b_ = Bs + buf * 9216 + (wn * 64 + r) * 72 + h * 8;
    bf16x8 fa0, fa1, fb0, fb1, ga0, ga1, gb0, gb1, ha0, ha1, hb0, hb1, ia0, ia1, ib0, ib1;
    fa0 = *(const bf16x8*)(a_ + 0);            fa1 = *(const bf16x8*)(a_ + 32 * 72);
    fb0 = *(const bf16x8*)(b_ + 0);            fb1 = *(const bf16x8*)(b_ + 32 * 72);
    ga0 = *(const bf16x8*)(a_ + 16);           ga1 = *(const bf16x8*)(a_ + 32 * 72 + 16);
    gb0 = *(const bf16x8*)(b_ + 16);           gb1 = *(const bf16x8*)(b_ + 32 * 72 + 16);
    ha0 = *(const bf16x8*)(a_ + 32);           ha1 = *(const bf16x8*)(a_ + 32 * 72 + 32);
    hb0 = *(const bf16x8*)(b_ + 32);           hb1 = *(const bf16x8*)(b_ + 32 * 72 + 32);
    ia0 = *(const bf16x8*)(a_ + 48);           ia1 = *(const bf16x8*)(a_ + 32 * 72 + 48);
    ib0 = *(const bf16x8*)(b_ + 48);           ib1 = *(const bf16x8*)(b_ + 32 * 72 + 48);
    __builtin_amdgcn_sched_barrier(0);
    acc[0][0] = MFMA32(fa0, fb0, acc[0][0]); acc[0][1] = MFMA32(fa0, fb1, acc[0][1]);
    acc[1][0] = MFMA32(fa1, fb0, acc[1][0]); acc[1][1] = MFMA32(fa1, fb1, acc[1][1]);
    acc[0][0] = MFMA32(ga0, gb0, acc[0][0]); acc[0][1] = MFMA32(ga0, gb1, acc[0][1]);
    acc[1][0] = MFMA32(ga1, gb0, acc[1][0]); acc[1][1] = MFMA32(ga1, gb1, acc[1][1]);
    acc[0][0] = MFMA32(ha0, hb0, acc[0][0]); acc[0][1] = MFMA32(ha0, hb1, acc[0][1]);
    acc[1][0] = MFMA32(ha1, hb0, acc[1][0]); acc[1][1] = MFMA32(ha1, hb1, acc[1][1]);
    acc[0][0] = MFMA32(ia0, ib0, acc[0][0]); acc[0][1] = MFMA32(ia0, ib1, acc[0][1]);
    acc[1][0] = MFMA32(ia1, ib0, acc[1][0]); acc[1][1] = MFMA32(ia1, ib1, acc[1][1]);
    __builtin_amdgcn_sched_barrier(0);
  };
  __syncthreads();
  const int nk = K >> 6;
  GLOAD(0, 0);
  SSTORE(0, 0);
  GLOAD(0, 64);
  __syncthreads();
  for (int kt = 0; kt < nk; kt += 2) {
    if (kt + 2 < nk) GLOAD(1, (kt + 2) * 64);
    compute(0);
    SSTORE(0, 1);
    __syncthreads();
    if (kt + 3 < nk) GLOAD(0, (kt + 3) * 64);
    compute(1);
    if (kt + 2 < nk) SSTORE(1, 0);
    __syncthreads();
  }
#undef GLOAD
#undef SSTORE
#undef LD1
#undef ST1
  float* Cs = (float*)smem;
#pragma unroll
  for (int mb = 0; mb < 2; ++mb)
#pragma unroll
    for (int nb = 0; nb < 2; ++nb)
#pragma unroll
      for (int i = 0; i < 16; ++i)
        Cs[(wm * 64 + mb * 32 + crow(i, h)) * 132 + wn * 64 + nb * 32 + r] = acc[mb][nb][i];
  __syncthreads();
  epi(Cs);
}


template <class AF, class Epi>
DI void gemm_tile2(AF af, const bf16* __restrict__ Bt, int ldb, int K, char* smem, int& n0ref, int nhalf, Epi epi) {
  const int tid = otid(), lane = tid & 63, w = tid >> 6, r = lane & 31, h = lane >> 5;
  const int wm = w >> 1, wn = w & 1;
  bf16* As = (bf16*)smem;
  bf16* Bs = As + 128 * 72;
  f32x16 acc[2][4];
#pragma unroll
  for (int a = 0; a < 2; ++a)
#pragma unroll
    for (int b = 0; b < 4; ++b)
#pragma unroll
      for (int i = 0; i < 16; ++i) acc[a][b][i] = 0.f;
  uint4 pa_0, pa_1, pa_2, pa_3, pb_0, pb_1, pb_2, pb_3, pb_4, pb_5, pb_6, pb_7;
#define LDA2(I, K0) { int c = tl + 256 * I; int row = c >> 3, kc = (c & 7) * 8; pa_##I = *(const uint4*)af(row, (K0) + kc); }
#define LDB2(I, K0) { int c = tl + 256 * I; int row = c >> 3, kc = (c & 7) * 8; pb_##I = *(const uint4*)(Bt + (size_t)row * ldb + (K0) + kc); }
#define STA2(I) { int c = tid + 256 * I; int row = c >> 3, kc = (c & 7) * 8; *(uint4*)(As + row * 72 + kc) = pa_##I; }
#define STB2(I) { int c = tid + 256 * I; int row = c >> 3, kc = (c & 7) * 8; *(uint4*)(Bs + row * 72 + kc) = pb_##I; }
#define GLOAD2(K0) { const int tl = otid(); LDA2(0, K0) LDA2(1, K0) LDA2(2, K0) LDA2(3, K0) LDB2(0, K0) LDB2(1, K0) LDB2(2, K0) LDB2(3, K0) LDB2(4, K0) LDB2(5, K0) LDB2(6, K0) LDB2(7, K0) }
#define SSTORE2() { STA2(0) STA2(1) STA2(2) STA2(3) STB2(0) STB2(1) STB2(2) STB2(3) STB2(4) STB2(5) STB2(6) STB2(7) }
  const int nk = K >> 6;
  GLOAD2(0);
  const bf16* a_ = As + (wm * 64 + r) * 72 + h * 8;
  const bf16* b_ = Bs + (wn * 128 + r) * 72 + h * 8;
  for (int kt = 0; kt < nk; ++kt) {
    __syncthreads();
    SSTORE2();
    __syncthreads();
    if (kt + 1 < nk) GLOAD2((kt + 1) * 64);
#pragma unroll
    for (int ks = 0; ks < 4; ++ks) {
      bf16x8 fa[2], fb[4];
#pragma unroll
      for (int mb = 0; mb < 2; ++mb) fa[mb] = *(const bf16x8*)(a_ + mb * 32 * 72 + ks * 16);
#pragma unroll
      for (int nb = 0; nb < 4; ++nb) fb[nb] = *(const bf16x8*)(b_ + nb * 32 * 72 + ks * 16);
#pragma unroll
      for (int mb = 0; mb < 2; ++mb)
#pragma unroll
        for (int nb = 0; nb < 4; ++nb) acc[mb][nb] = MFMA32(fa[mb], fb[nb], acc[mb][nb]);
    }
  }
#undef LDA2
#undef LDB2
#undef STA2
#undef STB2
#undef GLOAD2
#undef SSTORE2
  float* Cs = (float*)smem;
#pragma unroll
  for (int hf = 0; hf < 2; ++hf) {
    if (hf < nhalf) {
      __syncthreads();
      if (wn == hf) {
#pragma unroll
        for (int mb = 0; mb < 2; ++mb)
#pragma unroll
          for (int nb = 0; nb < 4; ++nb)
#pragma unroll
            for (int i = 0; i < 16; ++i) Cs[(wm * 64 + mb * 32 + crow(i, h)) * 132 + nb * 32 + r] = acc[mb][nb][i];
      }
      __syncthreads();
      epi(Cs);
      n0ref += 128;
    }
  }
}

DI void tile_map(int t, int ntn, int& tm, int& tn) {
  const int per = 8 * ntn;
  const int grp = t / per, rem = t - grp * per;
  tm = grp * 8 + (rem & 7);
  tn = rem >> 3;
}
template <class F>
DI void epi_rows(const float* Cs, F f) {
  const int tid = otid();
#pragma unroll
  for (int j = 0; j < 8; ++j) {
    int c = tid + 256 * j;
    int row = c >> 4, cc = (c & 15) * 8;
    float v[8];
    float4 a = *(const float4*)(Cs + row * 132 + cc);
    float4 b = *(const float4*)(Cs + row * 132 + cc + 4);
    v[0] = a.x; v[1] = a.y; v[2] = a.z; v[3] = a.w; v[4] = b.x; v[5] = b.y; v[6] = b.z; v[7] = b.w;
    f(row, cc, v);
  }
}
template <class F>
DI void epi_cols(const float* Cs, F f) {
  const int tid = otid();
#pragma unroll
  for (int j = 0; j < 8; ++j) {
    int c = tid + 256 * j;
    int col = c & 127, r8 = (c >> 7) * 8;
    float v[8];
#pragma unroll
    for (int e = 0; e < 8; ++e) v[e] = Cs[(r8 + e) * 132 + col];
    f(col, r8, v);
  }
}
template <class F>
DI void epi_rope(const float* Cs, int cb, int m0, const float* rc, const float* rs, float scale_unused, F f) {
  const int tid = otid();
#pragma unroll
  for (int j = 0; j < 2; ++j) {
    int c = tid + 256 * j;
    int row = c >> 2, cc = (c & 3) * 8;
    float x1[8], x2[8], o1[8], o2[8];
#pragma unroll
    for (int e = 0; e < 8; ++e) {
      x1[e] = Cs[row * 132 + cb + cc + e];
      x2[e] = Cs[row * 132 + cb + 32 + cc + e];
    }
    const float* pc = rc + (size_t)(m0 + row) * 32 + cc;
    const float* ps = rs + (size_t)(m0 + row) * 32 + cc;
#pragma unroll
    for (int e = 0; e < 8; ++e) {
      float cs = pc[e], sn = ps[e];
      o1[e] = x1[e] * cs - x2[e] * sn;
      o2[e] = x1[e] * sn + x2[e] * cs;
    }
    f(row, cc, o1);
    f(row, cc + 32, o2);
  }
}

template <int DK>
struct KVPre {
  uint4 k[DK / 32];
  uint4 v[4];
  float aux;
};
constexpr int AT_VS = 25600;
constexpr int AT_AUX = 43008;
constexpr int AT_X0 = 43264;
constexpr int AT_IMP = AT_X0 + 12800;
constexpr int AT_SEL = AT_IMP + 16896;

template <int DK, bool PV, class SF, class PH>
DI void attn_tile(const bf16x8 (&qf)[DK / 16], f32x16 (&o)[4], float& m, float& l, const char* smem, SF sf, PH ph) {
  const int lane = otid() & 63, r = lane & 31, h = lane >> 5;
  const bf16* Ks = (const bf16*)smem;
  const bf16* Vs = (const bf16*)(smem + AT_VS);
  const float* auxs = (const float*)(smem + AT_AUX);
  f32x16 s[2];
#pragma unroll
  for (int kb = 0; kb < 2; ++kb) {
#pragma unroll
    for (int i = 0; i < 16; ++i) s[kb][i] = 0.f;
#pragma unroll
    for (int ks = 0; ks < DK / 16; ++ks) {
      bf16x8 a = *(const bf16x8*)(Ks + (kb * 32 + r) * (DK + 8) + ks * 16 + h * 8);
      s[kb] = MFMA32(a, qf[ks], s[kb]);
    }
  }
  float mx = m;
#pragma unroll
  for (int kb = 0; kb < 2; ++kb)
#pragma unroll
    for (int i = 0; i < 16; ++i) {
      int kl = kb * 32 + crow(i, h);
      float v = sf(s[kb][i], kl, auxs[kl]);
      s[kb][i] = v;
      mx = fmaxf(mx, v);
    }
  mx = fmaxf(mx, __shfl_xor(mx, 32));
  float alpha = ex2(m - mx);
  m = mx;
  float psum = 0.f;
#pragma unroll
  for (int kb = 0; kb < 2; ++kb)
#pragma unroll
    for (int i = 0; i < 16; ++i) {
      float pv = ex2(s[kb][i] - mx);
      s[kb][i] = pv;
      psum += pv;
    }
  l = l * alpha + psum;
  ph(0, s[0]);
  ph(1, s[1]);
  if (PV) {
    if (__builtin_amdgcn_ballot_w64(alpha != 1.f) != 0ull) {
#pragma unroll
      for (int d = 0; d < 4; ++d)
#pragma unroll
        for (int i = 0; i < 16; ++i) o[d][i] *= alpha;
    }
#pragma unroll
    for (int st = 0; st < 4; ++st) {
      const int kb = st >> 1, s2 = st & 1;
      uint4 pu;
      pu.x = pack2(s[kb][8 * s2 + 0], s[kb][8 * s2 + 1]);
      pu.y = pack2(s[kb][8 * s2 + 2], s[kb][8 * s2 + 3]);
      pu.z = pack2(s[kb][8 * s2 + 4], s[kb][8 * s2 + 5]);
      pu.w = pack2(s[kb][8 * s2 + 6], s[kb][8 * s2 + 7]);
      bf16x8 pf = __builtin_bit_cast(bf16x8, pu);
#pragma unroll
      for (int d = 0; d < 4; ++d) {
        const bf16* vp = Vs + (d * 32 + r) * 68 + st * 16 + 4 * h;
        uint2 lo = *(const uint2*)vp;
        uint2 hi = *(const uint2*)(vp + 8);
        uint4 vu = make_uint4(lo.x, lo.y, hi.x, hi.y);
        bf16x8 vf = __builtin_bit_cast(bf16x8, vu);
        o[d] = MFMA32(vf, pf, o[d]);
      }
    }
  }
}

template <int DK, int FM>
DI void attn_tile_c(const bf16x8 (&qf)[DK / 16], f32x16 (&o)[4], float& m, float& l, const char* smem, float sc, float c) {
  const int lane = otid() & 63, r = lane & 31, h = lane >> 5;
  const bf16* Ks = (const bf16*)smem;
  const bf16* Vs = (const bf16*)(smem + AT_VS);
  const float* auxs = (const float*)(smem + AT_AUX);
  f32x16 s0, s1;
#pragma unroll
  for (int i = 0; i < 16; ++i) { s0[i] = 0.f; s1[i] = 0.f; }
#pragma unroll
  for (int ks = 0; ks < DK / 16; ++ks) {
    bf16x8 a = *(const bf16x8*)(Ks + r * (DK + 8) + ks * 16 + h * 8);
    s0 = MFMA32(a, qf[ks], s0);
  }
#pragma unroll
  for (int ks = 0; ks < DK / 16; ++ks) {
    bf16x8 a = *(const bf16x8*)(Ks + (32 + r) * (DK + 8) + ks * 16 + h * 8);
    s1 = MFMA32(a, qf[ks], s1);
  }
  float mx;
  if (FM == 2) {
    mx = m;
#pragma unroll
    for (int i = 0; i < 16; ++i) {
      float v = __builtin_fmaf(s0[i], sc, -auxs[crow(i, h)]);
      s0[i] = v;
      mx = fmaxf(mx, v);
    }
  } else {
    float rm = s0[0];
#pragma unroll
    for (int i = 1; i < 16; ++i) rm = fmaxf(rm, s0[i]);
    mx = fmaxf(m, __builtin_fmaf(rm, sc, c));
  }
  mx = fmaxf(mx, __shfl_xor(mx, 32));
  const float alpha = ex2(m - mx);
  m = mx;
  const float off = c - mx;
#pragma unroll
  for (int d = 0; d < 4; ++d)
#pragma unroll
    for (int i = 0; i < 16; ++i) o[d][i] *= alpha;
  l *= alpha;
  float psum = 0.f;
#pragma unroll
  for (int i = 0; i < 16; ++i) {
    float pv = (FM == 2) ? ex2(s0[i] - mx) : ex2(__builtin_fmaf(s0[i], sc, off));
    s0[i] = pv;
    psum += pv;
  }
#pragma unroll
  for (int s2 = 0; s2 < 2; ++s2) {
    uint4 pu;
    pu.x = pack2(s0[8 * s2 + 0], s0[8 * s2 + 1]);
    pu.y = pack2(s0[8 * s2 + 2], s0[8 * s2 + 3]);
    pu.z = pack2(s0[8 * s2 + 4], s0[8 * s2 + 5]);
    pu.w = pack2(s0[8 * s2 + 6], s0[8 * s2 + 7]);
    bf16x8 pf = __builtin_bit_cast(bf16x8, pu);
#pragma unroll
    for (int d = 0; d < 4; ++d) {
      const bf16* vp = Vs + (d * 32 + r) * 68 + s2 * 16 + 4 * h;
      uint2 lo = *(const uint2*)vp;
      uint2 hi = *(const uint2*)(vp + 8);
      uint4 vu = make_uint4(lo.x, lo.y, hi.x, hi.y);
      o[d] = MFMA32(__builtin_bit_cast(bf16x8, vu), pf, o[d]);
    }
  }
#pragma unroll
  for (int i = 0; i < 16; ++i) {
    float pv;
    if (FM == 2) pv = ex2(__builtin_fmaf(s1[i], sc, -auxs[32 + crow(i, h)]) - mx);
    else pv = ex2(__builtin_fmaf(s1[i], sc, off));
    s1[i] = pv;
    psum += pv;
  }
  l += psum;
#pragma unroll
  for (int s2 = 0; s2 < 2; ++s2) {
    uint4 pu;
    pu.x = pack2(s1[8 * s2 + 0], s1[8 * s2 + 1]);
    pu.y = pack2(s1[8 * s2 + 2], s1[8 * s2 + 3]);
    pu.z = pack2(s1[8 * s2 + 4], s1[8 * s2 + 5]);
    pu.w = pack2(s1[8 * s2 + 6], s1[8 * s2 + 7]);
    bf16x8 pf = __builtin_bit_cast(bf16x8, pu);
#pragma unroll
    for (int d = 0; d < 4; ++d) {
      const bf16* vp = Vs + (d * 32 + r) * 68 + (2 + s2) * 16 + 4 * h;
      uint2 lo = *(const uint2*)vp;
      uint2 hi = *(const uint2*)(vp + 8);
      uint4 vu = make_uint4(lo.x, lo.y, hi.x, hi.y);
      o[d] = MFMA32(__builtin_bit_cast(bf16x8, vu), pf, o[d]);
    }
  }
}

struct NoHook { DI void operator()(int, const f32x16&) const {} };

template <int DK, bool PV, bool PF, class Ctx>
DI void attn_run(const bf16x8 (&qf)[DK / 16], f32x16 (&o)[4], float& m, float& l, const bf16* K1, int ldk1,
                 const bf16* K2, int ldk2, const bf16* Vt, int ldv, int first, Ctx& ctx, char* smem) {
  const int tid = otid();
  int tcur = first;
  if (tcur < 0) return;
  constexpr int CPR = DK / 8;
  constexpr int NKC = DK / 32;
  uint4 rk0, rk1, rk2, rk3, rk4 = make_uint4(0, 0, 0, 0), rk5 = make_uint4(0, 0, 0, 0), rv[4];
  float raux;
  bf16* Ks = (bf16*)smem;
  bf16* Vs = (bf16*)(smem + AT_VS);
  auto ldk = [&](int i, int key0) -> uint4 {
    int c = otid() + 256 * i;
    int row = c / CPR, cc = c % CPR;
    const bf16* src;
    if (DK == 128 || cc < 16) src = K1 + (size_t)(key0 + row) * ldk1 + cc * 8;
    else src = K2 + (size_t)(key0 + row) * ldk2 + (cc - 16) * 8;
    return *(const uint4*)src;
  };
  auto stk = [&](int i, const uint4& v) {
    int c = tid + 256 * i;
    int row = c / CPR, cc = c % CPR;
    *(uint4*)(Ks + row * (DK + 8) + cc * 8) = v;
  };
  auto gload = [&](int key0) {
    rk0 = ldk(0, key0); rk1 = ldk(1, key0); rk2 = ldk(2, key0); rk3 = ldk(3, key0);
    if (NKC > 4) { rk4 = ldk(4, key0); rk5 = ldk(5, key0); }
    const int tl = otid();
#pragma unroll
    for (int i = 0; i < 4; ++i) {
      int c = tl + 256 * i;
      int d = c >> 3, cc = c & 7;
      rv[i] = *(const uint4*)(Vt + (size_t)d * ldv + key0 + cc * 8);
    }
    raux = (tid < 64) ? ctx.aux(key0 + tid) : 0.f;
  };
  auto sstore = [&]() {
    stk(0, rk0); stk(1, rk1); stk(2, rk2); stk(3, rk3);
    if (NKC > 4) { stk(4, rk4); stk(5, rk5); }
#pragma unroll
    for (int i = 0; i < 4; ++i) {
      int c = tid + 256 * i;
      int d = c >> 3, cc = c & 7;
      uint2* dst = (uint2*)(Vs + d * 68 + cc * 8);
      dst[0] = make_uint2(rv[i].x, rv[i].y);
      dst[1] = make_uint2(rv[i].z, rv[i].w);
    }
    if (tid < 64) ((float*)(smem + AT_AUX))[tid] = raux;
  };
  if (PF) gload(tcur * 64);
  while (tcur >= 0) {
    __syncthreads();
    if (!PF) gload(tcur * 64);
    sstore();
    __syncthreads();
    int tnext = ctx.next(tcur);
    if (PF && tnext >= 0) gload(tnext * 64);
    if (!ctx.skip(tcur)) {
      const int tc = tcur;
      if (Ctx::FMODE != 0 && (Ctx::ALWAYS_FAST || ctx.fast(tc))) {
        attn_tile_c<DK, (Ctx::FMODE == 2 ? 2 : 1)>(qf, o, m, l, smem, ctx.sc, ctx.fconst(tc));
      } else if (!Ctx::ALWAYS_FAST) {
        attn_tile<DK, PV>(qf, o, m, l, smem,
                          [&](float s, int kl, float ax) { return ctx.score(s, tc * 64 + kl, ax, tc); },
                          [&](int kb, const f32x16& pt) { ctx.hook(kb, pt, tc); });
      }
    }
    tcur = tnext;
  }
}

template <int DK>
DI void load_q(bf16x8 (&qf)[DK / 16], const bf16* qrow, int h) {
#pragma unroll
  for (int ks = 0; ks < DK / 16; ++ks) qf[ks] = *(const bf16x8*)(qrow + ks * 16 + h * 8);
}
DI void zero_o(f32x16 (&o)[4]) {
#pragma unroll
  for (int d = 0; d < 4; ++d)
#pragma unroll
    for (int i = 0; i < 16; ++i) o[d][i] = 0.f;
}

struct CtxCausal {
  int tq, q0w, last; float sc;
  DI int next(int t) const { return t + 1 <= last ? t + 1 : -1; }
  DI float aux(int) const { return 0.f; }
  DI bool skip(int t) const { return t * 64 > q0w + 31; }
  DI float score(float s, int key, float, int) const { return key <= tq ? s * sc : NEG; }
  static constexpr int FMODE = 1;
  static constexpr bool ALWAYS_FAST = false;
  DI bool fast(int t) const { return t * 64 + 63 <= q0w; }
  DI float fconst(int) const { return 0.f; }
  DI void hook(int, const f32x16&, int) const {}
};
struct CtxFox {
  int tq, q0w, last; float sc; const float* cuml; const float* cpre;
  DI int next(int t) const { return t + 1 <= last ? t + 1 : -1; }
  DI float aux(int key) const { return (cuml[key] + cpre[key >> 7]) * LOG2E; }
  DI bool skip(int t) const { return t * 64 > q0w + 31; }
  DI float score(float s, int key, float ax, int) const { return key <= tq ? s * sc - ax : NEG; }
  static constexpr int FMODE = 2;
  static constexpr bool ALWAYS_FAST = false;
  DI bool fast(int t) const { return t * 64 + 63 <= q0w; }
  DI float fconst(int) const { return 0.f; }
  DI void hook(int, const f32x16&, int) const {}
};
struct CtxMem {
  float sc;
  DI int next(int t) const { return t + 1 < 4 ? t + 1 : -1; }
  DI float aux(int) const { return 0.f; }
  DI bool skip(int) const { return false; }
  DI float score(float s, int, float, int) const { return s * sc; }
  static constexpr int FMODE = 1;
  static constexpr bool ALWAYS_FAST = true;
  DI bool fast(int) const { return true; }
  DI float fconst(int) const { return 0.f; }
  DI void hook(int, const f32x16&, int) const {}
};

DI void store_out_A(const f32x16 (&o)[4], float inv_l, const bf16* grow, bf16* orow, int h) {
#pragma unroll
  for (int d = 0; d < 4; ++d)
#pragma unroll
    for (int i4 = 0; i4 < 4; ++i4) {
      int dv0 = d * 32 + 8 * i4 + 4 * h;
      uint2 gu = *(const uint2*)(grow + dv0);
      float g0 = bflo(gu.x), g1 = bfhi(gu.x), g2 = bflo(gu.y), g3 = bfhi(gu.y);
      uint2 ou;
      ou.x = pack2(o[d][4 * i4 + 0] * inv_l * silu(g0), o[d][4 * i4 + 1] * inv_l * silu(g1));
      ou.y = pack2(o[d][4 * i4 + 2] * inv_l * silu(g2), o[d][4 * i4 + 3] * inv_l * silu(g3));
      *(uint2*)(orow + dv0) = ou;
    }
}

        struct CtxCmp {
          int tq, posq, last; float sc; const float* lutr; const int* pos; float invl; float* imp; int ql; bool p2;
          DI int next(int t) const { return t + 1 <= last ? t + 1 : -1; }
          DI float aux(int key) const { int n = key < 511 ? key : 510; return __int_as_float(pos[16 * n + 31]); }
          DI bool skip(int) const { return false; }
          DI float score(float s, int key, float ax, int) const {
            bool valid = (16 * key + 31 <= tq) && key < 511;
            int d = posq - __float_as_int(ax);
            d = d < 0 ? 0 : (d > 799 ? 799 : d);
            return valid ? s * sc + lutr[d] : NEG;
          }
          static constexpr int FMODE = 0;
          static constexpr bool ALWAYS_FAST = false;
          DI bool fast(int) const { return false; }
          DI float fconst(int) const { return 0.f; }
          DI void hook(int kb, const f32x16& pt, int tc) const {
            if (!p2) return;
            const int lane = otid() & 63, h = lane >> 5, r = lane & 31;
#pragma unroll
            for (int gq = 0; gq < 4; ++gq) {
              float p3 = 0.5f * pt[4 * gq + 3];
              float vm = (pt[4 * gq] + pt[4 * gq + 1] + pt[4 * gq + 2] + p3) * invl;
              float vs = p3 * invl;
              vm += __shfl_xor(vm, 8); vm += __shfl_xor(vm, 16);
              vs += __shfl_xor(vs, 8); vs += __shfl_xor(vs, 16);
              int j = tc * 16 + kb * 8 + 2 * gq + h;
              if (r < 8) { atomicAdd(&imp[ql * 132 + j], vm); atomicAdd(&imp[ql * 132 + j + 1], vs); }
            }
          }
        };
struct CtxSlc {
  int tq, posq; float sc; const float* lutr; const int* pos; unsigned long long ulo, uhi, mlo, mhi;
  const int* posmax; int pqmin, q0;
  DI bool farj(int j) const { return (j * 64 + 63 < q0) && (pqmin - posmax[j] >= 799); }
  DI bool inu(int j) const {
    unsigned long long a = (ulo >> (j & 63)) & (j < 64 ? 1ull : 0ull);
    unsigned long long b = (uhi >> (j & 63)) & (j >= 64 ? 1ull : 0ull);
    return (a | b) != 0ull;
  }
  DI bool mine(int j) const {
    unsigned long long a = (mlo >> (j & 63)) & (j < 64 ? 1ull : 0ull);
    unsigned long long b = (mhi >> (j & 63)) & (j >= 64 ? 1ull : 0ull);
    return (a | b) != 0ull;
  }
  DI int next(int t) const { for (int j = t + 1; j < 128; ++j) if (inu(j) && !farj(j)) return j; return -1; }
  DI float aux(int key) const { return __int_as_float(pos[key]); }
  DI bool skip(int t) const { return __builtin_amdgcn_ballot_w64(mine(t)) == 0ull; }
  DI float score(float s, int key, float ax, int t) const {
    bool valid = mine(t) && key <= tq;
    int d = posq - __float_as_int(ax);
    d = d < 0 ? 0 : (d > 799 ? 799 : d);
    return valid ? s * sc + lutr[d] : NEG;
  }
  static constexpr int FMODE = 0;
  static constexpr bool ALWAYS_FAST = false;
  DI bool fast(int) const { return false; }
  DI float fconst(int) const { return 0.f; }
  DI void hook(int, const f32x16&, int) const {}
};
struct CtxSlcFar {
  float sc, bfar; unsigned long long ulo, uhi, mlo, mhi; const int* posmax; int pqmin, q0;
  DI bool farj(int j) const { return (j * 64 + 63 < q0) && (pqmin - posmax[j] >= 799); }
  DI bool inu(int j) const {
    unsigned long long a = (ulo >> (j & 63)) & (j < 64 ? 1ull : 0ull);
    unsigned long long b = (uhi >> (j & 63)) & (j >= 64 ? 1ull : 0ull);
    return (a | b) != 0ull;
  }
  DI bool mine(int j) const {
    unsigned long long a = (mlo >> (j & 63)) & (j < 64 ? 1ull : 0ull);
    unsigned long long b = (mhi >> (j & 63)) & (j >= 64 ? 1ull : 0ull);
    return (a | b) != 0ull;
  }
  DI int next(int t) const { for (int j = t + 1; j < 128; ++j) if (inu(j) && farj(j)) return j; return -1; }
  DI float aux(int) const { return 0.f; }
  DI bool skip(int t) const { return __builtin_amdgcn_ballot_w64(mine(t)) == 0ull; }
  DI float score(float s, int, float, int t) const { return mine(t) ? s * sc + bfar : NEG; }
  static constexpr int FMODE = 1;
  static constexpr bool ALWAYS_FAST = true;
  DI bool fast(int) const { return true; }
  DI float fconst(int t) const { return mine(t) ? bfar : NEG; }
  DI void hook(int, const f32x16&, int) const {}
};
struct CtxWin {
  int tq, posq, last; float sc; const float* lutr; const int* pos;
  DI int next(int t) const { return t + 1 <= last ? t + 1 : -1; }
  DI float aux(int key) const { return __int_as_float(pos[key]); }
  DI bool skip(int) const { return false; }
  DI float score(float s, int key, float ax, int) const {
    bool valid = key <= tq && (tq - key) < 512;
    int d = posq - __float_as_int(ax);
    d = d < 0 ? 0 : (d > 799 ? 799 : d);
    return valid ? s * sc + lutr[d] : NEG;
  }
  static constexpr int FMODE = 0;
  static constexpr bool ALWAYS_FAST = false;
  DI bool fast(int) const { return false; }
  DI float fconst(int) const { return 0.f; }
  DI void hook(int, const f32x16&, int) const {}
};

DI int cvt_next_count(const Params& p, int nl) {
      const bool ne = (nl & 1) == 0;
      const int nli = nl >> 1;
      return cvt_set_count(p, ne ? SET_IN_EVEN : SET_IN_ODD, nli) + cvt_set_count(p, SET_MEM, nl) +
             cvt_set_count(p, ne ? SET_MISC_EVEN : SET_MISC_ODD, nli) + (ne ? 16 : 32);
}
DI void cvt_next(const Params& p, char* smem, int nl, int t) {
  char* ws = p.ws;
      const bool ne = (nl & 1) == 0;
      const int nli = nl >> 1;
      const int s0 = ne ? SET_IN_EVEN : SET_IN_ODD, s2 = ne ? SET_MISC_EVEN : SET_MISC_ODD;
      const int c0 = cvt_set_count(p, s0, nli), c1 = cvt_set_count(p, SET_MEM, nl), c2 = cvt_set_count(p, s2, nli);
      if (t < c0) cvt_set_task(p, s0, nli, t, smem);
      else if (t < c0 + c1) cvt_set_task(p, SET_MEM, nl, t - c0, smem);
      else if (t < c0 + c1 + c2) cvt_set_task(p, s2, nli, t - c0 - c1, smem);
      else {
            const int tid = otid();
            int e = t - c0 - c1 - c2;
            if (ne) {
              float* S5P = (float*)(ws + WS_S5P);
              int gp = e * 256 + tid;
              int g = gp >> 6;
              float dt = expf(p.log_dt[nli * 64 + g]);
              float lr = p.lam_re[nli * 4096 + gp], lim = p.lam_im[nli * 4096 + gp];
              float mag = expf(lr * dt);
              float abr = mag * cosf(lim * dt), abi = mag * sinf(lim * dt);
              float den = lr * lr + lim * lim;
              float nr = abr - 1.f;
              float fre = (nr * lr + abi * lim) / den;
              float fim = (abi * lr - nr * lim) / den;
              S5P[gp] = abr;
              S5P[4096 + gp] = abi;
              float ar = abr, ai = abi;
#pragma unroll
              for (int q = 0; q < 7; ++q) { float nr2 = ar * ar - ai * ai; ai = 2.f * ar * ai; ar = nr2; }
              S5P[8192 + gp] = ar;
              S5P[12288 + gp] = ai;
              const float* br = p.b_re + (size_t)nli * 65536 + gp * 16;
              const float* bi = p.b_im + (size_t)nli * 65536 + gp * 16;
#pragma unroll
              for (int c = 0; c < 16; ++c) {
                S5P[16384 + gp * 16 + c] = fre * br[c] - fim * bi[c];
                S5P[16384 + 65536 + gp * 16 + c] = fre * bi[c] + fim * br[c];
              }
            } else {
              int which = e >> 4, part = e & 15;
              const float* pe = p.cmp_pe + (size_t)(nli * 2 + which) * 4096 + part * 256;
              const float* w1 = p.cmp_w1 + ((size_t)(nli * 2 + which) * 4096 + part * 256) * 256 + tid;
              float acc = 0.f;
#pragma unroll 8
              for (int k = 0; k < 256; ++k) acc += pe[k] * w1[(size_t)k * 256];
              ((float*)(ws + WS_CMPB))[(which * 16 + part) * 256 + tid] = acc;
            }
      }
}

#define XB_TMO      128
#define XB_XCNT(j)  (256  + 64 * (j))
#define XB_XSUB(j)  (1280 + 64 * (j))
#define XB_XGEN(j)  (2304 + 64 * (j))
#define XB_TOP      3328
#define XB_TOPGEN   3392
#define XCD_BAR_WORDS 3456
#define XB_SPIN_CAP (1u << 18)
#define LAS __attribute__((address_space(3)))

__device__ __forceinline__ unsigned xb_ld(unsigned* p)              { return __hip_atomic_load(p, __ATOMIC_RELAXED, __HIP_MEMORY_SCOPE_AGENT); }
__device__ __forceinline__ unsigned xb_add(unsigned* p, unsigned v) { return __hip_atomic_fetch_add(p, v, __ATOMIC_RELAXED, __HIP_MEMORY_SCOPE_AGENT); }
__device__ __forceinline__ unsigned xb_xcc_id() { return (unsigned)__builtin_amdgcn_s_getreg((3 << 11) | 20) & 0xFu; }
#define XB_SPIN(cond, bar) do { unsigned _sp = 0; while (cond) { __builtin_amdgcn_s_sleep(1); \
    if ((++_sp & 255u) == 0u) { if (xb_ld(&(bar)[XB_TMO])) break; if (_sp > XB_SPIN_CAP) { atomicAdd(&(bar)[XB_TMO], 1u); break; } } } } while (0)

struct XcdBarrier {
    unsigned* bar; unsigned x;
    volatile LAS unsigned* st;
};

__device__ __forceinline__ XcdBarrier xcd_barrier_post(unsigned* bar, volatile LAS unsigned* st) {
    XcdBarrier b; b.bar = bar; b.x = xb_xcc_id(); b.st = st;
    if (threadIdx.x == 0) (void)xb_add(&bar[XB_XCNT(b.x)], 1u);
    return b;
}
__device__ __forceinline__ void xcd_barrier_complete(unsigned* bar, unsigned x, unsigned& nloc, unsigned& nx) {
    const unsigned G = gridDim.x * gridDim.y * gridDim.z;
    unsigned sum, cnt, mine, sp = 0u;
    for (;;) {
        sum = 0u; cnt = 0u; mine = 0u;
#pragma unroll
        for (unsigned j = 0; j < 16; ++j) { const unsigned c = xb_ld(&bar[XB_XCNT(j)]); sum += c; cnt += (c > 0u) ? 1u : 0u; mine = (j == x) ? c : mine; }
        if (sum == G) break;
        __builtin_amdgcn_s_sleep(1);
        if ((++sp & 255u) == 0u) { if (xb_ld(&bar[XB_TMO])) break; if (sp > XB_SPIN_CAP) { atomicAdd(&bar[XB_TMO], 1u); break; } }
    }
    nloc = mine > 0u ? mine : 1u; nx = cnt > 0u ? cnt : 1u;
}

__device__ __forceinline__ void xcd_barrier(const XcdBarrier& b) {
    asm volatile("s_waitcnt vmcnt(0)" ::: "memory");
    __syncthreads();
    if (threadIdx.x == 0) {
        unsigned* bar = b.bar;
        __builtin_amdgcn_s_waitcnt(0);
        unsigned nloc = b.st[0], nx = b.st[1];
        if (nloc == 0u) { xcd_barrier_complete(bar, b.x, nloc, nx); b.st[0] = nloc; b.st[1] = nx; }
        const unsigned old = xb_add(&bar[XB_XSUB(b.x)], 1u);
        const unsigned gen = old / nloc;
        if (old + 1u == (gen + 1u) * nloc) {
            __builtin_amdgcn_fence(__ATOMIC_RELEASE, "agent");
            asm volatile("s_waitcnt vmcnt(0)" ::: "memory");
            const unsigned og = xb_add(&bar[XB_TOP], 1u);
            const unsigned tg = og / nx;
            if (og + 1u == (tg + 1u) * nx) xb_add(&bar[XB_TOPGEN], 1u);
            else XB_SPIN(xb_ld(&bar[XB_TOPGEN]) == tg, bar);
            __builtin_amdgcn_fence(__ATOMIC_ACQUIRE, "agent");
            xb_add(&bar[XB_XGEN(b.x)], 1u);
            asm volatile("s_waitcnt vmcnt(0)" ::: "memory");
        } else {
            XB_SPIN(xb_ld(&bar[XB_XGEN(b.x)]) == gen, bar);
            __builtin_amdgcn_fence(__ATOMIC_ACQUIRE, "agent");
            asm volatile("s_waitcnt vmcnt(0)" ::: "memory");
        }
    }
    __syncthreads();
}


__global__ void __launch_bounds__(256, LB2) mega(Params p, int ph_lo, int ph_hi) {
  __shared__ __attribute__((aligned(16))) char smem[SM_TOTAL];
  __shared__ int s_task;
  __shared__ uint4 xb_words;
  if (threadIdx.x == 0) xb_words = make_uint4(0u, 0u, 0u, 0u);
  __syncthreads();
  (void)xcd_barrier_post((unsigned*)(p.ws + WS_BAR), (volatile LAS unsigned*)&xb_words);
  const int bid = blockIdx.x, nb = gridDim.x;

  for (int ph = ph_lo; ph <= ph_hi; ++ph) {
    if (ph > ph_lo) {
      if (ph == ph_lo + 1) cg::this_grid().sync();
      else {
        XcdBarrier xb2;
        xb2.bar = (unsigned*)(((const Params*)__builtin_amdgcn_kernarg_segment_ptr())->ws + WS_BAR);
        xb2.x = xb_xcc_id();
        xb2.st = (volatile LAS unsigned*)&xb_words;
        xcd_barrier(xb2);
      }
    }
    const int nrep = (REP_PH >= 0 && ph == REP_PH) ? 2 : 1;
    for (int rep = 0; rep < nrep; ++rep) {
    if (rep) cg::this_grid().sync();
    const int tid = otid(), lane = tid & 63, w = tid >> 6, r = lane & 31, h = lane >> 5;
    const int vb = (bid & 7) * (nb >> 3) + (bid >> 3);
    int zoff_;
    asm volatile("s_mov_b32 %0, 0" : "=s"(zoff_));
    const Params& p = *(const Params*)((const char*)__builtin_amdgcn_kernarg_segment_ptr() + zoff_);
    char* ws = p.ws;
    char* const ws_ph = ws;
    bf16* XN = (bf16*)(ws + WS_XN);
    bf16* P = (bf16*)(ws + WS_P);
    bf16* MIXED = (bf16*)(ws + WS_MIXED);
    float* ROPEC = (float*)(ws + WS_ROPEC);
    float* ROPES = (float*)(ws + WS_ROPES);
    float* hbuf = p.out;
    int* CTR = (int*)(ws + WS_CTR);
    auto fetch_task = [&](int* ctr) {
      __syncthreads();
      if (tid == 0) s_task = atomicAdd(ctr, 1);
      __syncthreads();
      return s_task;
    };
    const int layer = ph == 0 ? 0 : (ph - 1) / 6;
    const int sub = ph == 0 ? -1 : (ph - 1) % 6;
    const bool even = (layer & 1) == 0;
    const int li = layer >> 1;
    const int NP = even ? NPE : NPO;

    if ((PHM & 1) && (ph == 0 || sub == 5)) {
      if (ph == 0) {
        if (bid == 0) { CTR[tid] = 0; CTR[256 + tid] = 0; }
        if (bid == 1 % nb && tid < 128) {
          int mx = p.pos[tid * 64];
          for (int q = 1; q < 64; ++q) mx = max(mx, p.pos[tid * 64 + q]);
          ((int*)(ws + WS_POSMAX))[tid] = mx;
        }
        for (int i = bid * 256 + tid; i < L * 32; i += nb * 256) {
          int t = i >> 5, f = i & 31;
          float inv = powf(10000.f, -(float)f / 32.f);
          float ang = (float)p.pos[t] * inv;
          ROPEC[i] = cosf(ang);
          ROPES[i] = sinf(ang);
        }
        for (int row = bid * 4 + w; row < 256; row += nb * 4)
          norm_row_bf16(p.mem + (size_t)row * DM, p.mem_norm_g, (bf16*)(ws + WS_MEMN) + (size_t)row * DM, lane);
      }
      const int nl = ph == 0 ? 0 : layer + 1;
      if (nl < 4) {
        const float* src = ph == 0 ? p.x : hbuf;
        const bool ownr = (nb & 7) == 0;
        for (int rr = ownr ? (bid >> 3) * 4 + w : bid * 4 + w; rr < (ownr ? L / 8 : L); rr += ownr ? (nb >> 3) * 4 : nb * 4) {
          const int row = ownr ? (bid & 7) * (L / 8) + rr : rr;
          norm_row_bf16(src + (size_t)row * DM, p.norm_g + nl * DM, XN + (size_t)row * LDX, lane);
        }
      } else {
        for (int row = bid * 4 + w; row < L; row += nb * 4) norm_row_f32(hbuf + (size_t)row * DM, p.final_norm_g, lane);
      }
    }
    if ((PHM & 4) && sub == 0) {
      const int ntn = (NP / 128 + 1) / 2;
      const int n_in = 64 * ntn;
      const bf16* Win = (const bf16*)(ws + WS_WIN);
      const bool own = (nb & 7) == 0;
      const int per_g = 8 * ntn, nloc = nb >> 3;
      const int u_end = own ? per_g + 2 : n_in + 16;
      for (int u = own ? (bid >> 3) : vb; u < u_end; u += own ? nloc : nb) {
        const int t = own ? (u < per_g ? (bid & 7) * per_g + u : n_in + (bid & 7) * 2 + (u - per_g)) : u;
        if (t < n_in) {
          int tm, tn;
          tile_map(t, ntn, tm, tn);
          const int m0 = tm * 128;
          int n0 = tn * 256;
          const int nhalf = (n0 + 128 < NP) ? 2 : 1;
          ALin af{XN + (size_t)m0 * LDX, LDX};
          if (even) {
            gemm_tile2(af, Win + (size_t)n0 * LDX, LDX, DM, smem, n0, nhalf, [&](const float* Cs) {
              if (n0 >= 4096 && n0 < 5120) {
                bf16* VT = (bf16*)(ws + WS_VTFOX);
                epi_cols(Cs, [&](int col, int r8, const float* v) {
                  *(uint4*)(VT + (size_t)(n0 - 4096 + col) * L + m0 + r8) = pack8(v);
                });
              } else if (n0 == 7168) {
                float* FL = (float*)(ws + WS_FLOG);
                for (int i = tid; i < 128 * 8; i += 256) {
                  int row = i >> 3, c = i & 7;
                  FL[(size_t)(m0 + row) * 8 + c] = Cs[row * 132 + c];
                }
              } else {
                epi_rows(Cs, [&](int row, int cc, const float* v) {
                  *(uint4*)(P + (size_t)(m0 + row) * NPE + n0 + cc) = pack8(v);
                });
              }
            });
          } else {
            gemm_tile2(af, Win + (size_t)n0 * LDX, LDX, DM, smem, n0, nhalf, [&](const float* Cs) {
              if (n0 == 3840 || n0 == 3968 || n0 == 4352 || n0 == 4480) {
                bf16* VT = (n0 < 4096) ? (bf16*)(ws + WS_VTSLC) + (size_t)(n0 - 3840) * L
                                       : (bf16*)(ws + WS_VTWIN) + (size_t)(n0 - 4352) * L;
                epi_cols(Cs, [&](int col, int r8, const float* v) {
                  *(uint4*)(VT + (size_t)col * L + m0 + r8) = pack8(v);
                });
              } else if (n0 == 6656) {
                epi_rope(Cs, 0, m0, ROPEC, ROPES, 1.f, [&](int row, int cl, const float* v) {
                  *(uint4*)(P + (size_t)(m0 + row) * NPO + 6656 + cl) = pack8(v);
                });
                float* GT = (float*)(ws + WS_FLOG);
                for (int i = tid; i < 128 * 24; i += 256) {
                  int row = i / 24, c = i % 24;
                  GT[(size_t)(m0 + row) * 24 + c] = Cs[row * 132 + 64 + c];
                }
              } else {
                epi_rows(Cs, [&](int row, int cc, const float* v) {
                  *(uint4*)(P + (size_t)(m0 + row) * NPO + n0 + cc) = pack8(v);
                });
              }
            });
          }
        } else {
          const int t2 = t - n_in;
          const int m0 = (t2 >> 3) * 128, n0 = (t2 & 7) * 128;
          ALin af{(const bf16*)(ws + WS_MEMN) + (size_t)m0 * DM, DM};
          gemm_tile(af, (const bf16*)(ws + WS_WMEM) + (size_t)n0 * DM, DM, DM, smem, [&](const float* Cs) {
            if (n0 < 512) {
              bf16* MK = (bf16*)(ws + WS_MEMK);
              epi_rows(Cs, [&](int row, int cc, const float* v) {
                *(uint4*)(MK + (size_t)(m0 + row) * 512 + n0 + cc) = pack8(v);
              });
            } else {
              bf16* MV = (bf16*)(ws + WS_MEMVT);
              epi_cols(Cs, [&](int col, int r8, const float* v) {
                *(uint4*)(MV + (size_t)(n0 - 512 + col) * 256 + m0 + r8) = pack8(v);
              });
            }
          });
        }
      }
    }

    if ((PHM & 4) && sub == 0) {
      const int cw = cvt_set_count(p, SET_OUT, layer), cw4 = (cw + 3) >> 2;
      for (;;) {
        const int t = fetch_task(CTR + 32 + ph);
        if (t >= cw4) break;
        for (int q = 0; q < 4; ++q) {
          const int ci = t * 4 + q;
          if (ci < cw) cvt_set_task(p, SET_OUT, layer, ci, smem);
        }
      }
    }
    auto mem_attn_task = [&](int t) {
      const int tid = otid(), lane = tid & 63, w = tid >> 6, r = lane & 31, h = lane >> 5;
      (void)tid;
      const int qt = t >> 2, head = t & 3;
      const int tq = qt * 128 + w * 32 + r;
      const int qcol = even ? 6144 : 5632, gcol = even ? 6656 : 6144;
      bf16x8 qf[8];
      load_q<128>(qf, P + (size_t)tq * NP + qcol + head * 128, h);
      f32x16 o[4];
      zero_o(o);
      float m = NEG, l = 0.f;
      CtxMem ctx{0.08838834764831845f * LOG2E};
      attn_run<128, true, true>(qf, o, m, l, (const bf16*)(ws + WS_MEMK) + head * 128, 512, nullptr, 0,
                          (const bf16*)(ws + WS_MEMVT) + (size_t)head * 128 * 256, 256, 0, ctx, smem);
      float lt = l + __shfl_xor(l, 32);
      store_out_A(o, 1.f / lt, P + (size_t)tq * NP + gcol + head * 128, MIXED + (size_t)tq * MIXW + 2048 + head * 128, h);
    };

    if ((PHM & 8) && sub == 1 && even) {
      const int cw = 0;
      const int n_s5 = 1024, n_cum = 64, n_mem = 256;
      for (int t = bid; t < n_mem + n_s5 + n_cum + cw; t += nb) {
        if (t < n_mem) {
          mem_attn_task(t);
        } else if (t < n_mem + n_s5) {
          const int t2 = t - n_mem;
          const int ch = t2 >> 4, gq = t2 & 15;
          float* us = (float*)smem;
          __syncthreads();
          for (int i = tid; i < 128 * 8; i += 256) {
            int tt = i >> 3, c8 = (i & 7) * 8;
            uint4 u = *(const uint4*)(P + (size_t)(ch * 128 + tt) * NPE + gq * 64 + c8);
            float* d = us + tt * 64 + c8;
            d[0] = bflo(u.x); d[1] = bfhi(u.x); d[2] = bflo(u.y); d[3] = bfhi(u.y);
            d[4] = bflo(u.z); d[5] = bfhi(u.z); d[6] = bflo(u.w); d[7] = bfhi(u.w);
          }
          __syncthreads();
          const float* S5P = (const float*)(ws + WS_S5P);
          const int gp = (gq * 4 + w) * 64 + lane;
          const float ar = S5P[gp], ai = S5P[4096 + gp];
          float bbr[16], bbi[16];
#pragma unroll
          for (int c = 0; c < 16; ++c) { bbr[c] = S5P[16384 + gp * 16 + c]; bbi[c] = S5P[16384 + 65536 + gp * 16 + c]; }
          float xr = 0.f, xi = 0.f;
          for (int tt = 0; tt < 128; ++tt) {
            const float* up = us + tt * 64 + w * 16;
            float bur = 0.f, bui = 0.f;
#pragma unroll
            for (int c = 0; c < 16; ++c) { float uv = up[c]; bur += bbr[c] * uv; bui += bbi[c] * uv; }
            float nxr = ar * xr - ai * xi + bur;
            float nxi = ar * xi + ai * xr + bui;
            xr = nxr; xi = nxi;
          }
          float2* E = (float2*)(ws + WS_S5E);
          E[(size_t)ch * 4096 + gp] = make_float2(xr, xi);
        } else if (t < n_mem + n_s5 + n_cum) {
          const int ch = t - n_mem - n_s5;
          const float* FL = (const float*)(ws + WS_FLOG);
          float* CUML = (float*)(ws + WS_CUML);
          float* CT = (float*)(ws + WS_CT);
#pragma unroll
          for (int hh = 0; hh < 2; ++hh) {
            const int head = w * 2 + hh;
            const float bf = p.fox_b_f[li * 8 + head];
            const int t0 = ch * 128 + lane * 2;
            float x0 = FL[(size_t)t0 * 8 + head] + bf, x1 = FL[(size_t)(t0 + 1) * 8 + head] + bf;
            float v0 = x0 >= 0.f ? -log1pf(expf(-x0)) : x0 - log1pf(expf(x0));
            float v1 = x1 >= 0.f ? -log1pf(expf(-x1)) : x1 - log1pf(expf(x1));
            float s = v0 + v1;
            float inc = s;
#pragma unroll
            for (int o = 1; o < 64; o <<= 1) {
              float n = __shfl_up(inc, o);
              if (lane >= o) inc += n;
            }
            float excl = inc - s;
            CUML[(size_t)head * L + t0] = excl + v0;
            CUML[(size_t)head * L + t0 + 1] = excl + v0 + v1;
            if (lane == 63) CT[head * 64 + ch] = inc;
          }
        } else {
          cvt_set_task(p, SET_OUT, layer, t - n_mem - n_s5 - n_cum, smem);
        }
      }
    }
    if ((PHM & 16) && sub == 2 && even) {
      const int n_fox = 512, n_s5 = 1024;
      for (int qd_ = 0; qd_ < 8; ++qd_) {
      const int xq_ = ((bid & 7) + qd_) & 7;
      for (;;) {
        const int i_ = fetch_task(CTR + 64 + ph * 8 + xq_);
        if (i_ >= 64 + 128) break;
        const int t = i_ < 64 ? i_ * 8 + xq_ : n_fox + (i_ - 64) * 8 + xq_;
        const int tid = otid(), lane = tid & 63, w = tid >> 6, r = lane & 31, h = lane >> 5;
        int zt_;
        asm volatile("s_mov_b32 %0, 0" : "=s"(zt_));
        char* const ws = ws_ph + zt_;
        if (t < n_fox) {
          const int qt = 63 - (t >> 3), head = t & 7;
          const int q0w = qt * 128 + w * 32, tq = q0w + r;
          float* cpre = (float*)(smem + AT_X0);
          __syncthreads();
          if (tid < 64) {
            const float v0 = ((const float*)(ws + WS_CT))[head * 64 + tid];
            float inc = v0;
#pragma unroll
            for (int of = 1; of < 64; of <<= 1) {
              float n = __shfl_up(inc, of);
              if (tid >= of) inc += n;
            }
            cpre[tid] = inc - v0;
          }
          __syncthreads();
          const float* cuml = (const float*)(ws + WS_CUML) + (size_t)head * L;
          bf16x8 qf[8];
          load_q<128>(qf, P + (size_t)tq * NPE + 2048 + head * 128, h);
          f32x16 o[4];
          zero_o(o);
          float m = NEG, l = 0.f;
          CtxFox ctx{tq, q0w, 2 * qt + 1, 0.08838834764831845f * LOG2E, cuml, cpre};
          attn_run<128, true, true>(qf, o, m, l, P + 3072 + head * 128, NPE, nullptr, 0,
                              (const bf16*)(ws + WS_VTFOX) + (size_t)head * 128 * L, L, 0, ctx, smem);
          float lt = l + __shfl_xor(l, 32);
          store_out_A(o, 1.f / lt, P + (size_t)tq * NPE + 5120 + head * 128, MIXED + (size_t)tq * MIXW + 1024 + head * 128, h);
        } else {
          const int t2 = t - n_fox;
          const int ch = t2 >> 4, gq = t2 & 15;
          float* us = (float*)smem;
          float* xs = (float*)(smem + 32768) + w * 16 * 132;
          __syncthreads();
          for (int i = tid; i < 128 * 8; i += 256) {
            int tt = i >> 3, c8 = (i & 7) * 8;
            uint4 u = *(const uint4*)(P + (size_t)(ch * 128 + tt) * NPE + gq * 64 + c8);
            float* d = us + tt * 64 + c8;
            d[0] = bflo(u.x); d[1] = bfhi(u.x); d[2] = bflo(u.y); d[3] = bfhi(u.y);
            d[4] = bflo(u.z); d[5] = bfhi(u.z); d[6] = bflo(u.w); d[7] = bfhi(u.w);
          }
          __syncthreads();
          const float* S5P = (const float*)(ws + WS_S5P);
          const int g = gq * 4 + w;
          const int gp = g * 64 + lane;
          const float ar = S5P[gp], ai = S5P[4096 + gp];
          const float atr = S5P[8192 + gp], ati = S5P[12288 + gp];
          float xr = 0.f, xi = 0.f;
          {
            const float2* E = (const float2*)(ws + WS_S5E) + gp;
#define CSTEP(e) { float nxr = atr * xr - ati * xi + e.x; float nxi = atr * xi + ati * xr + e.y; xr = nxr; xi = nxi; }
            int c = 0;
            for (; c + 8 <= ch; c += 8) {
              float2 e0 = E[(size_t)(c + 0) * 4096], e1 = E[(size_t)(c + 1) * 4096], e2 = E[(size_t)(c + 2) * 4096],
                     e3 = E[(size_t)(c + 3) * 4096], e4 = E[(size_t)(c + 4) * 4096], e5 = E[(size_t)(c + 5) * 4096],
                     e6 = E[(size_t)(c + 6) * 4096], e7 = E[(size_t)(c + 7) * 4096];
              CSTEP(e0) CSTEP(e1) CSTEP(e2) CSTEP(e3) CSTEP(e4) CSTEP(e5) CSTEP(e6) CSTEP(e7)
            }
            for (; c < ch; ++c) {
              float2 e = E[(size_t)c * 4096];
              CSTEP(e)
            }
#undef CSTEP
          }
          float bbr[16], bbi[16];
#pragma unroll
          for (int c = 0; c < 16; ++c) { bbr[c] = S5P[16384 + gp * 16 + c]; bbi[c] = S5P[16384 + 65536 + gp * 16 + c]; }
          const int chn = lane & 15, kq = lane >> 4;
          float cb[32];
          {
            const float* cre = p.c_re + ((size_t)li * 64 + g) * 1024 + chn * 64;
            const float* cim = p.c_im + ((size_t)li * 64 + g) * 1024 + chn * 64;
#pragma unroll
            for (int ks = 0; ks < 16; ++ks) { cb[ks] = cre[4 * ks + kq]; cb[16 + ks] = -cim[4 * ks + kq]; }
          }
          const float dsk = p.s5_d[li * 1024 + g * 16 + chn];
          bf16* Z = (bf16*)(ws + WS_Z);
          for (int sc = 0; sc < 8; ++sc) {
#pragma unroll 4
            for (int tt = 0; tt < 16; ++tt) {
              const float* up = us + (sc * 16 + tt) * 64 + w * 16;
              float bur = 0.f, bui = 0.f;
#pragma unroll
              for (int c = 0; c < 16; ++c) { float uv = up[c]; bur += bbr[c] * uv; bui += bbi[c] * uv; }
              float nxr = ar * xr - ai * xi + bur;
              float nxi = ar * xi + ai * xr + bui;
              xr = nxr; xi = nxi;
              xs[tt * 132 + lane] = xr;
              xs[tt * 132 + 64 + lane] = xi;
            }
            __syncthreads();
            f32x4 y = {0.f, 0.f, 0.f, 0.f};
#pragma unroll
            for (int ks = 0; ks < 32; ++ks) {
              float a = xs[chn * 132 + 4 * ks + kq];
              y = __builtin_amdgcn_mfma_f32_16x16x4f32(a, cb[ks], y, 0, 0, 0);
            }
#pragma unroll
            for (int i = 0; i < 4; ++i) {
              int tt = 4 * kq + i;
              float uv = us[(sc * 16 + tt) * 64 + w * 16 + chn];
              float yy = y[i] + dsk * uv;
              Z[(size_t)(ch * 128 + sc * 16 + tt) * LDZ + g * 16 + chn] = f2bf(gelu_t(yy));
            }
            __syncthreads();
          }
        }
      }
      }
    }
    if ((PHM & 32) && sub == 3 && even) {
      const bf16* Z = (const bf16*)(ws + WS_Z);
      for (int t = vb; t < 64 * 8; t += nb) {
        int tm, tn;
        tile_map(t, 8, tm, tn);
        const int m0 = tm * 128, n0 = tn * 128;
        ALin af{Z + (size_t)m0 * LDZ, LDZ};
        gemm_tile(af, (const bf16*)(ws + WS_WMISC + WM_GLU) + (size_t)n0 * LDZ, LDZ, 1024, smem, [&](const float* Cs) {
          epi_rows(Cs, [&](int row, int cc, const float* v) {
            uint4 zu = *(const uint4*)(Z + (size_t)(m0 + row) * LDZ + n0 + cc);
            uint4 gu = *(const uint4*)(P + (size_t)(m0 + row) * NPE + 1024 + n0 + cc);
            float zz[8] = {bflo(zu.x), bfhi(zu.x), bflo(zu.y), bfhi(zu.y), bflo(zu.z), bfhi(zu.z), bflo(zu.w), bfhi(zu.w)};
            float gg[8] = {bflo(gu.x), bfhi(gu.x), bflo(gu.y), bfhi(gu.y), bflo(gu.z), bfhi(gu.z), bflo(gu.w), bfhi(gu.w)};
            float o[8];
#pragma unroll
            for (int e = 0; e < 8; ++e) o[e] = zz[e] * sigm(v[e]) * silu(gg[e]);
            *(uint4*)(MIXED + (size_t)(m0 + row) * MIXW + n0 + cc) = pack8(o);
          });
        });
      }
    }
    if ((PHM & 64) && sub == 1 && !even) {
      const int cw = 0;
      const int n_c1 = 32, n_q = 64 * 12, n_kv = 64 * 16, n_mem = 256;
      float* rsx = (float*)(smem + SM_EXTRA);
      const bool split = (nb % 8 == 0) && nb >= 64;
      int t0, tstride;
      if (!split) { t0 = bid; tstride = nb; }
      else if (bid < n_c1) { t0 = bid; tstride = 1 << 28; }
      else { t0 = n_c1 + (bid & 7) * ((nb - n_c1) >> 3) + ((bid >> 3) - (n_c1 >> 3)); tstride = nb - n_c1; }
      for (int t = t0; t < n_c1 + n_q + n_kv + n_mem + cw; t += tstride) {
        if (t < n_c1) {
          const int which = t >> 4, tm = (t >> 1) & 7, tn = t & 1;
          const int m0 = tm * 128, n0 = tn * 128;
          __syncthreads();
          if (tid < 128) {
            const float* CB = (const float*)(ws + WS_CMPB) + which * 16 * 256 + n0 + tid;
            float b = 0.f;
            for (int q = 0; q < 16; ++q) b += CB[q * 256];
            rsx[tid] = b;
          }
          ACmp af{P + (which ? 3328 : 3072), m0};
          bf16* HID = (bf16*)(ws + WS_HID) + (size_t)which * 1024 * 256;
          gemm_tile(af, (const bf16*)(ws + WS_WMISC + WM_W1) + (size_t)which * 256 * 4096 + (size_t)n0 * 4096, 4096, 4096,
                    smem, [&](const float* Cs) {
                      epi_rows(Cs, [&](int row, int cc, const float* v) {
                        float o[8];
#pragma unroll
                        for (int e = 0; e < 8; ++e) o[e] = gelu_t(v[e] + rsx[cc + e]);
                        *(uint4*)(HID + (size_t)(m0 + row) * 256 + n0 + cc) = pack8(o);
                      });
                    });
        } else if (t < n_c1 + n_q + n_kv) {
          const int t2 = t - n_c1;
          const bool isq = t2 < n_q;
          const int t3 = isq ? t2 : t2 - n_q;
          const int ntn = isq ? 12 : 16;
          int tm, tn;
          tile_map(t3, ntn, tm, tn);
          const int m0 = tm * 128, n0 = tn * 128;
          const bf16* Ab = P + (size_t)m0 * NPO + (isq ? 0 : 512);
          __syncthreads();
          for (int r8 = 0; r8 < 4; ++r8) {
            float ssq[8];
#pragma unroll
            for (int q = 0; q < 8; ++q) {
              int row = w * 32 + r8 * 8 + q;
              uint4 u = *(const uint4*)(Ab + (size_t)row * NPO + lane * 8);
              float a0 = bflo(u.x), a1 = bfhi(u.x), a2 = bflo(u.y), a3 = bfhi(u.y), a4 = bflo(u.z), a5 = bfhi(u.z),
                    a6 = bflo(u.w), a7 = bfhi(u.w);
              ssq[q] = a0 * a0 + a1 * a1 + a2 * a2 + a3 * a3 + a4 * a4 + a5 * a5 + a6 * a6 + a7 * a7;
            }
#pragma unroll
            for (int q = 0; q < 8; ++q) {
              float ss = wave_sum(ssq[q]);
              if (lane == 0) rsx[w * 32 + r8 * 8 + q] = rsqrtf(ss * (1.f / 512.f) + EPS);
            }
          }
          ALin af{Ab, NPO};
          if (isq) {
            bf16* QM = (bf16*)(ws + WS_QMLA);
            gemm_tile(af, (const bf16*)(ws + WS_WMISC + WM_UQ) + (size_t)n0 * 512, 512, 512, smem, [&](const float* Cs) {
              const int md = n0 % 192;
              const int ropehalf = md == 128 ? 0 : (md == 64 ? 1 : -1);
              epi_rows(Cs, [&](int row, int cc, const float* v) {
                if ((cc >> 6) == ropehalf) return;
                float o[8];
                float sc = rsx[row];
#pragma unroll
                for (int e = 0; e < 8; ++e) o[e] = v[e] * sc;
                *(uint4*)(QM + (size_t)(m0 + row) * 1536 + n0 + cc) = pack8(o);
              });
              if (ropehalf >= 0) {
                epi_rope(Cs, ropehalf * 64, m0, ROPEC, ROPES, 1.f, [&](int row, int cl, const float* v) {
                  float o[8];
                  float sc = rsx[row];
#pragma unroll
                  for (int e = 0; e < 8; ++e) o[e] = v[e] * sc;
                  *(uint4*)(QM + (size_t)(m0 + row) * 1536 + n0 + ropehalf * 64 + cl) = pack8(o);
                });
              }
            });
          } else {
            gemm_tile(af, (const bf16*)(ws + WS_WMISC + WM_UKV) + (size_t)n0 * 512, 512, 512, smem, [&](const float* Cs) {
              const int head = n0 >> 8, part = (n0 >> 7) & 1;
              if (part == 0) {
                bf16* KM = (bf16*)(ws + WS_KMLA);
                epi_rows(Cs, [&](int row, int cc, const float* v) {
                  float o[8];
                  float sc = rsx[row];
#pragma unroll
                  for (int e = 0; e < 8; ++e) o[e] = v[e] * sc;
                  *(uint4*)(KM + (size_t)(m0 + row) * 1024 + head * 128 + cc) = pack8(o);
                });
              } else {
                bf16* VT = (bf16*)(ws + WS_VTMLA);
                epi_cols(Cs, [&](int col, int r8, const float* v) {
                  float o[8];
#pragma unroll
                  for (int e = 0; e < 8; ++e) o[e] = v[e] * rsx[r8 + e];
                  *(uint4*)(VT + (size_t)(head * 128 + col) * L + m0 + r8) = pack8(o);
                });
              }
            });
          }
        } else if (t < n_c1 + n_q + n_kv + n_mem) {
          mem_attn_task(t - n_c1 - n_q - n_kv);
        } else {
          cvt_set_task(p, SET_OUT, layer, t - n_c1 - n_q - n_kv - n_mem, smem);
        }
      }
    }
    if ((PHM & 128) && sub == 2 && !even) {
      const int n_c2 = 16, n_mem2 = 0;
      for (int t = bid; t < n_c2 + n_mem2; t += nb) {
        if (t >= n_c2) {
          mem_attn_task(t - n_c2);
        } else {
          const int t2 = t;
          const int which = t2 >> 3, m0 = (t2 & 7) * 128;
          ALin af{(const bf16*)(ws + WS_HID) + (size_t)which * 1024 * 256 + (size_t)m0 * 256, 256};
          gemm_tile(af, (const bf16*)(ws + WS_WMISC + WM_W2) + (size_t)which * 128 * 256, 256, 256, smem, [&](const float* Cs) {
            if (which == 0) {
              bf16* KC = (bf16*)(ws + WS_KC);
              epi_rows(Cs, [&](int row, int cc, const float* v) {
                int gr = m0 + row;
                int n = gr >> 1, g = gr & 1;
                *(uint4*)(KC + ((size_t)g * 512 + n) * 128 + cc) = pack8(v);
              });
            } else {
              bf16* VC = (bf16*)(ws + WS_VCT);
              for (int i = tid; i < 128 * 128; i += 256) {
                int row = i & 127, col = i >> 7;
                int gr = m0 + row;
                int n = gr >> 1, g = gr & 1;
                VC[((size_t)g * 128 + col) * 512 + n] = f2bf(Cs[row * 132 + col]);
              }
            }
          });
        }
      }
    }
    if ((PHM & 256) && sub == 3 && !even) {
      const int* pos = p.pos;
      float* lut = (float*)(smem + AT_X0);
      float* imp = (float*)(smem + AT_IMP);
      unsigned* sel = (unsigned*)(smem + AT_SEL);
      const float* GT = (const float*)(ws + WS_FLOG);
      float* NSAO = (float*)(ws + WS_NSAO);
      for (int qd_ = 0; qd_ < 8; ++qd_) {
      const int xq_ = ((bid & 7) + qd_) & 7;
      for (;;) {
        const int i_ = fetch_task(CTR + 64 + ph * 8 + xq_);
        if (i_ >= 128) break;
        const int tt_ = 2 * ((i_ >> 1) * 8 + xq_) + (i_ & 1);
        const int t = tt_ >> 1;
        const int tid = otid(), lane = tid & 63, w = tid >> 6, r = lane & 31, h = lane >> 5;
        int zt_;
        asm volatile("s_mov_b32 %0, 0" : "=s"(zt_));
        char* const ws = ws_ph + zt_;
        if ((tt_ & 1) == 0) {
          const int qt = 63 - (t >> 3), head = t & 7;
          const int q0w = qt * 128 + w * 32, tq = q0w + r;
          bf16x8 qf[12];
          load_q<192>(qf, (const bf16*)(ws + WS_QMLA) + (size_t)tq * 1536 + head * 192, h);
          f32x16 o[4];
          zero_o(o);
          float m = NEG, l = 0.f;
          CtxCausal ctx{tq, q0w, 2 * qt + 1, 0.07216878364870322f * LOG2E};
          attn_run<192, true, true>(qf, o, m, l, (const bf16*)(ws + WS_KMLA) + head * 128, 1024, P + 6656, NPO,
                              (const bf16*)(ws + WS_VTMLA) + (size_t)head * 128 * L, L, 0, ctx, smem);
          float lt = l + __shfl_xor(l, 32);
          store_out_A(o, 1.f / lt, P + (size_t)tq * NPO + 1024 + head * 128, MIXED + (size_t)tq * MIXW + head * 128, h);
          continue;
        }
        const int qt = 255 - (t >> 1), g = t & 1;
        const int q0 = qt * 32;
        const int hr = r >> 3, qi = r & 7;
        const int ql = w * 8 + qi;
        const int tq = q0 + ql;
        const int head = g * 4 + hr;
        const int posq = pos[tq];
        __syncthreads();
        for (int i = tid; i < 4 * 800; i += 256) {
          int rr = i / 800, n = i % 800;
          int b;
          if (n < 16) b = n;
          else {
            float lr = logf((float)n / 16.f) / 4.1588830833596715f;
            b = 16 + (int)(lr * 16.f);
            if (b > 31) b = 31;
          }
          lut[i] = p.t5[b * 8 + g * 4 + rr] * LOG2E;
        }
        for (int i = tid; i < 32 * 132; i += 256) imp[i] = 0.f;
        __syncthreads();
        const float* lutr = lut + hr * 800;
        bf16x8 qf[8];
        load_q<128>(qf, P + (size_t)tq * NPO + 2048 + head * 128, h);
        const float sc = 0.08838834764831845f * LOG2E;
        f32x16 o[4];
        float* orow = NSAO + (size_t)tq * 1024 + head * 128;

        const int ncv = min(q0 / 16 + 1, 511);
        const int last_c = (ncv - 1) >> 6;
        float m = NEG, l = 0.f;
        CtxCmp cc{tq, posq, last_c, sc, lutr, pos, 0.f, imp, ql, false};
        zero_o(o);
        const bf16* KCg = (const bf16*)(ws + WS_KC) + (size_t)g * 512 * 128;
        const bf16* VCg = (const bf16*)(ws + WS_VCT) + (size_t)g * 128 * 512;
        attn_run<128, false, false>(qf, o, m, l, KCg, 128, nullptr, 0, VCg, 512, 0, cc, smem);
        float lt = l + __shfl_xor(l, 32);
        const bool has_c = m > -1e29f;
        float m2 = has_c ? m : 0.f;
        float invl = has_c ? 1.f / lt : 0.f;
        cc.invl = invl; cc.p2 = true;
        float l2 = 0.f;
        attn_run<128, true, false>(qf, o, m2, l2, KCg, 128, nullptr, 0, VCg, 512, 0, cc, smem);
        {
          float gs = sigm(GT[(size_t)tq * 24 + head * 3 + 0]) * invl;
#pragma unroll
          for (int d = 0; d < 4; ++d)
#pragma unroll
            for (int i4 = 0; i4 < 4; ++i4) {
              int dv0 = d * 32 + 8 * i4 + 4 * h;
              float4 v = make_float4(o[d][4 * i4] * gs, o[d][4 * i4 + 1] * gs, o[d][4 * i4 + 2] * gs, o[d][4 * i4 + 3] * gs);
              *(float4*)(orow + dv0) = v;
            }
        }
        __syncthreads();
        for (int q8 = 0; q8 < 8; ++q8) {
          const int qq = w * 8 + q8;
          const int tt = q0 + qq;
          const int cur = tt >> 6;
          const float* ip = imp + qq * 132;
          const int j0 = lane, j1 = lane + 64;
          const bool v0 = j0 <= cur, v1 = j1 <= cur;
          const bool f0 = (j0 == 0) || (j0 == cur) || (j0 == cur - 1);
          const bool f1 = (j1 == cur) || (j1 == cur - 1);
          const int nforced = cur == 0 ? 1 : (cur == 1 ? 2 : 3);
          const int nfree = 16 - nforced;
          const bool c0 = v0 && !f0, c1 = v1 && !f1;
          const unsigned u0 = __float_as_uint(ip[j0]), u1 = __float_as_uint(ip[j1]);
          const int ncand = __popcll(__ballot(c0)) + __popcll(__ballot(c1));
          bool s0, s1;
          if (ncand <= nfree) {
            s0 = v0; s1 = v1;
          } else {
            unsigned T = 0u;
            for (int bit = 30; bit >= 0; --bit) {
              const unsigned cth = T | (1u << bit);
              const int cnt = __popcll(__ballot(c0 && u0 >= cth)) + __popcll(__ballot(c1 && u1 >= cth));
              if (cnt >= nfree) T = cth;
            }
            const bool g0 = c0 && u0 > T, g1 = c1 && u1 > T;
            const bool e0 = c0 && u0 == T, e1 = c1 && u1 == T;
            const unsigned long long me0 = __ballot(e0), me1 = __ballot(e1);
            const int need0 = nfree - (__popcll(__ballot(g0)) + __popcll(__ballot(g1)));
            const int need1 = need0 - __popcll(me0);
            const int rk0 = __builtin_amdgcn_mbcnt_hi((unsigned)(me0 >> 32), __builtin_amdgcn_mbcnt_lo((unsigned)me0, 0u));
            const int rk1 = __builtin_amdgcn_mbcnt_hi((unsigned)(me1 >> 32), __builtin_amdgcn_mbcnt_lo((unsigned)me1, 0u));
            s0 = (v0 && f0) || g0 || (e0 && rk0 < need0);
            s1 = (v1 && f1) || g1 || (e1 && rk1 < need1);
          }
          unsigned long long b0 = __ballot(s0), b1 = __ballot(s1);
          if (lane == 0) {
            sel[qq * 4 + 0] = (unsigned)b0; sel[qq * 4 + 1] = (unsigned)(b0 >> 32);
            sel[qq * 4 + 2] = (unsigned)b1; sel[qq * 4 + 3] = (unsigned)(b1 >> 32);
          }
        }
        __syncthreads();
        unsigned un0, un1, un2, un3;
        {
          un0 = sel[r * 4 + 0]; un1 = sel[r * 4 + 1]; un2 = sel[r * 4 + 2]; un3 = sel[r * 4 + 3];
#pragma unroll
          for (int of = 1; of < 32; of <<= 1) {
            un0 |= __shfl_xor(un0, of); un1 |= __shfl_xor(un1, of); un2 |= __shfl_xor(un2, of); un3 |= __shfl_xor(un3, of);
          }
          un0 = __builtin_amdgcn_readfirstlane(un0); un1 = __builtin_amdgcn_readfirstlane(un1);
          un2 = __builtin_amdgcn_readfirstlane(un2); un3 = __builtin_amdgcn_readfirstlane(un3);
        }
        {
          const unsigned long long ulo = (unsigned long long)un0 | ((unsigned long long)un1 << 32);
          const unsigned long long uhi = (unsigned long long)un2 | ((unsigned long long)un3 << 32);
          const unsigned long long mlo = (unsigned long long)sel[ql * 4] | ((unsigned long long)sel[ql * 4 + 1] << 32);
          const unsigned long long mhi = (unsigned long long)sel[ql * 4 + 2] | ((unsigned long long)sel[ql * 4 + 3] << 32);
          int pqmin = pos[q0];
          for (int q = 1; q < 32; ++q) pqmin = min(pqmin, pos[q0 + q]);
          const int* posmax = (const int*)(ws + WS_POSMAX);
          zero_o(o);
          m = NEG; l = 0.f;
          {
            CtxSlc cs{tq, posq, sc, lutr, pos, ulo, uhi, mlo, mhi, posmax, pqmin, q0};
            attn_run<128, true, false>(qf, o, m, l, P + 3584 + g * 128, NPO, nullptr, 0,
                                       (const bf16*)(ws + WS_VTSLC) + (size_t)g * 128 * L, L, cs.next(-1), cs, smem);
          }
          {
            CtxSlcFar cf{sc, lutr[799], ulo, uhi, mlo, mhi, posmax, pqmin, q0};
            attn_run<128, true, false>(qf, o, m, l, P + 3584 + g * 128, NPO, nullptr, 0,
                                       (const bf16*)(ws + WS_VTSLC) + (size_t)g * 128 * L, L, cf.next(-1), cf, smem);
          }
          lt = l + __shfl_xor(l, 32);
          float gs = sigm(GT[(size_t)tq * 24 + head * 3 + 1]) / lt;
#pragma unroll
          for (int d = 0; d < 4; ++d)
#pragma unroll
            for (int i4 = 0; i4 < 4; ++i4) {
              int dv0 = d * 32 + 8 * i4 + 4 * h;
              float4 v = *(float4*)(orow + dv0);
              v.x += o[d][4 * i4] * gs; v.y += o[d][4 * i4 + 1] * gs; v.z += o[d][4 * i4 + 2] * gs; v.w += o[d][4 * i4 + 3] * gs;
              *(float4*)(orow + dv0) = v;
            }
        }
        {
          const int kfirst = q0 - 511 > 0 ? (q0 - 511) >> 6 : 0;
          CtxWin cwn{tq, posq, (q0 + 31) >> 6, sc, lutr, pos};
          zero_o(o);
          m = NEG; l = 0.f;
          attn_run<128, true, false>(qf, o, m, l, P + 4096 + g * 128, NPO, nullptr, 0,
                              (const bf16*)(ws + WS_VTWIN) + (size_t)g * 128 * L, L, kfirst, cwn, smem);
          lt = l + __shfl_xor(l, 32);
          float gs = sigm(GT[(size_t)tq * 24 + head * 3 + 2]) / lt;
          const bf16* grow = P + (size_t)tq * NPO + 4608 + head * 128;
          bf16* mrow = MIXED + (size_t)tq * MIXW + 1024 + head * 128;
#pragma unroll
          for (int d = 0; d < 4; ++d)
#pragma unroll
            for (int i4 = 0; i4 < 4; ++i4) {
              int dv0 = d * 32 + 8 * i4 + 4 * h;
              float4 v = *(float4*)(orow + dv0);
              v.x += o[d][4 * i4] * gs; v.y += o[d][4 * i4 + 1] * gs; v.z += o[d][4 * i4 + 2] * gs; v.w += o[d][4 * i4 + 3] * gs;
              uint2 gu = *(const uint2*)(grow + dv0);
              uint2 ou;
              ou.x = pack2(v.x * silu(bflo(gu.x)), v.y * silu(bfhi(gu.x)));
              ou.y = pack2(v.z * silu(bflo(gu.y)), v.w * silu(bfhi(gu.y)));
              *(uint2*)(mrow + dv0) = ou;
            }
        }
      }
      }
    }
    if ((PHM & 2) && (ph == 0 || (sub == 2 && even) || (sub == 3 && !even))) {
      const int nl = ph == 0 ? 0 : layer + 1;
      if (nl < 4) {
        const int n_cv = cvt_next_count(p, nl), n_cv4 = (n_cv + 3) >> 2;
        const bool dyn = ph != 0;
        int t = dyn ? fetch_task(CTR + 32 + ph) : bid;
        while (t < n_cv4) {
          for (int q = 0; q < 4; ++q) {
            const int ci = t * 4 + q;
            if (ci < n_cv) cvt_next(p, smem, nl, ci);
          }
          t = dyn ? fetch_task(CTR + 32 + ph) : t + nb;
        }
      }
    }
    if ((PHM & 512) && sub == 4) {
      const float* hin = layer == 0 ? p.x : hbuf;
      for (int t = vb; t < 64 * 8; t += nb) {
        int tm, tn;
        tile_map(t, 8, tm, tn);
        const int m0 = tm * 128;
        int n0 = tn * 256;
        ALin af{MIXED + (size_t)m0 * MIXW, MIXW};
        gemm_tile2(af, (const bf16*)(ws + WS_WOUT) + (size_t)n0 * MIXW, MIXW, MIXW, smem, n0, 2, [&](const float* Cs) {
          const int tid2 = otid();
#pragma unroll
          for (int j = 0; j < 16; ++j) {
            int c = tid2 + 256 * j;
            int row = c >> 5, cc = (c & 31) * 4;
            float4 a = *(const float4*)(Cs + row * 132 + cc);
            float4 hv = *(const float4*)(hin + (size_t)(m0 + row) * DM + n0 + cc);
            hv.x += a.x; hv.y += a.y; hv.z += a.z; hv.w += a.w;
            *(float4*)(hbuf + (size_t)(m0 + row) * DM + n0 + cc) = hv;
          }
        });
      }
    }
    }
  }
}

extern "C" void kernel_launch(void* const* d_in, const int* in_sizes, int n_in, void* d_out, int out_size, void* d_ws,
                              size_t ws_size, hipStream_t stream) {
  Params p{};
  p.x = (const float*)d_in[0]; p.mem = (const float*)d_in[1]; p.pos = (const int*)d_in[2];
  p.norm_g = (const float*)d_in[3]; p.mem_norm_g = (const float*)d_in[4]; p.final_norm_g = (const float*)d_in[5];
  p.t5 = (const float*)d_in[6]; p.w_out = (const float*)d_in[7]; p.mem_w_kv = (const float*)d_in[8];
  p.even_w_in = (const float*)d_in[9]; p.lam_re = (const float*)d_in[10]; p.lam_im = (const float*)d_in[11];
  p.log_dt = (const float*)d_in[12]; p.b_re = (const float*)d_in[13]; p.b_im = (const float*)d_in[14];
  p.c_re = (const float*)d_in[15]; p.c_im = (const float*)d_in[16]; p.s5_d = (const float*)d_in[17];
  p.w_glu = (const float*)d_in[18]; p.fox_b_f = (const float*)d_in[19]; p.odd_w_in = (const float*)d_in[20];
  p.g_cq = (const float*)d_in[21]; p.g_ckv = (const float*)d_in[22]; p.w_uq = (const float*)d_in[23];
  p.w_ukv = (const float*)d_in[24]; p.cmp_pe = (const float*)d_in[25]; p.cmp_w1 = (const float*)d_in[26];
  p.cmp_w2 = (const float*)d_in[27];
  p.out = (float*)d_out; p.ws = (char*)d_ws;
  if (ws_size < WS_END) fprintf(stderr, "workspace too small: %zu < %zu\n", ws_size, (size_t)WS_END);
  static int grid_blocks = 0;
  if (!grid_blocks) {
    int dev = 0, cus = 0, per_cu = 0;
    hipGetDevice(&dev);
    hipDeviceGetAttribute(&cus, hipDeviceAttributeMultiprocessorCount, dev);
    hipOccupancyMaxActiveBlocksPerMultiprocessor(&per_cu, mega, 256, 0);
    if (per_cu > 2) per_cu = 2;
    if (per_cu < 1) per_cu = 1;
    grid_blocks = cus * per_cu;
  }
  (void)hipMemsetAsync((char*)d_ws + WS_BAR, 0, XCD_BAR_WORDS * sizeof(unsigned), stream);
#if MULTI_LAUNCH
  for (int ph = 0; ph <= 24; ++ph) {
    int lo = ph, hi = ph;
    void* args[] = {&p, &lo, &hi};
    hipLaunchCooperativeKernel((void*)mega, dim3(grid_blocks), dim3(256), args, 0, stream);
  }
#else
  int lo = 0, hi = 24;
  void* args[] = {&p, &lo, &hi};
  hipError_t e = hipLaunchCooperativeKernel((void*)mega, dim3(grid_blocks), dim3(256), args, 0, stream);
  if (e != hipSuccess) fprintf(stderr, "cooperative launch failed: %s (grid %d)\n", hipGetErrorString(e), grid_blocks);
#endif
}
```

```cpp
#include <hip/hip_runtime.h>
#include <hip/hip_cooperative_groups.h>
#include <cstdio>
#include <cstdint>
namespace cg = cooperative_groups;

typedef unsigned short bf16;
typedef short bf16x8 __attribute__((ext_vector_type(8)));
typedef float f32x16 __attribute__((ext_vector_type(16)));
typedef float f32x4 __attribute__((ext_vector_type(4)));
typedef __bf16 bf2v __attribute__((ext_vector_type(2)));
typedef float f2v __attribute__((ext_vector_type(2)));

#define DI __device__ __forceinline__
#define MFMA32(a, b, c) __builtin_amdgcn_mfma_f32_32x32x16_bf16((a), (b), (c), 0, 0, 0)

#ifndef LB2
#define LB2 2
#endif
#ifndef REP_PH
#define REP_PH -1
#endif
#ifndef PHM
#define PHM 1023
#endif
#ifndef MULTI_LAUNCH
#define MULTI_LAUNCH 0
#endif

constexpr int L = 8192;
constexpr int DM = 2048;
constexpr int NPE = 7296;
constexpr int NPO = 6784;
constexpr int EVEN_IN = 7176;
constexpr int ODD_IN = 6744;
constexpr int MIXW = 2560;
constexpr int LDX = 2112;
constexpr int LDZ = 1088;
constexpr float LOG2E = 1.4426950408889634f;
constexpr float NEG = -1e30f;
constexpr float EPS = 1e-6f;

constexpr size_t MB = 1024 * 1024;
constexpr size_t WS_WIN = 0;
constexpr size_t WS_WOUT = WS_WIN + 32 * MB;
constexpr size_t WS_WMEM = WS_WOUT + 10 * MB;
constexpr size_t WS_WMISC = WS_WMEM + 4 * MB;
constexpr size_t WS_XN = WS_WMISC + 11 * MB;
constexpr size_t WS_MEMN = WS_XN + 36 * MB;
constexpr size_t WS_P = WS_MEMN + 1 * MB;
constexpr size_t WS_MIXED = WS_P + 114 * MB;
constexpr size_t WS_MEMK = WS_MIXED + 40 * MB;
constexpr size_t WS_MEMVT = WS_MEMK + 256 * 1024;
constexpr size_t WS_ROPEC = WS_MEMVT + 256 * 1024;
constexpr size_t WS_ROPES = WS_ROPEC + 1 * MB;
constexpr size_t WS_FLOG = WS_ROPES + 1 * MB;
constexpr size_t WS_CUML = WS_FLOG + 1 * MB;
constexpr size_t WS_CT = WS_CUML + 256 * 1024;
constexpr size_t WS_S5P = WS_CT + 4096;
constexpr size_t WS_S5E = WS_S5P + 1 * MB;
constexpr size_t WS_CMPB = WS_S5E + 2 * MB;
constexpr size_t WS_CTR = WS_CMPB + 64 * 1024;
constexpr size_t WS_BAR = WS_CTR + 4096;
constexpr size_t WS_POSMAX = WS_BAR + 16384;
constexpr size_t WS_VAR = WS_POSMAX + 4096;
constexpr size_t WS_Z = WS_VAR;
constexpr size_t WS_VTFOX = WS_Z + 18 * MB;
constexpr size_t WS_QMLA = WS_VAR;
constexpr size_t WS_KMLA = WS_QMLA + 24 * MB;
constexpr size_t WS_VTMLA = WS_KMLA + 16 * MB;
constexpr size_t WS_VTSLC = WS_VTMLA + 16 * MB;
constexpr size_t WS_VTWIN = WS_VTSLC + 4 * MB;
constexpr size_t WS_HID = WS_VTWIN + 4 * MB;
constexpr size_t WS_KC = WS_HID + 1 * MB;
constexpr size_t WS_VCT = WS_KC + 256 * 1024;
constexpr size_t WS_NSAO = WS_VCT + 256 * 1024;
constexpr size_t WS_END = WS_NSAO + 32 * MB;
constexpr size_t WM_GLU = 0;
constexpr size_t WM_UQ = 5 * MB / 2;
constexpr size_t WM_UKV = WM_UQ + 1536 * 512 * 2;
constexpr size_t WM_W1 = WM_UKV + 2048 * 512 * 2;
constexpr size_t WM_W2 = WM_W1 + 2 * 256 * 4096 * 2;

constexpr int SM_EXTRA = 73728;
constexpr int SM_TOTAL = 73728 + 1024;

struct Params {
  const float *x, *mem;
  const int* pos;
  const float *norm_g, *mem_norm_g, *final_norm_g, *t5, *w_out, *mem_w_kv, *even_w_in, *lam_re, *lam_im, *log_dt,
      *b_re, *b_im, *c_re, *c_im, *s5_d, *w_glu, *fox_b_f, *odd_w_in, *g_cq, *g_ckv, *w_uq, *w_ukv, *cmp_pe,
      *cmp_w1, *cmp_w2;
  float* out;
  char* ws;
};

DI unsigned pack2(float a, float b) {
  f2v v = {a, b};
  bf2v r = __builtin_convertvector(v, bf2v);
  return __builtin_bit_cast(unsigned, r);
}
DI float bflo(unsigned u) { return __uint_as_float(u << 16); }
DI float bfhi(unsigned u) { return __uint_as_float(u & 0xffff0000u); }
DI float bf2f(bf16 v) { return __uint_as_float(((unsigned)v) << 16); }
DI bf16 f2bf(float f) { return (bf16)(pack2(f, 0.f) & 0xffffu); }
DI int otid() { int z; asm volatile("s_mov_b32 %0, 0" : "=s"(z)); return (int)threadIdx.x + z; }
DI int crow(int i, int h) { return (i & 3) + 8 * (i >> 2) + 4 * h; }
DI float sigm(float x) { return 1.f / (1.f + __expf(-x)); }
DI float silu(float x) { return x * sigm(x); }
DI float gelu_t(float x) {
  float u = 0.7978845608028654f * (x + 0.044715f * x * x * x);
  float e = __expf(2.f * u);
  float t = 1.f - 2.f / (e + 1.f);
  return 0.5f * x * (1.f + t);
}
DI float ex2(float x) { return __builtin_amdgcn_exp2f(x); }
DI float wave_sum(float v) {
#pragma unroll
  for (int o = 32; o > 0; o >>= 1) v += __shfl_xor(v, o);
  return v;
}
DI uint4 pack8(const float* v) {
  uint4 u;
  u.x = pack2(v[0], v[1]); u.y = pack2(v[2], v[3]); u.z = pack2(v[4], v[5]); u.w = pack2(v[6], v[7]);
  return u;
}

struct CvtSeg {
  const float* src; int lds; int sc0; bf16* dst; int dr0; int ncols; int npad; int K; const float* kscale; int ldd;
};
DI int cvt_count(const CvtSeg& s) { return (s.K >> 6) * (s.npad >> 6); }
DI void cvt_tile(const CvtSeg& s, int tile, char* smem) {
  float* T = (float*)smem;
  const int tid = otid();
  const int nkt = s.K >> 6;
  const int kt = tile % nkt, nt = tile / nkt;
  const int k0 = kt * 64, n0 = nt * 64;
  __syncthreads();
#pragma unroll
  for (int i = 0; i < 4; ++i) {
    const int k = i * 16 + (tid >> 4), n4 = (tid & 15) * 4;
    float4 v = make_float4(0.f, 0.f, 0.f, 0.f);
    if (n0 + n4 < s.ncols) {
      v = *(const float4*)(s.src + (size_t)(k0 + k) * s.lds + s.sc0 + n0 + n4);
      if (s.kscale) { float sc = s.kscale[k0 + k]; v.x *= sc; v.y *= sc; v.z *= sc; v.w *= sc; }
    }
    float* d = T + k * 65 + n4;
    d[0] = v.x; d[1] = v.y; d[2] = v.z; d[3] = v.w;
  }
  __syncthreads();
#pragma unroll
  for (int j = 0; j < 2; ++j) {
    int c = tid + 256 * j;
    int n = c >> 3, kc = (c & 7) * 8;
    float v[8];
#pragma unroll
    for (int e = 0; e < 8; ++e) v[e] = T[(kc + e) * 65 + n];
    *(uint4*)(s.dst + (size_t)(s.dr0 + n0 + n) * s.ldd + k0 + kc) = pack8(v);
  }
}

enum { SET_IN_EVEN = 0, SET_IN_ODD, SET_OUT, SET_MEM, SET_MISC_EVEN, SET_MISC_ODD };
DI int cvt_nseg(int set) {
  switch (set) {
    case SET_IN_EVEN: return 3;
    case SET_IN_ODD: return 5;
    case SET_OUT: return 1;
    case SET_MEM: return 1;
    case SET_MISC_EVEN: return 1;
    default: return 6;
  }
}
DI CvtSeg cvt_get(const Params& p, int set, int li, int s) {
  CvtSeg r;
  r.kscale = nullptr;
  char* ws = p.ws;
  if (set == SET_IN_EVEN) {
    r.src = p.even_w_in + (size_t)li * DM * EVEN_IN; r.lds = EVEN_IN; r.K = DM; r.dst = (bf16*)(ws + WS_WIN);
    if (s == 0) { r.sc0 = 0; r.dr0 = 0; r.ncols = 5120; r.npad = 5120; }
    else if (s == 1) { r.sc0 = 5128; r.dr0 = 5120; r.ncols = 2048; r.npad = 2048; }
    else { r.sc0 = 5120; r.dr0 = 7168; r.ncols = 8; r.npad = 128; }
  } else if (set == SET_IN_ODD) {
    r.src = p.odd_w_in + (size_t)li * DM * ODD_IN; r.lds = ODD_IN; r.K = DM; r.dst = (bf16*)(ws + WS_WIN);
    if (s == 0) { r.sc0 = 0; r.dr0 = 0; r.ncols = 1024; r.npad = 1024; }
    else if (s == 1) { r.sc0 = 1088; r.dr0 = 1024; r.ncols = 3584; r.npad = 3584; }
    else if (s == 2) { r.sc0 = 4696; r.dr0 = 4608; r.ncols = 2048; r.npad = 2048; }
    else if (s == 3) { r.sc0 = 1024; r.dr0 = 6656; r.ncols = 64; r.npad = 64; }
    else { r.sc0 = 4672; r.dr0 = 6720; r.ncols = 24; r.npad = 64; }
  } else if (set == SET_OUT) {
    r.src = p.w_out + (size_t)li * MIXW * DM; r.lds = DM; r.K = MIXW; r.dst = (bf16*)(ws + WS_WOUT);
    r.sc0 = 0; r.dr0 = 0; r.ncols = DM; r.npad = DM;
  } else if (set == SET_MEM) {
    r.src = p.mem_w_kv + (size_t)li * DM * 1024; r.lds = 1024; r.K = DM; r.dst = (bf16*)(ws + WS_WMEM);
    r.sc0 = 0; r.dr0 = 0; r.ncols = 1024; r.npad = 1024;
  } else if (set == SET_MISC_EVEN) {
    r.src = p.w_glu + (size_t)li * 1024 * 1024; r.lds = 1024; r.K = 1024; r.dst = (bf16*)(ws + WS_WMISC + WM_GLU);
    r.sc0 = 0; r.dr0 = 0; r.ncols = 1024; r.npad = 1024;
  } else {
    r.sc0 = 0; r.dr0 = 0;
    if (s == 0) {
      r.src = p.w_uq + (size_t)li * 512 * 1536; r.lds = 1536; r.K = 512; r.dst = (bf16*)(ws + WS_WMISC + WM_UQ);
      r.ncols = 1536; r.npad = 1536; r.kscale = p.g_cq + li * 512;
    } else if (s == 1) {
      r.src = p.w_ukv + (size_t)li * 512 * 2048; r.lds = 2048; r.K = 512; r.dst = (bf16*)(ws + WS_WMISC + WM_UKV);
      r.ncols = 2048; r.npad = 2048; r.kscale = p.g_ckv + li * 512;
    } else if (s < 4) {
      int which = s - 2;
      r.src = p.cmp_w1 + (size_t)(li * 2 + which) * 4096 * 256; r.lds = 256; r.K = 4096;
      r.dst = (bf16*)(ws + WS_WMISC + WM_W1) + (size_t)which * 256 * 4096; r.ncols = 256; r.npad = 256;
    } else {
      int which = s - 4;
      r.src = p.cmp_w2 + (size_t)(li * 2 + which) * 256 * 128; r.lds = 128; r.K = 256;
      r.dst = (bf16*)(ws + WS_WMISC + WM_W2) + (size_t)which * 128 * 256; r.ncols = 128; r.npad = 128;
    }
  }
  r.ldd = (set == SET_IN_EVEN || set == SET_IN_ODD) ? LDX : (set == SET_MISC_EVEN ? LDZ : r.K);
  return r;
}
DI int cvt_set_count(const Params& p, int set, int li) {
  int n = 0;
  for (int s = 0; s < cvt_nseg(set); ++s) n += cvt_count(cvt_get(p, set, li, s));
  return n;
}
DI void cvt_set_task(const Params& p, int set, int li, int t, char* smem) {
  const int ns = cvt_nseg(set);
  for (int s = 0; s < ns; ++s) {
    CvtSeg sg = cvt_get(p, set, li, s);
    int c = cvt_count(sg);
    if (t < c) { cvt_tile(sg, t, smem); return; }
    t -= c;
  }
}

DI void norm_row_bf16(const float* __restrict__ src, const float* __restrict__ g, bf16* __restrict__ dst, int lane) {
  float4 v[8];
  float ss = 0.f;
#pragma unroll
  for (int i = 0; i < 8; ++i) {
    v[i] = *(const float4*)(src + (i * 64 + lane) * 4);
    ss += v[i].x * v[i].x + v[i].y * v[i].y + v[i].z * v[i].z + v[i].w * v[i].w;
  }
  ss = wave_sum(ss);
  float r = rsqrtf(ss * (1.f / DM) + EPS);
#pragma unroll
  for (int i = 0; i < 8; ++i) {
    float4 gg = *(const float4*)(g + (i * 64 + lane) * 4);
    uint2 u;
    u.x = pack2(v[i].x * r * gg.x, v[i].y * r * gg.y);
    u.y = pack2(v[i].z * r * gg.z, v[i].w * r * gg.w);
    *(uint2*)(dst + (i * 64 + lane) * 4) = u;
  }
}
DI void norm_row_f32(float* __restrict__ io, const float* __restrict__ g, int lane) {
  float4 v[8];
  float ss = 0.f;
#pragma unroll
  for (int i = 0; i < 8; ++i) {
    v[i] = *(const float4*)(io + (i * 64 + lane) * 4);
    ss += v[i].x * v[i].x + v[i].y * v[i].y + v[i].z * v[i].z + v[i].w * v[i].w;
  }
  ss = wave_sum(ss);
  float r = rsqrtf(ss * (1.f / DM) + EPS);
#pragma unroll
  for (int i = 0; i < 8; ++i) {
    float4 gg = *(const float4*)(g + (i * 64 + lane) * 4);
    float4 o;
    o.x = v[i].x * r * gg.x; o.y = v[i].y * r * gg.y; o.z = v[i].z * r * gg.z; o.w = v[i].w * r * gg.w;
    *(float4*)(io + (i * 64 + lane) * 4) = o;
  }
}

struct ALin {
  const bf16* p; int ld;
  DI const bf16* operator()(int row, int k) const { return p + (size_t)row * ld + k; }
};
struct ACmp {
  const bf16* p; int m0;
  DI const bf16* operator()(int row, int k) const {
    int gr = m0 + row;
    if (gr > 1021) gr = 1021;
    int n = gr >> 1, g = gr & 1;
    return p + (size_t)(16 * n + (k >> 7)) * NPO + g * 128 + (k & 127);
  }
};

template <class AF, class Epi>
DI void gemm_tile(AF af, const bf16* __restrict__ Bt, int ldb, int K, char* smem, Epi epi) {
  const int tid = otid(), lane = tid & 63, w = tid >> 6, r = lane & 31, h = lane >> 5;
  const int wm = w >> 1, wn = w & 1;
  bf16* As = (bf16*)smem;
  bf16* Bs = As + 2 * 128 * 72;
  f32x16 acc[2][2];
#pragma unroll
  for (int a = 0; a < 2; ++a)
#pragma unroll
    for (int b = 0; b < 2; ++b)
#pragma unroll
      for (int i = 0; i < 16; ++i) acc[a][b][i] = 0.f;
  uint4 ra0_0, ra0_1, ra0_2, ra0_3, rb0_0, rb0_1, rb0_2, rb0_3, ra1_0, ra1_1, ra1_2, ra1_3, rb1_0, rb1_1, rb1_2, rb1_3;
#define LD1(S, I, K0)                                                                  \
  {                                                                                    \
    int c = tl + 256 * I;                                                              \
    int row = c >> 3, kc = (c & 7) * 8;                                                \
    ra##S##_##I = *(const uint4*)af(row, (K0) + kc);                                   \
    rb##S##_##I = *(const uint4*)(Bt + (size_t)row * ldb + (K0) + kc);                 \
  }
#define ST1(S, I, BUF)                                                                 \
  {                                                                                    \
    int c = tid + 256 * I;                                                             \
    int row = c >> 3, kc = (c & 7) * 8;                                                \
    *(uint4*)(As + (BUF) * 9216 + row * 72 + kc) = ra##S##_##I;                        \
    *(uint4*)(Bs + (BUF) * 9216 + row * 72 + kc) = rb##S##_##I;                        \
  }
#define GLOAD(S, K0) { const int tl = otid(); LD1(S, 0, K0) LD1(S, 1, K0) LD1(S, 2, K0) LD1(S, 3, K0) }
#define SSTORE(S, BUF) { ST1(S, 0, BUF) ST1(S, 1, BUF) ST1(S, 2, BUF) ST1(S, 3, BUF) }
  auto compute = [&](int buf) {
    const bf16* a_ = As + buf * 9216 + (wm * 64 + r) * 72 + h * 8;
    const bf16* b_ = Bs + buf * 9216 + (wn * 64 + r) * 72 + h * 8;
    bf16x8 fa0, fa1, fb0, fb1, ga0, ga1, gb0, gb1, ha0, ha1, hb0, hb1, ia0, ia1, ib0, ib1;
    fa0 = *(const bf16x8*)(a_ + 0);            fa1 = *(const bf16x8*)(a_ + 32 * 72);
    fb0 = *(const bf16x8*)(b_ + 0);            fb1 = *(const bf16x8*)(b_ + 32 * 72);
    ga0 = *(const bf16x8*)(a_ + 16);           ga1 = *(const bf16x8*)(a_ + 32 * 72 + 16);
    gb0 = *(const bf16x8*)(b_ + 16);           gb1 = *(const bf16x8*)(b_ + 32 * 72 + 16);
    ha0 = *(const bf16x8*)(a_ + 32);           ha1 = *(const bf16x8*)(a_ + 32 * 72 + 32);
    hb0 = *(const bf16x8*)(b_ + 32);           hb1 = *(const bf16x8*)(b_ + 32 * 72 + 32);
    ia0 = *(const bf16x8*)(a_ + 48);           ia1 = *(const bf16x8*)(a_ + 32 * 72 + 48);
    ib0 = *(const bf16x8*)(b_ + 48);           ib1 = *(const bf16x8*)(b_ + 32 * 72 + 48);
    __builtin_amdgcn_sched_barrier(0);
    acc[0][0] = MFMA32(fa0, fb0, acc[0][0]); acc[0][1] = MFMA32(fa0, fb1, acc[0][1]);
    acc[1][0] = MFMA32(fa1, fb0, acc[1][0]); acc[1][1] = MFMA32(fa1, fb1, acc[1][1]);
    acc[0][0] = MFMA32(ga0, gb0, acc[0][0]); acc[0][1] = MFMA32(ga0, gb1, acc[0][1]);
    acc[1][0] = MFMA32(ga1, gb0, acc[1][0]); acc[1][1] = MFMA32(ga1, gb1, acc[1][1]);
    acc[0][0] = MFMA32(ha0, hb0, acc[0][0]); acc[0][1] = MFMA32(ha0, hb1, acc[0][1]);
    acc[1][0] = MFMA32(ha1, hb0, acc[1][0]); acc[1][1] = MFMA32(ha1, hb1, acc[1][1]);
    acc[0][0] = MFMA32(ia0, ib0, acc[0][0]); acc[0][1] = MFMA32(ia0, ib1, acc[0][1]);
    acc[1][0] = MFMA32(ia1, ib0, acc[1][0]); acc[1][1] = MFMA32(ia1, ib1, acc[1][1]);
    __builtin_amdgcn_sched_barrier(0);
  };
  __syncthreads();
  const int nk = K >> 6;
  GLOAD(0, 0);
  SSTORE(0, 0);
  GLOAD(0, 64);
  __syncthreads();
  for (int kt = 0; kt < nk; kt += 2) {
    if (kt + 2 < nk) GLOAD(1, (kt + 2) * 64);
    compute(0);
    SSTORE(0, 1);
    __syncthreads();
    if (kt + 3 < nk) GLOAD(0, (kt + 3) * 64);
    compute(1);
    if (kt + 2 < nk) SSTORE(1, 0);
    __syncthreads();
  }
#undef GLOAD
#undef SSTORE
#undef LD1
#undef ST1
  float* Cs = (float*)smem;
#pragma unroll
  for (int mb = 0; mb < 2; ++mb)
#pragma unroll
    for (int nb = 0; nb < 2; ++nb)
#pragma unroll
      for (int i = 0; i < 16; ++i)
        Cs[(wm * 64 + mb * 32 + crow(i, h)) * 132 + wn * 64 + nb * 32 + r] = acc[mb][nb][i];
  __syncthreads();
  epi(Cs);
}


template <class AF, class Epi>
DI void gemm_tile2(AF af, const bf16* __restrict__ Bt, int ldb, int K, char* smem, int& n0ref, int nhalf, Epi epi) {
  const int tid = otid(), lane = tid & 63, w = tid >> 6, r = lane & 31, h = lane >> 5;
  const int wm = w >> 1, wn = w & 1;
  bf16* As = (bf16*)smem;
  bf16* Bs = As + 128 * 72;
  f32x16 acc[2][4];
#pragma unroll
  for (int a = 0; a < 2; ++a)
#pragma unroll
    for (int b = 0; b < 4; ++b)
#pragma unroll
      for (int i = 0; i < 16; ++i) acc[a][b][i] = 0.f;
  uint4 pa_0, pa_1, pa_2, pa_3, pb_0, pb_1, pb_2, pb_3, pb_4, pb_5, pb_6, pb_7;
#define LDA2(I, K0) { int c = tl + 256 * I; int row = c >> 3, kc = (c & 7) * 8; pa_##I = *(const uint4*)af(row, (K0) + kc); }
#define LDB2(I, K0) { int c = tl + 256 * I; int row = c >> 3, kc = (c & 7) * 8; pb_##I = *(const uint4*)(Bt + (size_t)row * ldb + (K0) + kc); }
#define STA2(I) { int c = tid + 256 * I; int row = c >> 3, kc = (c & 7) * 8; *(uint4*)(As + row * 72 + kc) = pa_##I; }
#define STB2(I) { int c = tid + 256 * I; int row = c >> 3, kc = (c & 7) * 8; *(uint4*)(Bs + row * 72 + kc) = pb_##I; }
#define GLOAD2(K0) { const int tl = otid(); LDA2(0, K0) LDA2(1, K0) LDA2(2, K0) LDA2(3, K0) LDB2(0, K0) LDB2(1, K0) LDB2(2, K0) LDB2(3, K0) LDB2(4, K0) LDB2(5, K0) LDB2(6, K0) LDB2(7, K0) }
#define SSTORE2() { STA2(0) STA2(1) STA2(2) STA2(3) STB2(0) STB2(1) STB2(2) STB2(3) STB2(4) STB2(5) STB2(6) STB2(7) }
  const int nk = K >> 6;
  GLOAD2(0);
  const bf16* a_ = As + (wm * 64 + r) * 72 + h * 8;
  const bf16* b_ = Bs + (wn * 128 + r) * 72 + h * 8;
  for (int kt = 0; kt < nk; ++kt) {
    __syncthreads();
    SSTORE2();
    __syncthreads();
    if (kt + 1 < nk) GLOAD2((kt + 1) * 64);
#pragma unroll
    for (int ks = 0; ks < 4; ++ks) {
      bf16x8 fa[2], fb[4];
#pragma unroll
      for (int mb = 0; mb < 2; ++mb) fa[mb] = *(const bf16x8*)(a_ + mb * 32 * 72 + ks * 16);
#pragma unroll
      for (int nb = 0; nb < 4; ++nb) fb[nb] = *(const bf16x8*)(b_ + nb * 32 * 72 + ks * 16);
#pragma unroll
      for (int mb = 0; mb < 2; ++mb)
#pragma unroll
        for (int nb = 0; nb < 4; ++nb) acc[mb][nb] = MFMA32(fa[mb], fb[nb], acc[mb][nb]);
    }
  }
#undef LDA2
#undef LDB2
#undef STA2
#undef STB2
#undef GLOAD2
#undef SSTORE2
  float* Cs = (float*)smem;
#pragma unroll
  for (int hf = 0; hf < 2; ++hf) {
    if (hf < nhalf) {
      __syncthreads();
      if (wn == hf) {
#pragma unroll
        for (int mb = 0; mb < 2; ++mb)
#pragma unroll
          for (int nb = 0; nb < 4; ++nb)
#pragma unroll
            for (int i = 0; i < 16; ++i) Cs[(wm * 64 + mb * 32 + crow(i, h)) * 132 + nb * 32 + r] = acc[mb][nb][i];
      }
      __syncthreads();
      epi(Cs);
      n0ref += 128;
    }
  }
}

DI void tile_map(int t, int ntn, int& tm, int& tn) {
  const int per = 8 * ntn;
  const int grp = t / per, rem = t - grp * per;
  tm = grp * 8 + (rem & 7);
  tn = rem >> 3;
}
template <class F>
DI void epi_rows(const float* Cs, F f) {
  const int tid = otid();
#pragma unroll
  for (int j = 0; j < 8; ++j) {
    int c = tid + 256 * j;
    int row = c >> 4, cc = (c & 15) * 8;
    float v[8];
    float4 a = *(const float4*)(Cs + row * 132 + cc);
    float4 b = *(const float4*)(Cs + row * 132 + cc + 4);
    v[0] = a.x; v[1] = a.y; v[2] = a.z; v[3] = a.w; v[4] = b.x; v[5] = b.y; v[6] = b.z; v[7] = b.w;
    f(row, cc, v);
  }
}
template <class F>
DI void epi_cols(const float* Cs, F f) {
  const int tid = otid();
#pragma unroll
  for (int j = 0; j < 8; ++j) {
    int c = tid + 256 * j;
    int col = c & 127, r8 = (c >> 7) * 8;
    float v[8];
#pragma unroll
    for (int e = 0; e < 8; ++e) v[e] = Cs[(r8 + e) * 132 + col];
    f(col, r8, v);
  }
}
template <class F>
DI void epi_rope(const float* Cs, int cb, int m0, const float* rc, const float* rs, float scale_unused, F f) {
  const int tid = otid();
#pragma unroll
  for (int j = 0; j < 2; ++j) {
    int c = tid + 256 * j;
    int row = c >> 2, cc = (c & 3) * 8;
    float x1[8], x2[8], o1[8], o2[8];
#pragma unroll
    for (int e = 0; e < 8; ++e) {
      x1[e] = Cs[row * 132 + cb + cc + e];
      x2[e] = Cs[row * 132 + cb + 32 + cc + e];
    }
    const float* pc = rc + (size_t)(m0 + row) * 32 + cc;
    const float* ps = rs + (size_t)(m0 + row) * 32 + cc;
#pragma unroll
    for (int e = 0; e < 8; ++e) {
      float cs = pc[e], sn = ps[e];
      o1[e] = x1[e] * cs - x2[e] * sn;
      o2[e] = x1[e] * sn + x2[e] * cs;
    }
    f(row, cc, o1);
    f(row, cc + 32, o2);
  }
}

template <int DK>
struct KVPre {
  uint4 k[DK / 32];
  uint4 v[4];
  float aux;
};
constexpr int AT_VS = 25600;
constexpr int AT_AUX = 43008;
constexpr int AT_X0 = 43264;
constexpr int AT_IMP = AT_X0 + 12800;
constexpr int AT_SEL = AT_IMP + 16896;

template <int DK, bool PV, class SF, class PH>
DI void attn_tile(const bf16x8 (&qf)[DK / 16], f32x16 (&o)[4], float& m, float& l, const char* smem, SF sf, PH ph) {
  const int lane = otid() & 63, r = lane & 31, h = lane >> 5;
  const bf16* Ks = (const bf16*)smem;
  const bf16* Vs = (const bf16*)(smem + AT_VS);
  const float* auxs = (const float*)(smem + AT_AUX);
  f32x16 s[2];
#pragma unroll
  for (int kb = 0; kb < 2; ++kb) {
#pragma unroll
    for (int i = 0; i < 16; ++i) s[kb][i] = 0.f;
#pragma unroll
    for (int ks = 0; ks < DK / 16; ++ks) {
      bf16x8 a = *(const bf16x8*)(Ks + (kb * 32 + r) * (DK + 8) + ks * 16 + h * 8);
      s[kb] = MFMA32(a, qf[ks], s[kb]);
    }
  }
  float mx = m;
#pragma unroll
  for (int kb = 0; kb < 2; ++kb)
#pragma unroll
    for (int i = 0; i < 16; ++i) {
      int kl = kb * 32 + crow(i, h);
      float v = sf(s[kb][i], kl, auxs[kl]);
      s[kb][i] = v;
      mx = fmaxf(mx, v);
    }
  mx = fmaxf(mx, __shfl_xor(mx, 32));
  float alpha = ex2(m - mx);
  m = mx;
  float psum = 0.f;
#pragma unroll
  for (int kb = 0; kb < 2; ++kb)
#pragma unroll
    for (int i = 0; i < 16; ++i) {
      float pv = ex2(s[kb][i] - mx);
      s[kb][i] = pv;
      psum += pv;
    }
  l = l * alpha + psum;
  ph(0, s[0]);
  ph(1, s[1]);
  if (PV) {
    if (__builtin_amdgcn_ballot_w64(alpha != 1.f) != 0ull) {
#pragma unroll
      for (int d = 0; d < 4; ++d)
#pragma unroll
        for (int i = 0; i < 16; ++i) o[d][i] *= alpha;
    }
#pragma unroll
    for (int st = 0; st < 4; ++st) {
      const int kb = st >> 1, s2 = st & 1;
      uint4 pu;
      pu.x = pack2(s[kb][8 * s2 + 0], s[kb][8 * s2 + 1]);
      pu.y = pack2(s[kb][8 * s2 + 2], s[kb][8 * s2 + 3]);
      pu.z = pack2(s[kb][8 * s2 + 4], s[kb][8 * s2 + 5]);
      pu.w = pack2(s[kb][8 * s2 + 6], s[kb][8 * s2 + 7]);
      bf16x8 pf = __builtin_bit_cast(bf16x8, pu);
#pragma unroll
      for (int d = 0; d < 4; ++d) {
        const bf16* vp = Vs + (d * 32 + r) * 68 + st * 16 + 4 * h;
        uint2 lo = *(const uint2*)vp;
        uint2 hi = *(const uint2*)(vp + 8);
        uint4 vu = make_uint4(lo.x, lo.y, hi.x, hi.y);
        bf16x8 vf = __builtin_bit_cast(bf16x8, vu);
        o[d] = MFMA32(vf, pf, o[d]);
      }
    }
  }
}

template <int DK, int FM>
DI void attn_tile_c(const bf16x8 (&qf)[DK / 16], f32x16 (&o)[4], float& m, float& l, const char* smem, float sc, float c) {
  const int lane = otid() & 63, r = lane & 31, h = lane >> 5;
  const bf16* Ks = (const bf16*)smem;
  const bf16* Vs = (const bf16*)(smem + AT_VS);
  const float* auxs = (const float*)(smem + AT_AUX);
  f32x16 s0, s1;
#pragma unroll
  for (int i = 0; i < 16; ++i) { s0[i] = 0.f; s1[i] = 0.f; }
#pragma unroll
  for (int ks = 0; ks < DK / 16; ++ks) {
    bf16x8 a = *(const bf16x8*)(Ks + r * (DK + 8) + ks * 16 + h * 8);
    s0 = MFMA32(a, qf[ks], s0);
  }
#pragma unroll
  for (int ks = 0; ks < DK / 16; ++ks) {
    bf16x8 a = *(const bf16x8*)(Ks + (32 + r) * (DK + 8) + ks * 16 + h * 8);
    s1 = MFMA32(a, qf[ks], s1);
  }
  float mx;
  if (FM == 2) {
    mx = m;
#pragma unroll
    for (int i = 0; i < 16; ++i) {
      float v = __builtin_fmaf(s0[i], sc, -auxs[crow(i, h)]);
      s0[i] = v;
      mx = fmaxf(mx, v);
    }
  } else {
    float rm = s0[0];
#pragma unroll
    for (int i = 1; i < 16; ++i) rm = fmaxf(rm, s0[i]);
    mx = fmaxf(m, __builtin_fmaf(rm, sc, c));
  }
  mx = fmaxf(mx, __shfl_xor(mx, 32));
  const float alpha = ex2(m - mx);
  m = mx;
  const float off = c - mx;
#pragma unroll
  for (int d = 0; d < 4; ++d)
#pragma unroll
    for (int i = 0; i < 16; ++i) o[d][i] *= alpha;
  l *= alpha;
  float psum = 0.f;
#pragma unroll
  for (int i = 0; i < 16; ++i) {
    float pv = (FM == 2) ? ex2(s0[i] - mx) : ex2(__builtin_fmaf(s0[i], sc, off));
    s0[i] = pv;
    psum += pv;
  }
#pragma unroll
  for (int s2 = 0; s2 < 2; ++s2) {
    uint4 pu;
    pu.x = pack2(s0[8 * s2 + 0], s0[8 * s2 + 1]);
    pu.y = pack2(s0[8 * s2 + 2], s0[8 * s2 + 3]);
    pu.z = pack2(s0[8 * s2 + 4], s0[8 * s2 + 5]);
    pu.w = pack2(s0[8 * s2 + 6], s0[8 * s2 + 7]);
    bf16x8 pf = __builtin_bit_cast(bf16x8, pu);
#pragma unroll
    for (int d = 0; d < 4; ++d) {
      const bf16* vp = Vs + (d * 32 + r) * 68 + s2 * 16 + 4 * h;
      uint2 lo = *(const uint2*)vp;
      uint2 hi = *(const uint2*)(vp + 8);
      uint4 vu = make_uint4(lo.x, lo.y, hi.x, hi.y);
      o[d] = MFMA32(__builtin_bit_cast(bf16x8, vu), pf, o[d]);
    }
  }
#pragma unroll
  for (int i = 0; i < 16; ++i) {
    float pv;
    if (FM == 2) pv = ex2(__builtin_fmaf(s1[i], sc, -auxs[32 + crow(i, h)]) - mx);
    else pv = ex2(__builtin_fmaf(s1[i], sc, off));
    s1[i] = pv;
    psum += pv;
  }
  l += psum;
#pragma unroll
  for (int s2 = 0; s2 < 2; ++s2) {
    uint4 pu;
    pu.x = pack2(s1[8 * s2 + 0], s1[8 * s2 + 1]);
    pu.y = pack2(s1[8 * s2 + 2], s1[8 * s2 + 3]);
    pu.z = pack2(s1[8 * s2 + 4], s1[8 * s2 + 5]);
    pu.w = pack2(s1[8 * s2 + 6], s1[8 * s2 + 7]);
    bf16x8 pf = __builtin_bit_cast(bf16x8, pu);
#pragma unroll
    for (int d = 0; d < 4; ++d) {
      const bf16* vp = Vs + (d * 32 + r) * 68 + (2 + s2) * 16 + 4 * h;
      uint2 lo = *(const uint2*)vp;
      uint2 hi = *(const uint2*)(vp + 8);
      uint4 vu = make_uint4(lo.x, lo.y, hi.x, hi.y);
      o[d] = MFMA32(__builtin_bit_cast(bf16x8, vu), pf, o[d]);
    }
  }
}

struct NoHook { DI void operator()(int, const f32x16&) const {} };

template <int DK, bool PV, bool PF, class Ctx>
DI void attn_run(const bf16x8 (&qf)[DK / 16], f32x16 (&o)[4], float& m, float& l, const bf16* K1, int ldk1,
                 const bf16* K2, int ldk2, const bf16* Vt, int ldv, int first, Ctx& ctx, char* smem) {
  const int tid = otid();
  int tcur = first;
  if (tcur < 0) return;
  constexpr int CPR = DK / 8;
  constexpr int NKC = DK / 32;
  uint4 rk0, rk1, rk2, rk3, rk4 = make_uint4(0, 0, 0, 0), rk5 = make_uint4(0, 0, 0, 0), rv[4];
  float raux;
  bf16* Ks = (bf16*)smem;
  bf16* Vs = (bf16*)(smem + AT_VS);
  auto ldk = [&](int i, int key0) -> uint4 {
    int c = otid() + 256 * i;
    int row = c / CPR, cc = c % CPR;
    const bf16* src;
    if (DK == 128 || cc < 16) src = K1 + (size_t)(key0 + row) * ldk1 + cc * 8;
    else src = K2 + (size_t)(key0 + row) * ldk2 + (cc - 16) * 8;
    return *(const uint4*)src;
  };
  auto stk = [&](int i, const uint4& v) {
    int c = tid + 256 * i;
    int row = c / CPR, cc = c % CPR;
    *(uint4*)(Ks + row * (DK + 8) + cc * 8) = v;
  };
  auto gload = [&](int key0) {
    rk0 = ldk(0, key0); rk1 = ldk(1, key0); rk2 = ldk(2, key0); rk3 = ldk(3, key0);
    if (NKC > 4) { rk4 = ldk(4, key0); rk5 = ldk(5, key0); }
    const int tl = otid();
#pragma unroll
    for (int i = 0; i < 4; ++i) {
      int c = tl + 256 * i;
      int d = c >> 3, cc = c & 7;
      rv[i] = *(const uint4*)(Vt + (size_t)d * ldv + key0 + cc * 8);
    }
    raux = (tid < 64) ? ctx.aux(key0 + tid) : 0.f;
  };
  auto sstore = [&]() {
    stk(0, rk0); stk(1, rk1); stk(2, rk2); stk(3, rk3);
    if (NKC > 4) { stk(4, rk4); stk(5, rk5); }
#pragma unroll
    for (int i = 0; i < 4; ++i) {
      int c = tid + 256 * i;
      int d = c >> 3, cc = c & 7;
      uint2* dst = (uint2*)(Vs + d * 68 + cc * 8);
      dst[0] = make_uint2(rv[i].x, rv[i].y);
      dst[1] = make_uint2(rv[i].z, rv[i].w);
    }
    if (tid < 64) ((float*)(smem + AT_AUX))[tid] = raux;
  };
  if (PF) gload(tcur * 64);
  while (tcur >= 0) {
    __syncthreads();
    if (!PF) gload(tcur * 64);
    sstore();
    __syncthreads();
    int tnext = ctx.next(tcur);
    if (PF && tnext >= 0) gload(tnext * 64);
    if (!ctx.skip(tcur)) {
      const int tc = tcur;
      if (Ctx::FMODE != 0 && (Ctx::ALWAYS_FAST || ctx.fast(tc))) {
        attn_tile_c<DK, (Ctx::FMODE == 2 ? 2 : 1)>(qf, o, m, l, smem, ctx.sc, ctx.fconst(tc));
      } else if (!Ctx::ALWAYS_FAST) {
        attn_tile<DK, PV>(qf, o, m, l, smem,
                          [&](float s, int kl, float ax) { return ctx.score(s, tc * 64 + kl, ax, tc); },
                          [&](int kb, const f32x16& pt) { ctx.hook(kb, pt, tc); });
      }
    }
    tcur = tnext;
  }
}

template <int DK>
DI void load_q(bf16x8 (&qf)[DK / 16], const bf16* qrow, int h) {
#pragma unroll
  for (int ks = 0; ks < DK / 16; ++ks) qf[ks] = *(const bf16x8*)(qrow + ks * 16 + h * 8);
}
DI void zero_o(f32x16 (&o)[4]) {
#pragma unroll
  for (int d = 0; d < 4; ++d)
#pragma unroll
    for (int i = 0; i < 16; ++i) o[d][i] = 0.f;
}

struct CtxCausal {
  int tq, q0w, last; float sc;
  DI int next(int t) const { return t + 1 <= last ? t + 1 : -1; }
  DI float aux(int) const { return 0.f; }
  DI bool skip(int t) const { return t * 64 > q0w + 31; }
  DI float score(float s, int key, float, int) const { return key <= tq ? s * sc : NEG; }
  static constexpr int FMODE = 1;
  static constexpr bool ALWAYS_FAST = false;
  DI bool fast(int t) const { return t * 64 + 63 <= q0w; }
  DI float fconst(int) const { return 0.f; }
  DI void hook(int, const f32x16&, int) const {}
};
struct CtxFox {
  int tq, q0w, last; float sc; const float* cuml; const float* cpre;
  DI int next(int t) const { return t + 1 <= last ? t + 1 : -1; }
  DI float aux(int key) const { return (cuml[key] + cpre[key >> 7]) * LOG2E; }
  DI bool skip(int t) const { return t * 64 > q0w + 31; }
  DI float score(float s, int key, float ax, int) const { return key <= tq ? s * sc - ax : NEG; }
  static constexpr int FMODE = 2;
  static constexpr bool ALWAYS_FAST = false;
  DI bool fast(int t) const { return t * 64 + 63 <= q0w; }
  DI float fconst(int) const { return 0.f; }
  DI void hook(int, const f32x16&, int) const {}
};
struct CtxMem {
  float sc;
  DI int next(int t) const { return t + 1 < 4 ? t + 1 : -1; }
  DI float aux(int) const { return 0.f; }
  DI bool skip(int) const { return false; }
  DI float score(float s, int, float, int) const { return s * sc; }
  static constexpr int FMODE = 1;
  static constexpr bool ALWAYS_FAST = true;
  DI bool fast(int) const { return true; }
  DI float fconst(int) const { return 0.f; }
  DI void hook(int, const f32x16&, int) const {}
};

DI void store_out_A(const f32x16 (&o)[4], float inv_l, const bf16* grow, bf16* orow, int h) {
#pragma unroll
  for (int d = 0; d < 4; ++d)
#pragma unroll
    for (int i4 = 0; i4 < 4; ++i4) {
      int dv0 = d * 32 + 8 * i4 + 4 * h;
      uint2 gu = *(const uint2*)(grow + dv0);
      float g0 = bflo(gu.x), g1 = bfhi(gu.x), g2 = bflo(gu.y), g3 = bfhi(gu.y);
      uint2 ou;
      ou.x = pack2(o[d][4 * i4 + 0] * inv_l * silu(g0), o[d][4 * i4 + 1] * inv_l * silu(g1));
      ou.y = pack2(o[d][4 * i4 + 2] * inv_l * silu(g2), o[d][4 * i4 + 3] * inv_l * silu(g3));
      *(uint2*)(orow + dv0) = ou;
    }
}

        struct CtxCmp {
          int tq, posq, last; float sc; const float* lutr; const int* pos; float invl; float* imp; int ql; bool p2;
          DI int next(int t) const { return t + 1 <= last ? t + 1 : -1; }
          DI float aux(int key) const { int n = key < 511 ? key : 510; return __int_as_float(pos[16 * n + 31]); }
          DI bool skip(int) const { return false; }
          DI float score(float s, int key, float ax, int) const {
            bool valid = (16 * key + 31 <= tq) && key < 511;
            int d = posq - __float_as_int(ax);
            d = d < 0 ? 0 : (d > 799 ? 799 : d);
            return valid ? s * sc + lutr[d] : NEG;
          }
          static constexpr int FMODE = 0;
          static constexpr bool ALWAYS_FAST = false;
          DI bool fast(int) const { return false; }
          DI float fconst(int) const { return 0.f; }
          DI void hook(int kb, const f32x16& pt, int tc) const {
            if (!p2) return;
            const int lane = otid() & 63, h = lane >> 5, r = lane & 31;
#pragma unroll
            for (int gq = 0; gq < 4; ++gq) {
              float p3 = 0.5f * pt[4 * gq + 3];
              float vm = (pt[4 * gq] + pt[4 * gq + 1] + pt[4 * gq + 2] + p3) * invl;
              float vs = p3 * invl;
              vm += __shfl_xor(vm, 8); vm += __shfl_xor(vm, 16);
              vs += __shfl_xor(vs, 8); vs += __shfl_xor(vs, 16);
              int j = tc * 16 + kb * 8 + 2 * gq + h;
              if (r < 8) { atomicAdd(&imp[ql * 132 + j], vm); atomicAdd(&imp[ql * 132 + j + 1], vs); }
            }
          }
        };
struct CtxSlc {
  int tq, posq; float sc; const float* lutr; const int* pos; unsigned long long ulo, uhi, mlo, mhi;
  const int* posmax; int pqmin, q0;
  DI bool farj(int j) const { return (j * 64 + 63 < q0) && (pqmin - posmax[j] >= 799); }
  DI bool inu(int j) const {
    unsigned long long a = (ulo >> (j & 63)) & (j < 64 ? 1ull : 0ull);
    unsigned long long b = (uhi >> (j & 63)) & (j >= 64 ? 1ull : 0ull);
    return (a | b) != 0ull;
  }
  DI bool mine(int j) const {
    unsigned long long a = (mlo >> (j & 63)) & (j < 64 ? 1ull : 0ull);
    unsigned long long b = (mhi >> (j & 63)) & (j >= 64 ? 1ull : 0ull);
    return (a | b) != 0ull;
  }
  DI int next(int t) const { for (int j = t + 1; j < 128; ++j) if (inu(j) && !farj(j)) return j; return -1; }
  DI float aux(int key) const { return __int_as_float(pos[key]); }
  DI bool skip(int t) const { return __builtin_amdgcn_ballot_w64(mine(t)) == 0ull; }
  DI float score(float s, int key, float ax, int t) const {
    bool valid = mine(t) && key <= tq;
    int d = posq - __float_as_int(ax);
    d = d < 0 ? 0 : (d > 799 ? 799 : d);
    return valid ? s * sc + lutr[d] : NEG;
  }
  static constexpr int FMODE = 0;
  static constexpr bool ALWAYS_FAST = false;
  DI bool fast(int) const { return false; }
  DI float fconst(int) const { return 0.f; }
  DI void hook(int, const f32x16&, int) const {}
};
struct CtxSlcFar {
  float sc, bfar; unsigned long long ulo, uhi, mlo, mhi; const int* posmax; int pqmin, q0;
  DI bool farj(int j) const { return (j * 64 + 63 < q0) && (pqmin - posmax[j] >= 799); }
  DI bool inu(int j) const {
    unsigned long long a = (ulo >> (j & 63)) & (j < 64 ? 1ull : 0ull);
    unsigned long long b = (uhi >> (j & 63)) & (j >= 64 ? 1ull : 0ull);
    return (a | b) != 0ull;
  }
  DI bool mine(int j) const {
    unsigned long long a = (mlo >> (j & 63)) & (j < 64 ? 1ull : 0ull);
    unsigned long long b = (mhi >> (j & 63)) & (j >= 64 ? 1ull : 0ull);
    return (a | b) != 0ull;
  }
  DI int next(int t) const { for (int j = t + 1; j < 128; ++j) if (inu(j) && farj(j)) return j; return -1; }
  DI float aux(int) const { return 0.f; }
  DI bool skip(int t) const { return __builtin_amdgcn_ballot_w64(mine(t)) == 0ull; }
  DI float score(float s, int, float, int t) const { return mine(t) ? s * sc + bfar : NEG; }
  static constexpr int FMODE = 1;
  static constexpr bool ALWAYS_FAST = true;
  DI bool fast(int) const { return true; }
  DI float fconst(int t) const { return mine(t) ? bfar : NEG; }
  DI void hook(int, const f32x16&, int) const {}
};
struct CtxWin {
  int tq, posq, last; float sc; const float* lutr; const int* pos;
  DI int next(int t) const { return t + 1 <= last ? t + 1 : -1; }
  DI float aux(int key) const { return __int_as_float(pos[key]); }
  DI bool skip(int) const { return false; }
  DI float score(float s, int key, float ax, int) const {
    bool valid = key <= tq && (tq - key) < 512;
    int d = posq - __float_as_int(ax);
    d = d < 0 ? 0 : (d > 799 ? 799 : d);
    return valid ? s * sc + lutr[d] : NEG;
  }
  static constexpr int FMODE = 0;
  static constexpr bool ALWAYS_FAST = false;
  DI bool fast(int) const { return false; }
  DI float fconst(int) const { return 0.f; }
  DI void hook(int, const f32x16&, int) const {}
};

DI int cvt_next_count(const Params& p, int nl) {
      const bool ne = (nl & 1) == 0;
      const int nli = nl >> 1;
      return cvt_set_count(p, ne ? SET_IN_EVEN : SET_IN_ODD, nli) + cvt_set_count(p, SET_MEM, nl) +
             cvt_set_count(p, ne ? SET_MISC_EVEN : SET_MISC_ODD, nli) + (ne ? 16 : 32);
}
DI void cvt_next(const Params& p, char* smem, int nl, int t) {
  char* ws = p.ws;
      const bool ne = (nl & 1) == 0;
      const int nli = nl >> 1;
      const int s0 = ne ? SET_IN_EVEN : SET_IN_ODD, s2 = ne ? SET_MISC_EVEN : SET_MISC_ODD;
      const int c0 = cvt_set_count(p, s0, nli), c1 = cvt_set_count(p, SET_MEM, nl), c2 = cvt_set_count(p, s2, nli);
      if (t < c0) cvt_set_task(p, s0, nli, t, smem);
      else if (t < c0 + c1) cvt_set_task(p, SET_MEM, nl, t - c0, smem);
      else if (t < c0 + c1 + c2) cvt_set_task(p, s2, nli, t - c0 - c1, smem);
      else {
            const int tid = otid();
            int e = t - c0 - c1 - c2;
            if (ne) {
              float* S5P = (float*)(ws + WS_S5P);
              int gp = e * 256 + tid;
              int g = gp >> 6;
              float dt = expf(p.log_dt[nli * 64 + g]);
              float lr = p.lam_re[nli * 4096 + gp], lim = p.lam_im[nli * 4096 + gp];
              float mag = expf(lr * dt);
              float abr = mag * cosf(lim * dt), abi = mag * sinf(lim * dt);
              float den = lr * lr + lim * lim;
              float nr = abr - 1.f;
              float fre = (nr * lr + abi * lim) / den;
              float fim = (abi * lr - nr * lim) / den;
              S5P[gp] = abr;
              S5P[4096 + gp] = abi;
              float ar = abr, ai = abi;
#pragma unroll
              for (int q = 0; q < 7; ++q) { float nr2 = ar * ar - ai * ai; ai = 2.f * ar * ai; ar = nr2; }
              S5P[8192 + gp] = ar;
              S5P[12288 + gp] = ai;
              const float* br = p.b_re + (size_t)nli * 65536 + gp * 16;
              const float* bi = p.b_im + (size_t)nli * 65536 + gp * 16;
#pragma unroll
              for (int c = 0; c < 16; ++c) {
                S5P[16384 + gp * 16 + c] = fre * br[c] - fim * bi[c];
                S5P[16384 + 65536 + gp * 16 + c] = fre * bi[c] + fim * br[c];
              }
            } else {
              int which = e >> 4, part = e & 15;
              const float* pe = p.cmp_pe + (size_t)(nli * 2 + which) * 4096 + part * 256;
              const float* w1 = p.cmp_w1 + ((size_t)(nli * 2 + which) * 4096 + part * 256) * 256 + tid;
              float acc = 0.f;
#pragma unroll 8
              for (int k = 0; k < 256; ++k) acc += pe[k] * w1[(size_t)k * 256];
              ((float*)(ws + WS_CMPB))[(which * 16 + part) * 256 + tid] = acc;
            }
      }
}

#define XB_TMO      128
#define XB_XCNT(j)  (256  + 64 * (j))
#define XB_XSUB(j)  (1280 + 64 * (j))
#define XB_XGEN(j)  (2304 + 64 * (j))
#define XB_TOP      3328
#define XB_TOPGEN   3392
#define XCD_BAR_WORDS 3456
#define XB_SPIN_CAP (1u << 18)
#define LAS __attribute__((address_space(3)))

__device__ __forceinline__ unsigned xb_ld(unsigned* p)              { return __hip_atomic_load(p, __ATOMIC_RELAXED, __HIP_MEMORY_SCOPE_AGENT); }
__device__ __forceinline__ unsigned xb_add(unsigned* p, unsigned v) { return __hip_atomic_fetch_add(p, v, __ATOMIC_RELAXED, __HIP_MEMORY_SCOPE_AGENT); }
__device__ __forceinline__ unsigned xb_xcc_id() { return (unsigned)__builtin_amdgcn_s_getreg((3 << 11) | 20) & 0xFu; }
#define XB_SPIN(cond, bar) do { unsigned _sp = 0; while (cond) { __builtin_amdgcn_s_sleep(1); \
    if ((++_sp & 255u) == 0u) { if (xb_ld(&(bar)[XB_TMO])) break; if (_sp > XB_SPIN_CAP) { atomicAdd(&(bar)[XB_TMO], 1u); break; } } } } while (0)

struct XcdBarrier {
    unsigned* bar; unsigned x;
    volatile LAS unsigned* st;
};

__device__ __forceinline__ XcdBarrier xcd_barrier_post(unsigned* bar, volatile LAS unsigned* st) {
    XcdBarrier b; b.bar = bar; b.x = xb_xcc_id(); b.st = st;
    if (threadIdx.x == 0) (void)xb_add(&bar[XB_XCNT(b.x)], 1u);
    return b;
}
__device__ __forceinline__ void xcd_barrier_complete(unsigned* bar, unsigned x, unsigned& nloc, unsigned& nx) {
    const unsigned G = gridDim.x * gridDim.y * gridDim.z;
    unsigned sum, cnt, mine, sp = 0u;
    for (;;) {
        sum = 0u; cnt = 0u; mine = 0u;
#pragma unroll
        for (unsigned j = 0; j < 16; ++j) { const unsigned c = xb_ld(&bar[XB_XCNT(j)]); sum += c; cnt += (c > 0u) ? 1u : 0u; mine = (j == x) ? c : mine; }
        if (sum == G) break;
        __builtin_amdgcn_s_sleep(1);
        if ((++sp & 255u) == 0u) { if (xb_ld(&bar[XB_TMO])) break; if (sp > XB_SPIN_CAP) { atomicAdd(&bar[XB_TMO], 1u); break; } }
    }
    nloc = mine > 0u ? mine : 1u; nx = cnt > 0u ? cnt : 1u;
}

__device__ __forceinline__ void xcd_barrier(const XcdBarrier& b) {
    asm volatile("s_waitcnt vmcnt(0)" ::: "memory");
    __syncthreads();
    if (threadIdx.x == 0) {
        unsigned* bar = b.bar;
        __builtin_amdgcn_s_waitcnt(0);
        unsigned nloc = b.st[0], nx = b.st[1];
        if (nloc == 0u) { xcd_barrier_complete(bar, b.x, nloc, nx); b.st[0] = nloc; b.st[1] = nx; }
        const unsigned old = xb_add(&bar[XB_XSUB(b.x)], 1u);
        const unsigned gen = old / nloc;
        if (old + 1u == (gen + 1u) * nloc) {
            __builtin_amdgcn_fence(__ATOMIC_RELEASE, "agent");
            asm volatile("s_waitcnt vmcnt(0)" ::: "memory");
            const unsigned og = xb_add(&bar[XB_TOP], 1u);
            const unsigned tg = og / nx;
            if (og + 1u == (tg + 1u) * nx) xb_add(&bar[XB_TOPGEN], 1u);
            else XB_SPIN(xb_ld(&bar[XB_TOPGEN]) == tg, bar);
            __builtin_amdgcn_fence(__ATOMIC_ACQUIRE, "agent");
            xb_add(&bar[XB_XGEN(b.x)], 1u);
            asm volatile("s_waitcnt vmcnt(0)" ::: "memory");
        } else {
            XB_SPIN(xb_ld(&bar[XB_XGEN(b.x)]) == gen, bar);
            __builtin_amdgcn_fence(__ATOMIC_ACQUIRE, "agent");
            asm volatile("s_waitcnt vmcnt(0)" ::: "memory");
        }
    }
    __syncthreads();
}


__global__ void __launch_bounds__(256, LB2) mega(Params p, int ph_lo, int ph_hi) {
  __shared__ __attribute__((aligned(16))) char smem[SM_TOTAL];
  __shared__ int s_task;
  __shared__ uint4 xb_words;
  if (threadIdx.x == 0) xb_words = make_uint4(0u, 0u, 0u, 0u);
  __syncthreads();
  (void)xcd_barrier_post((unsigned*)(p.ws + WS_BAR), (volatile LAS unsigned*)&xb_words);
  const int bid = blockIdx.x, nb = gridDim.x;

  for (int ph = ph_lo; ph <= ph_hi; ++ph) {
    if (ph > ph_lo) {
      if (ph_hi > (1 << 20)) cg::this_grid().sync();
      else {
        XcdBarrier xb2;
        xb2.bar = (unsigned*)(((const Params*)__builtin_amdgcn_kernarg_segment_ptr())->ws + WS_BAR);
        xb2.x = xb_xcc_id();
        xb2.st = (volatile LAS unsigned*)&xb_words;
        xcd_barrier(xb2);
      }
    }
    const int nrep = (REP_PH >= 0 && ph == REP_PH) ? 2 : 1;
    for (int rep = 0; rep < nrep; ++rep) {
    if (rep) cg::this_grid().sync();
    const int tid = otid(), lane = tid & 63, w = tid >> 6, r = lane & 31, h = lane >> 5;
    const int vb = (bid & 7) * (nb >> 3) + (bid >> 3);
    int zoff_;
    asm volatile("s_mov_b32 %0, 0" : "=s"(zoff_));
    const Params& p = *(const Params*)((const char*)__builtin_amdgcn_kernarg_segment_ptr() + zoff_);
    char* ws = p.ws;
    char* const ws_ph = ws;
    bf16* XN = (bf16*)(ws + WS_XN);
    bf16* P = (bf16*)(ws + WS_P);
    bf16* MIXED = (bf16*)(ws + WS_MIXED);
    float* ROPEC = (float*)(ws + WS_ROPEC);
    float* ROPES = (float*)(ws + WS_ROPES);
    float* hbuf = p.out;
    int* CTR = (int*)(ws + WS_CTR);
    auto fetch_task = [&](int* ctr) {
      __syncthreads();
      if (tid == 0) s_task = atomicAdd(ctr, 1);
      __syncthreads();
      return s_task;
    };
    const int layer = ph == 0 ? 0 : (ph - 1) / 6;
    const int sub = ph == 0 ? -1 : (ph - 1) % 6;
    const bool even = (layer & 1) == 0;
    const int li = layer >> 1;
    const int NP = even ? NPE : NPO;

    if ((PHM & 1) && (ph == 0 || sub == 5)) {
      if (ph == 0) {
        if (bid == 0) { CTR[tid] = 0; CTR[256 + tid] = 0; }
        if (bid == 1 % nb && tid < 128) {
          int mx = p.pos[tid * 64];
          for (int q = 1; q < 64; ++q) mx = max(mx, p.pos[tid * 64 + q]);
          ((int*)(ws + WS_POSMAX))[tid] = mx;
        }
        for (int i = bid * 256 + tid; i < L * 32; i += nb * 256) {
          int t = i >> 5, f = i & 31;
          float inv = powf(10000.f, -(float)f / 32.f);
          float ang = (float)p.pos[t] * inv;
          ROPEC[i] = cosf(ang);
          ROPES[i] = sinf(ang);
        }
        for (int row = bid * 4 + w; row < 256; row += nb * 4)
          norm_row_bf16(p.mem + (size_t)row * DM, p.mem_norm_g, (bf16*)(ws + WS_MEMN) + (size_t)row * DM, lane);
      }
      const int nl = ph == 0 ? 0 : layer + 1;
      if (nl < 4) {
        const float* src = ph == 0 ? p.x : hbuf;
        const bool ownr = (nb & 7) == 0;
        for (int rr = ownr ? (bid >> 3) * 4 + w : bid * 4 + w; rr < (ownr ? L / 8 : L); rr += ownr ? (nb >> 3) * 4 : nb * 4) {
          const int row = ownr ? (bid & 7) * (L / 8) + rr : rr;
          norm_row_bf16(src + (size_t)row * DM, p.norm_g + nl * DM, XN + (size_t)row * LDX, lane);
        }
      } else {
        for (int row = bid * 4 + w; row < L; row += nb * 4) norm_row_f32(hbuf + (size_t)row * DM, p.final_norm_g, lane);
      }
    }
    if ((PHM & 4) && sub == 0) {
      const int ntn = (NP / 128 + 1) / 2;
      const int n_in = 64 * ntn;
      const bf16* Win = (const bf16*)(ws + WS_WIN);
      const bool own = (nb & 7) == 0;
      const int per_g = 8 * ntn, nloc = nb >> 3;
      const int u_end = own ? per_g + 2 : n_in + 16;
      for (int u = own ? (bid >> 3) : vb; u < u_end; u += own ? nloc : nb) {
        const int t = own ? (u < per_g ? (bid & 7) * per_g + u : n_in + (bid & 7) * 2 + (u - per_g)) : u;
        if (t < n_in) {
          int tm, tn;
          tile_map(t, ntn, tm, tn);
          const int m0 = tm * 128;
          int n0 = tn * 256;
          const int nhalf = (n0 + 128 < NP) ? 2 : 1;
          ALin af{XN + (size_t)m0 * LDX, LDX};
          if (even) {
            gemm_tile2(af, Win + (size_t)n0 * LDX, LDX, DM, smem, n0, nhalf, [&](const float* Cs) {
              if (n0 >= 4096 && n0 < 5120) {
                bf16* VT = (bf16*)(ws + WS_VTFOX);
                epi_cols(Cs, [&](int col, int r8, const float* v) {
                  *(uint4*)(VT + (size_t)(n0 - 4096 + col) * L + m0 + r8) = pack8(v);
                });
              } else if (n0 == 7168) {
                float* FL = (float*)(ws + WS_FLOG);
                for (int i = tid; i < 128 * 8; i += 256) {
                  int row = i >> 3, c = i & 7;
                  FL[(size_t)(m0 + row) * 8 + c] = Cs[row * 132 + c];
                }
              } else {
                epi_rows(Cs, [&](int row, int cc, const float* v) {
                  *(uint4*)(P + (size_t)(m0 + row) * NPE + n0 + cc) = pack8(v);
                });
              }
            });
          } else {
            gemm_tile2(af, Win + (size_t)n0 * LDX, LDX, DM, smem, n0, nhalf, [&](const float* Cs) {
              if (n0 == 3840 || n0 == 3968 || n0 == 4352 || n0 == 4480) {
                bf16* VT = (n0 < 4096) ? (bf16*)(ws + WS_VTSLC) + (size_t)(n0 - 3840) * L
                                       : (bf16*)(ws + WS_VTWIN) + (size_t)(n0 - 4352) * L;
                epi_cols(Cs, [&](int col, int r8, const float* v) {
                  *(uint4*)(VT + (size_t)col * L + m0 + r8) = pack8(v);
                });
              } else if (n0 == 6656) {
                epi_rope(Cs, 0, m0, ROPEC, ROPES, 1.f, [&](int row, int cl, const float* v) {
                  *(uint4*)(P + (size_t)(m0 + row) * NPO + 6656 + cl) = pack8(v);
                });
                float* GT = (float*)(ws + WS_FLOG);
                for (int i = tid; i < 128 * 24; i += 256) {
                  int row = i / 24, c = i % 24;
                  GT[(size_t)(m0 + row) * 24 + c] = Cs[row * 132 + 64 + c];
                }
              } else {
                epi_rows(Cs, [&](int row, int cc, const float* v) {
                  *(uint4*)(P + (size_t)(m0 + row) * NPO + n0 + cc) = pack8(v);
                });
              }
            });
          }
        } else {
          const int t2 = t - n_in;
          const int m0 = (t2 >> 3) * 128, n0 = (t2 & 7) * 128;
          ALin af{(const bf16*)(ws + WS_MEMN) + (size_t)m0 * DM, DM};
          gemm_tile(af, (const bf16*)(ws + WS_WMEM) + (size_t)n0 * DM, DM, DM, smem, [&](const float* Cs) {
            if (n0 < 512) {
              bf16* MK = (bf16*)(ws + WS_MEMK);
              epi_rows(Cs, [&](int row, int cc, const float* v) {
                *(uint4*)(MK + (size_t)(m0 + row) * 512 + n0 + cc) = pack8(v);
              });
            } else {
              bf16* MV = (bf16*)(ws + WS_MEMVT);
              epi_cols(Cs, [&](int col, int r8, const float* v) {
                *(uint4*)(MV + (size_t)(n0 - 512 + col) * 256 + m0 + r8) = pack8(v);
              });
            }
          });
        }
      }
    }

    if ((PHM & 4) && sub == 0) {
      const int cw = cvt_set_count(p, SET_OUT, layer), cw4 = (cw + 3) >> 2;
      for (;;) {
        const int t = fetch_task(CTR + 32 + ph);
        if (t >= cw4) break;
        for (int q = 0; q < 4; ++q) {
          const int ci = t * 4 + q;
          if (ci < cw) cvt_set_task(p, SET_OUT, layer, ci, smem);
        }
      }
    }
    auto mem_attn_task = [&](int t) {
      const int tid = otid(), lane = tid & 63, w = tid >> 6, r = lane & 31, h = lane >> 5;
      (void)tid;
      const int qt = t >> 2, head = t & 3;
      const int tq = qt * 128 + w * 32 + r;
      const int qcol = even ? 6144 : 5632, gcol = even ? 6656 : 6144;
      bf16x8 qf[8];
      load_q<128>(qf, P + (size_t)tq * NP + qcol + head * 128, h);
      f32x16 o[4];
      zero_o(o);
      float m = NEG, l = 0.f;
      CtxMem ctx{0.08838834764831845f * LOG2E};
      attn_run<128, true, true>(qf, o, m, l, (const bf16*)(ws + WS_MEMK) + head * 128, 512, nullptr, 0,
                          (const bf16*)(ws + WS_MEMVT) + (size_t)head * 128 * 256, 256, 0, ctx, smem);
      float lt = l + __shfl_xor(l, 32);
      store_out_A(o, 1.f / lt, P + (size_t)tq * NP + gcol + head * 128, MIXED + (size_t)tq * MIXW + 2048 + head * 128, h);
    };

    if ((PHM & 8) && sub == 1 && even) {
      const int cw = 0;
      const int n_s5 = 1024, n_cum = 64, n_mem = 256;
      for (int t = bid; t < n_mem + n_s5 + n_cum + cw; t += nb) {
        if (t < n_mem) {
          mem_attn_task(t);
        } else if (t < n_mem + n_s5) {
          const int t2 = t - n_mem;
          const int ch = t2 >> 4, gq = t2 & 15;
          float* us = (float*)smem;
          __syncthreads();
          for (int i = tid; i < 128 * 8; i += 256) {
            int tt = i >> 3, c8 = (i & 7) * 8;
            uint4 u = *(const uint4*)(P + (size_t)(ch * 128 + tt) * NPE + gq * 64 + c8);
            float* d = us + tt * 64 + c8;
            d[0] = bflo(u.x); d[1] = bfhi(u.x); d[2] = bflo(u.y); d[3] = bfhi(u.y);
            d[4] = bflo(u.z); d[5] = bfhi(u.z); d[6] = bflo(u.w); d[7] = bfhi(u.w);
          }
          __syncthreads();
          const float* S5P = (const float*)(ws + WS_S5P);
          const int gp = (gq * 4 + w) * 64 + lane;
          const float ar = S5P[gp], ai = S5P[4096 + gp];
          float bbr[16], bbi[16];
#pragma unroll
          for (int c = 0; c < 16; ++c) { bbr[c] = S5P[16384 + gp * 16 + c]; bbi[c] = S5P[16384 + 65536 + gp * 16 + c]; }
          float xr = 0.f, xi = 0.f;
          for (int tt = 0; tt < 128; ++tt) {
            const float* up = us + tt * 64 + w * 16;
            float bur = 0.f, bui = 0.f;
#pragma unroll
            for (int c = 0; c < 16; ++c) { float uv = up[c]; bur += bbr[c] * uv; bui += bbi[c] * uv; }
            float nxr = ar * xr - ai * xi + bur;
            float nxi = ar * xi + ai * xr + bui;
            xr = nxr; xi = nxi;
          }
          float2* E = (float2*)(ws + WS_S5E);
          E[(size_t)ch * 4096 + gp] = make_float2(xr, xi);
        } else if (t < n_mem + n_s5 + n_cum) {
          const int ch = t - n_mem - n_s5;
          const float* FL = (const float*)(ws + WS_FLOG);
          float* CUML = (float*)(ws + WS_CUML);
          float* CT = (float*)(ws + WS_CT);
#pragma unroll
          for (int hh = 0; hh < 2; ++hh) {
            const int head = w * 2 + hh;
            const float bf = p.fox_b_f[li * 8 + head];
            const int t0 = ch * 128 + lane * 2;
            float x0 = FL[(size_t)t0 * 8 + head] + bf, x1 = FL[(size_t)(t0 + 1) * 8 + head] + bf;
            float v0 = x0 >= 0.f ? -log1pf(expf(-x0)) : x0 - log1pf(expf(x0));
            float v1 = x1 >= 0.f ? -log1pf(expf(-x1)) : x1 - log1pf(expf(x1));
            float s = v0 + v1;
            float inc = s;
#pragma unroll
            for (int o = 1; o < 64; o <<= 1) {
              float n = __shfl_up(inc, o);
              if (lane >= o) inc += n;
            }
            float excl = inc - s;
            CUML[(size_t)head * L + t0] = excl + v0;
            CUML[(size_t)head * L + t0 + 1] = excl + v0 + v1;
            if (lane == 63) CT[head * 64 + ch] = inc;
          }
        } else {
          cvt_set_task(p, SET_OUT, layer, t - n_mem - n_s5 - n_cum, smem);
        }
      }
    }
    if ((PHM & 16) && sub == 2 && even) {
      const int n_fox = 512, n_s5 = 1024;
      for (int qd_ = 0; qd_ < 8; ++qd_) {
      const int xq_ = ((bid & 7) + qd_) & 7;
      for (;;) {
        const int i_ = fetch_task(CTR + 64 + ph * 8 + xq_);
        if (i_ >= 64 + 128) break;
        const int t = i_ < 64 ? i_ * 8 + xq_ : n_fox + (i_ - 64) * 8 + xq_;
        const int tid = otid(), lane = tid & 63, w = tid >> 6, r = lane & 31, h = lane >> 5;
        int zt_;
        asm volatile("s_mov_b32 %0, 0" : "=s"(zt_));
        char* const ws = ws_ph + zt_;
        if (t < n_fox) {
          const int qt = 63 - (t >> 3), head = t & 7;
          const int q0w = qt * 128 + w * 32, tq = q0w + r;
          float* cpre = (float*)(smem + AT_X0);
          __syncthreads();
          if (tid < 64) {
            const float v0 = ((const float*)(ws + WS_CT))[head * 64 + tid];
            float inc = v0;
#pragma unroll
            for (int of = 1; of < 64; of <<= 1) {
              float n = __shfl_up(inc, of);
              if (tid >= of) inc += n;
            }
            cpre[tid] = inc - v0;
          }
          __syncthreads();
          const float* cuml = (const float*)(ws + WS_CUML) + (size_t)head * L;
          bf16x8 qf[8];
          load_q<128>(qf, P + (size_t)tq * NPE + 2048 + head * 128, h);
          f32x16 o[4];
          zero_o(o);
          float m = NEG, l = 0.f;
          CtxFox ctx{tq, q0w, 2 * qt + 1, 0.08838834764831845f * LOG2E, cuml, cpre};
          attn_run<128, true, true>(qf, o, m, l, P + 3072 + head * 128, NPE, nullptr, 0,
                              (const bf16*)(ws + WS_VTFOX) + (size_t)head * 128 * L, L, 0, ctx, smem);
          float lt = l + __shfl_xor(l, 32);
          store_out_A(o, 1.f / lt, P + (size_t)tq * NPE + 5120 + head * 128, MIXED + (size_t)tq * MIXW + 1024 + head * 128, h);
        } else {
          const int t2 = t - n_fox;
          const int ch = t2 >> 4, gq = t2 & 15;
          float* us = (float*)smem;
          float* xs = (float*)(smem + 32768) + w * 16 * 132;
          __syncthreads();
          for (int i = tid; i < 128 * 8; i += 256) {
            int tt = i >> 3, c8 = (i & 7) * 8;
            uint4 u = *(const uint4*)(P + (size_t)(ch * 128 + tt) * NPE + gq * 64 + c8);
            float* d = us + tt * 64 + c8;
            d[0] = bflo(u.x); d[1] = bfhi(u.x); d[2] = bflo(u.y); d[3] = bfhi(u.y);
            d[4] = bflo(u.z); d[5] = bfhi(u.z); d[6] = bflo(u.w); d[7] = bfhi(u.w);
          }
          __syncthreads();
          const float* S5P = (const float*)(ws + WS_S5P);
          const int g = gq * 4 + w;
          const int gp = g * 64 + lane;
          const float ar = S5P[gp], ai = S5P[4096 + gp];
          const float atr = S5P[8192 + gp], ati = S5P[12288 + gp];
          float xr = 0.f, xi = 0.f;
          {
            const float2* E = (const float2*)(ws + WS_S5E) + gp;
#define CSTEP(e) { float nxr = atr * xr - ati * xi + e.x; float nxi = atr * xi + ati * xr + e.y; xr = nxr; xi = nxi; }
            int c = 0;
            for (; c + 8 <= ch; c += 8) {
              float2 e0 = E[(size_t)(c + 0) * 4096], e1 = E[(size_t)(c + 1) * 4096], e2 = E[(size_t)(c + 2) * 4096],
                     e3 = E[(size_t)(c + 3) * 4096], e4 = E[(size_t)(c + 4) * 4096], e5 = E[(size_t)(c + 5) * 4096],
                     e6 = E[(size_t)(c + 6) * 4096], e7 = E[(size_t)(c + 7) * 4096];
              CSTEP(e0) CSTEP(e1) CSTEP(e2) CSTEP(e3) CSTEP(e4) CSTEP(e5) CSTEP(e6) CSTEP(e7)
            }
            for (; c < ch; ++c) {
              float2 e = E[(size_t)c * 4096];
              CSTEP(e)
            }
#undef CSTEP
          }
          float bbr[16], bbi[16];
#pragma unroll
          for (int c = 0; c < 16; ++c) { bbr[c] = S5P[16384 + gp * 16 + c]; bbi[c] = S5P[16384 + 65536 + gp * 16 + c]; }
          const int chn = lane & 15, kq = lane >> 4;
          float cb[32];
          {
            const float* cre = p.c_re + ((size_t)li * 64 + g) * 1024 + chn * 64;
            const float* cim = p.c_im + ((size_t)li * 64 + g) * 1024 + chn * 64;
#pragma unroll
            for (int ks = 0; ks < 16; ++ks) { cb[ks] = cre[4 * ks + kq]; cb[16 + ks] = -cim[4 * ks + kq]; }
          }
          const float dsk = p.s5_d[li * 1024 + g * 16 + chn];
          bf16* Z = (bf16*)(ws + WS_Z);
          for (int sc = 0; sc < 8; ++sc) {
#pragma unroll 4
            for (int tt = 0; tt < 16; ++tt) {
              const float* up = us + (sc * 16 + tt) * 64 + w * 16;
              float bur = 0.f, bui = 0.f;
#pragma unroll
              for (int c = 0; c < 16; ++c) { float uv = up[c]; bur += bbr[c] * uv; bui += bbi[c] * uv; }
              float nxr = ar * xr - ai * xi + bur;
              float nxi = ar * xi + ai * xr + bui;
              xr = nxr; xi = nxi;
              xs[tt * 132 + lane] = xr;
              xs[tt * 132 + 64 + lane] = xi;
            }
            __syncthreads();
            f32x4 y = {0.f, 0.f, 0.f, 0.f};
#pragma unroll
            for (int ks = 0; ks < 32; ++ks) {
              float a = xs[chn * 132 + 4 * ks + kq];
              y = __builtin_amdgcn_mfma_f32_16x16x4f32(a, cb[ks], y, 0, 0, 0);
            }
#pragma unroll
            for (int i = 0; i < 4; ++i) {
              int tt = 4 * kq + i;
              float uv = us[(sc * 16 + tt) * 64 + w * 16 + chn];
              float yy = y[i] + dsk * uv;
              Z[(size_t)(ch * 128 + sc * 16 + tt) * LDZ + g * 16 + chn] = f2bf(gelu_t(yy));
            }
            __syncthreads();
          }
        }
      }
      }
    }
    if ((PHM & 32) && sub == 3 && even) {
      const bf16* Z = (const bf16*)(ws + WS_Z);
      for (int t = vb; t < 64 * 8; t += nb) {
        int tm, tn;
        tile_map(t, 8, tm, tn);
        const int m0 = tm * 128, n0 = tn * 128;
        ALin af{Z + (size_t)m0 * LDZ, LDZ};
        gemm_tile(af, (const bf16*)(ws + WS_WMISC + WM_GLU) + (size_t)n0 * LDZ, LDZ, 1024, smem, [&](const float* Cs) {
          epi_rows(Cs, [&](int row, int cc, const float* v) {
            uint4 zu = *(const uint4*)(Z + (size_t)(m0 + row) * LDZ + n0 + cc);
            uint4 gu = *(const uint4*)(P + (size_t)(m0 + row) * NPE + 1024 + n0 + cc);
            float zz[8] = {bflo(zu.x), bfhi(zu.x), bflo(zu.y), bfhi(zu.y), bflo(zu.z), bfhi(zu.z), bflo(zu.w), bfhi(zu.w)};
            float gg[8] = {bflo(gu.x), bfhi(gu.x), bflo(gu.y), bfhi(gu.y), bflo(gu.z), bfhi(gu.z), bflo(gu.w), bfhi(gu.w)};
            float o[8];
#pragma unroll
            for (int e = 0; e < 8; ++e) o[e] = zz[e] * sigm(v[e]) * silu(gg[e]);
            *(uint4*)(MIXED + (size_t)(m0 + row) * MIXW + n0 + cc) = pack8(o);
          });
        });
      }
    }
    if ((PHM & 64) && sub == 1 && !even) {
      const int cw = 0;
      const int n_c1 = 32, n_q = 64 * 12, n_kv = 64 * 16, n_mem = 256;
      float* rsx = (float*)(smem + SM_EXTRA);
      const bool split = (nb % 8 == 0) && nb >= 64;
      int t0, tstride;
      if (!split) { t0 = bid; tstride = nb; }
      else if (bid < n_c1) { t0 = bid; tstride = 1 << 28; }
      else { t0 = n_c1 + (bid & 7) * ((nb - n_c1) >> 3) + ((bid >> 3) - (n_c1 >> 3)); tstride = nb - n_c1; }
      for (int t = t0; t < n_c1 + n_q + n_kv + n_mem + cw; t += tstride) {
        if (t < n_c1) {
          const int which = t >> 4, tm = (t >> 1) & 7, tn = t & 1;
          const int m0 = tm * 128, n0 = tn * 128;
          __syncthreads();
          if (tid < 128) {
            const float* CB = (const float*)(ws + WS_CMPB) + which * 16 * 256 + n0 + tid;
            float b = 0.f;
            for (int q = 0; q < 16; ++q) b += CB[q * 256];
            rsx[tid] = b;
          }
          ACmp af{P + (which ? 3328 : 3072), m0};
          bf16* HID = (bf16*)(ws + WS_HID) + (size_t)which * 1024 * 256;
          gemm_tile(af, (const bf16*)(ws + WS_WMISC + WM_W1) + (size_t)which * 256 * 4096 + (size_t)n0 * 4096, 4096, 4096,
                    smem, [&](const float* Cs) {
                      epi_rows(Cs, [&](int row, int cc, const float* v) {
                        float o[8];
#pragma unroll
                        for (int e = 0; e < 8; ++e) o[e] = gelu_t(v[e] + rsx[cc + e]);
                        *(uint4*)(HID + (size_t)(m0 + row) * 256 + n0 + cc) = pack8(o);
                      });
                    });
        } else if (t < n_c1 + n_q + n_kv) {
          const int t2 = t - n_c1;
          const bool isq = t2 < n_q;
          const int t3 = isq ? t2 : t2 - n_q;
          const int ntn = isq ? 12 : 16;
          int tm, tn;
          tile_map(t3, ntn, tm, tn);
          const int m0 = tm * 128, n0 = tn * 128;
          const bf16* Ab = P + (size_t)m0 * NPO + (isq ? 0 : 512);
          __syncthreads();
          for (int r8 = 0; r8 < 4; ++r8) {
            float ssq[8];
#pragma unroll
            for (int q = 0; q < 8; ++q) {
              int row = w * 32 + r8 * 8 + q;
              uint4 u = *(const uint4*)(Ab + (size_t)row * NPO + lane * 8);
              float a0 = bflo(u.x), a1 = bfhi(u.x), a2 = bflo(u.y), a3 = bfhi(u.y), a4 = bflo(u.z), a5 = bfhi(u.z),
                    a6 = bflo(u.w), a7 = bfhi(u.w);
              ssq[q] = a0 * a0 + a1 * a1 + a2 * a2 + a3 * a3 + a4 * a4 + a5 * a5 + a6 * a6 + a7 * a7;
            }
#pragma unroll
            for (int q = 0; q < 8; ++q) {
              float ss = wave_sum(ssq[q]);
              if (lane == 0) rsx[w * 32 + r8 * 8 + q] = rsqrtf(ss * (1.f / 512.f) + EPS);
            }
          }
          ALin af{Ab, NPO};
          if (isq) {
            bf16* QM = (bf16*)(ws + WS_QMLA);
            gemm_tile(af, (const bf16*)(ws + WS_WMISC + WM_UQ) + (size_t)n0 * 512, 512, 512, smem, [&](const float* Cs) {
              const int md = n0 % 192;
              const int ropehalf = md == 128 ? 0 : (md == 64 ? 1 : -1);
              epi_rows(Cs, [&](int row, int cc, const float* v) {
                if ((cc >> 6) == ropehalf) return;
                float o[8];
                float sc = rsx[row];
#pragma unroll
                for (int e = 0; e < 8; ++e) o[e] = v[e] * sc;
                *(uint4*)(QM + (size_t)(m0 + row) * 1536 + n0 + cc) = pack8(o);
              });
              if (ropehalf >= 0) {
                epi_rope(Cs, ropehalf * 64, m0, ROPEC, ROPES, 1.f, [&](int row, int cl, const float* v) {
                  float o[8];
                  float sc = rsx[row];
#pragma unroll
                  for (int e = 0; e < 8; ++e) o[e] = v[e] * sc;
                  *(uint4*)(QM + (size_t)(m0 + row) * 1536 + n0 + ropehalf * 64 + cl) = pack8(o);
                });
              }
            });
          } else {
            gemm_tile(af, (const bf16*)(ws + WS_WMISC + WM_UKV) + (size_t)n0 * 512, 512, 512, smem, [&](const float* Cs) {
              const int head = n0 >> 8, part = (n0 >> 7) & 1;
              if (part == 0) {
                bf16* KM = (bf16*)(ws + WS_KMLA);
                epi_rows(Cs, [&](int row, int cc, const float* v) {
                  float o[8];
                  float sc = rsx[row];
#pragma unroll
                  for (int e = 0; e < 8; ++e) o[e] = v[e] * sc;
                  *(uint4*)(KM + (size_t)(m0 + row) * 1024 + head * 128 + cc) = pack8(o);
                });
              } else {
                bf16* VT = (bf16*)(ws + WS_VTMLA);
                epi_cols(Cs, [&](int col, int r8, const float* v) {
                  float o[8];
#pragma unroll
                  for (int e = 0; e < 8; ++e) o[e] = v[e] * rsx[r8 + e];
                  *(uint4*)(VT + (size_t)(head * 128 + col) * L + m0 + r8) = pack8(o);
                });
              }
            });
          }
        } else if (t < n_c1 + n_q + n_kv + n_mem) {
          mem_attn_task(t - n_c1 - n_q - n_kv);
        } else {
          cvt_set_task(p, SET_OUT, layer, t - n_c1 - n_q - n_kv - n_mem, smem);
        }
      }
    }
    if ((PHM & 128) && sub == 2 && !even) {
      const int n_c2 = 16, n_mem2 = 0;
      for (int t = bid; t < n_c2 + n_mem2; t += nb) {
        if (t >= n_c2) {
          mem_attn_task(t - n_c2);
        } else {
          const int t2 = t;
          const int which = t2 >> 3, m0 = (t2 & 7) * 128;
          ALin af{(const bf16*)(ws + WS_HID) + (size_t)which * 1024 * 256 + (size_t)m0 * 256, 256};
          gemm_tile(af, (const bf16*)(ws + WS_WMISC + WM_W2) + (size_t)which * 128 * 256, 256, 256, smem, [&](const float* Cs) {
            if (which == 0) {
              bf16* KC = (bf16*)(ws + WS_KC);
              epi_rows(Cs, [&](int row, int cc, const float* v) {
                int gr = m0 + row;
                int n = gr >> 1, g = gr & 1;
                *(uint4*)(KC + ((size_t)g * 512 + n) * 128 + cc) = pack8(v);
              });
            } else {
              bf16* VC = (bf16*)(ws + WS_VCT);
              for (int i = tid; i < 128 * 128; i += 256) {
                int row = i & 127, col = i >> 7;
                int gr = m0 + row;
                int n = gr >> 1, g = gr & 1;
                VC[((size_t)g * 128 + col) * 512 + n] = f2bf(Cs[row * 132 + col]);
              }
            }
          });
        }
      }
    }
    if ((PHM & 256) && sub == 3 && !even) {
      const int* pos = p.pos;
      float* lut = (float*)(smem + AT_X0);
      float* imp = (float*)(smem + AT_IMP);
      unsigned* sel = (unsigned*)(smem + AT_SEL);
      const float* GT = (const float*)(ws + WS_FLOG);
      float* NSAO = (float*)(ws + WS_NSAO);
      for (int qd_ = 0; qd_ < 8; ++qd_) {
      const int xq_ = ((bid & 7) + qd_) & 7;
      for (;;) {
        const int i_ = fetch_task(CTR + 64 + ph * 8 + xq_);
        if (i_ >= 128) break;
        const int tt_ = 2 * ((i_ >> 1) * 8 + xq_) + (i_ & 1);
        const int t = tt_ >> 1;
        const int tid = otid(), lane = tid & 63, w = tid >> 6, r = lane & 31, h = lane >> 5;
        int zt_;
        asm volatile("s_mov_b32 %0, 0" : "=s"(zt_));
        char* const ws = ws_ph + zt_;
        if ((tt_ & 1) == 0) {
          const int qt = 63 - (t >> 3), head = t & 7;
          const int q0w = qt * 128 + w * 32, tq = q0w + r;
          bf16x8 qf[12];
          load_q<192>(qf, (const bf16*)(ws + WS_QMLA) + (size_t)tq * 1536 + head * 192, h);
          f32x16 o[4];
          zero_o(o);
          float m = NEG, l = 0.f;
          CtxCausal ctx{tq, q0w, 2 * qt + 1, 0.07216878364870322f * LOG2E};
          attn_run<192, true, true>(qf, o, m, l, (const bf16*)(ws + WS_KMLA) + head * 128, 1024, P + 6656, NPO,
                              (const bf16*)(ws + WS_VTMLA) + (size_t)head * 128 * L, L, 0, ctx, smem);
          float lt = l + __shfl_xor(l, 32);
          store_out_A(o, 1.f / lt, P + (size_t)tq * NPO + 1024 + head * 128, MIXED + (size_t)tq * MIXW + head * 128, h);
          continue;
        }
        const int qt = 255 - (t >> 1), g = t & 1;
        const int q0 = qt * 32;
        const int hr = r >> 3, qi = r & 7;
        const int ql = w * 8 + qi;
        const int tq = q0 + ql;
        const int head = g * 4 + hr;
        const int posq = pos[tq];
        __syncthreads();
        for (int i = tid; i < 4 * 800; i += 256) {
          int rr = i / 800, n = i % 800;
          int b;
          if (n < 16) b = n;
          else {
            float lr = logf((float)n / 16.f) / 4.1588830833596715f;
            b = 16 + (int)(lr * 16.f);
            if (b > 31) b = 31;
          }
          lut[i] = p.t5[b * 8 + g * 4 + rr] * LOG2E;
        }
        for (int i = tid; i < 32 * 132; i += 256) imp[i] = 0.f;
        __syncthreads();
        const float* lutr = lut + hr * 800;
        bf16x8 qf[8];
        load_q<128>(qf, P + (size_t)tq * NPO + 2048 + head * 128, h);
        const float sc = 0.08838834764831845f * LOG2E;
        f32x16 o[4];
        float* orow = NSAO + (size_t)tq * 1024 + head * 128;

        const int ncv = min(q0 / 16 + 1, 511);
        const int last_c = (ncv - 1) >> 6;
        float m = NEG, l = 0.f;
        CtxCmp cc{tq, posq, last_c, sc, lutr, pos, 0.f, imp, ql, false};
        zero_o(o);
        const bf16* KCg = (const bf16*)(ws + WS_KC) + (size_t)g * 512 * 128;
        const bf16* VCg = (const bf16*)(ws + WS_VCT) + (size_t)g * 128 * 512;
        attn_run<128, false, false>(qf, o, m, l, KCg, 128, nullptr, 0, VCg, 512, 0, cc, smem);
        float lt = l + __shfl_xor(l, 32);
        const bool has_c = m > -1e29f;
        float m2 = has_c ? m : 0.f;
        float invl = has_c ? 1.f / lt : 0.f;
        cc.invl = invl; cc.p2 = true;
        float l2 = 0.f;
        attn_run<128, true, false>(qf, o, m2, l2, KCg, 128, nullptr, 0, VCg, 512, 0, cc, smem);
        {
          float gs = sigm(GT[(size_t)tq * 24 + head * 3 + 0]) * invl;
#pragma unroll
          for (int d = 0; d < 4; ++d)
#pragma unroll
            for (int i4 = 0; i4 < 4; ++i4) {
              int dv0 = d * 32 + 8 * i4 + 4 * h;
              float4 v = make_float4(o[d][4 * i4] * gs, o[d][4 * i4 + 1] * gs, o[d][4 * i4 + 2] * gs, o[d][4 * i4 + 3] * gs);
              *(float4*)(orow + dv0) = v;
            }
        }
        __syncthreads();
        for (int q8 = 0; q8 < 8; ++q8) {
          const int qq = w * 8 + q8;
          const int tt = q0 + qq;
          const int cur = tt >> 6;
          const float* ip = imp + qq * 132;
          const int j0 = lane, j1 = lane + 64;
          const bool v0 = j0 <= cur, v1 = j1 <= cur;
          const bool f0 = (j0 == 0) || (j0 == cur) || (j0 == cur - 1);
          const bool f1 = (j1 == cur) || (j1 == cur - 1);
          const int nforced = cur == 0 ? 1 : (cur == 1 ? 2 : 3);
          const int nfree = 16 - nforced;
          const bool c0 = v0 && !f0, c1 = v1 && !f1;
          const unsigned u0 = __float_as_uint(ip[j0]), u1 = __float_as_uint(ip[j1]);
          const int ncand = __popcll(__ballot(c0)) + __popcll(__ballot(c1));
          bool s0, s1;
          if (ncand <= nfree) {
            s0 = v0; s1 = v1;
          } else {
            unsigned T = 0u;
            for (int bit = 30; bit >= 0; --bit) {
              const unsigned cth = T | (1u << bit);
              const int cnt = __popcll(__ballot(c0 && u0 >= cth)) + __popcll(__ballot(c1 && u1 >= cth));
              if (cnt >= nfree) T = cth;
            }
            const bool g0 = c0 && u0 > T, g1 = c1 && u1 > T;
            const bool e0 = c0 && u0 == T, e1 = c1 && u1 == T;
            const unsigned long long me0 = __ballot(e0), me1 = __ballot(e1);
            const int need0 = nfree - (__popcll(__ballot(g0)) + __popcll(__ballot(g1)));
            const int need1 = need0 - __popcll(me0);
            const int rk0 = __builtin_amdgcn_mbcnt_hi((unsigned)(me0 >> 32), __builtin_amdgcn_mbcnt_lo((unsigned)me0, 0u));
            const int rk1 = __builtin_amdgcn_mbcnt_hi((unsigned)(me1 >> 32), __builtin_amdgcn_mbcnt_lo((unsigned)me1, 0u));
            s0 = (v0 && f0) || g0 || (e0 && rk0 < need0);
            s1 = (v1 && f1) || g1 || (e1 && rk1 < need1);
          }
          unsigned long long b0 = __ballot(s0), b1 = __ballot(s1);
          if (lane == 0) {
            sel[qq * 4 + 0] = (unsigned)b0; sel[qq * 4 + 1] = (unsigned)(b0 >> 32);
            sel[qq * 4 + 2] = (unsigned)b1; sel[qq * 4 + 3] = (unsigned)(b1 >> 32);
          }
        }
        __syncthreads();
        unsigned un0, un1, un2, un3;
        {
          un0 = sel[r * 4 + 0]; un1 = sel[r * 4 + 1]; un2 = sel[r * 4 + 2]; un3 = sel[r * 4 + 3];
#pragma unroll
          for (int of = 1; of < 32; of <<= 1) {
            un0 |= __shfl_xor(un0, of); un1 |= __shfl_xor(un1, of); un2 |= __shfl_xor(un2, of); un3 |= __shfl_xor(un3, of);
          }
          un0 = __builtin_amdgcn_readfirstlane(un0); un1 = __builtin_amdgcn_readfirstlane(un1);
          un2 = __builtin_amdgcn_readfirstlane(un2); un3 = __builtin_amdgcn_readfirstlane(un3);
        }
        {
          const unsigned long long ulo = (unsigned long long)un0 | ((unsigned long long)un1 << 32);
          const unsigned long long uhi = (unsigned long long)un2 | ((unsigned long long)un3 << 32);
          const unsigned long long mlo = (unsigned long long)sel[ql * 4] | ((unsigned long long)sel[ql * 4 + 1] << 32);
          const unsigned long long mhi = (unsigned long long)sel[ql * 4 + 2] | ((unsigned long long)sel[ql * 4 + 3] << 32);
          int pqmin = pos[q0];
          for (int q = 1; q < 32; ++q) pqmin = min(pqmin, pos[q0 + q]);
          const int* posmax = (const int*)(ws + WS_POSMAX);
          zero_o(o);
          m = NEG; l = 0.f;
          {
            CtxSlc cs{tq, posq, sc, lutr, pos, ulo, uhi, mlo, mhi, posmax, pqmin, q0};
            attn_run<128, true, false>(qf, o, m, l, P + 3584 + g * 128, NPO, nullptr, 0,
                                       (const bf16*)(ws + WS_VTSLC) + (size_t)g * 128 * L, L, cs.next(-1), cs, smem);
          }
          {
            CtxSlcFar cf{sc, lutr[799], ulo, uhi, mlo, mhi, posmax, pqmin, q0};
            attn_run<128, true, false>(qf, o, m, l, P + 3584 + g * 128, NPO, nullptr, 0,
                                       (const bf16*)(ws + WS_VTSLC) + (size_t)g * 128 * L, L, cf.next(-1), cf, smem);
          }
          lt = l + __shfl_xor(l, 32);
          float gs = sigm(GT[(size_t)tq * 24 + head * 3 + 1]) / lt;
#pragma unroll
          for (int d = 0; d < 4; ++d)
#pragma unroll
            for (int i4 = 0; i4 < 4; ++i4) {
              int dv0 = d * 32 + 8 * i4 + 4 * h;
              float4 v = *(float4*)(orow + dv0);
              v.x += o[d][4 * i4] * gs; v.y += o[d][4 * i4 + 1] * gs; v.z += o[d][4 * i4 + 2] * gs; v.w += o[d][4 * i4 + 3] * gs;
              *(float4*)(orow + dv0) = v;
            }
        }
        {
          const int kfirst = q0 - 511 > 0 ? (q0 - 511) >> 6 : 0;
          CtxWin cwn{tq, posq, (q0 + 31) >> 6, sc, lutr, pos};
          zero_o(o);
          m = NEG; l = 0.f;
          attn_run<128, true, false>(qf, o, m, l, P + 4096 + g * 128, NPO, nullptr, 0,
                              (const bf16*)(ws + WS_VTWIN) + (size_t)g * 128 * L, L, kfirst, cwn, smem);
          lt = l + __shfl_xor(l, 32);
          float gs = sigm(GT[(size_t)tq * 24 + head * 3 + 2]) / lt;
          const bf16* grow = P + (size_t)tq * NPO + 4608 + head * 128;
          bf16* mrow = MIXED + (size_t)tq * MIXW + 1024 + head * 128;
#pragma unroll
          for (int d = 0; d < 4; ++d)
#pragma unroll
            for (int i4 = 0; i4 < 4; ++i4) {
              int dv0 = d * 32 + 8 * i4 + 4 * h;
              float4 v = *(float4*)(orow + dv0);
              v.x += o[d][4 * i4] * gs; v.y += o[d][4 * i4 + 1] * gs; v.z += o[d][4 * i4 + 2] * gs; v.w += o[d][4 * i4 + 3] * gs;
              uint2 gu = *(const uint2*)(grow + dv0);
              uint2 ou;
              ou.x = pack2(v.x * silu(bflo(gu.x)), v.y * silu(bfhi(gu.x)));
              ou.y = pack2(v.z * silu(bflo(gu.y)), v.w * silu(bfhi(gu.y)));
              *(uint2*)(mrow + dv0) = ou;
            }
        }
      }
      }
    }
    if ((PHM & 2) && (ph == 0 || (sub == 2 && even) || (sub == 3 && !even))) {
      const int nl = ph == 0 ? 0 : layer + 1;
      if (nl < 4) {
        const int n_cv = cvt_next_count(p, nl), n_cv4 = (n_cv + 3) >> 2;
        const bool dyn = ph != 0;
        int t = dyn ? fetch_task(CTR + 32 + ph) : bid;
        while (t < n_cv4) {
          for (int q = 0; q < 4; ++q) {
            const int ci = t * 4 + q;
            if (ci < n_cv) cvt_next(p, smem, nl, ci);
          }
          t = dyn ? fetch_task(CTR + 32 + ph) : t + nb;
        }
      }
    }
    if ((PHM & 512) && sub == 4) {
      const float* hin = layer == 0 ? p.x : hbuf;
      for (int t = vb; t < 64 * 8; t += nb) {
        int tm, tn;
        tile_map(t, 8, tm, tn);
        const int m0 = tm * 128;
        int n0 = tn * 256;
        ALin af{MIXED + (size_t)m0 * MIXW, MIXW};
        gemm_tile2(af, (const bf16*)(ws + WS_WOUT) + (size_t)n0 * MIXW, MIXW, MIXW, smem, n0, 2, [&](const float* Cs) {
          const int tid2 = otid();
#pragma unroll
          for (int j = 0; j < 16; ++j) {
            int c = tid2 + 256 * j;
            int row = c >> 5, cc = (c & 31) * 4;
            float4 a = *(const float4*)(Cs + row * 132 + cc);
            float4 hv = *(const float4*)(hin + (size_t)(m0 + row) * DM + n0 + cc);
            hv.x += a.x; hv.y += a.y; hv.z += a.z; hv.w += a.w;
            *(float4*)(hbuf + (size_t)(m0 + row) * DM + n0 + cc) = hv;
          }
        });
      }
    }
    }
  }
}

extern "C" void kernel_launch(void* const* d_in, const int* in_sizes, int n_in, void* d_out, int out_size, void* d_ws,
                              size_t ws_size, hipStream_t stream) {
  Params p{};
  p.x = (const float*)d_in[0]; p.mem = (const float*)d_in[1]; p.pos = (const int*)d_in[2];
  p.norm_g = (const float*)d_in[3]; p.mem_norm_g = (const float*)d_in[4]; p.final_norm_g = (const float*)d_in[5];
  p.t5 = (const float*)d_in[6]; p.w_out = (const float*)d_in[7]; p.mem_w_kv = (const float*)d_in[8];
  p.even_w_in = (const float*)d_in[9]; p.lam_re = (const float*)d_in[10]; p.lam_im = (const float*)d_in[11];
  p.log_dt = (const float*)d_in[12]; p.b_re = (const float*)d_in[13]; p.b_im = (const float*)d_in[14];
  p.c_re = (const float*)d_in[15]; p.c_im = (const float*)d_in[16]; p.s5_d = (const float*)d_in[17];
  p.w_glu = (const float*)d_in[18]; p.fox_b_f = (const float*)d_in[19]; p.odd_w_in = (const float*)d_in[20];
  p.g_cq = (const float*)d_in[21]; p.g_ckv = (const float*)d_in[22]; p.w_uq = (const float*)d_in[23];
  p.w_ukv = (const float*)d_in[24]; p.cmp_pe = (const float*)d_in[25]; p.cmp_w1 = (const float*)d_in[26];
  p.cmp_w2 = (const float*)d_in[27];
  p.out = (float*)d_out; p.ws = (char*)d_ws;
  if (ws_size < WS_END) fprintf(stderr, "workspace too small: %zu < %zu\n", ws_size, (size_t)WS_END);
  static int grid_blocks = 0;
  if (!grid_blocks) {
    int dev = 0, cus = 0, per_cu = 0;
    hipGetDevice(&dev);
    hipDeviceGetAttribute(&cus, hipDeviceAttributeMultiprocessorCount, dev);
    hipOccupancyMaxActiveBlocksPerMultiprocessor(&per_cu, mega, 256, 0);
    if (per_cu > 2) per_cu = 2;
    if (per_cu < 1) per_cu = 1;
    grid_blocks = cus * per_cu;
  }
  (void)hipMemsetAsync((char*)d_ws + WS_BAR, 0, XCD_BAR_WORDS * sizeof(unsigned), stream);
#if MULTI_LAUNCH
  for (int ph = 0; ph <= 24; ++ph) {
    int lo = ph, hi = ph;
    void* args[] = {&p, &lo, &hi};
    hipLaunchCooperativeKernel((void*)mega, dim3(grid_blocks), dim3(256), args, 0, stream);
  }
#else
  int lo = 0, hi = 24;
  void* args[] = {&p, &lo, &hi};
  hipError_t e = hipLaunchCooperativeKernel((void*)mega, dim3(grid_blocks), dim3(256), args, 0, stream);
  if (e != hipSuccess) fprintf(stderr, "cooperative launch failed: %s (grid %d)\n", hipGetErrorString(e), grid_blocks);
#endif
}
```
